# Optimizing an MI355X kernel written in HIP

```python
import math
import jax, jax.numpy as jnp
from jax import lax
import numpy as np

D_MODEL = 1024
BATCH = 4
SEQ = 8192
DEPTH = 4

CTX_LEN = 256
GRID_W = 64
HEAD_DIM = 64
ATTN_SCALE = HEAD_DIM ** -0.5
ROPE_THETA = 10000.0
NEG_INF = -1e30
Q_BLOCK = 128

NA_HEADS = 8
NA_KH = 8
NA_KW = 16
SWA_Q_HEADS = 8
SWA_KV_HEADS = 2
SWA_WINDOW = 128
GA_Q_HEADS = 8
GA_KV_HEADS = 2
SSM_HEADS = 8
SSM_HEAD_DIM = 64
SSM_INNER = SSM_HEADS * SSM_HEAD_DIM
SSM_GROUPS = 2
SSM_STATE = 128
SSM_CONV = 5
SSM_CONV_CH = SSM_INNER + 2 * SSM_GROUPS * SSM_STATE
SSM_CHUNK = 128
N_BRANCH = 4
BRANCH_W = 512
D_FF = 2816
N_EXPERTS = 8
TOP_K = 2
D_FF_EXPERT = 3584
MOE_BLOCK = 512
ALPHA = (2 * DEPTH) ** 0.25
BETA = (8 * DEPTH) ** -0.25
LN_EPS = 1e-5
RMS_EPS = 1e-6

IN_SPLITS = (
    NA_HEADS * HEAD_DIM, NA_HEADS * HEAD_DIM, NA_HEADS * HEAD_DIM,
    SWA_Q_HEADS * HEAD_DIM, SWA_KV_HEADS * HEAD_DIM, SWA_KV_HEADS * HEAD_DIM,
    GA_Q_HEADS * HEAD_DIM, GA_KV_HEADS * HEAD_DIM, GA_KV_HEADS * HEAD_DIM,
    SSM_INNER, SSM_CONV_CH, 2 * SSM_HEADS,
)
D_IN = sum(IN_SPLITS)

kernel_name = 'hybrid_gated_na_swa_ga_ssd_moe_dit'


def layer_norm(x, g, b):
    xf = x.astype(jnp.float32)
    mu = jnp.mean(xf, -1, keepdims=True)
    var = jnp.mean(jnp.square(xf - mu), -1, keepdims=True)
    y = (xf - mu) * lax.rsqrt(var + LN_EPS) * g.astype(jnp.float32) + b.astype(jnp.float32)
    return y.astype(x.dtype)


def rms_norm(x, g):
    xf = x.astype(jnp.float32)
    y = xf * lax.rsqrt(jnp.mean(jnp.square(xf), -1, keepdims=True) + RMS_EPS) * g.astype(jnp.float32)
    return y.astype(x.dtype)


def heads(t):
    return t.reshape(t.shape[0], t.shape[1], -1, HEAD_DIM)


def group(t, n_kv):
    return t.reshape(t.shape[0], t.shape[1], n_kv, -1, HEAD_DIM)


def split_cols(p):
    return jnp.split(p, np.cumsum(IN_SPLITS)[:-1].tolist(), axis=-1)


def axial_rope_tables(n_tok):
    t = jnp.arange(n_tok, dtype=jnp.int32)
    row = (t // GRID_W).astype(jnp.float32)
    col = (t % GRID_W).astype(jnp.float32)
    n_freq = HEAD_DIM // 4
    inv_freq = ROPE_THETA ** (-jnp.arange(n_freq, dtype=jnp.float32) / n_freq)
    ang = jnp.concatenate([row[:, None] * inv_freq, col[:, None] * inv_freq], axis=-1)
    return jnp.cos(ang), jnp.sin(ang)


def apply_rope(x, cos, sin):
    half = HEAD_DIM // 2
    x1, x2 = x[..., :half], x[..., half:]
    cs = cos[:, None, :].astype(x.dtype)
    sn = sin[:, None, :].astype(x.dtype)
    return jnp.concatenate([x1 * cs - x2 * sn, x2 * cs + x1 * sn], axis=-1)


def attend(q, k, v, mask=None, sink=None):
    s = jnp.einsum('bqkgd,bjkd->bkgqj', q, k).astype(jnp.float32) * ATTN_SCALE
    if mask is not None:
        s = jnp.where(mask, s, NEG_INF)
    if sink is not None:
        s_sink = jnp.broadcast_to(sink.astype(jnp.float32)[None, :, :, None, None], s.shape[:-1] + (1,))
        s = jnp.concatenate([s, s_sink], axis=-1)
    p = jax.nn.softmax(s, axis=-1)
    if sink is not None:
        p = p[..., :-1]
    return jnp.einsum('bkgqj,bjkd->bqkgd', p.astype(v.dtype), v)


def neighbourhood_attention(q, k, v, qc, kc, vc, rpb, with_ctx):
    bsz, n_tok, n_h, dh = q.shape
    rows = n_tok // GRID_W
    kh = min(NA_KH, rows)
    qg = q.reshape(bsz, rows, GRID_W, n_h, dh)
    kg = k.reshape(bsz, rows, GRID_W, n_h, dh)
    vg = v.reshape(bsz, rows, GRID_W, n_h, dh)
    r_idx = jnp.arange(rows, dtype=jnp.int32)
    row_start = jnp.clip(r_idx - kh // 2, 0, rows - kh)
    c_idx = jnp.arange(GRID_W, dtype=jnp.int32)
    col_start = jnp.clip(c_idx - NA_KW // 2, 0, GRID_W - NA_KW)
    col_idx = col_start[:, None] + jnp.arange(NA_KW, dtype=jnp.int32)
    dc = col_idx - c_idx[:, None] + NA_KW - 1
    n_loc = kh * NA_KW

    def row_fn(args):
        r, start, q_row = args
        kb = lax.dynamic_slice_in_dim(kg, start, kh, axis=1)[:, :, col_idx]
        vb = lax.dynamic_slice_in_dim(vg, start, kh, axis=1)[:, :, col_idx]
        dr = start + jnp.arange(kh, dtype=jnp.int32) - r + NA_KH - 1
        bias = rpb[:, dr][:, :, dc].transpose(0, 2, 1, 3).astype(jnp.float32)
        s_loc = jnp.einsum('bqhd,bkqwhd->bhqkw', q_row, kb).astype(jnp.float32) * ATTN_SCALE + bias[None]
        s_ctx = jnp.einsum('bqhd,bjhd->bhqj', q_row, kc).astype(jnp.float32) * ATTN_SCALE
        s = jnp.concatenate([s_loc.reshape(bsz, n_h, GRID_W, n_loc), s_ctx], axis=-1)
        p = jax.nn.softmax(s, axis=-1).astype(v.dtype)
        p_loc = p[..., :n_loc].reshape(bsz, n_h, GRID_W, kh, NA_KW)
        return (jnp.einsum('bhqkw,bkqwhd->bqhd', p_loc, vb)
                + jnp.einsum('bhqj,bjhd->bqhd', p[..., n_loc:], vc))

    out = lax.map(row_fn, (r_idx, row_start, qg.transpose(1, 0, 2, 3, 4)))
    out = out.transpose(1, 0, 2, 3, 4).reshape(bsz, n_tok, n_h * dh)
    out_c = attend(qc[:, :, :, None], kc, vc).reshape(bsz, qc.shape[1], -1) if with_ctx else None
    return out, out_c


def window_attention(q, k, v, qc, kc, vc, sink, with_ctx):
    bsz, n_tok = q.shape[:2]
    n_blk = n_tok // Q_BLOCK
    band = Q_BLOCK + 2 * SWA_WINDOW
    kp = jnp.pad(k, ((0, 0), (SWA_WINDOW, SWA_WINDOW), (0, 0), (0, 0)))
    vp = jnp.pad(v, ((0, 0), (SWA_WINDOW, SWA_WINDOW), (0, 0), (0, 0)))
    qi = jnp.arange(Q_BLOCK, dtype=jnp.int32)
    kj = jnp.arange(band, dtype=jnp.int32)
    in_win = jnp.abs(kj[None, :] - SWA_WINDOW - qi[:, None]) <= SWA_WINDOW
    ctx_ok = jnp.ones((Q_BLOCK, kc.shape[1]), dtype=bool)

    def block(args):
        n, qb = args
        kb = lax.dynamic_slice_in_dim(kp, n * Q_BLOCK, band, axis=1)
        vb = lax.dynamic_slice_in_dim(vp, n * Q_BLOCK, band, axis=1)
        key_pos = n * Q_BLOCK - SWA_WINDOW + kj
        valid = in_win & ((key_pos >= 0) & (key_pos < n_tok))[None, :]
        mask = jnp.concatenate([valid, ctx_ok], axis=-1)
        return attend(qb, jnp.concatenate([kb, kc], axis=1), jnp.concatenate([vb, vc], axis=1), mask, sink)

    qbl = q.reshape(bsz, n_blk, Q_BLOCK, *q.shape[2:]).swapaxes(0, 1)
    out = lax.map(block, (jnp.arange(n_blk, dtype=jnp.int32), qbl)).swapaxes(0, 1).reshape(bsz, n_tok, -1)
    out_c = attend(qc, kc, vc, sink=sink).reshape(bsz, qc.shape[1], -1) if with_ctx else None
    return out, out_c


def global_attention(q, k, v, qc, kc, vc, with_ctx):
    bsz, n_tok = q.shape[:2]
    n_blk = n_tok // Q_BLOCK
    k_all = jnp.concatenate([k, kc], axis=1)
    v_all = jnp.concatenate([v, vc], axis=1)
    qbl = q.reshape(bsz, n_blk, Q_BLOCK, *q.shape[2:]).swapaxes(0, 1)
    out = lax.map(lambda qb: attend(qb, k_all, v_all), qbl).swapaxes(0, 1).reshape(bsz, n_tok, -1)
    out_c = attend(qc, kc, vc).reshape(bsz, qc.shape[1], -1) if with_ctx else None
    return out, out_c


def dwconv_silu(u, w, b):
    ch = u.shape[-1]
    y = lax.conv_general_dilated(u, w[:, None, :].astype(u.dtype), window_strides=(1,),
                                 padding=[(SSM_CONV // 2, SSM_CONV // 2)],
                                 dimension_numbers=('NWC', 'WIO', 'NWC'), feature_group_count=ch)
    return jax.nn.silu(y + b)


def segsum_exp(a):
    q_len = a.shape[-1]
    cs = jnp.cumsum(a, axis=-1)
    diff = cs[..., :, None] - cs[..., None, :]
    mask = jnp.tril(jnp.ones((q_len, q_len), dtype=bool))
    return jnp.where(mask, jnp.exp(jnp.where(mask, diff, 0.0)), 0.0)


def ssd_scan(x, dt, a, bm, cm, h0, return_y):
    bsz, n_tok, n_h, p_dim = x.shape
    n_st = bm.shape[-1]
    n_c = n_tok // SSM_CHUNK
    xdt = (x.astype(jnp.float32) * dt[..., None]).reshape(bsz, n_c, SSM_CHUNK, n_h, p_dim)
    da = (dt * a.astype(jnp.float32)).reshape(bsz, n_c, SSM_CHUNK, n_h).transpose(0, 3, 1, 2)
    a_cum = jnp.cumsum(da, axis=-1)
    bc = bm.astype(jnp.float32).reshape(bsz, n_c, SSM_CHUNK, n_h, n_st)
    cc = cm.astype(jnp.float32).reshape(bsz, n_c, SSM_CHUNK, n_h, n_st)
    decay_states = jnp.exp(a_cum[..., -1:] - a_cum)
    states = jnp.einsum('bclhn,bhcl,bclhp->bchpn', bc, decay_states, xdt)
    chunk_decay = jnp.exp(a_cum[..., -1])

    def step(h, inp):
        st, dec = inp
        return h * dec[..., None, None] + st, (h if return_y else None)

    h_final, h_in = lax.scan(step, h0, (states.transpose(1, 0, 2, 3, 4), chunk_decay.transpose(2, 0, 1)))
    if not return_y:
        return None, h_final
    h_in = h_in.transpose(1, 0, 2, 3, 4)
    y_diag = jnp.einsum('bclhn,bcshn,bhcls,bcshp->bclhp', cc, bc, segsum_exp(da), xdt)
    y_off = jnp.einsum('bclhn,bchpn,bhcl->bclhp', cc, h_in, jnp.exp(a_cum))
    return (y_diag + y_off).reshape(bsz, n_tok, n_h, p_dim), h_final


def mamba_branch(z, xbc, dt_raw, zc, xbcc, dtc_raw, conv_w, conv_b, dt_bias, a_log, d_skip, norm_g, with_ctx):
    a = -jnp.exp(a_log.astype(jnp.float32))
    rep = SSM_HEADS // SSM_GROUPS
    gn = SSM_GROUPS * SSM_STATE

    def prep(xbc_, dt_raw_):
        u = dwconv_silu(xbc_, conv_w, conv_b)
        bsz, n_tok = u.shape[:2]
        xs = u[..., :SSM_INNER].reshape(bsz, n_tok, SSM_HEADS, SSM_HEAD_DIM)
        bm = jnp.repeat(u[..., SSM_INNER:SSM_INNER + gn].reshape(bsz, n_tok, SSM_GROUPS, SSM_STATE), rep, axis=2)
        cm = jnp.repeat(u[..., SSM_INNER + gn:].reshape(bsz, n_tok, SSM_GROUPS, SSM_STATE), rep, axis=2)
        dt = jax.nn.softplus(dt_raw_.astype(jnp.float32).reshape(bsz, n_tok, 2, SSM_HEADS) + dt_bias.astype(jnp.float32))
        return xs, bm, cm, dt

    xl, bl, cl, dtl = prep(xbc, dt_raw)
    xc, bc, cc, dtc = prep(xbcc, dtc_raw)
    fl = lambda t: jnp.flip(t, axis=1)
    h0 = jnp.zeros((xl.shape[0], SSM_HEADS, SSM_HEAD_DIM, SSM_STATE), jnp.float32)
    yc_f, hc_f = ssd_scan(xc, dtc[:, :, 0], a[0], bc, cc, h0, with_ctx)
    yc_b, hc_b = ssd_scan(fl(xc), fl(dtc[:, :, 1]), a[1], fl(bc), fl(cc), h0, with_ctx)
    yl_f, _ = ssd_scan(xl, dtl[:, :, 0], a[0], bl, cl, hc_f, True)
    yl_b, _ = ssd_scan(fl(xl), fl(dtl[:, :, 1]), a[1], fl(bl), fl(cl), hc_b, True)

    def finish(y, xs, z_):
        y = y + d_skip.astype(jnp.float32)[:, None] * xs.astype(jnp.float32)
        y = y.reshape(y.shape[0], y.shape[1], SSM_INNER)
        return rms_norm(y * jax.nn.silu(z_.astype(jnp.float32)), norm_g).astype(z_.dtype)

    out = finish(yl_f + fl(yl_b), xl, z)
    out_c = finish(yc_f + fl(yc_b), xc, zc) if with_ctx else None
    return out, out_c


def hybrid_mixer(h, hc, w_in, w_gate, b_gate, na_rpb, swa_sink, qk_gain_q, qk_gain_k, conv_w, conv_b,
                 dt_bias, a_log, d_skip, ssm_norm_g, w_branch, w_out, with_ctx):
    cos, sin = axial_rope_tables(h.shape[1])
    rope = lambda t: apply_rope(t, cos, sin)
    (na_q, na_k, na_v, sw_q, sw_k, sw_v, ga_q, ga_k, ga_v, z, xbc, dt_raw) = split_cols(h @ w_in)
    (na_qc, na_kc, na_vc, sw_qc, sw_kc, sw_vc, ga_qc, ga_kc, ga_vc, zc, xbcc, dtc_raw) = split_cols(hc @ w_in)
    o_a, o_ac = neighbourhood_attention(heads(na_q), heads(na_k), heads(na_v),
                                        heads(na_qc), heads(na_kc), heads(na_vc), na_rpb, with_ctx)
    o_b, o_bc = window_attention(group(rope(heads(sw_q)), SWA_KV_HEADS), rope(heads(sw_k)), heads(sw_v),
                                 group(heads(sw_qc), SWA_KV_HEADS), heads(sw_kc), heads(sw_vc),
                                 swa_sink.reshape(SWA_KV_HEADS, -1), with_ctx)
    o_c, o_cc = global_attention(group(rope(rms_norm(heads(ga_q), qk_gain_q)), GA_KV_HEADS),
                                 rope(rms_norm(heads(ga_k), qk_gain_k)), heads(ga_v),
                                 group(rms_norm(heads(ga_qc), qk_gain_q), GA_KV_HEADS),
                                 rms_norm(heads(ga_kc), qk_gain_k), heads(ga_vc), with_ctx)
    o_d, o_dc = mamba_branch(z, xbc, dt_raw, zc, xbcc, dtc_raw, conv_w, conv_b, dt_bias, a_log, d_skip,
                             ssm_norm_g, with_ctx)

    def merge(h_in, branches):
        terms = [jax.nn.sigmoid(h_in @ w_gate[i] + b_gate[i]) * (u @ w_branch[i]) for i, u in enumerate(branches)]
        return (terms[0] + terms[1] + terms[2] + terms[3]) @ w_out

    out = merge(h, (o_a, o_b, o_c, o_d))
    out_c = merge(hc, (o_ac, o_bc, o_cc, o_dc)) if with_ctx else None
    return out, out_c


def swiglu(h, w_up, w_down):
    g, u = jnp.split(h @ w_up, 2, axis=-1)
    return (jax.nn.silu(g) * u) @ w_down


def moe_swiglu(tokens, w_router, b_router, w_up, w_down):
    n_tok, d = tokens.shape
    logits = (tokens @ w_router).astype(jnp.float32) + b_router.astype(jnp.float32)
    top_logit, top_idx = lax.top_k(logits, TOP_K)
    gate = jax.nn.softmax(top_logit, axis=-1)
    n_slot = n_tok * TOP_K
    expert = top_idx.reshape(-1)
    token = jnp.repeat(jnp.arange(n_tok, dtype=jnp.int32), TOP_K)
    order = jnp.argsort(expert)
    e_s, t_s, w_s = expert[order], token[order], gate.reshape(-1)[order]
    counts = jax.ops.segment_sum(jnp.ones_like(expert), expert, num_segments=N_EXPERTS)
    padded = (counts + MOE_BLOCK - 1) // MOE_BLOCK * MOE_BLOCK
    grp_start = jnp.cumsum(counts) - counts
    pad_end = jnp.cumsum(padded)
    pad_start = pad_end - padded
    dest = pad_start[e_s] + jnp.arange(n_slot, dtype=jnp.int32) - grp_start[e_s]
    n_blk = -(-n_slot // MOE_BLOCK) + N_EXPERTS
    x_pad = jnp.zeros((n_blk * MOE_BLOCK, d), tokens.dtype).at[dest].set(tokens[t_s])
    blk_expert = jnp.minimum(
        jnp.searchsorted(pad_end, jnp.arange(n_blk, dtype=jnp.int32) * MOE_BLOCK, side='right'), N_EXPERTS - 1)

    def expert_block(args):
        xb, e = args
        return swiglu(xb, w_up[e], w_down[e])

    y_pad = lax.map(expert_block, (x_pad.reshape(n_blk, MOE_BLOCK, d), blk_expert)).reshape(-1, d)
    y = y_pad[dest] * w_s[:, None].astype(tokens.dtype)
    return jnp.zeros_like(tokens).at[t_s].add(y)


def setup_inputs(seed: int = 0) -> dict:
    key = jax.random.key(seed)
    ks = iter(jax.random.split(key, 48))
    nrm = lambda shape, scale: jax.random.normal(next(ks), shape, jnp.float32) * scale
    d = D_MODEL
    n_l = DEPTH
    n_dense = (DEPTH + 1) // 2
    n_moe = DEPTH // 2
    x = nrm((BATCH, SEQ, d), 1.0)
    c = nrm((BATCH, d), 1.0)
    ctx = nrm((BATCH, CTX_LEN, d), 1.0)
    c_ctx = nrm((d,), 1.0)
    w_mod = nrm((n_l, d, 6 * d), d ** -0.5)
    b_mod = nrm((n_l, 6 * d), 0.02)
    w_in = nrm((n_l, d, D_IN), d ** -0.5)
    w_gate = nrm((n_l, N_BRANCH, d, d), d ** -0.5)
    b_gate = nrm((n_l, N_BRANCH, d), 0.02)
    na_rpb = nrm((n_l, NA_HEADS, 2 * NA_KH - 1, 2 * NA_KW - 1), 0.5)
    swa_sink = nrm((n_l, SWA_Q_HEADS), 1.0)
    qk_gain_q = 1.0 + nrm((n_l, HEAD_DIM), 0.02)
    qk_gain_k = 1.0 + nrm((n_l, HEAD_DIM), 0.02)
    conv_w = nrm((n_l, SSM_CONV, SSM_CONV_CH), SSM_CONV ** -0.5)
    conv_b = nrm((n_l, SSM_CONV_CH), 0.02)
    dt0 = jnp.exp(jax.random.uniform(next(ks), (n_l, 2, SSM_HEADS), jnp.float32,
                                     minval=math.log(1e-3), maxval=math.log(1e-1)))
    dt_bias = dt0 + jnp.log(-jnp.expm1(-dt0))
    a_log = jnp.log(jax.random.uniform(next(ks), (n_l, 2, SSM_HEADS), jnp.float32, minval=1.0, maxval=16.0))
    d_skip = 1.0 + nrm((n_l, SSM_HEADS), 0.1)
    ssm_norm_g = 1.0 + nrm((n_l, SSM_INNER), 0.02)
    w_branch = nrm((n_l, N_BRANCH, BRANCH_W, d), BRANCH_W ** -0.5)
    w_out = nrm((n_l, d, d), d ** -0.5 * BETA)
    ln1_g = 1.0 + nrm((n_l, d), 0.02)
    ln1_b = nrm((n_l, d), 0.02)
    ln2_g = 1.0 + nrm((n_l, d), 0.02)
    ln2_b = nrm((n_l, d), 0.02)
    ffn_w_up = nrm((n_dense, d, 2 * D_FF), d ** -0.5)
    ffn_w_down = nrm((n_dense, D_FF, d), D_FF ** -0.5 * BETA)
    moe_w_router = nrm((n_moe, d, N_EXPERTS), d ** -0.5)
    moe_b_router = nrm((n_moe, N_EXPERTS), 0.01)
    moe_w_up = nrm((n_moe, N_EXPERTS, d, 2 * D_FF_EXPERT), d ** -0.5)
    moe_w_down = nrm((n_moe, N_EXPERTS, D_FF_EXPERT, d), D_FF_EXPERT ** -0.5 * BETA)
    return {'x': x, 'c': c, 'ctx': ctx, 'c_ctx': c_ctx, 'w_mod': w_mod, 'b_mod': b_mod, 'w_in': w_in,
            'w_gate': w_gate, 'b_gate': b_gate, 'na_rpb': na_rpb, 'swa_sink': swa_sink,
            'qk_gain_q': qk_gain_q, 'qk_gain_k': qk_gain_k, 'conv_w': conv_w, 'conv_b': conv_b,
            'dt_bias': dt_bias, 'a_log': a_log, 'd_skip': d_skip, 'ssm_norm_g': ssm_norm_g,
            'w_branch': w_branch, 'w_out': w_out, 'ln1_g': ln1_g, 'ln1_b': ln1_b, 'ln2_g': ln2_g,
            'ln2_b': ln2_b, 'ffn_w_up': ffn_w_up, 'ffn_w_down': ffn_w_down, 'moe_w_router': moe_w_router,
            'moe_b_router': moe_b_router, 'moe_w_up': moe_w_up, 'moe_w_down': moe_w_down}


def reference(x, c, ctx, c_ctx, w_mod, b_mod, w_in, w_gate, b_gate, na_rpb, swa_sink, qk_gain_q, qk_gain_k,
              conv_w, conv_b, dt_bias, a_log, d_skip, ssm_norm_g, w_branch, w_out, ln1_g, ln1_b, ln2_g, ln2_b,
              ffn_w_up, ffn_w_down, moe_w_router, moe_b_router, moe_w_up, moe_w_down):
    s_lat = jax.nn.silu(c)
    s_ctx = jax.nn.silu(c_ctx)
    for l in range(DEPTH):
        with_ctx = l < DEPTH - 1
        m = jnp.split((s_lat @ w_mod[l] + b_mod[l])[:, None, :], 6, axis=-1)
        mc = jnp.split(s_ctx @ w_mod[l] + b_mod[l], 6, axis=-1)
        h = x * (1 + m[1]) + m[0]
        hc = ctx * (1 + mc[1]) + mc[0]
        o, oc = hybrid_mixer(h, hc, w_in[l], w_gate[l], b_gate[l], na_rpb[l], swa_sink[l], qk_gain_q[l],
                             qk_gain_k[l], conv_w[l], conv_b[l], dt_bias[l], a_log[l], d_skip[l],
                             ssm_norm_g[l], w_branch[l], w_out[l], with_ctx)
        x = layer_norm(ALPHA * x + m[2] * o, ln1_g[l], ln1_b[l])
        h2 = x * (1 + m[4]) + m[3]
        if with_ctx:
            ctx = layer_norm(ALPHA * ctx + mc[2] * oc, ln1_g[l], ln1_b[l])
            h2c = ctx * (1 + mc[4]) + mc[3]
        i = l // 2
        if l % 2 == 0:
            f = swiglu(h2, ffn_w_up[i], ffn_w_down[i])
            if with_ctx:
                fc = swiglu(h2c, ffn_w_up[i], ffn_w_down[i])
        elif with_ctx:
            n_lat = h2.shape[0] * h2.shape[1]
            tok = jnp.concatenate([h2.reshape(-1, D_MODEL), h2c.reshape(-1, D_MODEL)], axis=0)
            y = moe_swiglu(tok, moe_w_router[i], moe_b_router[i], moe_w_up[i], moe_w_down[i])
            f = y[:n_lat].reshape(h2.shape)
            fc = y[n_lat:].reshape(h2c.shape)
        else:
            f = moe_swiglu(h2.reshape(-1, D_MODEL), moe_w_router[i], moe_b_router[i], moe_w_up[i],
                           moe_w_down[i]).reshape(h2.shape)
        x = layer_norm(ALPHA * x + m[5] * f, ln2_g[l], ln2_b[l])
        if with_ctx:
            ctx = layer_norm(ALPHA * ctx + mc[5] * fc, ln2_g[l], ln2_b[l])
    return x
```

```cpp
#include <hip/hip_runtime.h>
#include <cstdio>
#include <cstdint>

#define DI __device__ __forceinline__
#define LAS __attribute__((address_space(3)))
#define GAS __attribute__((address_space(1)))
typedef unsigned short bf16_t;
typedef short bf16x8 __attribute__((ext_vector_type(8)));
typedef short s16x4 __attribute__((ext_vector_type(4)));
typedef float f32x2 __attribute__((ext_vector_type(2)));
typedef float f32x4 __attribute__((ext_vector_type(4)));
typedef float f32x16 __attribute__((ext_vector_type(16)));
typedef unsigned u32x2 __attribute__((ext_vector_type(2)));
typedef unsigned u32x4 __attribute__((ext_vector_type(4)));
typedef __bf16 bf16x2_t __attribute__((ext_vector_type(2)));
typedef GAS unsigned gu32;

#ifndef MK_PER_PHASE
#define MK_PER_PHASE 0
#endif
#ifndef PHMASK
#define PHMASK 0xFFFF
#endif
#define PHM(k) ((PHMASK >> (k)) & 1)
#ifndef ABL
#define ABL 0
#endif

constexpr int DM = 1024, NB = 4, SEQ = 8192, CTXL = 256, NLAT = NB * SEQ, NCTX = NB * CTXL, MTOT = NLAT + NCTX;
constexpr int DEPTH = 4, DIN = 4624, PRJW = 4608, GTW = 4096, NCOMB = PRJW + GTW, OCW = 2048;
constexpr int DFF = 2816, DFFE = 3584, NEXP = 8, MOE_ROWS_MAX = 69632;
constexpr int NCH = 66;
constexpr float ALPHA = 1.6817928305074292f;
constexpr float LOG2E = 1.4426950408889634f;
constexpr float C2 = 0.125f * LOG2E;
constexpr float LN_EPS = 1e-5f, RMS_EPS = 1e-6f;
constexpr int C_NAQ = 0, C_NAK = 512, C_NAV = 1024, C_SWQ = 1536, C_SWK = 2048, C_SWV = 2176, C_GAQ = 2304, C_GAK = 2816, C_GAV = 2944, C_Z = 3072, C_XBC = 3584;

constexpr size_t KiB = 1024, MiB = 1u << 20;
constexpr size_t WS_CTL = 0, CTL_ZERO_BYTES = 1 * MiB;
constexpr size_t WS_MVEC = 1 * MiB;
constexpr size_t WS_ROPE = WS_MVEC + 512 * KiB;
constexpr size_t WS_DT = 4 * MiB;
constexpr size_t WS_SSQ = WS_DT + (size_t)MTOT * 16 * 4;
constexpr size_t WS_SLOT = WS_SSQ + (size_t)MTOT * 8 * 4;
constexpr size_t WS_CDEC = WS_SLOT + (size_t)MTOT * 8 * 4;
constexpr size_t WS_W = 10 * MiB;
constexpr size_t SZ_WCOMB = (size_t)NCOMB * DM * 2, SZ_WB = (size_t)4096 * 512 * 2, SZ_WO = (size_t)1024 * 4096 * 2;
constexpr size_t SZ_WUP = (size_t)2 * DFF * DM * 2, SZ_WDN = (size_t)DM * DFF * 2, SZ_MUP = (size_t)NEXP * 2 * DFFE * DM * 2, SZ_MDN = (size_t)NEXP * DM * DFFE * 2;
constexpr size_t WS_WCOMB = WS_W, WS_WB = WS_WCOMB + 4 * SZ_WCOMB, WS_WO = WS_WB + 4 * SZ_WB, WS_WUP = WS_WO + 4 * SZ_WO, WS_WDN = WS_WUP + 2 * SZ_WUP,
                 WS_MUP = WS_WDN + 2 * SZ_WDN, WS_MDN = WS_MUP + 2 * SZ_MUP, WS_WEND = WS_MDN + 2 * SZ_MDN;
constexpr size_t WS_XS = (WS_WEND + 255) & ~(size_t)255;
constexpr size_t WS_HB = WS_XS + (size_t)MTOT * DM * 4;
constexpr size_t WS_U = WS_HB + (size_t)MTOT * DM * 2;
constexpr size_t WS_PRJ = WS_U;
constexpr size_t WS_GT = WS_PRJ + (size_t)MTOT * PRJW * 2;
constexpr size_t WS_OC = WS_GT + (size_t)MTOT * GTW * 2;
constexpr size_t WS_ST = WS_OC + (size_t)MTOT * OCW * 2;
constexpr size_t WS_UEND = WS_ST + (size_t)NB * NCH * 16 * 8192 * 4;
constexpr size_t WS_HID = WS_U;
constexpr size_t WS_XPAD = WS_HID + (size_t)MOE_ROWS_MAX * DFFE * 2;
constexpr size_t WS_YPAD = WS_XPAD + (size_t)MOE_ROWS_MAX * DM * 2;
static_assert(WS_YPAD + (size_t)MOE_ROWS_MAX * DM * 2 <= WS_UEND, "FFN overlay fits the union region");
constexpr size_t WS_END = WS_UEND;
constexpr int CW_BAR = 4096, CW_MOECNT = 16384;

constexpr int RING_BYTES = 131072, MISC_OFF = RING_BYTES + 320, LDS_BYTES = 147456;
constexpr int NWAVES = 8, NTHR = 512;

DI unsigned pk2(float lo, float hi) { f32x2 v = {lo, hi}; bf16x2_t b = __builtin_convertvector(v, bf16x2_t); return __builtin_bit_cast(unsigned, b); }
DI float bflo(unsigned u) { return __uint_as_float(u << 16); }
DI float bfhi(unsigned u) { return __uint_as_float(u & 0xffff0000u); }
DI float sigm(float x) { return __builtin_amdgcn_rcpf(1.f + __expf(-x)); }
DI float silu(float x) { return x * sigm(x); }
DI float wave_sum(float v) {
#pragma unroll
    for (int o = 1; o < 64; o <<= 1) v += __shfl_xor(v, o);
    return v;
}
DI int clampi(int v, int lo, int hi) { return v < lo ? lo : (v > hi ? hi : v); }
#define MFMA32(a, b, c) __builtin_amdgcn_mfma_f32_32x32x16_bf16((a), (b), (c), 0, 0, 0)
DI int crow(int reg, int h) { return (reg & 3) + 8 * (reg >> 2) + 4 * h; }
typedef short v4i16_t __attribute__((ext_vector_type(4)));
DI s16x4 tr_read(const LAS unsigned char* p) { return __builtin_bit_cast(s16x4, __builtin_amdgcn_ds_read_tr16_b64_v4i16((LAS v4i16_t*)p)); }
DI bf16x8 cat8(s16x4 lo, s16x4 hi) { return __builtin_shufflevector(lo, hi, 0, 1, 2, 3, 4, 5, 6, 7); }
template <int S> DI bf16x8 pack8(const f32x16& x) {
    u32x4 w; w.x = pk2(x[8 * S], x[8 * S + 1]); w.y = pk2(x[8 * S + 2], x[8 * S + 3]); w.z = pk2(x[8 * S + 4], x[8 * S + 5]); w.w = pk2(x[8 * S + 6], x[8 * S + 7]);
    return __builtin_bit_cast(bf16x8, w);
}

#define XB_TMO      128
#define XB_XCNT(j)  (256  + 64 * (j))
#define XB_XSUB(j)  (1280 + 64 * (j))
#define XB_XGEN(j)  (2304 + 64 * (j))
#define XB_TOP      3328
#define XB_TOPGEN   3392
#define XCD_BAR_WORDS 3456
#define XB_SPIN_CAP (1u << 18)
DI unsigned xb_ld(unsigned* p)              { return __hip_atomic_load(p, __ATOMIC_RELAXED, __HIP_MEMORY_SCOPE_AGENT); }
DI unsigned xb_add(unsigned* p, unsigned v) { return __hip_atomic_fetch_add(p, v, __ATOMIC_RELAXED, __HIP_MEMORY_SCOPE_AGENT); }
DI unsigned xb_xcc_id() { return (unsigned)__builtin_amdgcn_s_getreg((3 << 11) | 20) & 0xFu; }
#define XB_SPIN(cond, bar) do { unsigned _sp = 0; while (cond) { __builtin_amdgcn_s_sleep(1); \
    if ((++_sp & 255u) == 0u) { if (xb_ld(&(bar)[XB_TMO])) break; if (_sp > XB_SPIN_CAP) { atomicAdd(&(bar)[XB_TMO], 1u); break; } } } } while (0)
struct XcdBarrier { unsigned* bar; unsigned x; volatile LAS unsigned* st; };
DI XcdBarrier xcd_barrier_post(unsigned* bar, volatile LAS unsigned* st) {
    XcdBarrier b; b.bar = bar; b.x = xb_xcc_id(); b.st = st;
    if (threadIdx.x == 0) (void)xb_add(&bar[XB_XCNT(b.x)], 1u);
    return b;
}
DI void xcd_barrier_complete(unsigned* bar, unsigned x, unsigned& nloc, unsigned& nx) {
    const unsigned G = gridDim.x * gridDim.y * gridDim.z;
    unsigned sum, cnt, mine, sp = 0u;
    for (;;) {
        sum = 0u; cnt = 0u; mine = 0u;
#pragma unroll
        for (unsigned j = 0; j < 16; ++j) { const unsigned c = xb_ld(&bar[XB_XCNT(j)]); sum += c; cnt += (c > 0u) ? 1u : 0u; mine = (j == x) ? c : mine; }
        if (sum == G) break;
        __builtin_amdgcn_s_sleep(1);
        if ((++sp & 255u) == 0u) { if (xb_ld(&bar[XB_TMO])) break; if (sp > XB_SPIN_CAP) { atomicAdd(&bar[XB_TMO], 1u); break; } }
    }
    nloc = mine > 0u ? mine : 1u; nx = cnt > 0u ? cnt : 1u;
}
DI void xcd_barrier(const XcdBarrier& b) {
    asm volatile("s_waitcnt vmcnt(0)" ::: "memory");
    __syncthreads();
    if (threadIdx.x == 0) {
        unsigned* bar = b.bar;
        __builtin_amdgcn_s_waitcnt(0);
        unsigned nloc = b.st[0], nx = b.st[1];
        if (nloc == 0u) { xcd_barrier_complete(bar, b.x, nloc, nx); b.st[0] = nloc; b.st[1] = nx; }
        const unsigned old = xb_add(&bar[XB_XSUB(b.x)], 1u);
        const unsigned gen = old / nloc;
        if (old + 1u == (gen + 1u) * nloc) {
            __builtin_amdgcn_fence(__ATOMIC_RELEASE, "agent");
            asm volatile("s_waitcnt vmcnt(0)" ::: "memory");
            const unsigned og = xb_add(&bar[XB_TOP], 1u);
            const unsigned tg = og / nx;
            if (og + 1u == (tg + 1u) * nx) xb_add(&bar[XB_TOPGEN], 1u);
            else XB_SPIN(xb_ld(&bar[XB_TOPGEN]) == tg, bar);
            __builtin_amdgcn_fence(__ATOMIC_ACQUIRE, "agent");
            xb_add(&bar[XB_XGEN(b.x)], 1u);
            asm volatile("s_waitcnt vmcnt(0)" ::: "memory");
        } else {
            XB_SPIN(xb_ld(&bar[XB_XGEN(b.x)]) == gen, bar);
            __builtin_amdgcn_fence(__ATOMIC_ACQUIRE, "agent");
            asm volatile("s_waitcnt vmcnt(0)" ::: "memory");
        }
    }
    __syncthreads();
}

namespace pg8 {
constexpr int BM = 256, BK = 64, HALF = 128, HTB = HALF * BK * 2, STAGE_BYTES = 8 * HTB;
__host__ __device__ __forceinline__ int lds_byte(int r, int c) { const int st = (r >> 4) * 2 + (c >> 5), rr = r & 15, cc = c & 31, ob = rr * 64 + cc * 2; return st * 1024 + (ob ^ (((ob >> 9) & 1) << 5)); }
__host__ __device__ __forceinline__ void stage_rc(int b, int& R, int& C) { const int st = b / 1024, sb = b % 1024, swz = sb ^ (((sb >> 9) & 1) << 5); R = (st >> 1) * 16 + swz / 64; C = (st & 1) * 32 + (swz % 64) / 2; }
__host__ __device__ __forceinline__ int perm32(int rho) { const int n = rho >> 4, i = rho & 15; return 8 * (i >> 2) + 4 * n + (i & 3); }
struct Unit { int pm, pn; const char* A; const char* B; };

template <class Epi, class Sched>
DI void gemm_phase(LAS unsigned char* lds, const int tid, const int K, const int lda, const int ldb, const Sched& S, const Epi& E) {
    const int wid = __builtin_amdgcn_readfirstlane(tid >> 6), lane = tid & 63, wr = wid >> 2, wc = wid & 3, fr = lane & 15, fq = lane >> 4;
    const int nt = K / BK;
    unsigned voffA[2], voffB[2];
#pragma unroll
    for (int i = 0; i < 2; ++i) { int R, C; stage_rc(tid * 16 + i * 8192, R, C); const int Rb = (R & ~31) + perm32(R & 31);
        voffA[i] = (unsigned)(R * lda + C) * 2u; voffB[i] = (unsigned)(Rb * ldb + C) * 2u; }
    const size_t kstep = (size_t)(BK * 2);
    const size_t hstepA = (size_t)HALF * lda * 2, hstepB = (size_t)HALF * ldb * 2;
    const unsigned ldsw = (unsigned)wid * 1024u;
    const int aoff = lds_byte(wr * 64 + fr, fq * 8), boff = lds_byte(wc * 32 + fr, fq * 8);
#define PG8_SA(b, h) (((b) * 2 + (h)) * HTB)
#define PG8_SB(b, h) ((4 + (b) * 2 + (h)) * HTB)
#define PG8_STAGE(bufoff, gbase, voff) do { _Pragma("unroll") for (int _i = 0; _i < 2; ++_i) \
        __builtin_amdgcn_global_load_lds((const unsigned*)((const char*)(gbase) + (voff)[_i]), (LAS unsigned*)(lds + (bufoff) + ldsw + _i * 8192), 16, 0, 0); } while (0)
#define PG8_LDA(dst, b, h) do { _Pragma("unroll") for (int m = 0; m < 4; ++m) _Pragma("unroll") for (int k = 0; k < 2; ++k) dst[m][k] = *(const LAS bf16x8*)(lds + PG8_SA(b, h) + aoff + m * 2048 + k * 1024); } while (0)
#define PG8_LDB(dst, b, h) do { _Pragma("unroll") for (int n = 0; n < 2; ++n) _Pragma("unroll") for (int k = 0; k < 2; ++k) dst[n][k] = *(const LAS bf16x8*)(lds + PG8_SB(b, h) + boff + n * 2048 + k * 1024); } while (0)
#define PG8_MMA(ai, bj, At, Bt) do { __builtin_amdgcn_s_setprio(1); _Pragma("unroll") for (int m = 0; m < 4; ++m) _Pragma("unroll") for (int n = 0; n < 2; ++n) _Pragma("unroll") for (int k = 0; k < 2; ++k) \
        acc[ai][bj][m][n] = __builtin_amdgcn_mfma_f32_16x16x32_bf16(Bt[n][k], At[m][k], acc[ai][bj][m][n], 0, 0, 0); __builtin_amdgcn_s_setprio(0); } while (0)
#define PG8_WAIT_V(n) asm volatile("s_waitcnt vmcnt(" #n ")" ::: "memory")
#define PG8_WAIT_L(n) asm volatile("s_waitcnt lgkmcnt(" #n ")" ::: "memory")
#define PG8_BAR __builtin_amdgcn_s_barrier()
#define PG8_SCHED __builtin_amdgcn_sched_barrier(0)
    Unit cur, nxt; int ui = 0;
    if (!S.next(0, cur)) return;
    f32x4 acc[2][2][4][2];
#pragma unroll
    for (int a = 0; a < 2; ++a)
#pragma unroll
        for (int b = 0; b < 2; ++b)
#pragma unroll
            for (int m = 0; m < 4; ++m)
#pragma unroll
                for (int n = 0; n < 2; ++n) acc[a][b][m][n] = (f32x4){0.f, 0.f, 0.f, 0.f};
    bf16x8 At[4][2], B0[2][2], B1[2][2];
    const char* cA = cur.A; const char* cB = cur.B;
    PG8_STAGE(PG8_SB(0, 0), cB, voffB); PG8_STAGE(PG8_SB(0, 1), cB + hstepB, voffB); PG8_STAGE(PG8_SA(0, 0), cA, voffA); PG8_STAGE(PG8_SA(0, 1), cA + hstepA, voffA);
    if (wr == 1) PG8_BAR;
    PG8_WAIT_V(2); PG8_BAR;
    PG8_STAGE(PG8_SB(1, 0), cB + kstep, voffB); PG8_STAGE(PG8_SA(1, 0), cA + kstep, voffA); PG8_STAGE(PG8_SB(1, 1), cB + hstepB + kstep, voffB);
    PG8_WAIT_V(6); PG8_BAR;
    for (;;) {
        const bool has_next = S.next(ui + 1, nxt);
        const char* nA = has_next ? nxt.A : cA; const char* nB = has_next ? nxt.B : cB;
        for (int t = 0; t < nt; t += 2) {
            const bool last = (t == nt - 2);
            const char* a1 = cA + (size_t)(t + 1) * kstep;
            const char* a2 = last ? nA : cA + (size_t)(t + 2) * kstep; const char* b2 = last ? nB : cB + (size_t)(t + 2) * kstep;
            const char* a3 = a2 + kstep; const char* b3 = b2 + kstep;
            PG8_LDB(B0, 0, 0); PG8_LDB(B1, 0, 1); PG8_SCHED; PG8_LDA(At, 0, 0); PG8_STAGE(PG8_SA(1, 1), a1 + hstepA, voffA);
            PG8_WAIT_V(8); PG8_WAIT_L(0); PG8_BAR; PG8_MMA(0, 0, At, B0); PG8_MMA(0, 1, At, B1); PG8_BAR; PG8_SCHED;
            PG8_LDA(At, 0, 1); PG8_STAGE(PG8_SB(0, 0), b2, voffB); PG8_STAGE(PG8_SB(0, 1), b2 + hstepB, voffB); PG8_STAGE(PG8_SA(0, 0), a2, voffA);
            PG8_WAIT_V(8); PG8_WAIT_L(0); PG8_BAR; PG8_MMA(1, 0, At, B0); PG8_MMA(1, 1, At, B1); PG8_BAR; PG8_SCHED;
            PG8_LDB(B0, 1, 0); PG8_LDB(B1, 1, 1); PG8_SCHED; PG8_LDA(At, 1, 0); PG8_STAGE(PG8_SA(0, 1), a2 + hstepA, voffA);
            PG8_WAIT_V(8); PG8_WAIT_L(0); PG8_BAR; PG8_MMA(0, 0, At, B0); PG8_MMA(0, 1, At, B1); PG8_BAR; PG8_SCHED;
            PG8_LDA(At, 1, 1); PG8_STAGE(PG8_SB(1, 0), b3, voffB); PG8_STAGE(PG8_SB(1, 1), b3 + hstepB, voffB); PG8_STAGE(PG8_SA(1, 0), a3, voffA);
            PG8_WAIT_V(8); PG8_WAIT_L(0); PG8_BAR; PG8_MMA(1, 0, At, B0); PG8_MMA(1, 1, At, B1); PG8_BAR; PG8_SCHED;
        }
        if (wr == 0) PG8_BAR;
        E(acc, cur, wr, wc, fr, fq);
        if (!has_next) break;
#pragma unroll
        for (int a = 0; a < 2; ++a)
#pragma unroll
            for (int b = 0; b < 2; ++b)
#pragma unroll
                for (int m = 0; m < 4; ++m)
#pragma unroll
                    for (int n = 0; n < 2; ++n) acc[a][b][m][n] = (f32x4){0.f, 0.f, 0.f, 0.f};
        cur = nxt; cA = nA; cB = nB; ++ui;
        if (wr == 1) PG8_BAR;
    }
    PG8_WAIT_V(0);
    PG8_BAR;
#undef PG8_SA
#undef PG8_SB
#undef PG8_STAGE
#undef PG8_LDA
#undef PG8_LDB
#undef PG8_MMA
#undef PG8_WAIT_V
#undef PG8_WAIT_L
#undef PG8_BAR
#undef PG8_SCHED
}

struct SchedGrid {
    int nMa, nNa, nMb, nNb, total, G, c; const char* A; const char* B; int lda, ldb, a_div, a_cols;
    DI bool next(int i, Unit& u) const {
        const long L = (long)i * G + c; if (L >= total) return false;
        const int La = nMa * nNa; int pm, pn;
        if (L < La) { pm = (int)L / nNa; pn = (int)L % nNa; } else { const int r = (int)L - La; pm = nMa + r / nNb; pn = r % nNb; }
        u.pm = pm; u.pn = pn; u.A = A + ((size_t)pm * 256 * lda + (size_t)(pn / a_div) * a_cols) * 2; u.B = B + (size_t)pn * 256 * ldb * 2; return true;
    }
};
struct SchedMoE {
    int nN, total, G, c; const LAS int* pe; const char* A; const char* B; int lda, ldb; size_t estride;
    DI bool next(int i, Unit& u) const {
        const long L = (long)i * G + c; if (L >= total) return false;
        const int pm = (int)L / nN, pn = (int)L % nN; int e = 0;
#pragma unroll
        for (int j = 0; j < 7; ++j) e += (pe[j] <= pm * 256) ? 1 : 0;
        e = __builtin_amdgcn_readfirstlane(e);
        u.pm = pm; u.pn = pn; u.A = A + (size_t)pm * 256 * lda * 2; u.B = B + (size_t)e * estride + (size_t)pn * 256 * ldb * 2; return true;
    }
};

struct EpiInGate {
    bf16_t* PRJ; bf16_t* GT; const float* bg;
    DI void operator()(const f32x4 (&acc)[2][2][4][2], const Unit& u, int wr, int wc, int fr, int fq) const {
        const int row0 = u.pm * BM + wr * 64 + fr; const bool sg = u.pn >= 18;
        bf16_t* base = sg ? GT : PRJ; const int ldc = sg ? GTW : PRJW; const int col0 = (sg ? (u.pn - 18) : u.pn) * BM + wc * 32 + 8 * fq;
        f32x4 bv[2][2];
#pragma unroll
        for (int bj = 0; bj < 2; ++bj)
#pragma unroll
            for (int n = 0; n < 2; ++n) bv[bj][n] = sg ? *(const f32x4*)(bg + col0 + bj * HALF + 4 * n) : (f32x4){0.f, 0.f, 0.f, 0.f};
#pragma unroll
        for (int ai = 0; ai < 2; ++ai)
#pragma unroll
            for (int m = 0; m < 4; ++m) { bf16_t* rowp = base + (size_t)(row0 + ai * HALF + m * 16) * ldc + col0;
#pragma unroll
                for (int bj = 0; bj < 2; ++bj) { f32x4 v0 = acc[ai][bj][m][0] + bv[bj][0], v1 = acc[ai][bj][m][1] + bv[bj][1];
                    if (sg) { v0 = (f32x4){sigm(v0[0]), sigm(v0[1]), sigm(v0[2]), sigm(v0[3])}; v1 = (f32x4){sigm(v1[0]), sigm(v1[1]), sigm(v1[2]), sigm(v1[3])}; }
                    u32x4 w; w.x = pk2(v0[0], v0[1]); w.y = pk2(v0[2], v0[3]); w.z = pk2(v1[0], v1[1]); w.w = pk2(v1[2], v1[3]);
                    *(u32x4*)(rowp + bj * HALF) = w; } }
    }
};
struct EpiBranch {
    bf16_t* GT; const float* SSQ;
    DI void operator()(const f32x4 (&acc)[2][2][4][2], const Unit& u, int wr, int wc, int fr, int fq) const {
        const int row0 = u.pm * BM + wr * 64 + fr; const int col0 = u.pn * BM + wc * 32 + 8 * fq; const bool ssd = (u.pn >> 2) == 3;
#pragma unroll
        for (int ai = 0; ai < 2; ++ai)
#pragma unroll
            for (int m = 0; m < 4; ++m) { const int row = row0 + ai * HALF + m * 16; bf16_t* rowp = GT + (size_t)row * GTW + col0;
                float rs = 1.f;
                if (ssd) { const f32x4 s0 = *(const f32x4*)(SSQ + (size_t)row * 8), s1 = *(const f32x4*)(SSQ + (size_t)row * 8 + 4);
                    rs = __builtin_amdgcn_rsqf(((s0[0] + s0[1]) + (s0[2] + s0[3]) + (s1[0] + s1[1]) + (s1[2] + s1[3])) * (1.f / 512.f) + RMS_EPS); }
#pragma unroll
                for (int bj = 0; bj < 2; ++bj) { const u32x4 g = *(const u32x4*)(rowp + bj * HALF); const f32x4 a0 = acc[ai][bj][m][0] * rs, a1 = acc[ai][bj][m][1] * rs;
                    u32x4 w; w.x = pk2(bflo(g.x) * a0[0], bfhi(g.x) * a0[1]); w.y = pk2(bflo(g.y) * a0[2], bfhi(g.y) * a0[3]);
                    w.z = pk2(bflo(g.z) * a1[0], bfhi(g.z) * a1[1]); w.w = pk2(bflo(g.w) * a1[2], bfhi(g.w) * a1[3]);
                    *(u32x4*)(rowp + bj * HALF) = w; } }
    }
};
struct EpiResid {
    float* XS; const float* mv;
    DI void operator()(const f32x4 (&acc)[2][2][4][2], const Unit& u, int wr, int wc, int fr, int fq) const {
        const int row0 = u.pm * BM + wr * 64 + fr; const int col0 = u.pn * BM + wc * 32 + 8 * fq; const int v = u.pm < 128 ? (u.pm >> 5) : 4;
        const float* g = mv + (size_t)v * 6144 + col0;
        f32x4 gv[2][2];
#pragma unroll
        for (int bj = 0; bj < 2; ++bj)
#pragma unroll
            for (int n = 0; n < 2; ++n) gv[bj][n] = *(const f32x4*)(g + bj * HALF + 4 * n);
#pragma unroll
        for (int ai = 0; ai < 2; ++ai)
#pragma unroll
            for (int m = 0; m < 4; ++m) { float* rowp = XS + (size_t)(row0 + ai * HALF + m * 16) * DM + col0;
#pragma unroll
                for (int bj = 0; bj < 2; ++bj)
#pragma unroll
                    for (int n = 0; n < 2; ++n) { f32x4* p = (f32x4*)(rowp + bj * HALF + 4 * n); const f32x4 x = *p; *p = x * ALPHA + gv[bj][n] * acc[ai][bj][m][n]; } }
    }
};
struct EpiSwiGLU {
    bf16_t* HID; int ldc;
    DI void operator()(const f32x4 (&acc)[2][2][4][2], const Unit& u, int wr, int wc, int fr, int fq) const {
        const int row0 = u.pm * BM + wr * 64 + fr; const int col0 = u.pn * HALF + wc * 32 + 8 * fq;
#pragma unroll
        for (int ai = 0; ai < 2; ++ai)
#pragma unroll
            for (int m = 0; m < 4; ++m) { bf16_t* rowp = HID + (size_t)(row0 + ai * HALF + m * 16) * ldc + col0;
                const f32x4 g0 = acc[ai][0][m][0], g1 = acc[ai][0][m][1], u0 = acc[ai][1][m][0], u1 = acc[ai][1][m][1];
                u32x4 w; w.x = pk2(silu(g0[0]) * u0[0], silu(g0[1]) * u0[1]); w.y = pk2(silu(g0[2]) * u0[2], silu(g0[3]) * u0[3]);
                w.z = pk2(silu(g1[0]) * u1[0], silu(g1[1]) * u1[1]); w.w = pk2(silu(g1[2]) * u1[2], silu(g1[3]) * u1[3]);
                *(u32x4*)rowp = w; }
    }
};
struct EpiPlain {
    bf16_t* O; int ldc;
    DI void operator()(const f32x4 (&acc)[2][2][4][2], const Unit& u, int wr, int wc, int fr, int fq) const {
        const int row0 = u.pm * BM + wr * 64 + fr; const int col0 = u.pn * BM + wc * 32 + 8 * fq;
#pragma unroll
        for (int ai = 0; ai < 2; ++ai)
#pragma unroll
            for (int m = 0; m < 4; ++m) { bf16_t* rowp = O + (size_t)(row0 + ai * HALF + m * 16) * ldc + col0;
#pragma unroll
                for (int bj = 0; bj < 2; ++bj) { const f32x4 v0 = acc[ai][bj][m][0], v1 = acc[ai][bj][m][1];
                    u32x4 w; w.x = pk2(v0[0], v0[1]); w.y = pk2(v0[2], v0[3]); w.z = pk2(v1[0], v1[1]); w.w = pk2(v1[2], v1[3]);
                    *(u32x4*)(rowp + bj * HALF) = w; } }
    }
};
}

struct Args { const float* in[31]; float* out; unsigned char* ws; int ph_lo, ph_hi; };
enum { I_X = 0, I_C, I_CTX, I_CCTX, I_WMOD, I_BMOD, I_WIN, I_WGATE, I_BGATE, I_RPB, I_SINK, I_QGQ, I_QGK, I_CONVW, I_CONVB, I_DTB, I_ALOG, I_DSKIP, I_NORMG,
       I_WBR, I_WOUT, I_LN1G, I_LN1B, I_LN2G, I_LN2B, I_FUP, I_FDN, I_MRW, I_MRB, I_MUP, I_MDN };
struct Frame {
    LAS unsigned char* lds; gu32* ctl; int tid, lane, wave, vcu, G;
    const float* const* in; float* out; unsigned char* ws;
};
#define WSP(T, off) ((T*)(F.ws + (off)))
DI Frame launder(const Frame& F0) {
    Frame F = F0;
    asm volatile("" : "+v"(F.tid), "+v"(F.lane));
    asm volatile("" : "+s"(F.wave), "+s"(F.vcu), "+s"(F.ws));
    return F;
}

DI void transpose_item(const float* W, int ld, bf16_t* dst, int ldk, int koff, int map_h, int rowoff, int cscale, const float* kscale, LAS float* scr, int kb, int nb, int lane) {
    const int k0 = 64 * kb, n0 = 32 * nb;
#pragma unroll 8
    for (int i = 0; i < 32; ++i) { const int kk = 2 * i + (lane >> 5); scr[kk * 33 + (lane & 31)] = W[(size_t)(k0 + kk) * ld + n0 + (lane & 31)]; }
    asm volatile("s_waitcnt lgkmcnt(0)" ::: "memory");
    const int c = lane & 7;
    float ks[8];
#pragma unroll
    for (int e = 0; e < 8; ++e) ks[e] = kscale ? kscale[k0 + 8 * c + e] : 1.f;
#pragma unroll
    for (int j = 0; j < 4; ++j) { const int nl = (lane >> 3) + 8 * j, n = n0 + nl; const LAS float* s = scr + (8 * c) * 33 + nl;
        float cs = 1.f; if (cscale && (n < 512 || (n >= 1536 && n < 2048))) cs = C2;
        int drow;
        if (map_h == 0) drow = rowoff + n;
        else if (n < map_h) drow = rowoff + 256 * (n >> 7) + (n & 127);
        else { const int n2 = n - map_h; drow = rowoff + 256 * (n2 >> 7) + 128 + (n2 & 127); }
        u32x4 o; o.x = pk2(s[0 * 33] * ks[0] * cs, s[1 * 33] * ks[1] * cs); o.y = pk2(s[2 * 33] * ks[2] * cs, s[3 * 33] * ks[3] * cs);
        o.z = pk2(s[4 * 33] * ks[4] * cs, s[5 * 33] * ks[5] * cs); o.w = pk2(s[6 * 33] * ks[6] * cs, s[7 * 33] * ks[7] * cs);
        *(u32x4*)(dst + (size_t)drow * ldk + koff + k0 + 8 * c) = o; }
    asm volatile("s_waitcnt lgkmcnt(0)" ::: "memory");
}
struct CvtJob { const float* W; int K, N, ld; bf16_t* dst; int ldk, koff, map_h, rowoff, cscale; const float* kscale; };
DI void get_job(const Frame& F, int j, CvtJob& J) {
    J.koff = 0; J.map_h = 0; J.rowoff = 0; J.cscale = 0; J.kscale = nullptr;
    if (j < 52) {
        const int l = j / 13, r = j % 13;
        if (r == 0) { J.W = F.in[I_WIN] + (size_t)l * DM * DIN; J.K = DM; J.N = PRJW; J.ld = DIN; J.dst = WSP(bf16_t, WS_WCOMB + l * SZ_WCOMB); J.ldk = DM; J.cscale = 1; }
        else if (r < 5) { const int i = r - 1; J.W = F.in[I_WGATE] + ((size_t)l * 4 + i) * DM * DM; J.K = DM; J.N = DM; J.ld = DM; J.dst = WSP(bf16_t, WS_WCOMB + l * SZ_WCOMB); J.ldk = DM; J.rowoff = PRJW + 1024 * i; }
        else if (r < 9) { const int i = r - 5; J.W = F.in[I_WBR] + ((size_t)l * 4 + i) * 512 * DM; J.K = 512; J.N = DM; J.ld = DM; J.dst = WSP(bf16_t, WS_WB + l * SZ_WB); J.ldk = 512; J.rowoff = 1024 * i;
            if (i == 3) J.kscale = F.in[I_NORMG] + l * 512; }
        else { const int rep = r - 9; J.W = F.in[I_WOUT] + (size_t)l * DM * DM; J.K = DM; J.N = DM; J.ld = DM; J.dst = WSP(bf16_t, WS_WO + l * SZ_WO); J.ldk = 4096; J.koff = 1024 * rep; }
    } else if (j < 56) {
        const int i = (j - 52) >> 1;
        if (((j - 52) & 1) == 0) { J.W = F.in[I_FUP] + (size_t)i * DM * 2 * DFF; J.K = DM; J.N = 2 * DFF; J.ld = 2 * DFF; J.dst = WSP(bf16_t, WS_WUP + i * SZ_WUP); J.ldk = DM; J.map_h = DFF; }
        else { J.W = F.in[I_FDN] + (size_t)i * DFF * DM; J.K = DFF; J.N = DM; J.ld = DM; J.dst = WSP(bf16_t, WS_WDN + i * SZ_WDN); J.ldk = DFF; }
    } else {
        const int q = j - 56, ie = q >> 1, i = ie >> 3, e = ie & 7;
        if ((q & 1) == 0) { J.W = F.in[I_MUP] + ((size_t)i * NEXP + e) * DM * 2 * DFFE; J.K = DM; J.N = 2 * DFFE; J.ld = 2 * DFFE; J.dst = WSP(bf16_t, WS_MUP + i * SZ_MUP); J.ldk = DM; J.map_h = DFFE; J.rowoff = e * 2 * DFFE; }
        else { J.W = F.in[I_MDN] + ((size_t)i * NEXP + e) * DFFE * DM; J.K = DFFE; J.N = DM; J.ld = DM; J.dst = WSP(bf16_t, WS_MDN + i * SZ_MDN); J.ldk = DFFE; J.rowoff = e * DM; }
    }
}
constexpr int NJOBS = 52 + 4 + 32;

DI void phase_prologue_a(const Frame& F) {
    const int NGW = F.G * NWAVES, gw = F.vcu * NWAVES + F.wave;
    {
        LAS float* sv = (LAS float*)(F.lds + 73728);
        LAS float* red = (LAS float*)(F.lds + 73728 + 20480);
        for (int i = F.tid; i < 5 * 1024; i += NTHR) { const int v = i >> 10, k = i & 1023; const float c = v < 4 ? F.in[I_C][v * DM + k] : F.in[I_CCTX][k]; sv[i] = silu(c); }
        __syncthreads();
        float* MV = WSP(float, WS_MVEC);
        for (int item = F.vcu; item < 4 * 96; item += F.G) {
            const int l = item / 96, n0 = (item % 96) * 64, c = F.tid & 63, ks = F.tid >> 6;
            const float* w = F.in[I_WMOD] + (size_t)l * DM * 6144 + n0 + c;
            float a0 = 0.f, a1 = 0.f, a2 = 0.f, a3 = 0.f, a4 = 0.f;
#pragma unroll 8
            for (int k = ks * 128; k < ks * 128 + 128; ++k) { const float wv = w[(size_t)k * 6144]; a0 += sv[k] * wv; a1 += sv[1024 + k] * wv; a2 += sv[2048 + k] * wv; a3 += sv[3072 + k] * wv; a4 += sv[4096 + k] * wv; }
            red[(ks * 5 + 0) * 64 + c] = a0; red[(ks * 5 + 1) * 64 + c] = a1; red[(ks * 5 + 2) * 64 + c] = a2; red[(ks * 5 + 3) * 64 + c] = a3; red[(ks * 5 + 4) * 64 + c] = a4;
            __syncthreads();
            if (F.tid < 320) { const int v = F.tid >> 6, cc = F.tid & 63; float s = F.in[I_BMOD][l * 6144 + n0 + cc];
#pragma unroll
                for (int q = 0; q < 8; ++q) s += red[(q * 5 + v) * 64 + cc];
                MV[((size_t)l * 5 + v) * 6144 + n0 + cc] = s; }
            __syncthreads();
        }
    }
    {
        float* rc = WSP(float, WS_ROPE); float* rs = rc + SEQ * 32;
        for (int i = F.vcu * NTHR + F.tid; i < SEQ * 32; i += F.G * NTHR) {
            const int t = i >> 5, p = i & 31; const float pos = (p < 16) ? (float)(t >> 6) : (float)(t & 63);
            const float invf = exp2f(-(float)(p & 15) * (13.287712379549449f / 16.f));
            const float ang = pos * invf; const float rev = ang * 0.15915494309189535f; const float fr = rev - rintf(rev);
            rc[i] = __builtin_amdgcn_cosf(fr); rs[i] = __builtin_amdgcn_sinf(fr);
        }
    }
    {
        LAS float* scr = (LAS float*)(F.lds + F.wave * 8448);
        int base = 0;
        for (int j = 0; j < NJOBS; ++j) {
            CvtJob J; get_job(F, j, J);
            const int nblk = J.N / 32, nit = (J.K / 64) * nblk;
            int vid = (gw - base) % NGW; if (vid < 0) vid += NGW;
            for (int it = vid; it < nit; it += NGW) transpose_item(J.W, J.ld, J.dst, J.ldk, J.koff, J.map_h, J.rowoff, J.cscale, J.kscale, scr, it / nblk, it % nblk, F.lane);
            base = (base + nit) % NGW;
        }
    }
}

DI void load_wdt(const Frame& F, int l) {
    LAS float* wd = (LAS float*)F.lds; const float* w = F.in[I_WIN] + (size_t)l * DM * DIN + PRJW;
    for (int i = F.tid; i < DM * 16; i += NTHR) wd[i] = w[(size_t)(i >> 4) * DIN + (i & 15)];
}
DI void emit_h_dt(const Frame& F, const f32x4 (&xn)[4], const float* mv, int m, const float* dtb) {
    bf16_t* hb = WSP(bf16_t, WS_HB) + (size_t)m * DM; float* DT = WSP(float, WS_DT);
    const LAS float* wd = (const LAS float*)F.lds;
    float acc[16];
#pragma unroll
    for (int c = 0; c < 16; ++c) acc[c] = 0.f;
#pragma unroll
    for (int j = 0; j < 4; ++j) {
        const int k = 4 * F.lane + 256 * j;
        const f32x4 sh = *(const f32x4*)(mv + k), sc = *(const f32x4*)(mv + 1024 + k);
        const f32x4 h = xn[j] * (sc + 1.f) + sh;
        u32x2 w; w.x = pk2(h[0], h[1]); w.y = pk2(h[2], h[3]); *(u32x2*)(hb + k) = w;
#pragma unroll
        for (int e = 0; e < 4; ++e) {
            const LAS f32x4* wr = (const LAS f32x4*)(wd + (k + e) * 16);
#pragma unroll
            for (int q = 0; q < 4; ++q) { const f32x4 wv = wr[q]; acc[4 * q] += h[e] * wv[0]; acc[4 * q + 1] += h[e] * wv[1]; acc[4 * q + 2] += h[e] * wv[2]; acc[4 * q + 3] += h[e] * wv[3]; }
            asm volatile("" ::: "memory");
        }
    }
    const bool b0 = F.lane & 1, b1 = F.lane & 2, b2 = F.lane & 4, b3 = F.lane & 8;
    float t8[8], t4[4], t2[2], t1;
#pragma unroll
    for (int i = 0; i < 8; ++i) { const float keep = b0 ? acc[2 * i + 1] : acc[2 * i], give = b0 ? acc[2 * i] : acc[2 * i + 1]; t8[i] = keep + __shfl_xor(give, 1); }
#pragma unroll
    for (int i = 0; i < 4; ++i) { const float keep = b1 ? t8[2 * i + 1] : t8[2 * i], give = b1 ? t8[2 * i] : t8[2 * i + 1]; t4[i] = keep + __shfl_xor(give, 2); }
#pragma unroll
    for (int i = 0; i < 2; ++i) { const float keep = b2 ? t4[2 * i + 1] : t4[2 * i], give = b2 ? t4[2 * i] : t4[2 * i + 1]; t2[i] = keep + __shfl_xor(give, 4); }
    { const float keep = b3 ? t2[1] : t2[0], give = b3 ? t2[0] : t2[1]; t1 = keep + __shfl_xor(give, 8); }
    t1 += __shfl_xor(t1, 16); t1 += __shfl_xor(t1, 32);
    if (F.lane < 16) { const float x = t1 + dtb[F.lane]; DT[(size_t)m * 16 + F.lane] = x > 15.f ? x : log1pf(__expf(x)); }
}
DI void ln_rows(f32x4 (&v)[4], const float* g, const float* b, int lane) {
    float s = 0.f;
#pragma unroll
    for (int j = 0; j < 4; ++j) s += (v[j][0] + v[j][1]) + (v[j][2] + v[j][3]);
    const float mean = wave_sum(s) * (1.f / DM); float s2 = 0.f;
#pragma unroll
    for (int j = 0; j < 4; ++j) { v[j] = v[j] - mean; s2 += (v[j][0] * v[j][0] + v[j][1] * v[j][1]) + (v[j][2] * v[j][2] + v[j][3] * v[j][3]); }
    const float rstd = 1.f / sqrtf(wave_sum(s2) * (1.f / DM) + LN_EPS);
#pragma unroll
    for (int j = 0; j < 4; ++j) { const int k = 4 * lane + 256 * j; v[j] = v[j] * rstd * *(const f32x4*)(g + k) + *(const f32x4*)(b + k); }
}
DI void phase_prologue_b(const Frame& F) {
    load_wdt(F, 0); __syncthreads();
    const int NGW = F.G * NWAVES, gw = F.vcu * NWAVES + F.wave;
    float* XS = WSP(float, WS_XS); const float* MV = WSP(float, WS_MVEC);
    const float* dtb = F.in[I_DTB];
    for (int m = gw; m < MTOT; m += NGW) {
        const float* src = m < NLAT ? F.in[I_X] + (size_t)m * DM : F.in[I_CTX] + (size_t)(m - NLAT) * DM; const int v = m < NLAT ? (m >> 13) : 4;
        f32x4 x[4];
#pragma unroll
        for (int j = 0; j < 4; ++j) { x[j] = *(const f32x4*)(src + 4 * F.lane + 256 * j); *(f32x4*)(XS + (size_t)m * DM + 4 * F.lane + 256 * j) = x[j]; }
        emit_h_dt(F, x, MV + (size_t)v * 6144, m, dtb);
    }
}
DI void phase_ln1(const Frame& F, int l, int mrows) {
    const bool moe = l & 1; const int mi = l >> 1;
    LAS float* wrt = (LAS float*)F.lds;
    if (moe) { const float* w = F.in[I_MRW] + (size_t)mi * DM * 8; for (int i = F.tid; i < DM * 8; i += NTHR) wrt[i] = w[i]; __syncthreads(); }
    const int NGW = F.G * NWAVES, gw = F.vcu * NWAVES + F.wave;
    float* XS = WSP(float, WS_XS); const float* MV = WSP(float, WS_MVEC) + (size_t)l * 5 * 6144; bf16_t* HB = WSP(bf16_t, WS_HB);
    const float* g = F.in[I_LN1G] + l * DM; const float* b = F.in[I_LN1B] + l * DM;
    unsigned* SL = WSP(unsigned, WS_SLOT); unsigned* gcnt = (unsigned*)F.ctl + CW_MOECNT + mi * 1024;
    int cnt = 0, nst = 0; int me0 = 0, me1 = 0, mr0 = 0, mr1 = 0, mm = 0; float mg0 = 0.f, mg1 = 0.f;
    for (int m = gw; m < mrows; m += NGW) {
        const int v = m < NLAT ? (m >> 13) : 4;
        f32x4 x[4];
#pragma unroll
        for (int j = 0; j < 4; ++j) x[j] = *(const f32x4*)(XS + (size_t)m * DM + 4 * F.lane + 256 * j);
        ln_rows(x, g, b, F.lane);
        float acc[8];
#pragma unroll
        for (int c = 0; c < 8; ++c) acc[c] = 0.f;
        const float* mv = MV + (size_t)v * 6144;
#pragma unroll
        for (int j = 0; j < 4; ++j) {
            const int k = 4 * F.lane + 256 * j;
            *(f32x4*)(XS + (size_t)m * DM + k) = x[j];
            const f32x4 sh = *(const f32x4*)(mv + 3072 + k), sc = *(const f32x4*)(mv + 4096 + k);
            const f32x4 h = x[j] * (sc + 1.f) + sh;
            u32x2 w; w.x = pk2(h[0], h[1]); w.y = pk2(h[2], h[3]); *(u32x2*)(HB + (size_t)m * DM + k) = w;
            if (moe) {
#pragma unroll
                for (int e = 0; e < 4; ++e) { const LAS f32x4* wr = (const LAS f32x4*)(wrt + (k + e) * 8);
#pragma unroll
                    for (int q = 0; q < 2; ++q) { const f32x4 wv = wr[q]; acc[4 * q] += h[e] * wv[0]; acc[4 * q + 1] += h[e] * wv[1]; acc[4 * q + 2] += h[e] * wv[2]; acc[4 * q + 3] += h[e] * wv[3]; } }
            }
        }
        if (moe) {
            const bool b0 = F.lane & 1, b1 = F.lane & 2, b2 = F.lane & 4;
            float t4[4], t2[2], t1;
#pragma unroll
            for (int i = 0; i < 4; ++i) { const float keep = b0 ? acc[2 * i + 1] : acc[2 * i], give = b0 ? acc[2 * i] : acc[2 * i + 1]; t4[i] = keep + __shfl_xor(give, 1); }
#pragma unroll
            for (int i = 0; i < 2; ++i) { const float keep = b1 ? t4[2 * i + 1] : t4[2 * i], give = b1 ? t4[2 * i] : t4[2 * i + 1]; t2[i] = keep + __shfl_xor(give, 2); }
            { const float keep = b2 ? t2[1] : t2[0], give = b2 ? t2[0] : t2[1]; t1 = keep + __shfl_xor(give, 4); }
            t1 += __shfl_xor(t1, 8); t1 += __shfl_xor(t1, 16); t1 += __shfl_xor(t1, 32);
            t1 += F.in[I_MRB][mi * 8 + (F.lane & 7)];
            float lg[8];
#pragma unroll
            for (int e = 0; e < 8; ++e) lg[e] = __shfl(t1, e);
            int e0 = 0; float l0 = lg[0];
#pragma unroll
            for (int e = 1; e < 8; ++e) if (lg[e] > l0) { l0 = lg[e]; e0 = e; }
            int e1 = -1; float l1 = -3.0e38f;
#pragma unroll
            for (int e = 0; e < 8; ++e) if (e != e0 && lg[e] > l1) { l1 = lg[e]; e1 = e; }
            const float g1 = 1.f / (1.f + __expf(l0 - l1)), g0 = 1.f - g1;
            const int r0 = __shfl(cnt, e0); if (F.lane == e0) cnt++;
            const int r1 = __shfl(cnt, e1); if (F.lane == e1) cnt++;
            if (F.lane == nst) { me0 = e0; me1 = e1; mr0 = r0; mr1 = r1; mg0 = g0; mg1 = g1; mm = m; }
            ++nst;
        }
        if (moe && (nst == 64 || m + NGW >= mrows)) {
            unsigned base = 0u; if (F.lane < 8) base = __hip_atomic_fetch_add(gcnt + F.lane * 64, (unsigned)cnt, __ATOMIC_RELAXED, __HIP_MEMORY_SCOPE_AGENT);
            const unsigned p0 = __shfl(base, me0) + mr0, p1 = __shfl(base, me1) + mr1;
            if (F.lane < nst) { u32x4 a; a.x = me0; a.y = me1; a.z = p0; a.w = p1; *(u32x4*)(SL + (size_t)mm * 8) = a; u32x2 c; c.x = __float_as_uint(mg0); c.y = __float_as_uint(mg1); *(u32x2*)(SL + (size_t)mm * 8 + 4) = c; }
            cnt = 0; nst = 0;
        }
    }
}
DI void moe_pad_ends(const Frame& F, int mi, int (&pe)[8]) {
    unsigned* gcnt = (unsigned*)F.ctl + CW_MOECNT + mi * 1024; int run = 0;
#pragma unroll
    for (int e = 0; e < 8; ++e) { const int c = (int)__builtin_amdgcn_readfirstlane(__hip_atomic_load(gcnt + e * 64, __ATOMIC_RELAXED, __HIP_MEMORY_SCOPE_AGENT)); run += (c + 255) & ~255; pe[e] = run; }
}
DI int moe_pad_ends_lds(const Frame& F, int mi) {
    int pe[8]; moe_pad_ends(F, mi, pe);
    LAS int* d = (LAS int*)(F.lds + MISC_OFF + 64);
    __syncthreads();
    if (F.tid == 0) {
#pragma unroll
        for (int e = 0; e < 8; ++e) d[e] = pe[e];
    }
    __syncthreads();
    return pe[7];
}
DI void phase_gather(const Frame& F, int l, int mrows) {
    int pe[8]; moe_pad_ends(F, l >> 1, pe);
    const int NGW = F.G * NWAVES, gw = F.vcu * NWAVES + F.wave;
    unsigned* SL = WSP(unsigned, WS_SLOT); const bf16_t* HB = WSP(bf16_t, WS_HB); bf16_t* XP = WSP(bf16_t, WS_XPAD);
    for (int m = gw; m < mrows; m += NGW) {
        const u32x4 a = *(const u32x4*)(SL + (size_t)m * 8);
        int ps0 = 0, ps1 = 0;
#pragma unroll
        for (int e = 1; e < 8; ++e) { if ((int)a.x == e) ps0 = pe[e - 1]; if ((int)a.y == e) ps1 = pe[e - 1]; }
        const int d0 = ps0 + (int)a.z, d1 = ps1 + (int)a.w;
        const u32x4* src = (const u32x4*)(HB + (size_t)m * DM);
        const u32x4 v0 = src[F.lane], v1 = src[64 + F.lane];
        u32x4* q0 = (u32x4*)(XP + (size_t)d0 * DM); u32x4* q1 = (u32x4*)(XP + (size_t)d1 * DM);
        q0[F.lane] = v0; q0[64 + F.lane] = v1; q1[F.lane] = v0; q1[64 + F.lane] = v1;
        if (F.lane == 0) { u32x2 d; d.x = d0; d.y = d1; *(u32x2*)(SL + (size_t)m * 8 + 2) = d; }
    }
}
DI void phase_ln2(const Frame& F, int l, int mrows) {
    const bool moe = l & 1, lastl = (l == DEPTH - 1);
    if (!lastl) { load_wdt(F, l + 1); __syncthreads(); }
    const int NGW = F.G * NWAVES, gw = F.vcu * NWAVES + F.wave;
    float* XS = WSP(float, WS_XS); const float* MVl = WSP(float, WS_MVEC) + (size_t)l * 5 * 6144; const float* MVn = WSP(float, WS_MVEC) + (size_t)(l + 1) * 5 * 6144;
    const float* g = F.in[I_LN2G] + l * DM; const float* b = F.in[I_LN2B] + l * DM;
    const unsigned* SL = WSP(unsigned, WS_SLOT); const bf16_t* YP = WSP(bf16_t, WS_YPAD);
    const float* dtb = F.in[I_DTB] + (lastl ? 0 : (l + 1) * 16);
    for (int m = gw; m < mrows; m += NGW) {
        const int v = m < NLAT ? (m >> 13) : 4;
        f32x4 x[4];
#pragma unroll
        for (int j = 0; j < 4; ++j) x[j] = *(const f32x4*)(XS + (size_t)m * DM + 4 * F.lane + 256 * j);
        if (moe) {
            const u32x4 a = *(const u32x4*)(SL + (size_t)m * 8); const u32x2 gg = *(const u32x2*)(SL + (size_t)m * 8 + 4);
            const float g0 = __uint_as_float(gg.x), g1 = __uint_as_float(gg.y);
            const bf16_t* y0 = YP + (size_t)a.z * DM; const bf16_t* y1 = YP + (size_t)a.w * DM;
#pragma unroll
            for (int j = 0; j < 4; ++j) { const int k = 4 * F.lane + 256 * j; const u32x2 u0 = *(const u32x2*)(y0 + k), u1 = *(const u32x2*)(y1 + k);
                const f32x4 gt = *(const f32x4*)(MVl + (size_t)v * 6144 + 5120 + k);
                f32x4 f; f[0] = g0 * bflo(u0.x) + g1 * bflo(u1.x); f[1] = g0 * bfhi(u0.x) + g1 * bfhi(u1.x); f[2] = g0 * bflo(u0.y) + g1 * bflo(u1.y); f[3] = g0 * bfhi(u0.y) + g1 * bfhi(u1.y);
                if (ABL & 16) f = (f32x4){0.f, 0.f, 0.f, 0.f};
                x[j] = x[j] * ALPHA + gt * f; }
        }
        ln_rows(x, g, b, F.lane);
        if (lastl) {
#pragma unroll
            for (int j = 0; j < 4; ++j) *(f32x4*)(F.out + (size_t)m * DM + 4 * F.lane + 256 * j) = x[j];
        } else {
#pragma unroll
            for (int j = 0; j < 4; ++j) *(f32x4*)(XS + (size_t)m * DM + 4 * F.lane + 256 * j) = x[j];
            emit_h_dt(F, x, MVn + (size_t)v * 6144, m, dtb);
        }
    }
}

DI void phase_qkprep_rows(const Frame& F, int l) {
    const int NGW = F.G * NWAVES, gw = F.vcu * NWAVES + F.wave;
    bf16_t* PRJ = WSP(bf16_t, WS_PRJ); const float* rc = WSP(float, WS_ROPE); const float* rs = rc + SEQ * 32;
    const float* gq = F.in[I_QGQ] + l * 64; const float* gk = F.in[I_QGK] + l * 64;
    const int hs = F.lane >> 4, i2 = 2 * (F.lane & 15);
    for (int m = gw; m < MTOT; m += NGW) {
        const bool lat = m < NLAT; const int t = m & (SEQ - 1);
        float c0 = 1.f, c1 = 1.f, s0 = 0.f, s1 = 0.f;
        if (lat) { const f32x2 cc = *(const f32x2*)(rc + t * 32 + i2), ss = *(const f32x2*)(rs + t * 32 + i2); c0 = cc[0]; c1 = cc[1]; s0 = ss[0]; s1 = ss[1]; }
#pragma unroll
        for (int it = 0; it < 5; ++it) {
            const int hd = it * 4 + hs;
            const int col = hd < 8 ? C_SWQ + 64 * hd : hd < 10 ? C_SWK + 64 * (hd - 8) : hd < 18 ? C_GAQ + 64 * (hd - 10) : C_GAK + 64 * (hd - 18);
            bf16_t* p = PRJ + (size_t)m * PRJW + col + i2;
            const unsigned u1 = *(const unsigned*)p, u2 = *(const unsigned*)(p + 32);
            float a0 = bflo(u1), a1 = bfhi(u1), b0 = bflo(u2), b1 = bfhi(u2);
            if (hd >= 10) {
                float ss = a0 * a0 + a1 * a1 + b0 * b0 + b1 * b1;
                ss += __shfl_xor(ss, 1); ss += __shfl_xor(ss, 2); ss += __shfl_xor(ss, 4); ss += __shfl_xor(ss, 8);
                const float rn = 1.f / sqrtf(ss * (1.f / 64.f) + RMS_EPS); const float* gg = hd < 18 ? gq : gk; const float post = hd < 18 ? C2 : 1.f;
                a0 *= rn * gg[i2] * post; a1 *= rn * gg[i2 + 1] * post; b0 *= rn * gg[32 + i2] * post; b1 *= rn * gg[32 + i2 + 1] * post;
            }
            const float o0 = a0 * c0 - b0 * s0, o1 = a1 * c1 - b1 * s1, q0 = b0 * c0 + a0 * s0, q1 = b1 * c1 + a1 * s1;
            *(unsigned*)p = pk2(o0, o1); *(unsigned*)(p + 32) = pk2(q0, q1);
        }
    }
}

constexpr int AT_KVB = 18432, AT_VOFF = 9216, AT_RS = 144, AT_BIAS = 2 * AT_KVB;
DI void attn_unit(const Frame& F, int l, int mode, bool ctxq, int b, int hq, int qblk) {
    const int lane = F.lane, wid = F.wave, tid = F.tid, r = lane & 31, h = lane >> 5;
    const bf16_t* PRJ = WSP(bf16_t, WS_PRJ); bf16_t* OC = WSP(bf16_t, WS_OC);
    int qcol, kcol, vcol, ocol, kvh;
    if (mode == 0) { qcol = C_NAQ; kcol = C_NAK; vcol = C_NAV; ocol = 0; kvh = hq; }
    else if (mode == 1) { qcol = C_SWQ; kcol = C_SWK; vcol = C_SWV; ocol = 512; kvh = hq >> 2; }
    else { qcol = C_GAQ; kcol = C_GAK; vcol = C_GAV; ocol = 1024; kvh = hq >> 2; }
    const int qrow = ctxq ? (NLAT + b * CTXL + 32 * wid + r) : (b * SEQ + 256 * qblk + 32 * wid + r);
    bf16x8 qf[4];
    { const bf16_t* qp = PRJ + (size_t)qrow * PRJW + qcol + hq * 64 + 8 * h;
#pragma unroll
      for (int d0 = 0; d0 < 4; ++d0) qf[d0] = *(const bf16x8*)(qp + 16 * d0); }
    int tl_lo = 0, tl_hi = 0;
    if (!ctxq) {
        if (mode == 0) { tl_lo = clampi(4 * qblk - 4, 0, 120); tl_hi = clampi(4 * qblk - 1, 0, 120) + 8; }
        else if (mode == 1) { tl_lo = 4 * qblk - 2 < 0 ? 0 : 4 * qblk - 2; tl_hi = 4 * qblk + 6 > 128 ? 128 : 4 * qblk + 6; }
        else { tl_lo = 0; tl_hi = 128; }
    }
    const int ntile = 4 + (tl_hi - tl_lo);
    LAS float* biasT = (LAS float*)(F.lds + AT_BIAS);
    __syncthreads();
    if (mode == 0 && !ctxq) { const float* rp = F.in[I_RPB] + ((size_t)l * 8 + hq) * 465; for (int i = tid; i < 465; i += NTHR) biasT[i] = rp[i] * LOG2E; }
    const int lr = tid >> 3, ch = tid & 7;
    const size_t ctxbase = (size_t)(NLAT + b * CTXL), latbase = (size_t)b * SEQ;
    u32x4 kreg, vreg;
#define AT_LOAD(it) do { const size_t rb_ = ((it) < 4 ? ctxbase + 64 * (it) : latbase + 64 * (tl_lo + (it) - 4)) + lr; const bf16_t* rp_ = PRJ + rb_ * PRJW + kvh * 64 + ch * 8; \
        kreg = *(const u32x4*)(rp_ + kcol); vreg = *(const u32x4*)(rp_ + vcol); } while (0)
#define AT_STORE(buf) do { LAS unsigned char* d_ = F.lds + (buf) * AT_KVB + lr * AT_RS + ch * 16; *(LAS u32x4*)d_ = kreg; *(LAS u32x4*)(d_ + AT_VOFF) = vreg; } while (0)
    AT_LOAD(0); AT_STORE(0);
    __syncthreads();
    float mrun = -1e30f, lrun = 0.f;
    if (mode == 1) { mrun = F.in[I_SINK][l * 8 + hq] * LOG2E; lrun = (h == 0) ? 1.f : 0.f; }
    f32x16 o0, o1;
#pragma unroll
    for (int i = 0; i < 16; ++i) { o0[i] = 0.f; o1[i] = 0.f; }
    const int q4 = (lane & 15) >> 2, p4 = lane & 3, blk = (lane >> 4) & 1;
    const int tq = 256 * qblk + 32 * wid + r;
    const int gr = 4 * qblk + (wid >> 1), qc = 32 * (wid & 1) + r, cs = clampi(qc - 8, 0, 48), rsw = clampi(gr - 4, 0, 120);
    for (int it = 0; it < ntile; ++it) {
        const int buf = it & 1;
        if (it + 1 < ntile) AT_LOAD(it + 1);
        const int g = tl_lo + it - 4;
        bool rel = true;
        if (it >= 4) { if (mode == 0) rel = (g >= rsw && g < rsw + 8); else if (mode == 1) rel = (64 * g + 63 >= 256 * qblk + 32 * wid - 128) && (64 * g <= 256 * qblk + 32 * wid + 31 + 128); }
        if (rel) {
            const LAS unsigned char* Kb = F.lds + buf * AT_KVB; const LAS unsigned char* Vb = Kb + AT_VOFF;
            f32x16 p0, p1;
#pragma unroll
            for (int i = 0; i < 16; ++i) { p0[i] = 0.f; p1[i] = 0.f; }
#pragma unroll
            for (int d0 = 0; d0 < 4; ++d0) {
                const bf16x8 k0 = *(const LAS bf16x8*)(Kb + r * AT_RS + (16 * d0 + 8 * h) * 2);
                const bf16x8 k1 = *(const LAS bf16x8*)(Kb + (32 + r) * AT_RS + (16 * d0 + 8 * h) * 2);
                p0 = MFMA32(k0, qf[d0], p0); p1 = MFMA32(k1, qf[d0], p1);
            }
            if (it >= 4 && mode == 0) {
                const LAS float* bt = biasT + (g - gr + 7) * 31 + 15 - qc;
#pragma unroll
                for (int i = 0; i < 16; ++i) { const int k0 = crow(i, h), k1 = k0 + 32;
                    p0[i] = (k0 >= cs && k0 < cs + 16) ? p0[i] + bt[k0] : -INFINITY; p1[i] = (k1 >= cs && k1 < cs + 16) ? p1[i] + bt[k1] : -INFINITY; }
            } else if (it >= 4 && mode == 1) {
                const int d0 = 64 * g - tq;
#pragma unroll
                for (int i = 0; i < 16; ++i) { const int dd = d0 + crow(i, h);
                    if (dd > 128 || dd < -128) p0[i] = -INFINITY; if (dd + 32 > 128 || dd + 32 < -128) p1[i] = -INFINITY; }
            }
            float mx = p0[0];
#pragma unroll
            for (int i = 1; i < 16; ++i) mx = fmaxf(mx, p0[i]);
#pragma unroll
            for (int i = 0; i < 16; ++i) mx = fmaxf(mx, p1[i]);
            mx = fmaxf(mx, __shfl_xor(mx, 32));
            const float mnew = fmaxf(mrun, mx), alpha = __builtin_amdgcn_exp2f(mrun - mnew); mrun = mnew;
            float ls = 0.f;
#pragma unroll
            for (int i = 0; i < 16; ++i) { p0[i] = __builtin_amdgcn_exp2f(p0[i] - mnew); p1[i] = __builtin_amdgcn_exp2f(p1[i] - mnew); ls += p0[i] + p1[i]; }
            lrun = lrun * alpha + ls;
#pragma unroll
            for (int i = 0; i < 16; ++i) { o0[i] *= alpha; o1[i] *= alpha; }
            bf16x8 pa[4]; pa[0] = pack8<0>(p0); pa[1] = pack8<1>(p0); pa[2] = pack8<0>(p1); pa[3] = pack8<1>(p1);
            const LAS unsigned char* va = Vb + (4 * h + q4) * AT_RS + (16 * blk + 4 * p4) * 2;
#pragma unroll
            for (int ks = 0; ks < 4; ++ks) {
                const bf16x8 v0 = cat8(tr_read(va + (16 * ks) * AT_RS), tr_read(va + (16 * ks + 8) * AT_RS));
                const bf16x8 v1 = cat8(tr_read(va + (16 * ks) * AT_RS + 64), tr_read(va + (16 * ks + 8) * AT_RS + 64));
                o0 = MFMA32(v0, pa[ks], o0); o1 = MFMA32(v1, pa[ks], o1);
            }
        }
        if (it + 1 < ntile) AT_STORE(buf ^ 1);
        __syncthreads();
    }
#undef AT_LOAD
#undef AT_STORE
    const float lt = lrun + __shfl_xor(lrun, 32), inv = 1.f / lt;
    bf16_t* op = OC + (size_t)qrow * OCW + ocol + hq * 64 + 4 * h;
#pragma unroll
    for (int g4 = 0; g4 < 4; ++g4) {
        u32x2 w; w.x = pk2(o0[4 * g4] * inv, o0[4 * g4 + 1] * inv); w.y = pk2(o0[4 * g4 + 2] * inv, o0[4 * g4 + 3] * inv); *(u32x2*)(op + 8 * g4) = w;
        u32x2 w2; w2.x = pk2(o1[4 * g4] * inv, o1[4 * g4 + 1] * inv); w2.y = pk2(o1[4 * g4 + 2] * inv, o1[4 * g4 + 3] * inv); *(u32x2*)(op + 32 + 8 * g4) = w2;
    }
}

constexpr int SD_CUM = 0, SD_DTV = 1024, SD_XC = 2048, SD_XCS = 144, SD_BC = SD_XC + 128 * SD_XCS, SD_BCS = 272, SD_CC = SD_BC + 128 * SD_BCS, SD_HS = SD_CC + 128 * SD_BCS,
              SD_SSQ = SD_HS + 2 * 64 * SD_BCS, SD_XW = SD_CC;
static_assert(SD_SSQ + 1024 <= RING_BYTES && SD_XW + 2 * 128 * SD_XCS <= RING_BYTES, "SSD LDS map");
DI int chunk_row(int b, int cidx) { return cidx < 2 ? NLAT + b * CTXL + 128 * cidx : b * SEQ + 128 * (cidx - 2); }
DI void ssd_cum(const Frame& F, int l, int b, int cidx, int hd) {
    if (F.wave < 2) {
        const int dir = F.wave; const float* DT = WSP(float, WS_DT) + (size_t)chunk_row(b, cidx) * 16 + dir * 8 + hd;
        const float a = -__expf(F.in[I_ALOG][l * 16 + dir * 8 + hd]);
        const float d0 = DT[(size_t)(2 * F.lane) * 16], d1 = DT[(size_t)(2 * F.lane + 1) * 16];
        const float a0 = d0 * a, a1 = d1 * a, s = a0 + a1; float v = s;
        LAS float* cum = (LAS float*)(F.lds + SD_CUM) + dir * 128; LAS float* dtv = (LAS float*)(F.lds + SD_DTV) + dir * 128;
        if (dir == 0) {
#pragma unroll
            for (int o = 1; o < 64; o <<= 1) { const float t = __shfl_up(v, o); if (F.lane >= o) v += t; }
            cum[2 * F.lane] = v - s + a0; cum[2 * F.lane + 1] = v;
        } else {
#pragma unroll
            for (int o = 1; o < 64; o <<= 1) { const float t = __shfl_down(v, o); if (F.lane + o < 64) v += t; }
            cum[2 * F.lane + 1] = v - s + a1; cum[2 * F.lane] = v;
        }
        dtv[2 * F.lane] = d0; dtv[2 * F.lane + 1] = d1;
    }
}
DI void conv_tile(const Frame& F, int l, LAS unsigned char* dst, int dstride, int ch0, int nchunks, int rowbase, int seqlo, int seqhi) {
    const bf16_t* PRJ = WSP(bf16_t, WS_PRJ); const float* cw = F.in[I_CONVW] + (size_t)l * 5 * 1024; const float* cb = F.in[I_CONVB] + l * 1024;
    for (int item = F.tid; item < nchunks * 16; item += NTHR) {
        const int chunk = item % nchunks, seg = item / nchunks, t0 = seg * 8, c0 = ch0 + chunk * 8;
        float w[5][8], bb[8];
#pragma unroll
        for (int k = 0; k < 5; ++k) { const f32x4 wa = *(const f32x4*)(cw + k * 1024 + c0), wb = *(const f32x4*)(cw + k * 1024 + c0 + 4);
            w[k][0] = wa[0]; w[k][1] = wa[1]; w[k][2] = wa[2]; w[k][3] = wa[3]; w[k][4] = wb[0]; w[k][5] = wb[1]; w[k][6] = wb[2]; w[k][7] = wb[3]; }
        { const f32x4 ba = *(const f32x4*)(cb + c0), b2 = *(const f32x4*)(cb + c0 + 4); bb[0] = ba[0]; bb[1] = ba[1]; bb[2] = ba[2]; bb[3] = ba[3]; bb[4] = b2[0]; bb[5] = b2[1]; bb[6] = b2[2]; bb[7] = b2[3]; }
        u32x4 rows[12];
#pragma unroll
        for (int i = 0; i < 12; ++i) { const int row = rowbase + t0 - 2 + i;
            rows[i] = (row >= seqlo && row < seqhi) ? *(const u32x4*)(PRJ + (size_t)row * PRJW + C_XBC + c0) : (u32x4){0u, 0u, 0u, 0u}; }
#pragma unroll
        for (int j = 0; j < 8; ++j) {
            float y[8];
#pragma unroll
            for (int e = 0; e < 8; ++e) y[e] = bb[e];
#pragma unroll
            for (int k = 0; k < 5; ++k) { const u32x4 rr = rows[j + k];
                y[0] += w[k][0] * bflo(rr.x); y[1] += w[k][1] * bfhi(rr.x); y[2] += w[k][2] * bflo(rr.y); y[3] += w[k][3] * bfhi(rr.y);
                y[4] += w[k][4] * bflo(rr.z); y[5] += w[k][5] * bfhi(rr.z); y[6] += w[k][6] * bflo(rr.w); y[7] += w[k][7] * bfhi(rr.w); }
            u32x4 o; o.x = pk2(silu(y[0]), silu(y[1])); o.y = pk2(silu(y[2]), silu(y[3])); o.z = pk2(silu(y[4]), silu(y[5])); o.w = pk2(silu(y[6]), silu(y[7]));
            *(LAS u32x4*)(dst + (t0 + j) * dstride + chunk * 16) = o;
        }
    }
}
DI void ssd_s1_unit(const Frame& F, int l, int b, int cidx, int hd) {
    const int lane = F.lane, wid = F.wave, r = lane & 31, h = lane >> 5;
    const int rowbase = chunk_row(b, cidx), seqlo = cidx < 2 ? NLAT + b * CTXL : b * SEQ, seqhi = cidx < 2 ? seqlo + CTXL : seqlo + SEQ;
    __syncthreads();
    ssd_cum(F, l, b, cidx, hd);
    conv_tile(F, l, F.lds + SD_XC, SD_XCS, 64 * hd, 8, rowbase, seqlo, seqhi);
    conv_tile(F, l, F.lds + SD_BC, SD_BCS, 512 + 128 * (hd >> 2), 16, rowbase, seqlo, seqhi);
    __syncthreads();
    const LAS float* cum = (const LAS float*)(F.lds + SD_CUM); const LAS float* dtv = (const LAS float*)(F.lds + SD_DTV);
    for (int i = F.tid; i < 2 * 128 * 8; i += NTHR) {
        const int dir = i >> 10, t = (i >> 3) & 127, c8 = i & 7;
        const float ce = dir == 0 ? cum[127] : cum[128]; const float wgt = dtv[dir * 128 + t] * __expf(ce - cum[dir * 128 + t]);
        const u32x4 x = *(const LAS u32x4*)(F.lds + SD_XC + t * SD_XCS + c8 * 16);
        u32x4 o; o.x = pk2(bflo(x.x) * wgt, bfhi(x.x) * wgt); o.y = pk2(bflo(x.y) * wgt, bfhi(x.y) * wgt); o.z = pk2(bflo(x.z) * wgt, bfhi(x.z) * wgt); o.w = pk2(bflo(x.w) * wgt, bfhi(x.w) * wgt);
        *(LAS u32x4*)(F.lds + SD_XW + (dir * 128 + t) * SD_XCS + c8 * 16) = o;
    }
    __syncthreads();
    const int dir = wid >> 2, nb = wid & 3, q4 = (lane & 15) >> 2, p4 = lane & 3, blk = (lane >> 4) & 1;
    f32x16 s0, s1;
#pragma unroll
    for (int i = 0; i < 16; ++i) { s0[i] = 0.f; s1[i] = 0.f; }
    const LAS unsigned char* xa = F.lds + SD_XW + (dir * 128 + 8 * h + q4) * SD_XCS + (16 * blk + 4 * p4) * 2;
    const LAS unsigned char* ba = F.lds + SD_BC + (8 * h + q4) * SD_BCS + (32 * nb + 16 * blk + 4 * p4) * 2;
#pragma unroll
    for (int ks = 0; ks < 8; ++ks) {
        const bf16x8 bfr = cat8(tr_read(ba + (16 * ks) * SD_BCS), tr_read(ba + (16 * ks + 4) * SD_BCS));
        const bf16x8 x0 = cat8(tr_read(xa + (16 * ks) * SD_XCS), tr_read(xa + (16 * ks + 4) * SD_XCS));
        const bf16x8 x1 = cat8(tr_read(xa + (16 * ks) * SD_XCS + 64), tr_read(xa + (16 * ks + 4) * SD_XCS + 64));
        s0 = MFMA32(x0, bfr, s0); s1 = MFMA32(x1, bfr, s1);
    }
    float* ST = WSP(float, WS_ST) + ((((size_t)b * NCH + cidx) * 8 + hd) * 2 + dir) * 8192 + 32 * nb + r;
#pragma unroll
    for (int i = 0; i < 16; ++i) { ST[(size_t)crow(i, h) * 128] = s0[i]; ST[(size_t)(32 + crow(i, h)) * 128] = s1[i]; }
    if (F.tid < 2) WSP(float, WS_CDEC)[(((size_t)b * NCH + cidx) * 8 + hd) * 2 + F.tid] = __expf(F.tid == 0 ? cum[127] : cum[128]);
}
DI void phase_scan(const Frame& F) {
    float* ST = WSP(float, WS_ST); const float* CD = WSP(float, WS_CDEC);
    for (int gid = F.vcu * NTHR + F.tid; gid < 64 * 2048; gid += F.G * NTHR) {
        const int chain = gid >> 11, e4 = gid & 2047, b = chain >> 4, hd = (chain >> 1) & 7, dir = chain & 1;
        f32x4 hst = (f32x4){0.f, 0.f, 0.f, 0.f};
#pragma unroll 6
        for (int k = 0; k < NCH; ++k) {
            const int cidx = dir == 0 ? k : (k < 2 ? 1 - k : 67 - k);
            const size_t idx = (((size_t)b * NCH + cidx) * 8 + hd) * 2 + dir;
            f32x4* p = (f32x4*)(ST + idx * 8192) + e4; const f32x4 st = *p; const float dec = CD[idx];
            *p = hst; hst = hst * dec + st;
        }
    }
}
DI void ssd_s3_unit(const Frame& F, int l, int b, int cidx, int hd) {
    const int lane = F.lane, wid = F.wave, r = lane & 31, h = lane >> 5;
    const int rowbase = chunk_row(b, cidx), seqlo = cidx < 2 ? NLAT + b * CTXL : b * SEQ, seqhi = cidx < 2 ? seqlo + CTXL : seqlo + SEQ;
    __syncthreads();
    ssd_cum(F, l, b, cidx, hd);
    conv_tile(F, l, F.lds + SD_XC, SD_XCS, 64 * hd, 8, rowbase, seqlo, seqhi);
    conv_tile(F, l, F.lds + SD_BC, SD_BCS, 512 + 128 * (hd >> 2), 16, rowbase, seqlo, seqhi);
    conv_tile(F, l, F.lds + SD_CC, SD_BCS, 768 + 128 * (hd >> 2), 16, rowbase, seqlo, seqhi);
    {
        const float* ST = WSP(float, WS_ST) + (((size_t)b * NCH + cidx) * 8 + hd) * 2 * 8192;
        for (int i = F.tid; i < 2 * 64 * 16; i += NTHR) { const int dp = i >> 4, c8 = i & 15; const f32x4 a = *(const f32x4*)(ST + (size_t)dp * 128 + c8 * 8), c = *(const f32x4*)(ST + (size_t)dp * 128 + c8 * 8 + 4);
            u32x4 o; o.x = pk2(a[0], a[1]); o.y = pk2(a[2], a[3]); o.z = pk2(c[0], c[1]); o.w = pk2(c[2], c[3]); *(LAS u32x4*)(F.lds + SD_HS + dp * SD_BCS + c8 * 16) = o; }
    }
    __syncthreads();
    const LAS float* cum = (const LAS float*)(F.lds + SD_CUM); const LAS float* dtv = (const LAS float*)(F.lds + SD_DTV);
    const int lb = wid & 3, ph = wid >> 2, q4 = (lane & 15) >> 2, p4 = lane & 3, blk = (lane >> 4) & 1;
    const int lidx = 32 * lb + r;
    bf16x8 cf[8];
#pragma unroll
    for (int ks = 0; ks < 8; ++ks) cf[ks] = *(const LAS bf16x8*)(F.lds + SD_CC + lidx * SD_BCS + (16 * ks + 8 * h) * 2);
    f32x16 gt[4];
#pragma unroll
    for (int sb = 0; sb < 4; ++sb) {
#pragma unroll
        for (int i = 0; i < 16; ++i) gt[sb][i] = 0.f;
#pragma unroll
        for (int ks = 0; ks < 8; ++ks) { const bf16x8 bfr = *(const LAS bf16x8*)(F.lds + SD_BC + (32 * sb + r) * SD_BCS + (16 * ks + 8 * h) * 2); gt[sb] = MFMA32(bfr, cf[ks], gt[sb]); }
    }
    f32x16 ytot;
#pragma unroll
    for (int i = 0; i < 16; ++i) ytot[i] = 0.f;
    const LAS unsigned char* xa = F.lds + SD_XC + (4 * h + q4) * SD_XCS + (32 * ph + 16 * blk + 4 * p4) * 2;
#pragma unroll
    for (int dir = 0; dir < 2; ++dir) {
        const float cl = cum[dir * 128 + lidx];
        f32x16 acc;
#pragma unroll
        for (int i = 0; i < 16; ++i) acc[i] = 0.f;
#pragma unroll
        for (int sb = 0; sb < 4; ++sb) {
            const bool relv = dir == 0 ? (sb <= lb) : (sb >= lb);
            if (relv) {
                f32x16 mt;
#pragma unroll
                for (int i = 0; i < 16; ++i) { const int sl = crow(i, h), s = 32 * sb + sl;
                    const bool ok = (sb != lb) || (dir == 0 ? (sl <= r) : (sl >= r));
                    const float e = __expf(cl - cum[dir * 128 + s]) * dtv[dir * 128 + s];
                    mt[i] = ok ? gt[sb][i] * e : 0.f; }
                const bf16x8 pa0 = pack8<0>(mt), pa1 = pack8<1>(mt);
                const bf16x8 x0 = cat8(tr_read(xa + (32 * sb) * SD_XCS), tr_read(xa + (32 * sb + 8) * SD_XCS));
                const bf16x8 x1 = cat8(tr_read(xa + (32 * sb + 16) * SD_XCS), tr_read(xa + (32 * sb + 24) * SD_XCS));
                acc = MFMA32(x0, pa0, acc); acc = MFMA32(x1, pa1, acc);
            }
        }
        f32x16 yo;
#pragma unroll
        for (int i = 0; i < 16; ++i) yo[i] = 0.f;
#pragma unroll
        for (int ks = 0; ks < 8; ++ks) { const bf16x8 hf = *(const LAS bf16x8*)(F.lds + SD_HS + (dir * 64 + 32 * ph + r) * SD_BCS + (16 * ks + 8 * h) * 2); yo = MFMA32(hf, cf[ks], yo); }
        const float el = __expf(cl);
#pragma unroll
        for (int i = 0; i < 16; ++i) ytot[i] += acc[i] + el * yo[i];
    }
    const float dsk = F.in[I_DSKIP][l * 8 + hd];
    const int row = rowbase + lidx;
    const bf16_t* zp = WSP(bf16_t, WS_PRJ) + (size_t)row * PRJW + C_Z + 64 * hd + 32 * ph + 4 * h;
    bf16_t* op = WSP(bf16_t, WS_OC) + (size_t)row * OCW + 1536 + 64 * hd + 32 * ph + 4 * h;
    float ss = 0.f;
#pragma unroll
    for (int g4 = 0; g4 < 4; ++g4) {
        const u32x2 zz = *(const u32x2*)(zp + 8 * g4);
        const u32x2 xx = *(const LAS u32x2*)(F.lds + SD_XC + lidx * SD_XCS + (32 * ph + 8 * g4 + 4 * h) * 2);
        const float v0 = (ytot[4 * g4] + dsk * bflo(xx.x)) * silu(bflo(zz.x)), v1 = (ytot[4 * g4 + 1] + dsk * bfhi(xx.x)) * silu(bfhi(zz.x));
        const float v2 = (ytot[4 * g4 + 2] + dsk * bflo(xx.y)) * silu(bflo(zz.y)), v3 = (ytot[4 * g4 + 3] + dsk * bfhi(xx.y)) * silu(bfhi(zz.y));
        ss += (v0 * v0 + v1 * v1) + (v2 * v2 + v3 * v3);
        u32x2 w; w.x = pk2(v0, v1); w.y = pk2(v2, v3); *(u32x2*)(op + 8 * g4) = w;
    }
    ss += __shfl_xor(ss, 32);
    LAS float* sq = (LAS float*)(F.lds + SD_SSQ);
    if (h == 0) sq[ph * 128 + lidx] = ss;
    __syncthreads();
    if (F.tid < 128) WSP(float, WS_SSQ)[(size_t)(rowbase + F.tid) * 8 + hd] = sq[F.tid] + sq[128 + F.tid];
}

constexpr int PH_PER_LAYER = 11, N_PHASES = 2 + PH_PER_LAYER * DEPTH;
__global__ void __launch_bounds__(NTHR, 2) fwd_kernel(Args args) {
    extern __shared__ __attribute__((aligned(16))) unsigned char smem[];
    Frame F0;
    F0.lds = (LAS unsigned char*)smem;
    F0.tid = threadIdx.x; F0.lane = F0.tid & 63; F0.wave = __builtin_amdgcn_readfirstlane(F0.tid >> 6);
    F0.G = gridDim.x; { const int bx = blockIdx.x; F0.vcu = (F0.G % 8 == 0) ? (bx % 8) * (F0.G / 8) + bx / 8 : bx; }
    F0.in = args.in; F0.out = args.out; F0.ws = args.ws; F0.ctl = (gu32*)(args.ws + WS_CTL);
    volatile LAS unsigned* MISC = (volatile LAS unsigned*)(F0.lds + MISC_OFF);
    for (int u = F0.tid; u < (LDS_BYTES - RING_BYTES) / 4; u += NTHR) ((LAS unsigned*)(F0.lds + RING_BYTES))[u] = 0u;
    __syncthreads();
    XcdBarrier bar; bar.bar = (unsigned*)(F0.ctl + CW_BAR); bar.x = 0; bar.st = nullptr;
    if (!MK_PER_PHASE) bar = xcd_barrier_post((unsigned*)(F0.ctl + CW_BAR), MISC + 8);
    const int lo = args.ph_lo, hi = args.ph_hi;
#define IN(k) (lo <= (k) && (k) < hi)
#define SEAM(k) do { if (IN(k) && IN((k) + 1)) { if (MK_PER_PHASE) { if (F0.tid == 0) __hip_atomic_store(F0.ctl + 0, 0xBADBA0u, __ATOMIC_RELAXED, __HIP_MEMORY_SCOPE_AGENT); } else xcd_barrier(bar); } } while (0)

    if (PHM(11) && IN(0)) { const Frame F = launder(F0); phase_prologue_a(F); } SEAM(0);
    if (PHM(12) && IN(1)) { const Frame F = launder(F0); phase_prologue_b(F); } SEAM(1);

    for (int l = 0; l < DEPTH; ++l) {
        const int pb = 2 + PH_PER_LAYER * l;
        const bool with_ctx = l < DEPTH - 1, moe = l & 1; const int fi = l >> 1;
        const int mrows = with_ctx ? MTOT : NLAT, mtiles = with_ctx ? 132 : 128;
        if (PHM(0) && IN(pb + 0)) { const Frame F = launder(F0);
            pg8::SchedGrid S; S.nMa = mtiles; S.nNa = 34; S.nMb = with_ctx ? 0 : 4; S.nNb = 18; S.total = S.nMa * S.nNa + S.nMb * S.nNb; S.G = F.G; S.c = F.vcu;
            S.A = (const char*)(F.ws + WS_HB); S.B = (const char*)(F.ws + WS_WCOMB + l * SZ_WCOMB); S.lda = DM; S.ldb = DM; S.a_div = 1; S.a_cols = 0;
            pg8::EpiInGate E{WSP(bf16_t, WS_PRJ), WSP(bf16_t, WS_GT), F.in[I_BGATE] + (size_t)l * 4096};
            pg8::gemm_phase(F.lds, F.tid, DM, DM, DM, S, E);
        }
        SEAM(pb + 0);
        if (PHM(1) && IN(pb + 1)) { const Frame F = launder(F0);
            phase_qkprep_rows(F, l);
            for (int u = F.vcu; u < NB * NCH * 8; u += F.G) { const int hd = u & 7, cidx = (u >> 3) % NCH, b = (u >> 3) / NCH; ssd_s1_unit(F, l, b, cidx, hd); }
        }
        SEAM(pb + 1);
        if (PHM(2) && IN(pb + 2)) { const Frame F = launder(F0); phase_scan(F); }
        SEAM(pb + 2);
        if (PHM(3) && IN(pb + 3)) { const Frame F = launder(F0);
            const int nchs = with_ctx ? NCH : NCH - 2, n_s3 = NB * nchs * 8, n_cx = with_ctx ? 96 : 0, total = 3072 + n_s3 + n_cx;
            for (int u = F.vcu; u < total; u += F.G) {
                if (u < 1024) { const int qblk = u & 31, hg = (u >> 5) & 3, kvh = (u >> 7) & 1, b = u >> 8; attn_unit(F, l, 2, false, b, kvh * 4 + hg, qblk); }
                else if (u < 2048) { const int v = u - 1024, qblk = v & 31, hq = (v >> 5) & 7, b = v >> 8; attn_unit(F, l, 0, false, b, hq, qblk); }
                else if (u < 3072) { const int v = u - 2048, qblk = v & 31, hg = (v >> 5) & 3, kvh = (v >> 7) & 1, b = v >> 8; attn_unit(F, l, 1, false, b, kvh * 4 + hg, qblk); }
                else if (u < 3072 + n_s3) { const int v = u - 3072, hd = v & 7, cc = (v >> 3) % nchs, b = (v >> 3) / nchs; ssd_s3_unit(F, l, b, with_ctx ? cc : cc + 2, hd); }
                else { const int v = u - 3072 - n_s3, mode = v >> 5, b = (v >> 3) & 3, hq = v & 7; attn_unit(F, l, mode, true, b, hq, 0); }
            }
        }
        SEAM(pb + 3);
        if (PHM(4) && IN(pb + 4)) { const Frame F = launder(F0);
            pg8::SchedGrid S; S.nMa = mtiles; S.nNa = 16; S.nMb = 0; S.nNb = 1; S.total = S.nMa * S.nNa; S.G = F.G; S.c = F.vcu;
            S.A = (const char*)(F.ws + WS_OC); S.B = (const char*)(F.ws + WS_WB + l * SZ_WB); S.lda = OCW; S.ldb = 512; S.a_div = 4; S.a_cols = 512;
            pg8::EpiBranch E{WSP(bf16_t, WS_GT), WSP(float, WS_SSQ)};
            pg8::gemm_phase(F.lds, F.tid, 512, OCW, 512, S, E);
        }
        SEAM(pb + 4);
        if (PHM(5) && IN(pb + 5)) { const Frame F = launder(F0);
            pg8::SchedGrid S; S.nMa = mtiles; S.nNa = 4; S.nMb = 0; S.nNb = 1; S.total = S.nMa * S.nNa; S.G = F.G; S.c = F.vcu;
            S.A = (const char*)(F.ws + WS_GT); S.B = (const char*)(F.ws + WS_WO + l * SZ_WO); S.lda = GTW; S.ldb = 4096; S.a_div = 1; S.a_cols = 0;
            pg8::EpiResid E{WSP(float, WS_XS), WSP(float, WS_MVEC) + (size_t)l * 5 * 6144 + 2048};
            pg8::gemm_phase(F.lds, F.tid, 4096, GTW, 4096, S, E);
        }
        SEAM(pb + 5);
        if (PHM(6) && IN(pb + 6)) { const Frame F = launder(F0); phase_ln1(F, l, mrows); }
        SEAM(pb + 6);
        if (moe) { if (PHM(7) && IN(pb + 7)) { const Frame F = launder(F0); phase_gather(F, l, mrows); } SEAM(pb + 7); }
        if (PHM(8) && IN(pb + 8)) { const Frame F = launder(F0);
            if (!moe) {
                pg8::SchedGrid S; S.nMa = mtiles; S.nNa = DFF / 128; S.nMb = 0; S.nNb = 1; S.total = S.nMa * S.nNa; S.G = F.G; S.c = F.vcu;
                S.A = (const char*)(F.ws + WS_HB); S.B = (const char*)(F.ws + WS_WUP + fi * SZ_WUP); S.lda = DM; S.ldb = DM; S.a_div = 1; S.a_cols = 0;
                pg8::EpiSwiGLU E{WSP(bf16_t, WS_HID), DFF};
                pg8::gemm_phase(F.lds, F.tid, DM, DM, DM, S, E);
            } else {
                pg8::SchedMoE S; const int npad = moe_pad_ends_lds(F, fi); S.pe = (const LAS int*)(F.lds + MISC_OFF + 64); S.nN = DFFE / 128; S.total = (npad / 256) * S.nN; S.G = F.G; S.c = F.vcu;
                S.A = (const char*)(F.ws + WS_XPAD); S.B = (const char*)(F.ws + WS_MUP + fi * SZ_MUP); S.lda = DM; S.ldb = DM; S.estride = (size_t)2 * DFFE * DM * 2;
                pg8::EpiSwiGLU E{WSP(bf16_t, WS_HID), DFFE};
                pg8::gemm_phase(F.lds, F.tid, DM, DM, DM, S, E);
            }
        }
        SEAM(pb + 8);
        if (PHM(9) && IN(pb + 9)) { const Frame F = launder(F0);
            if (!moe) {
                pg8::SchedGrid S; S.nMa = mtiles; S.nNa = 4; S.nMb = 0; S.nNb = 1; S.total = S.nMa * S.nNa; S.G = F.G; S.c = F.vcu;
                S.A = (const char*)(F.ws + WS_HID); S.B = (const char*)(F.ws + WS_WDN + fi * SZ_WDN); S.lda = DFF; S.ldb = DFF; S.a_div = 1; S.a_cols = 0;
                pg8::EpiResid E{WSP(float, WS_XS), WSP(float, WS_MVEC) + (size_t)l * 5 * 6144 + 5120};
                pg8::gemm_phase(F.lds, F.tid, DFF, DFF, DFF, S, E);
            } else {
                pg8::SchedMoE S; const int npad = moe_pad_ends_lds(F, fi); S.pe = (const LAS int*)(F.lds + MISC_OFF + 64); S.nN = 4; S.total = (npad / 256) * S.nN; S.G = F.G; S.c = F.vcu;
                S.A = (const char*)(F.ws + WS_HID); S.B = (const char*)(F.ws + WS_MDN + fi * SZ_MDN); S.lda = DFFE; S.ldb = DFFE; S.estride = (size_t)DM * DFFE * 2;
                pg8::EpiPlain E{WSP(bf16_t, WS_YPAD), DM};
                pg8::gemm_phase(F.lds, F.tid, DFFE, DFFE, DFFE, S, E);
            }
        }
        SEAM(pb + 9);
        if (PHM(10) && IN(pb + 10)) { const Frame F = launder(F0); phase_ln2(F, l, mrows); }
        if (l + 1 < DEPTH) SEAM(pb + 10);
    }
#undef IN
#undef SEAM
}

extern "C" void kernel_launch(void* const* d_in, const int* in_sizes, int n_in, void* d_out, int out_size, void* d_ws, size_t ws_size, hipStream_t stream) {
    static int grid = 0;
    if (grid == 0) {
        if (n_in != 31 || in_sizes[0] != NLAT * DM || out_size != NLAT * DM || ws_size < WS_END) {
            fprintf(stderr, "kernel_launch: unexpected shapes: n_in %d in0 %d out %d ws %zu (need %zu); nothing launched\n", n_in, n_in > 0 ? in_sizes[0] : -1, out_size, ws_size, (size_t)WS_END); grid = -1; return; }
        int dev = 0, cus = 0, per_cu = 0;
        if (hipGetDevice(&dev) != hipSuccess || hipDeviceGetAttribute(&cus, hipDeviceAttributeMultiprocessorCount, dev) != hipSuccess) { fprintf(stderr, "kernel_launch: device query failed\n"); grid = -1; return; }
        if (hipFuncSetAttribute((const void*)fwd_kernel, hipFuncAttributeMaxDynamicSharedMemorySize, LDS_BYTES) != hipSuccess) { fprintf(stderr, "kernel_launch: hipFuncSetAttribute failed\n"); grid = -1; return; }
        if (hipOccupancyMaxActiveBlocksPerMultiprocessor(&per_cu, (const void*)fwd_kernel, NTHR, LDS_BYTES) != hipSuccess || per_cu < 1)
            fprintf(stderr, "kernel_launch: note: occupancy query reports %d workgroups per CU\n", per_cu);
        (void)hipGetLastError();
        grid = cus;
    }
    if (grid < 0) return;
    if (hipMemsetAsync((char*)d_ws + WS_CTL, 0, CTL_ZERO_BYTES, stream) != hipSuccess) { fprintf(stderr, "kernel_launch: memset failed\n"); return; }
    Args a{};
    for (int i = 0; i < 31; ++i) a.in[i] = (const float*)d_in[i];
    a.out = (float*)d_out; a.ws = (unsigned char*)d_ws;
#if MK_PER_PHASE
    for (int p = 0; p < N_PHASES; ++p) { a.ph_lo = p; a.ph_hi = p + 1; hipLaunchKernelGGL(fwd_kernel, dim3(grid), dim3(NTHR), LDS_BYTES, stream, a); }
#else
    a.ph_lo = 0; a.ph_hi = N_PHASES;
    hipLaunchKernelGGL(fwd_kernel, dim3(grid), dim3(NTHR), LDS_BYTES, stream, a);
#endif
    const hipError_t le = hipPeekAtLastError();
    if (le != hipSuccess) fprintf(stderr, "kernel_launch: launch failed: %s\n", hipGetErrorName(le));
}
```

```cpp
#include <hip/hip_runtime.h>
#include <cstdio>
#include <cstdint>
#include <hip/hip_bf16.h>
#include <cmath>

#define DI __device__ __forceinline__
#define LAS __attribute__((address_space(3)))
#define GAS __attribute__((address_space(1)))
typedef unsigned short bf16_t;
typedef short bf16x8 __attribute__((ext_vector_type(8)));
typedef short s16x4 __attribute__((ext_vector_type(4)));
typedef float f32x2 __attribute__((ext_vector_type(2)));
typedef float f32x4 __attribute__((ext_vector_type(4)));
typedef float f32x16 __attribute__((ext_vector_type(16)));
typedef unsigned u32x2 __attribute__((ext_vector_type(2)));
typedef unsigned u32x4 __attribute__((ext_vector_type(4)));
typedef __bf16 bf16x2_t __attribute__((ext_vector_type(2)));
typedef GAS unsigned gu32;

#ifndef MK_PER_PHASE
#define MK_PER_PHASE 0
#endif
#ifndef PHMASK
#define PHMASK 0xFFFF
#endif
#define PHM(k) ((PHMASK >> (k)) & 1)
#ifndef REP_MASK
#define REP_MASK 0
#endif
#ifndef ABL
#define ABL 0
#endif

constexpr int DM = 1024, NB = 4, SEQ = 8192, CTXL = 256, NLAT = NB * SEQ, NCTX = NB * CTXL, MTOT = NLAT + NCTX;
constexpr int DEPTH = 4, DIN = 4624, PRJW = 4608, GTW = 4096, NCOMB = PRJW + GTW, OCW = 2048;
constexpr int DFF = 2816, DFFE = 3584, NEXP = 8, MOE_ROWS_MAX = 69632;
constexpr int NCH = 66;
constexpr float ALPHA = 1.6817928305074292f;
constexpr float LOG2E = 1.4426950408889634f;
constexpr float C2 = 0.125f * LOG2E;
constexpr float LN_EPS = 1e-5f, RMS_EPS = 1e-6f;
constexpr int C_NAQ = 0, C_NAK = 512, C_NAV = 1024, C_SWQ = 1536, C_SWK = 2048, C_SWV = 2176, C_GAQ = 2304, C_GAK = 2816, C_GAV = 2944, C_Z = 3072, C_XBC = 3584;

constexpr size_t KiB = 1024, MiB = 1u << 20;
constexpr size_t WS_CTL = 0, CTL_ZERO_BYTES = 1 * MiB;
constexpr size_t WS_MVEC = 1 * MiB;
constexpr size_t WS_ROPE = WS_MVEC + 512 * KiB;
constexpr size_t WS_DT = 4 * MiB;
constexpr size_t WS_SSQ = WS_DT + (size_t)MTOT * 16 * 4;
constexpr size_t WS_SLOT = WS_SSQ + (size_t)MTOT * 8 * 4;
constexpr size_t WS_CDEC = WS_SLOT + (size_t)MTOT * 8 * 4;
constexpr size_t WS_W = 10 * MiB;
constexpr size_t SZ_WCOMB = (size_t)NCOMB * DM * 2, SZ_WB = (size_t)4096 * 512 * 2, SZ_WO = (size_t)1024 * 4096 * 2;
constexpr size_t SZ_WUP = (size_t)2 * DFF * DM * 2, SZ_WDN = (size_t)DM * DFF * 2, SZ_MUP = (size_t)NEXP * 2 * DFFE * DM * 2, SZ_MDN = (size_t)NEXP * DM * DFFE * 2;
constexpr size_t WS_WCOMB = WS_W, WS_WB = WS_WCOMB + 4 * SZ_WCOMB, WS_WO = WS_WB + 4 * SZ_WB, WS_WUP = WS_WO + 4 * SZ_WO, WS_WDN = WS_WUP + 2 * SZ_WUP,
                 WS_MUP = WS_WDN + 2 * SZ_WDN, WS_MDN = WS_MUP + 2 * SZ_MUP, WS_WEND = WS_MDN + 2 * SZ_MDN;
constexpr size_t WS_XS = (WS_WEND + 255) & ~(size_t)255;
constexpr size_t WS_HB = WS_XS + (size_t)MTOT * DM * 4;
constexpr size_t WS_U = WS_HB + (size_t)MTOT * DM * 2;
constexpr size_t WS_PRJ = WS_U;
constexpr size_t WS_GT = WS_PRJ + (size_t)MTOT * PRJW * 2;
constexpr size_t WS_OC = WS_GT + (size_t)MTOT * GTW * 2;
constexpr size_t WS_ST = WS_OC + (size_t)MTOT * OCW * 2;
constexpr size_t WS_UEND = WS_ST + (size_t)NB * NCH * 16 * 8192 * 4;
constexpr size_t WS_HID = WS_U;
constexpr size_t WS_XPAD = WS_HID + (size_t)MOE_ROWS_MAX * DFFE * 2;
constexpr size_t WS_YPAD = WS_XPAD + (size_t)MOE_ROWS_MAX * DM * 2;
static_assert(WS_YPAD + (size_t)MOE_ROWS_MAX * DM * 2 <= WS_UEND, "FFN overlay fits the union region");
constexpr size_t WS_END = WS_UEND;
constexpr int CW_BAR = 4096, CW_MOECNT = 16384;

constexpr int RING_BYTES = 131072, MISC_OFF = RING_BYTES + 320, LDS_BYTES = 147456;
constexpr int NWAVES = 8, NTHR = 512;

DI unsigned pk2(float lo, float hi) { f32x2 v = {lo, hi}; bf16x2_t b = __builtin_convertvector(v, bf16x2_t); return __builtin_bit_cast(unsigned, b); }
DI float bflo(unsigned u) { return __uint_as_float(u << 16); }
DI float bfhi(unsigned u) { return __uint_as_float(u & 0xffff0000u); }
DI float sigm(float x) { return __builtin_amdgcn_rcpf(1.f + __expf(-x)); }
DI float silu(float x) { return x * sigm(x); }
DI float wave_sum(float v) {
#pragma unroll
    for (int o = 1; o < 64; o <<= 1) v += __shfl_xor(v, o);
    return v;
}
DI int clampi(int v, int lo, int hi) { return v < lo ? lo : (v > hi ? hi : v); }
#define MFMA32(a, b, c) __builtin_amdgcn_mfma_f32_32x32x16_bf16((a), (b), (c), 0, 0, 0)
DI int crow(int reg, int h) { return (reg & 3) + 8 * (reg >> 2) + 4 * h; }
typedef short v4i16_t __attribute__((ext_vector_type(4)));
DI s16x4 tr_read(const LAS unsigned char* p) { return __builtin_bit_cast(s16x4, __builtin_amdgcn_ds_read_tr16_b64_v4i16((LAS v4i16_t*)p)); }
DI bf16x8 cat8(s16x4 lo, s16x4 hi) { return __builtin_shufflevector(lo, hi, 0, 1, 2, 3, 4, 5, 6, 7); }
template <int S> DI bf16x8 pack8(const f32x16& x) {
    u32x4 w; w.x = pk2(x[8 * S], x[8 * S + 1]); w.y = pk2(x[8 * S + 2], x[8 * S + 3]); w.z = pk2(x[8 * S + 4], x[8 * S + 5]); w.w = pk2(x[8 * S + 6], x[8 * S + 7]);
    return __builtin_bit_cast(bf16x8, w);
}

#define XB_TMO      128
#define XB_XCNT(j)  (256  + 64 * (j))
#define XB_XSUB(j)  (1280 + 64 * (j))
#define XB_XGEN(j)  (2304 + 64 * (j))
#define XB_TOP      3328
#define XB_TOPGEN   3392
#define XCD_BAR_WORDS 3456
#define XB_SPIN_CAP (1u << 18)
DI unsigned xb_ld(unsigned* p)              { return __hip_atomic_load(p, __ATOMIC_RELAXED, __HIP_MEMORY_SCOPE_AGENT); }
DI unsigned xb_add(unsigned* p, unsigned v) { return __hip_atomic_fetch_add(p, v, __ATOMIC_RELAXED, __HIP_MEMORY_SCOPE_AGENT); }
DI unsigned xb_xcc_id() { return (unsigned)__builtin_amdgcn_s_getreg((3 << 11) | 20) & 0xFu; }
#define XB_SPIN(cond, bar) do { unsigned _sp = 0; while (cond) { __builtin_amdgcn_s_sleep(1); \
    if ((++_sp & 255u) == 0u) { if (xb_ld(&(bar)[XB_TMO])) break; if (_sp > XB_SPIN_CAP) { atomicAdd(&(bar)[XB_TMO], 1u); break; } } } } while (0)
struct XcdBarrier { unsigned* bar; unsigned x; volatile LAS unsigned* st; };
DI XcdBarrier xcd_barrier_post(unsigned* bar, volatile LAS unsigned* st) {
    XcdBarrier b; b.bar = bar; b.x = xb_xcc_id(); b.st = st;
    if (threadIdx.x == 0) (void)xb_add(&bar[XB_XCNT(b.x)], 1u);
    return b;
}
DI void xcd_barrier_complete(unsigned* bar, unsigned x, unsigned& nloc, unsigned& nx) {
    const unsigned G = gridDim.x * gridDim.y * gridDim.z;
    unsigned sum, cnt, mine, sp = 0u;
    for (;;) {
        sum = 0u; cnt = 0u; mine = 0u;
#pragma unroll
        for (unsigned j = 0; j < 16; ++j) { const unsigned c = xb_ld(&bar[XB_XCNT(j)]); sum += c; cnt += (c > 0u) ? 1u : 0u; mine = (j == x) ? c : mine; }
        if (sum == G) break;
        __builtin_amdgcn_s_sleep(1);
        if ((++sp & 255u) == 0u) { if (xb_ld(&bar[XB_TMO])) break; if (sp > XB_SPIN_CAP) { atomicAdd(&bar[XB_TMO], 1u); break; } }
    }
    nloc = mine > 0u ? mine : 1u; nx = cnt > 0u ? cnt : 1u;
}
DI void xcd_barrier(const XcdBarrier& b) {
    asm volatile("s_waitcnt vmcnt(0)" ::: "memory");
    __syncthreads();
    if (threadIdx.x == 0) {
        unsigned* bar = b.bar;
        __builtin_amdgcn_s_waitcnt(0);
        unsigned nloc = b.st[0], nx = b.st[1];
        if (nloc == 0u) { xcd_barrier_complete(bar, b.x, nloc, nx); b.st[0] = nloc; b.st[1] = nx; }
        const unsigned old = xb_add(&bar[XB_XSUB(b.x)], 1u);
        const unsigned gen = old / nloc;
        if (old + 1u == (gen + 1u) * nloc) {
            __builtin_amdgcn_fence(__ATOMIC_RELEASE, "agent");
            asm volatile("s_waitcnt vmcnt(0)" ::: "memory");
            const unsigned og = xb_add(&bar[XB_TOP], 1u);
            const unsigned tg = og / nx;
            if (og + 1u == (tg + 1u) * nx) xb_add(&bar[XB_TOPGEN], 1u);
            else XB_SPIN(xb_ld(&bar[XB_TOPGEN]) == tg, bar);
            __builtin_amdgcn_fence(__ATOMIC_ACQUIRE, "agent");
            xb_add(&bar[XB_XGEN(b.x)], 1u);
            asm volatile("s_waitcnt vmcnt(0)" ::: "memory");
        } else {
            XB_SPIN(xb_ld(&bar[XB_XGEN(b.x)]) == gen, bar);
            __builtin_amdgcn_fence(__ATOMIC_ACQUIRE, "agent");
            asm volatile("s_waitcnt vmcnt(0)" ::: "memory");
        }
    }
    __syncthreads();
}

namespace pg8 {
constexpr int BM = 256, BK = 64, HALF = 128, HTB = HALF * BK * 2, STAGE_BYTES = 8 * HTB;
__host__ __device__ __forceinline__ int lds_byte(int r, int c) { const int st = (r >> 4) * 2 + (c >> 5), rr = r & 15, cc = c & 31, ob = rr * 64 + cc * 2; return st * 1024 + (ob ^ (((ob >> 9) & 1) << 5)); }
__host__ __device__ __forceinline__ void stage_rc(int b, int& R, int& C) { const int st = b / 1024, sb = b % 1024, swz = sb ^ (((sb >> 9) & 1) << 5); R = (st >> 1) * 16 + swz / 64; C = (st & 1) * 32 + (swz % 64) / 2; }
__host__ __device__ __forceinline__ int perm32(int rho) { const int n = rho >> 4, i = rho & 15; return 8 * (i >> 2) + 4 * n + (i & 3); }
struct Unit { int pm, pn; const char* A; const char* B; };

template <class Epi, class Sched>
DI void gemm_phase(LAS unsigned char* lds, const int tid, const int K, const int lda, const int ldb, const Sched& S, const Epi& E) {
    const int wid = __builtin_amdgcn_readfirstlane(tid >> 6), lane = tid & 63, wr = wid >> 2, wc = wid & 3, fr = lane & 15, fq = lane >> 4;
    const int nt = K / BK;
    unsigned voffA[2], voffB[2];
#pragma unroll
    for (int i = 0; i < 2; ++i) { int R, C; stage_rc(tid * 16 + i * 8192, R, C); const int Rb = (R & ~31) + perm32(R & 31);
        voffA[i] = (unsigned)(R * lda + C) * 2u; voffB[i] = (unsigned)(Rb * ldb + C) * 2u; }
    const size_t kstep = (size_t)(BK * 2);
    const size_t hstepA = (size_t)HALF * lda * 2, hstepB = (size_t)HALF * ldb * 2;
    const unsigned ldsw = (unsigned)wid * 1024u;
    const int aoff = lds_byte(wr * 64 + fr, fq * 8), boff = lds_byte(wc * 32 + fr, fq * 8);
#define PG8_SA(b, h) (((b) * 2 + (h)) * HTB)
#define PG8_SB(b, h) ((4 + (b) * 2 + (h)) * HTB)
#define PG8_STAGE(bufoff, gbase, voff) do { _Pragma("unroll") for (int _i = 0; _i < 2; ++_i) \
        __builtin_amdgcn_global_load_lds((const unsigned*)((const char*)(gbase) + (voff)[_i]), (LAS unsigned*)(lds + (bufoff) + ldsw + _i * 8192), 16, 0, 0); } while (0)
#define PG8_LDA(dst, b, h) do { _Pragma("unroll") for (int m = 0; m < 4; ++m) _Pragma("unroll") for (int k = 0; k < 2; ++k) dst[m][k] = *(const LAS bf16x8*)(lds + PG8_SA(b, h) + aoff + m * 2048 + k * 1024); } while (0)
#define PG8_LDB(dst, b, h) do { _Pragma("unroll") for (int n = 0; n < 2; ++n) _Pragma("unroll") for (int k = 0; k < 2; ++k) dst[n][k] = *(const LAS bf16x8*)(lds + PG8_SB(b, h) + boff + n * 2048 + k * 1024); } while (0)
#define PG8_MMA(ai, bj, At, Bt) do { __builtin_amdgcn_s_setprio(1); _Pragma("unroll") for (int m = 0; m < 4; ++m) _Pragma("unroll") for (int n = 0; n < 2; ++n) _Pragma("unroll") for (int k = 0; k < 2; ++k) \
        acc[ai][bj][m][n] = __builtin_amdgcn_mfma_f32_16x16x32_bf16(Bt[n][k], At[m][k], acc[ai][bj][m][n], 0, 0, 0); __builtin_amdgcn_s_setprio(0); } while (0)
#define PG8_WAIT_V(n) asm volatile("s_waitcnt vmcnt(" #n ")" ::: "memory")
#define PG8_WAIT_L(n) asm volatile("s_waitcnt lgkmcnt(" #n ")" ::: "memory")
#define PG8_BAR __builtin_amdgcn_s_barrier()
#define PG8_SCHED __builtin_amdgcn_sched_barrier(0)
    Unit cur, nxt; int ui = 0;
    if (!S.next(0, cur)) return;
    f32x4 acc[2][2][4][2];
#pragma unroll
    for (int a = 0; a < 2; ++a)
#pragma unroll
        for (int b = 0; b < 2; ++b)
#pragma unroll
            for (int m = 0; m < 4; ++m)
#pragma unroll
                for (int n = 0; n < 2; ++n) acc[a][b][m][n] = (f32x4){0.f, 0.f, 0.f, 0.f};
    bf16x8 At[4][2], B0[2][2], B1[2][2];
    const char* cA = cur.A; const char* cB = cur.B;
    PG8_STAGE(PG8_SB(0, 0), cB, voffB); PG8_STAGE(PG8_SB(0, 1), cB + hstepB, voffB); PG8_STAGE(PG8_SA(0, 0), cA, voffA); PG8_STAGE(PG8_SA(0, 1), cA + hstepA, voffA);
    if (wr == 1) PG8_BAR;
    PG8_WAIT_V(2); PG8_BAR;
    PG8_STAGE(PG8_SB(1, 0), cB + kstep, voffB); PG8_STAGE(PG8_SA(1, 0), cA + kstep, voffA); PG8_STAGE(PG8_SB(1, 1), cB + hstepB + kstep, voffB);
    PG8_WAIT_V(6); PG8_BAR;
    for (;;) {
        const bool has_next = S.next(ui + 1, nxt);
        const char* nA = has_next ? nxt.A : cA; const char* nB = has_next ? nxt.B : cB;
        for (int t = 0; t < nt; t += 2) {
            const bool last = (t == nt - 2);
            const char* a1 = cA + (size_t)(t + 1) * kstep;
            const char* a2 = last ? nA : cA + (size_t)(t + 2) * kstep; const char* b2 = last ? nB : cB + (size_t)(t + 2) * kstep;
            const char* a3 = a2 + kstep; const char* b3 = b2 + kstep;
            PG8_LDB(B0, 0, 0); PG8_LDB(B1, 0, 1); PG8_SCHED; PG8_LDA(At, 0, 0); PG8_STAGE(PG8_SA(1, 1), a1 + hstepA, voffA);
            PG8_WAIT_V(8); PG8_WAIT_L(0); PG8_BAR; PG8_MMA(0, 0, At, B0); PG8_MMA(0, 1, At, B1); PG8_BAR; PG8_SCHED;
            PG8_LDA(At, 0, 1); PG8_STAGE(PG8_SB(0, 0), b2, voffB); PG8_STAGE(PG8_SB(0, 1), b2 + hstepB, voffB); PG8_STAGE(PG8_SA(0, 0), a2, voffA);
            PG8_WAIT_V(8); PG8_WAIT_L(0); PG8_BAR; PG8_MMA(1, 0, At, B0); PG8_MMA(1, 1, At, B1); PG8_BAR; PG8_SCHED;
            PG8_LDB(B0, 1, 0); PG8_LDB(B1, 1, 1); PG8_SCHED; PG8_LDA(At, 1, 0); PG8_STAGE(PG8_SA(0, 1), a2 + hstepA, voffA);
            PG8_WAIT_V(8); PG8_WAIT_L(0); PG8_BAR; PG8_MMA(0, 0, At, B0); PG8_MMA(0, 1, At, B1); PG8_BAR; PG8_SCHED;
            PG8_LDA(At, 1, 1); PG8_STAGE(PG8_SB(1, 0), b3, voffB); PG8_STAGE(PG8_SB(1, 1), b3 + hstepB, voffB); PG8_STAGE(PG8_SA(1, 0), a3, voffA);
            PG8_WAIT_V(8); PG8_WAIT_L(0); PG8_BAR; PG8_MMA(1, 0, At, B0); PG8_MMA(1, 1, At, B1); PG8_BAR; PG8_SCHED;
        }
        if (wr == 0) PG8_BAR;
        E(acc, cur, wr, wc, fr, fq);
        if (!has_next) break;
#pragma unroll
        for (int a = 0; a < 2; ++a)
#pragma unroll
            for (int b = 0; b < 2; ++b)
#pragma unroll
                for (int m = 0; m < 4; ++m)
#pragma unroll
                    for (int n = 0; n < 2; ++n) acc[a][b][m][n] = (f32x4){0.f, 0.f, 0.f, 0.f};
        cur = nxt; cA = nA; cB = nB; ++ui;
        if (wr == 1) PG8_BAR;
    }
    PG8_WAIT_V(0);
    PG8_BAR;
#undef PG8_SA
#undef PG8_SB
#undef PG8_STAGE
#undef PG8_LDA
#undef PG8_LDB
#undef PG8_MMA
#undef PG8_WAIT_V
#undef PG8_WAIT_L
#undef PG8_BAR
#undef PG8_SCHED
}

struct SchedGrid {
    int nMa, nNa, nMb, nNb, total, G, c; const char* A; const char* B; int lda, ldb, a_div, a_cols; const LAS int* pe; size_t estride;
    DI bool next(int i, Unit& u) const {
        const long L = (long)i * G + c; if (L >= total) return false;
        const int La = nMa * nNa; int pm, pn;
        if (L < La) { pm = (int)L / nNa; pn = (int)L % nNa; } else { const int r = (int)L - La; pm = nMa + r / nNb; pn = r % nNb; }
        size_t eoff = 0;
        if (pe) { int e = 0;
#pragma unroll
            for (int j = 0; j < 7; ++j) e += (pe[j] <= pm * 256) ? 1 : 0;
            eoff = (size_t)__builtin_amdgcn_readfirstlane(e) * estride; }
        u.pm = pm; u.pn = pn; u.A = A + ((size_t)pm * 256 * lda + (size_t)(pn / a_div) * a_cols) * 2; u.B = B + eoff + (size_t)pn * 256 * ldb * 2; return true;
    }
};

struct EpiInGate {
    bf16_t* PRJ; bf16_t* GT; const float* bg;
    DI void operator()(const f32x4 (&acc)[2][2][4][2], const Unit& u, int wr, int wc, int fr, int fq) const {
        const int row0 = u.pm * BM + wr * 64 + fr; const bool sg = u.pn >= 18;
        bf16_t* base = sg ? GT : PRJ; const int ldc = sg ? GTW : PRJW; const int col0 = (sg ? (u.pn - 18) : u.pn) * BM + wc * 32 + 8 * fq;
        f32x4 bv[2][2];
#pragma unroll
        for (int bj = 0; bj < 2; ++bj)
#pragma unroll
            for (int n = 0; n < 2; ++n) bv[bj][n] = sg ? *(const f32x4*)(bg + col0 + bj * HALF + 4 * n) : (f32x4){0.f, 0.f, 0.f, 0.f};
#pragma unroll
        for (int ai = 0; ai < 2; ++ai)
#pragma unroll
            for (int m = 0; m < 4; ++m) { bf16_t* rowp = base + (size_t)(row0 + ai * HALF + m * 16) * ldc + col0;
#pragma unroll
                for (int bj = 0; bj < 2; ++bj) { f32x4 v0 = acc[ai][bj][m][0] + bv[bj][0], v1 = acc[ai][bj][m][1] + bv[bj][1];
                    if (sg) { v0 = (f32x4){sigm(v0[0]), sigm(v0[1]), sigm(v0[2]), sigm(v0[3])}; v1 = (f32x4){sigm(v1[0]), sigm(v1[1]), sigm(v1[2]), sigm(v1[3])}; }
                    u32x4 w; w.x = pk2(v0[0], v0[1]); w.y = pk2(v0[2], v0[3]); w.z = pk2(v1[0], v1[1]); w.w = pk2(v1[2], v1[3]);
                    *(u32x4*)(rowp + bj * HALF) = w; } }
    }
};
struct EpiBranch {
    bf16_t* GT; const float* SSQ;
    DI void operator()(const f32x4 (&acc)[2][2][4][2], const Unit& u, int wr, int wc, int fr, int fq) const {
        const int row0 = u.pm * BM + wr * 64 + fr; const int col0 = u.pn * BM + wc * 32 + 8 * fq; const bool ssd = (u.pn >> 2) == 3;
#pragma unroll
        for (int ai = 0; ai < 2; ++ai)
#pragma unroll
            for (int m = 0; m < 4; ++m) { const int row = row0 + ai * HALF + m * 16; bf16_t* rowp = GT + (size_t)row * GTW + col0;
                float rs = 1.f;
                if (ssd) { const f32x4 s0 = *(const f32x4*)(SSQ + (size_t)row * 8), s1 = *(const f32x4*)(SSQ + (size_t)row * 8 + 4);
                    rs = __builtin_amdgcn_rsqf(((s0[0] + s0[1]) + (s0[2] + s0[3]) + (s1[0] + s1[1]) + (s1[2] + s1[3])) * (1.f / 512.f) + RMS_EPS); }
#pragma unroll
                for (int bj = 0; bj < 2; ++bj) { const u32x4 g = *(const u32x4*)(rowp + bj * HALF); const f32x4 a0 = acc[ai][bj][m][0] * rs, a1 = acc[ai][bj][m][1] * rs;
                    u32x4 w; w.x = pk2(bflo(g.x) * a0[0], bfhi(g.x) * a0[1]); w.y = pk2(bflo(g.y) * a0[2], bfhi(g.y) * a0[3]);
                    w.z = pk2(bflo(g.z) * a1[0], bfhi(g.z) * a1[1]); w.w = pk2(bflo(g.w) * a1[2], bfhi(g.w) * a1[3]);
                    *(u32x4*)(rowp + bj * HALF) = w; } }
    }
};
struct EpiResid {
    float* XS; const float* mv; bf16_t* plainO;
    DI void operator()(const f32x4 (&acc)[2][2][4][2], const Unit& u, int wr, int wc, int fr, int fq) const {
        const int row0 = u.pm * BM + wr * 64 + fr; const int col0 = u.pn * BM + wc * 32 + 8 * fq;
        if (plainO) {
#pragma unroll
            for (int ai = 0; ai < 2; ++ai)
#pragma unroll
                for (int m = 0; m < 4; ++m) { bf16_t* rowp = plainO + (size_t)(row0 + ai * HALF + m * 16) * DM + col0;
#pragma unroll
                    for (int bj = 0; bj < 2; ++bj) { const f32x4 v0 = acc[ai][bj][m][0], v1 = acc[ai][bj][m][1];
                        u32x4 w; w.x = pk2(v0[0], v0[1]); w.y = pk2(v0[2], v0[3]); w.z = pk2(v1[0], v1[1]); w.w = pk2(v1[2], v1[3]);
                        *(u32x4*)(rowp + bj * HALF) = w; } }
            return;
        }
        const int v = u.pm < 128 ? (u.pm >> 5) : 4;
        const float* g = mv + (size_t)v * 6144 + col0;
        f32x4 gv[2][2];
#pragma unroll
        for (int bj = 0; bj < 2; ++bj)
#pragma unroll
            for (int n = 0; n < 2; ++n) gv[bj][n] = *(const f32x4*)(g + bj * HALF + 4 * n);
#pragma unroll
        for (int ai = 0; ai < 2; ++ai)
#pragma unroll
            for (int m = 0; m < 4; ++m) { float* rowp = XS + (size_t)(row0 + ai * HALF + m * 16) * DM + col0;
#pragma unroll
                for (int bj = 0; bj < 2; ++bj)
#pragma unroll
                    for (int n = 0; n < 2; ++n) { f32x4* p = (f32x4*)(rowp + bj * HALF + 4 * n); const f32x4 x = *p; *p = x * ALPHA + gv[bj][n] * acc[ai][bj][m][n]; } }
    }
};
struct EpiSwiGLU {
    bf16_t* HID; int ldc;
    DI void operator()(const f32x4 (&acc)[2][2][4][2], const Unit& u, int wr, int wc, int fr, int fq) const {
        const int row0 = u.pm * BM + wr * 64 + fr; const int col0 = u.pn * HALF + wc * 32 + 8 * fq;
#pragma unroll
        for (int ai = 0; ai < 2; ++ai)
#pragma unroll
            for (int m = 0; m < 4; ++m) { bf16_t* rowp = HID + (size_t)(row0 + ai * HALF + m * 16) * ldc + col0;
                const f32x4 g0 = acc[ai][0][m][0], g1 = acc[ai][0][m][1], u0 = acc[ai][1][m][0], u1 = acc[ai][1][m][1];
                u32x4 w; w.x = pk2(silu(g0[0]) * u0[0], silu(g0[1]) * u0[1]); w.y = pk2(silu(g0[2]) * u0[2], silu(g0[3]) * u0[3]);
                w.z = pk2(silu(g1[0]) * u1[0], silu(g1[1]) * u1[1]); w.w = pk2(silu(g1[2]) * u1[2], silu(g1[3]) * u1[3]);
                *(u32x4*)rowp = w; }
    }
};
}

struct Args { const float* in[31]; float* out; unsigned char* ws; int ph_lo, ph_hi; };
enum { I_X = 0, I_C, I_CTX, I_CCTX, I_WMOD, I_BMOD, I_WIN, I_WGATE, I_BGATE, I_RPB, I_SINK, I_QGQ, I_QGK, I_CONVW, I_CONVB, I_DTB, I_ALOG, I_DSKIP, I_NORMG,
       I_WBR, I_WOUT, I_LN1G, I_LN1B, I_LN2G, I_LN2B, I_FUP, I_FDN, I_MRW, I_MRB, I_MUP, I_MDN };
struct Frame {
    LAS unsigned char* lds; gu32* ctl; int tid, lane, wave, vcu, G;
    const float* const* in; float* out; unsigned char* ws;
};
#define WSP(T, off) ((T*)(F.ws + (off)))
DI Frame launder(const Frame& F0) {
    Frame F = F0;
    asm volatile("" : "+v"(F.tid), "+v"(F.lane));
    asm volatile("" : "+s"(F.wave), "+s"(F.vcu), "+s"(F.ws), "+s"(F.lds));
    F.ws = (unsigned char*)(GAS unsigned char*)F.ws;
    return F;
}

DI void transpose_item(const float* W, int ld, bf16_t* dst, int ldk, int koff, int map_h, int rowoff, int cscale, const float* kscale, LAS float* scr, int kb, int nb, int lane) {
    const int k0 = 64 * kb, n0 = 32 * nb;
#pragma unroll 8
    for (int i = 0; i < 32; ++i) { const int kk = 2 * i + (lane >> 5); scr[kk * 33 + (lane & 31)] = W[(size_t)(k0 + kk) * ld + n0 + (lane & 31)]; }
    asm volatile("s_waitcnt lgkmcnt(0)" ::: "memory");
    const int c = lane & 7;
    float ks[8];
#pragma unroll
    for (int e = 0; e < 8; ++e) ks[e] = kscale ? kscale[k0 + 8 * c + e] : 1.f;
#pragma unroll
    for (int j = 0; j < 4; ++j) { const int nl = (lane >> 3) + 8 * j, n = n0 + nl; const LAS float* s = scr + (8 * c) * 33 + nl;
        float cs = 1.f; if (cscale && (n < 512 || (n >= 1536 && n < 2048))) cs = C2;
        int drow;
        if (map_h == 0) drow = rowoff + n;
        else if (n < map_h) drow = rowoff + 256 * (n >> 7) + (n & 127);
        else { const int n2 = n - map_h; drow = rowoff + 256 * (n2 >> 7) + 128 + (n2 & 127); }
        u32x4 o; o.x = pk2(s[0 * 33] * ks[0] * cs, s[1 * 33] * ks[1] * cs); o.y = pk2(s[2 * 33] * ks[2] * cs, s[3 * 33] * ks[3] * cs);
        o.z = pk2(s[4 * 33] * ks[4] * cs, s[5 * 33] * ks[5] * cs); o.w = pk2(s[6 * 33] * ks[6] * cs, s[7 * 33] * ks[7] * cs);
        *(u32x4*)(dst + (size_t)drow * ldk + koff + k0 + 8 * c) = o; }
    asm volatile("s_waitcnt lgkmcnt(0)" ::: "memory");
}
struct CvtJob { const float* W; int K, N, ld; bf16_t* dst; int ldk, koff, map_h, rowoff, cscale; const float* kscale; };
DI void get_job(const Frame& F, int j, CvtJob& J) {
    J.koff = 0; J.map_h = 0; J.rowoff = 0; J.cscale = 0; J.kscale = nullptr;
    if (j < 52) {
        const int l = j / 13, r = j % 13;
        if (r == 0) { J.W = F.in[I_WIN] + (size_t)l * DM * DIN; J.K = DM; J.N = PRJW; J.ld = DIN; J.dst = WSP(bf16_t, WS_WCOMB + l * SZ_WCOMB); J.ldk = DM; J.cscale = 1; }
        else if (r < 5) { const int i = r - 1; J.W = F.in[I_WGATE] + ((size_t)l * 4 + i) * DM * DM; J.K = DM; J.N = DM; J.ld = DM; J.dst = WSP(bf16_t, WS_WCOMB + l * SZ_WCOMB); J.ldk = DM; J.rowoff = PRJW + 1024 * i; }
        else if (r < 9) { const int i = r - 5; J.W = F.in[I_WBR] + ((size_t)l * 4 + i) * 512 * DM; J.K = 512; J.N = DM; J.ld = DM; J.dst = WSP(bf16_t, WS_WB + l * SZ_WB); J.ldk = 512; J.rowoff = 1024 * i;
            if (i == 3) J.kscale = F.in[I_NORMG] + l * 512; }
        else { const int rep = r - 9; J.W = F.in[I_WOUT] + (size_t)l * DM * DM; J.K = DM; J.N = DM; J.ld = DM; J.dst = WSP(bf16_t, WS_WO + l * SZ_WO); J.ldk = 4096; J.koff = 1024 * rep; }
    } else if (j < 56) {
        const int i = (j - 52) >> 1;
        if (((j - 52) & 1) == 0) { J.W = F.in[I_FUP] + (size_t)i * DM * 2 * DFF; J.K = DM; J.N = 2 * DFF; J.ld = 2 * DFF; J.dst = WSP(bf16_t, WS_WUP + i * SZ_WUP); J.ldk = DM; J.map_h = DFF; }
        else { J.W = F.in[I_FDN] + (size_t)i * DFF * DM; J.K = DFF; J.N = DM; J.ld = DM; J.dst = WSP(bf16_t, WS_WDN + i * SZ_WDN); J.ldk = DFF; }
    } else {
        const int q = j - 56, ie = q >> 1, i = ie >> 3, e = ie & 7;
        if ((q & 1) == 0) { J.W = F.in[I_MUP] + ((size_t)i * NEXP + e) * DM * 2 * DFFE; J.K = DM; J.N = 2 * DFFE; J.ld = 2 * DFFE; J.dst = WSP(bf16_t, WS_MUP + i * SZ_MUP); J.ldk = DM; J.map_h = DFFE; J.rowoff = e * 2 * DFFE; }
        else { J.W = F.in[I_MDN] + ((size_t)i * NEXP + e) * DFFE * DM; J.K = DFFE; J.N = DM; J.ld = DM; J.dst = WSP(bf16_t, WS_MDN + i * SZ_MDN); J.ldk = DFFE; J.rowoff = e * DM; }
    }
}
constexpr int NJOBS = 52 + 4 + 32;

DI void phase_prologue_a(const Frame& F) {
    const int NGW = F.G * NWAVES, gw = F.vcu * NWAVES + F.wave;
    {
        LAS float* sv = (LAS float*)(F.lds + 73728);
        LAS float* red = (LAS float*)(F.lds + 73728 + 20480);
        for (int i = F.tid; i < 5 * 1024; i += NTHR) { const int v = i >> 10, k = i & 1023; const float c = v < 4 ? F.in[I_C][v * DM + k] : F.in[I_CCTX][k]; sv[i] = silu(c); }
        __syncthreads();
        float* MV = WSP(float, WS_MVEC);
        for (int item = F.vcu; item < 4 * 96; item += F.G) {
            const int l = item / 96, n0 = (item % 96) * 64, c = F.tid & 63, ks = F.tid >> 6;
            const float* w = F.in[I_WMOD] + (size_t)l * DM * 6144 + n0 + c;
            float a0 = 0.f, a1 = 0.f, a2 = 0.f, a3 = 0.f, a4 = 0.f;
#pragma unroll 8
            for (int k = ks * 128; k < ks * 128 + 128; ++k) { const float wv = w[(size_t)k * 6144]; a0 += sv[k] * wv; a1 += sv[1024 + k] * wv; a2 += sv[2048 + k] * wv; a3 += sv[3072 + k] * wv; a4 += sv[4096 + k] * wv; }
            red[(ks * 5 + 0) * 64 + c] = a0; red[(ks * 5 + 1) * 64 + c] = a1; red[(ks * 5 + 2) * 64 + c] = a2; red[(ks * 5 + 3) * 64 + c] = a3; red[(ks * 5 + 4) * 64 + c] = a4;
            __syncthreads();
            if (F.tid < 320) { const int v = F.tid >> 6, cc = F.tid & 63; float s = F.in[I_BMOD][l * 6144 + n0 + cc];
#pragma unroll
                for (int q = 0; q < 8; ++q) s += red[(q * 5 + v) * 64 + cc];
                MV[((size_t)l * 5 + v) * 6144 + n0 + cc] = s; }
            __syncthreads();
        }
    }
    {
        float* rc = WSP(float, WS_ROPE); float* rs = rc + SEQ * 32;
        for (int i = F.vcu * NTHR + F.tid; i < SEQ * 32; i += F.G * NTHR) {
            const int t = i >> 5, p = i & 31; const float pos = (p < 16) ? (float)(t >> 6) : (float)(t & 63);
            const float invf = exp2f(-(float)(p & 15) * (13.287712379549449f / 16.f));
            const float ang = pos * invf; const float rev = ang * 0.15915494309189535f; const float fr = rev - rintf(rev);
            rc[i] = __builtin_amdgcn_cosf(fr); rs[i] = __builtin_amdgcn_sinf(fr);
        }
    }
    {
        LAS float* scr = (LAS float*)(F.lds + F.wave * 8448);
        int base = 0;
        for (int j = 0; j < NJOBS; ++j) {
            CvtJob J; get_job(F, j, J);
            const int nblk = J.N / 32, nit = (J.K / 64) * nblk;
            int vid = (gw - base) % NGW; if (vid < 0) vid += NGW;
            for (int it = vid; it < nit; it += NGW) transpose_item(J.W, J.ld, J.dst, J.ldk, J.koff, J.map_h, J.rowoff, J.cscale, J.kscale, scr, it / nblk, it % nblk, F.lane);
            base = (base + nit) % NGW;
        }
    }
}

DI void load_wdt(const Frame& F, int l) {
    LAS float* wd = (LAS float*)F.lds; const float* w = F.in[I_WIN] + (size_t)l * DM * DIN + PRJW;
    for (int i = F.tid; i < DM * 16; i += NTHR) wd[i] = w[(size_t)(i >> 4) * DIN + (i & 15)];
}
DI void emit_h_dt(const Frame& F, const f32x4 (&xn)[4], const float* mv, int m, const float* dtb) {
    bf16_t* hb = WSP(bf16_t, WS_HB) + (size_t)m * DM; float* DT = WSP(float, WS_DT);
    const LAS float* wd = (const LAS float*)F.lds;
    float acc[16];
#pragma unroll
    for (int c = 0; c < 16; ++c) acc[c] = 0.f;
#pragma unroll
    for (int j = 0; j < 4; ++j) {
        const int k = 4 * F.lane + 256 * j;
        const f32x4 sh = *(const f32x4*)(mv + k), sc = *(const f32x4*)(mv + 1024 + k);
        const f32x4 h = xn[j] * (sc + 1.f) + sh;
        u32x2 w; w.x = pk2(h[0], h[1]); w.y = pk2(h[2], h[3]); *(u32x2*)(hb + k) = w;
#pragma unroll
        for (int e = 0; e < 4; ++e) {
            const LAS f32x4* wr = (const LAS f32x4*)(wd + (k + e) * 16);
#pragma unroll
            for (int q = 0; q < 4; ++q) { const f32x4 wv = wr[q]; acc[4 * q] += h[e] * wv[0]; acc[4 * q + 1] += h[e] * wv[1]; acc[4 * q + 2] += h[e] * wv[2]; acc[4 * q + 3] += h[e] * wv[3]; }
            asm volatile("" ::: "memory");
        }
    }
    const bool b0 = F.lane & 1, b1 = F.lane & 2, b2 = F.lane & 4, b3 = F.lane & 8;
    float t8[8], t4[4], t2[2], t1;
#pragma unroll
    for (int i = 0; i < 8; ++i) { const float keep = b0 ? acc[2 * i + 1] : acc[2 * i], give = b0 ? acc[2 * i] : acc[2 * i + 1]; t8[i] = keep + __shfl_xor(give, 1); }
#pragma unroll
    for (int i = 0; i < 4; ++i) { const float keep = b1 ? t8[2 * i + 1] : t8[2 * i], give = b1 ? t8[2 * i] : t8[2 * i + 1]; t4[i] = keep + __shfl_xor(give, 2); }
#pragma unroll
    for (int i = 0; i < 2; ++i) { const float keep = b2 ? t4[2 * i + 1] : t4[2 * i], give = b2 ? t4[2 * i] : t4[2 * i + 1]; t2[i] = keep + __shfl_xor(give, 4); }
    { const float keep = b3 ? t2[1] : t2[0], give = b3 ? t2[0] : t2[1]; t1 = keep + __shfl_xor(give, 8); }
    t1 += __shfl_xor(t1, 16); t1 += __shfl_xor(t1, 32);
    if (F.lane < 16) { const float x = t1 + dtb[F.lane]; const float t = __expf(x); const float sp = t < 0.01f ? t * (1.f + t * (-0.5f + t * (1.f / 3.f))) : __logf(1.f + t); DT[(size_t)m * 16 + F.lane] = x > 15.f ? x : sp; }
}
DI void ln_rows(f32x4 (&v)[4], const float* g, const float* b, int lane) {
    float s = 0.f;
#pragma unroll
    for (int j = 0; j < 4; ++j) s += (v[j][0] + v[j][1]) + (v[j][2] + v[j][3]);
    const float mean = wave_sum(s) * (1.f / DM); float s2 = 0.f;
#pragma unroll
    for (int j = 0; j < 4; ++j) { v[j] = v[j] - mean; s2 += (v[j][0] * v[j][0] + v[j][1] * v[j][1]) + (v[j][2] * v[j][2] + v[j][3] * v[j][3]); }
    const float rstd = 1.f / sqrtf(wave_sum(s2) * (1.f / DM) + LN_EPS);
#pragma unroll
    for (int j = 0; j < 4; ++j) { const int k = 4 * lane + 256 * j; v[j] = v[j] * rstd * *(const f32x4*)(g + k) + *(const f32x4*)(b + k); }
}
DI void phase_prologue_b(const Frame& F) {
    load_wdt(F, 0); __syncthreads();
    const int NGW = F.G * NWAVES, gw = F.vcu * NWAVES + F.wave;
    float* XS = WSP(float, WS_XS); const float* MV = WSP(float, WS_MVEC);
    const float* dtb = F.in[I_DTB];
    for (int m = gw; m < MTOT; m += NGW) {
        const float* src = m < NLAT ? F.in[I_X] + (size_t)m * DM : F.in[I_CTX] + (size_t)(m - NLAT) * DM; const int v = m < NLAT ? (m >> 13) : 4;
        f32x4 x[4];
#pragma unroll
        for (int j = 0; j < 4; ++j) { x[j] = *(const f32x4*)(src + 4 * F.lane + 256 * j); *(f32x4*)(XS + (size_t)m * DM + 4 * F.lane + 256 * j) = x[j]; }
        emit_h_dt(F, x, MV + (size_t)v * 6144, m, dtb);
    }
}
DI void phase_ln1(const Frame& F, int l, int mrows) {
    const bool moe = l & 1; const int mi = l >> 1;
    LAS float* wrt = (LAS float*)F.lds;
    if (moe) { const float* w = F.in[I_MRW] + (size_t)mi * DM * 8; for (int i = F.tid; i < DM * 8; i += NTHR) wrt[i] = w[i]; __syncthreads(); }
    const int NGW = F.G * NWAVES, gw = F.vcu * NWAVES + F.wave;
    float* XS = WSP(float, WS_XS); const float* MV = WSP(float, WS_MVEC) + (size_t)l * 5 * 6144; bf16_t* HB = WSP(bf16_t, WS_HB);
    const float* g = F.in[I_LN1G] + l * DM; const float* b = F.in[I_LN1B] + l * DM;
    unsigned* SL = WSP(unsigned, WS_SLOT); unsigned* gcnt = (unsigned*)F.ctl + CW_MOECNT + mi * 1024;
    int cnt = 0, nst = 0; int me0 = 0, me1 = 0, mr0 = 0, mr1 = 0, mm = 0; float mg0 = 0.f, mg1 = 0.f;
    for (int m = gw; m < mrows; m += NGW) {
        const int v = m < NLAT ? (m >> 13) : 4;
        f32x4 x[4];
#pragma unroll
        for (int j = 0; j < 4; ++j) x[j] = *(const f32x4*)(XS + (size_t)m * DM + 4 * F.lane + 256 * j);
        ln_rows(x, g, b, F.lane);
        float acc[8];
#pragma unroll
        for (int c = 0; c < 8; ++c) acc[c] = 0.f;
        const float* mv = MV + (size_t)v * 6144;
#pragma unroll
        for (int j = 0; j < 4; ++j) {
            const int k = 4 * F.lane + 256 * j;
            *(f32x4*)(XS + (size_t)m * DM + k) = x[j];
            const f32x4 sh = *(const f32x4*)(mv + 3072 + k), sc = *(const f32x4*)(mv + 4096 + k);
            const f32x4 h = x[j] * (sc + 1.f) + sh;
            u32x2 w; w.x = pk2(h[0], h[1]); w.y = pk2(h[2], h[3]); *(u32x2*)(HB + (size_t)m * DM + k) = w;
            if (moe) {
#pragma unroll
                for (int e = 0; e < 4; ++e) { const LAS f32x4* wr = (const LAS f32x4*)(wrt + (k + e) * 8);
#pragma unroll
                    for (int q = 0; q < 2; ++q) { const f32x4 wv = wr[q]; acc[4 * q] += h[e] * wv[0]; acc[4 * q + 1] += h[e] * wv[1]; acc[4 * q + 2] += h[e] * wv[2]; acc[4 * q + 3] += h[e] * wv[3]; } }
            }
        }
        if (moe) {
            const bool b0 = F.lane & 1, b1 = F.lane & 2, b2 = F.lane & 4;
            float t4[4], t2[2], t1;
#pragma unroll
            for (int i = 0; i < 4; ++i) { const float keep = b0 ? acc[2 * i + 1] : acc[2 * i], give = b0 ? acc[2 * i] : acc[2 * i + 1]; t4[i] = keep + __shfl_xor(give, 1); }
#pragma unroll
            for (int i = 0; i < 2; ++i) { const float keep = b1 ? t4[2 * i + 1] : t4[2 * i], give = b1 ? t4[2 * i] : t4[2 * i + 1]; t2[i] = keep + __shfl_xor(give, 2); }
            { const float keep = b2 ? t2[1] : t2[0], give = b2 ? t2[0] : t2[1]; t1 = keep + __shfl_xor(give, 4); }
            t1 += __shfl_xor(t1, 8); t1 += __shfl_xor(t1, 16); t1 += __shfl_xor(t1, 32);
            t1 += F.in[I_MRB][mi * 8 + (F.lane & 7)];
            float lg[8];
#pragma unroll
            for (int e = 0; e < 8; ++e) lg[e] = __shfl(t1, e);
            int e0 = 0; float l0 = lg[0];
#pragma unroll
            for (int e = 1; e < 8; ++e) if (lg[e] > l0) { l0 = lg[e]; e0 = e; }
            int e1 = -1; float l1 = -3.0e38f;
#pragma unroll
            for (int e = 0; e < 8; ++e) if (e != e0 && lg[e] > l1) { l1 = lg[e]; e1 = e; }
            const float g1 = 1.f / (1.f + __expf(l0 - l1)), g0 = 1.f - g1;
            const int r0 = __shfl(cnt, e0); if (F.lane == e0) cnt++;
            const int r1 = __shfl(cnt, e1); if (F.lane == e1) cnt++;
            if (F.lane == nst) { me0 = e0; me1 = e1; mr0 = r0; mr1 = r1; mg0 = g0; mg1 = g1; mm = m; }
            ++nst;
        }
        if (moe && (nst == 64 || m + NGW >= mrows)) {
            unsigned base = 0u; if (F.lane < 8) base = __hip_atomic_fetch_add(gcnt + F.lane * 64, (unsigned)cnt, __ATOMIC_RELAXED, __HIP_MEMORY_SCOPE_AGENT);
            const unsigned p0 = __shfl(base, me0) + mr0, p1 = __shfl(base, me1) + mr1;
            if (F.lane < nst) { u32x4 a; a.x = me0; a.y = me1; a.z = p0; a.w = p1; *(u32x4*)(SL + (size_t)mm * 8) = a; u32x2 c; c.x = __float_as_uint(mg0); c.y = __float_as_uint(mg1); *(u32x2*)(SL + (size_t)mm * 8 + 4) = c; }
            cnt = 0; nst = 0;
        }
    }
}
DI void moe_pad_ends(const Frame& F, int mi, int (&pe)[8]) {
    unsigned* gcnt = (unsigned*)F.ctl + CW_MOECNT + mi * 1024; int run = 0;
#pragma unroll
    for (int e = 0; e < 8; ++e) { const int c = (int)__builtin_amdgcn_readfirstlane(__hip_atomic_load(gcnt + e * 64, __ATOMIC_RELAXED, __HIP_MEMORY_SCOPE_AGENT)); run += (c + 255) & ~255; pe[e] = run; }
}
DI int moe_pad_ends_lds(const Frame& F, int mi) {
    int pe[8]; moe_pad_ends(F, mi, pe);
    LAS int* d = (LAS int*)(F.lds + MISC_OFF + 64);
    __syncthreads();
    if (F.tid == 0) {
#pragma unroll
        for (int e = 0; e < 8; ++e) d[e] = pe[e];
    }
    __syncthreads();
    return pe[7];
}
DI void phase_gather(const Frame& F, int l, int mrows) {
    int pe[8]; moe_pad_ends(F, l >> 1, pe);
    const int NGW = F.G * NWAVES, gw = F.vcu * NWAVES + F.wave;
    unsigned* SL = WSP(unsigned, WS_SLOT); const bf16_t* HB = WSP(bf16_t, WS_HB); bf16_t* XP = WSP(bf16_t, WS_XPAD);
    for (int m = gw; m < mrows; m += NGW) {
        const u32x4 a = *(const u32x4*)(SL + (size_t)m * 8);
        int ps0 = 0, ps1 = 0;
#pragma unroll
        for (int e = 1; e < 8; ++e) { if ((int)a.x == e) ps0 = pe[e - 1]; if ((int)a.y == e) ps1 = pe[e - 1]; }
        const int d0 = ps0 + (int)a.z, d1 = ps1 + (int)a.w;
        const u32x4* src = (const u32x4*)(HB + (size_t)m * DM);
        const u32x4 v0 = src[F.lane], v1 = src[64 + F.lane];
        u32x4* q0 = (u32x4*)(XP + (size_t)d0 * DM); u32x4* q1 = (u32x4*)(XP + (size_t)d1 * DM);
        q0[F.lane] = v0; q0[64 + F.lane] = v1; q1[F.lane] = v0; q1[64 + F.lane] = v1;
        if (F.lane == 0) { u32x2 d; d.x = d0; d.y = d1; *(u32x2*)(SL + (size_t)m * 8 + 2) = d; }
    }
}
DI void phase_ln2(const Frame& F, int l, int mrows) {
    const bool moe = l & 1, lastl = (l == DEPTH - 1);
    if (!lastl) { load_wdt(F, l + 1); __syncthreads(); }
    const int NGW = F.G * NWAVES, gw = F.vcu * NWAVES + F.wave;
    float* XS = WSP(float, WS_XS); const float* MVl = WSP(float, WS_MVEC) + (size_t)l * 5 * 6144; const float* MVn = WSP(float, WS_MVEC) + (size_t)(l + 1) * 5 * 6144;
    const float* g = F.in[I_LN2G] + l * DM; const float* b = F.in[I_LN2B] + l * DM;
    const unsigned* SL = WSP(unsigned, WS_SLOT); const bf16_t* YP = WSP(bf16_t, WS_YPAD);
    const float* dtb = F.in[I_DTB] + (lastl ? 0 : (l + 1) * 16);
    for (int m = gw; m < mrows; m += NGW) {
        const int v = m < NLAT ? (m >> 13) : 4;
        f32x4 x[4];
#pragma unroll
        for (int j = 0; j < 4; ++j) x[j] = *(const f32x4*)(XS + (size_t)m * DM + 4 * F.lane + 256 * j);
        if (moe) {
            const u32x4 a = *(const u32x4*)(SL + (size_t)m * 8); const u32x2 gg = *(const u32x2*)(SL + (size_t)m * 8 + 4);
            const float g0 = __uint_as_float(gg.x), g1 = __uint_as_float(gg.y);
            const bf16_t* y0 = YP + (size_t)a.z * DM; const bf16_t* y1 = YP + (size_t)a.w * DM;
#pragma unroll
            for (int j = 0; j < 4; ++j) { const int k = 4 * F.lane + 256 * j; const u32x2 u0 = *(const u32x2*)(y0 + k), u1 = *(const u32x2*)(y1 + k);
                const f32x4 gt = *(const f32x4*)(MVl + (size_t)v * 6144 + 5120 + k);
                f32x4 f; f[0] = g0 * bflo(u0.x) + g1 * bflo(u1.x); f[1] = g0 * bfhi(u0.x) + g1 * bfhi(u1.x); f[2] = g0 * bflo(u0.y) + g1 * bflo(u1.y); f[3] = g0 * bfhi(u0.y) + g1 * bfhi(u1.y);
                if (ABL & 16) f = (f32x4){0.f, 0.f, 0.f, 0.f};
                x[j] = x[j] * ALPHA + gt * f; }
        }
        ln_rows(x, g, b, F.lane);
        if (lastl) {
#pragma unroll
            for (int j = 0; j < 4; ++j) *(f32x4*)(F.out + (size_t)m * DM + 4 * F.lane + 256 * j) = x[j];
        } else {
#pragma unroll
            for (int j = 0; j < 4; ++j) *(f32x4*)(XS + (size_t)m * DM + 4 * F.lane + 256 * j) = x[j];
            emit_h_dt(F, x, MVn + (size_t)v * 6144, m, dtb);
        }
    }
}

DI void phase_qkprep_rows(const Frame& F, int l) {
    const int NGW = F.G * NWAVES, gw = F.vcu * NWAVES + F.wave;
    bf16_t* PRJ = WSP(bf16_t, WS_PRJ); const float* rc = WSP(float, WS_ROPE); const float* rs = rc + SEQ * 32;
    const float* gq = F.in[I_QGQ] + l * 64; const float* gk = F.in[I_QGK] + l * 64;
    const int hs = F.lane >> 4, i2 = 2 * (F.lane & 15);
    for (int m = gw; m < MTOT; m += NGW) {
        const bool lat = m < NLAT; const int t = m & (SEQ - 1);
        float c0 = 1.f, c1 = 1.f, s0 = 0.f, s1 = 0.f;
        if (lat) { const f32x2 cc = *(const f32x2*)(rc + t * 32 + i2), ss = *(const f32x2*)(rs + t * 32 + i2); c0 = cc[0]; c1 = cc[1]; s0 = ss[0]; s1 = ss[1]; }
#pragma unroll
        for (int it = 0; it < 5; ++it) {
            const int hd = it * 4 + hs;
            const int col = hd < 8 ? C_SWQ + 64 * hd : hd < 10 ? C_SWK + 64 * (hd - 8) : hd < 18 ? C_GAQ + 64 * (hd - 10) : C_GAK + 64 * (hd - 18);
            bf16_t* p = PRJ + (size_t)m * PRJW + col + i2;
            const unsigned u1 = *(const unsigned*)p, u2 = *(const unsigned*)(p + 32);
            float a0 = bflo(u1), a1 = bfhi(u1), b0 = bflo(u2), b1 = bfhi(u2);
            if (hd >= 10) {
                float ss = a0 * a0 + a1 * a1 + b0 * b0 + b1 * b1;
                ss += __shfl_xor(ss, 1); ss += __shfl_xor(ss, 2); ss += __shfl_xor(ss, 4); ss += __shfl_xor(ss, 8);
                const float rn = 1.f / sqrtf(ss * (1.f / 64.f) + RMS_EPS); const float* gg = hd < 18 ? gq : gk; const float post = hd < 18 ? C2 : 1.f;
                a0 *= rn * gg[i2] * post; a1 *= rn * gg[i2 + 1] * post; b0 *= rn * gg[32 + i2] * post; b1 *= rn * gg[32 + i2 + 1] * post;
            }
            const float o0 = a0 * c0 - b0 * s0, o1 = a1 * c1 - b1 * s1, q0 = b0 * c0 + a0 * s0, q1 = b1 * c1 + a1 * s1;
            *(unsigned*)p = pk2(o0, o1); *(unsigned*)(p + 32) = pk2(q0, q1);
        }
    }
}

constexpr int AT_KVB = 18432, AT_VOFF = 9216, AT_RS = 144, AT_BIAS = 2 * AT_KVB;
DI void attn_unit(const Frame& Fin, int l, int mode, bool ctxq, int b, int hq, int qblk) {
    const Frame F = launder(Fin);
    const int lane = F.lane, wid = F.wave, tid = F.tid, r = lane & 31, h = lane >> 5;
    const bf16_t* PRJ = WSP(bf16_t, WS_PRJ); bf16_t* OC = WSP(bf16_t, WS_OC);
    int qcol, kcol, vcol, ocol, kvh;
    if (mode == 0) { qcol = C_NAQ; kcol = C_NAK; vcol = C_NAV; ocol = 0; kvh = hq; }
    else if (mode == 1) { qcol = C_SWQ; kcol = C_SWK; vcol = C_SWV; ocol = 512; kvh = hq >> 2; }
    else { qcol = C_GAQ; kcol = C_GAK; vcol = C_GAV; ocol = 1024; kvh = hq >> 2; }
    const int qrow = ctxq ? (NLAT + b * CTXL + 32 * wid + r) : (b * SEQ + 256 * qblk + 32 * wid + r);
    bf16x8 qf[4];
    { const bf16_t* qp = PRJ + (size_t)qrow * PRJW + qcol + hq * 64 + 8 * h;
#pragma unroll
      for (int d0 = 0; d0 < 4; ++d0) qf[d0] = *(const bf16x8*)(qp + 16 * d0); }
    int tl_lo = 0, tl_hi = 0;
    if (!ctxq) {
        if (mode == 0) { tl_lo = clampi(4 * qblk - 4, 0, 120); tl_hi = clampi(4 * qblk - 1, 0, 120) + 8; }
        else if (mode == 1) { tl_lo = 4 * qblk - 2 < 0 ? 0 : 4 * qblk - 2; tl_hi = 4 * qblk + 6 > 128 ? 128 : 4 * qblk + 6; }
        else { tl_lo = 0; tl_hi = 128; }
    }
    const int ntile = 4 + (tl_hi - tl_lo);
    LAS float* biasT = (LAS float*)(F.lds + AT_BIAS);
    __syncthreads();
    if (mode == 0 && !ctxq) { const float* rp = F.in[I_RPB] + ((size_t)l * 8 + hq) * 465; for (int i = tid; i < 465; i += NTHR) biasT[i] = rp[i] * LOG2E; }
    const int lr = tid >> 3, ch = tid & 7;
    const size_t ctxbase = (size_t)(NLAT + b * CTXL), latbase = (size_t)b * SEQ;
    u32x4 kreg, vreg;
#define AT_LOAD(it) do { const size_t rb_ = ((it) < 4 ? ctxbase + 64 * (it) : latbase + 64 * (tl_lo + (it) - 4)) + lr; const bf16_t* rp_ = PRJ + rb_ * PRJW + kvh * 64 + ch * 8; \
        kreg = *(const u32x4*)(rp_ + kcol); vreg = *(const u32x4*)(rp_ + vcol); } while (0)
#define AT_STORE(buf) do { LAS unsigned char* d_ = F.lds + (buf) * AT_KVB + lr * AT_RS + ch * 16; *(LAS u32x4*)d_ = kreg; *(LAS u32x4*)(d_ + AT_VOFF) = vreg; } while (0)
    AT_LOAD(0); AT_STORE(0);
    __syncthreads();
    float mrun = -1e30f, lrun = 0.f;
    if (mode == 1) { mrun = F.in[I_SINK][l * 8 + hq] * LOG2E; lrun = (h == 0) ? 1.f : 0.f; }
    f32x16 o0, o1;
#pragma unroll
    for (int i = 0; i < 16; ++i) { o0[i] = 0.f; o1[i] = 0.f; }
    const int q4 = (lane & 15) >> 2, p4 = lane & 3, blk = (lane >> 4) & 1;
    const int tq = 256 * qblk + 32 * wid + r;
    const int gr = 4 * qblk + (wid >> 1), qc = 32 * (wid & 1) + r, cs = clampi(qc - 8, 0, 48), rsw = clampi(gr - 4, 0, 120);
    for (int it = 0; it < ntile; ++it) {
        const int buf = it & 1;
        if (it + 1 < ntile) AT_LOAD(it + 1);
        const int g = tl_lo + it - 4;
        bool rel = true;
        if (it >= 4) { if (mode == 0) rel = (g >= rsw && g < rsw + 8); else if (mode == 1) rel = (64 * g + 63 >= 256 * qblk + 32 * wid - 128) && (64 * g <= 256 * qblk + 32 * wid + 31 + 128); }
        if (rel) {
            const LAS unsigned char* Kb = F.lds + buf * AT_KVB; const LAS unsigned char* Vb = Kb + AT_VOFF;
            f32x16 p0, p1;
#pragma unroll
            for (int i = 0; i < 16; ++i) { p0[i] = 0.f; p1[i] = 0.f; }
#pragma unroll
            for (int d0 = 0; d0 < 4; ++d0) {
                const bf16x8 k0 = *(const LAS bf16x8*)(Kb + r * AT_RS + (16 * d0 + 8 * h) * 2);
                const bf16x8 k1 = *(const LAS bf16x8*)(Kb + (32 + r) * AT_RS + (16 * d0 + 8 * h) * 2);
                p0 = MFMA32(k0, qf[d0], p0); p1 = MFMA32(k1, qf[d0], p1);
            }
            if (it >= 4 && mode == 0) {
                int csl = cs; asm volatile("" : "+v"(csl));
                const LAS float* bt = biasT + (g - gr + 7) * 31 + 15 - qc;
#pragma unroll
                for (int i = 0; i < 16; ++i) { const int k0 = crow(i, h), k1 = k0 + 32;
                    p0[i] = (k0 >= csl && k0 < csl + 16) ? p0[i] + bt[k0] : -INFINITY; p1[i] = (k1 >= csl && k1 < csl + 16) ? p1[i] + bt[k1] : -INFINITY; }
            } else if (it >= 4 && mode == 1) {
                const int d0 = 64 * g - tq;
#pragma unroll
                for (int i = 0; i < 16; ++i) { const int dd = d0 + crow(i, h);
                    if (dd > 128 || dd < -128) p0[i] = -INFINITY; if (dd + 32 > 128 || dd + 32 < -128) p1[i] = -INFINITY; }
            }
            float mx = p0[0];
#pragma unroll
            for (int i = 1; i < 16; ++i) mx = fmaxf(mx, p0[i]);
#pragma unroll
            for (int i = 0; i < 16; ++i) mx = fmaxf(mx, p1[i]);
            mx = fmaxf(mx, __shfl_xor(mx, 32));
            const float mnew = fmaxf(mrun, mx), alpha = __builtin_amdgcn_exp2f(mrun - mnew); mrun = mnew;
            float ls = 0.f;
#pragma unroll
            for (int i = 0; i < 16; ++i) { p0[i] = __builtin_amdgcn_exp2f(p0[i] - mnew); p1[i] = __builtin_amdgcn_exp2f(p1[i] - mnew); ls += p0[i] + p1[i]; }
            lrun = lrun * alpha + ls;
#pragma unroll
            for (int i = 0; i < 16; ++i) { o0[i] *= alpha; o1[i] *= alpha; }
            bf16x8 pa[4]; pa[0] = pack8<0>(p0); pa[1] = pack8<1>(p0); pa[2] = pack8<0>(p1); pa[3] = pack8<1>(p1);
            const LAS unsigned char* va = Vb + (4 * h + q4) * AT_RS + (16 * blk + 4 * p4) * 2;
#pragma unroll
            for (int ks = 0; ks < 4; ++ks) {
                const bf16x8 v0 = cat8(tr_read(va + (16 * ks) * AT_RS), tr_read(va + (16 * ks + 8) * AT_RS));
                const bf16x8 v1 = cat8(tr_read(va + (16 * ks) * AT_RS + 64), tr_read(va + (16 * ks + 8) * AT_RS + 64));
                o0 = MFMA32(v0, pa[ks], o0); o1 = MFMA32(v1, pa[ks], o1);
            }
        }
        if (it + 1 < ntile) AT_STORE(buf ^ 1);
        __syncthreads();
    }
#undef AT_LOAD
#undef AT_STORE
    const float lt = lrun + __shfl_xor(lrun, 32), inv = 1.f / lt;
    bf16_t* op = OC + (size_t)qrow * OCW + ocol + hq * 64 + 4 * h;
#pragma unroll
    for (int g4 = 0; g4 < 4; ++g4) {
        u32x2 w; w.x = pk2(o0[4 * g4] * inv, o0[4 * g4 + 1] * inv); w.y = pk2(o0[4 * g4 + 2] * inv, o0[4 * g4 + 3] * inv); *(u32x2*)(op + 8 * g4) = w;
        u32x2 w2; w2.x = pk2(o1[4 * g4] * inv, o1[4 * g4 + 1] * inv); w2.y = pk2(o1[4 * g4 + 2] * inv, o1[4 * g4 + 3] * inv); *(u32x2*)(op + 32 + 8 * g4) = w2;
    }
}

namespace ga_body {
using bf16=__hip_bfloat16;
using bf16x8=__attribute__((ext_vector_type(8)))short;
using s16x4=__attribute__((ext_vector_type(4)))short;
using f32x16=__attribute__((ext_vector_type(16)))float;
using u32x4=__attribute__((ext_vector_type(4)))unsigned;
constexpr int SEQ=8192,D=64,PQ=4608,PO=2048,NCTXT=4;
constexpr int NW=8,QBLK=32,QB=QBLK*NW,KVBLK=64,NQB=SEQ/QB;
__device__ __forceinline__ int crow(int r,int hi){return (r&3)+8*(r>>2)+4*hi;}
#define SBAR() __builtin_amdgcn_sched_barrier(0)
__device__ __forceinline__ void cmask(f32x16&p0,f32x16&p1,int jb,int qrel,int hi){
  const float NEG=-INFINITY; int kb=64*jb+4*hi;
  #pragma unroll
  for(int r=0;r<16;++r){int kv=kb+(r&3)+8*(r>>2); if(kv>qrel)p0[r]=NEG; if(kv+32>qrel)p1[r]=NEG;}
}

constexpr int NSLOT=3, SLOTB=8192;
constexpr int LDS_K=0, LDS_V=NSLOT*SLOTB, LDS_WS=2*NSLOT*SLOTB, LDS_OST=LDS_WS+NW*64*4, LDS_BYTES=LDS_OST+NW*4096;
constexpr float C2=0.125f*1.4426950408889634f;
__device__ __forceinline__ void glds16(const void*gsrc,unsigned lds_dst){unsigned keep;
  asm volatile("s_mov_b32 %0, m0\n\ts_mov_b32 m0, %2\n\ts_nop 0\n\tglobal_load_lds_dwordx4 %1, off\n\ts_mov_b32 m0, %0":"=&s"(keep):"v"(gsrc),"s"(lds_dst):"memory");}
__device__ __forceinline__ float max3f(float a,float b,float c){float r;asm("v_max3_f32 %0, %1, %2, %3":"=v"(r):"v"(a),"v"(b),"v"(c));return r;}
__device__ __forceinline__ float max2f(float a,float b){float r;asm("v_max_f32_e32 %0, %1, %2":"=v"(r):"v"(a),"v"(b));return r;}
__device__ __forceinline__ float fadd_s(float a,float b){float r;asm("v_add_f32_e32 %0, %1, %2":"=v"(r):"v"(a),"v"(b));return r;}
__device__ __forceinline__ float fsub_s(float a,float b){float r;asm("v_sub_f32_e32 %0, %1, %2":"=v"(r):"v"(a),"v"(b));return r;}
typedef float f32x2_t __attribute__((ext_vector_type(2))); typedef __bf16 bf16x2_t __attribute__((ext_vector_type(2)));
__device__ __forceinline__ unsigned cvtpk_s(float lo,float hi){f32x2_t v={lo,hi};bf16x2_t b=__builtin_convertvector(v,bf16x2_t);return __builtin_bit_cast(unsigned,b);}
#define WAIT_BAR(N) asm volatile("s_waitcnt vmcnt(" #N ") lgkmcnt(0)\n\ts_barrier":::"memory")

__device__ __forceinline__ void qkt(f32x16&p0,f32x16&p1,const char*Kslot,const bf16x8*qr,const f32x16&negm,int r32,int hi){
  const char*kb=Kslot+hi*1024+r32*16;
  #pragma unroll
  for(int d0=0;d0<4;++d0){
    const bf16x8 b0=*reinterpret_cast<const bf16x8*>(kb+d0*2048);
    const bf16x8 b1=*reinterpret_cast<const bf16x8*>(kb+d0*2048+512);
    if(d0==0){p0=__builtin_amdgcn_mfma_f32_32x32x16_bf16(b0,qr[0],negm,0,0,0);p1=__builtin_amdgcn_mfma_f32_32x32x16_bf16(b1,qr[0],negm,0,0,0);}
    else{p0=__builtin_amdgcn_mfma_f32_32x32x16_bf16(b0,qr[d0],p0,0,0,0);p1=__builtin_amdgcn_mfma_f32_32x32x16_bf16(b1,qr[d0],p1,0,0,0);}}
}
typedef __attribute__((address_space(3))) const char* lds_cptr;
typedef short v4i16_t __attribute__((ext_vector_type(4)));
__device__ __forceinline__ void kload8(bf16x8*kf,lds_cptr kp){
  kf[0]=*(const __attribute__((address_space(3))) bf16x8*)(kp);      kf[1]=*(const __attribute__((address_space(3))) bf16x8*)(kp+512);
  kf[2]=*(const __attribute__((address_space(3))) bf16x8*)(kp+2048); kf[3]=*(const __attribute__((address_space(3))) bf16x8*)(kp+2560);
  kf[4]=*(const __attribute__((address_space(3))) bf16x8*)(kp+4096); kf[5]=*(const __attribute__((address_space(3))) bf16x8*)(kp+4608);
  kf[6]=*(const __attribute__((address_space(3))) bf16x8*)(kp+6144); kf[7]=*(const __attribute__((address_space(3))) bf16x8*)(kp+6656);
}
__device__ __forceinline__ void kload2(bf16x8*kf,lds_cptr kp,int j){ kf[2*j]=*(const __attribute__((address_space(3))) bf16x8*)(kp+j*2048); kf[2*j+1]=*(const __attribute__((address_space(3))) bf16x8*)(kp+j*2048+512); }
__device__ __forceinline__ s16x4 vtr(lds_cptr p){ return __builtin_bit_cast(s16x4,__builtin_amdgcn_ds_read_tr16_b64_v4i16((__attribute__((address_space(3))) v4i16_t*)p)); }
__device__ __forceinline__ float rowmax(const f32x16&p0,const f32x16&p1){
  float a=max3f(p0[0],p0[1],p1[0]),b=max3f(p0[2],p0[3],p1[1]);a=max3f(a,p1[2],p1[3]);
  #pragma unroll
  for(int r=4;r<16;r+=4){a=max3f(a,p0[r],p0[r+1]);b=max3f(b,p0[r+2],p0[r+3]);a=max3f(a,p1[r],p1[r+1]);b=max3f(b,p1[r+2],p1[r+3]);}
  const float m=max2f(a,b);
  auto rr=__builtin_amdgcn_permlane32_swap(__float_as_uint(m),__float_as_uint(m),false,false);
  return max2f(__uint_as_float(rr[0]),__uint_as_float(rr[1]));
}
__device__ __forceinline__ void pv(f32x16*o,int vb,bf16x8 pa0,bf16x8 pa1,bf16x8 pa2,bf16x8 pa3){
  #pragma unroll
  for(int d0=0;d0<2;++d0){s16x4 lo[4],hi[4];
    #pragma unroll
    for(int ks=0;ks<4;++ks){
      asm volatile("ds_read_b64_tr_b16 %0,%1 offset:%c2":"=&v"(lo[ks]):"v"(vb),"i"(d0*4096+ks*1024):"memory");
      asm volatile("ds_read_b64_tr_b16 %0,%1 offset:%c2":"=&v"(hi[ks]):"v"(vb),"i"(d0*4096+ks*1024+512):"memory");}
    asm volatile("s_waitcnt lgkmcnt(0)":::"memory");SBAR();
    #define PK(k) (bf16x8){lo[k][0],lo[k][1],lo[k][2],lo[k][3],hi[k][0],hi[k][1],hi[k][2],hi[k][3]}
    o[d0]=__builtin_amdgcn_mfma_f32_32x32x16_bf16(pa0,PK(0),o[d0],0,0,0);
    o[d0]=__builtin_amdgcn_mfma_f32_32x32x16_bf16(pa1,PK(1),o[d0],0,0,0);
    o[d0]=__builtin_amdgcn_mfma_f32_32x32x16_bf16(pa2,PK(2),o[d0],0,0,0);
    o[d0]=__builtin_amdgcn_mfma_f32_32x32x16_bf16(pa3,PK(3),o[d0],0,0,0);
    #undef PK
  }
}

#ifndef ATTN_STORE16
#define ATTN_STORE16(p,v) (*(u32x4*)(p)=(v))
#endif
template<int THRL> __device__ __forceinline__ void attn_unit(int qb,const bf16*Qp,const bf16*__restrict__ Kl,const bf16*__restrict__ Vl,const bf16*__restrict__ Kc,const bf16*__restrict__ Vc,bf16*Op,char*shm,const int tid){
  const int lane=tid&63,r32=lane&31,hi=lane>>5; const int wid=__builtin_amdgcn_readfirstlane(tid>>6);
  const int q0=qb*QB;
  const bf16*Qw=Qp+(long)(q0+wid*QBLK)*PQ;
  const unsigned lds0=(unsigned)(uintptr_t)shm;
  float*wsf=(float*)(shm+LDS_WS)+wid*64;
  const long koff=(long)lane*PQ+wid*8;
  const long voff=(long)(16*(wid&3)+(lane>>2))*PQ+(wid>>2)*32+(lane&3)*8;
  const unsigned kdst=lds0+LDS_K+wid*1024, vdst=lds0+LDS_V+wid*1024;
  #define TILE_SRC(t,C,L) (((t)<NCTXT?(C)+(long)(t)*KVBLK*PQ:(L)+(long)((t)-NCTXT)*KVBLK*PQ))
  #define DMA_K(t,slot) glds16(TILE_SRC(t,Kc,Kl)+koff,(unsigned)__builtin_amdgcn_readfirstlane(kdst+(slot)))
  #define DMA_V(t,slot) glds16(TILE_SRC(t,Vc,Vl)+voff,(unsigned)__builtin_amdgcn_readfirstlane(vdst+(slot)))
  const int vb0=(int)(lds0+LDS_V)+((lane>>4)&1)*32+(lane&3)*8+(4*hi+((lane&15)>>2))*64;
  const char*Kbase=shm+LDS_K; bf16x8 kf[8];
  const lds_cptr shm3=(lds_cptr)shm; const lds_cptr kp0=shm3+LDS_K+hi*1024+r32*16; const lds_cptr vp0=shm3+LDS_V+((lane>>4)&1)*32+(lane&3)*8+(4*hi+((lane&15)>>2))*64;
  constexpr int NT=NCTXT+SEQ/KVBLK;
  DMA_K(0,0);DMA_V(0,0);DMA_K(1,SLOTB);
  bf16x8 qr[4];
  #pragma unroll
  for(int d0=0;d0<4;++d0)qr[d0]=*reinterpret_cast<const bf16x8*>(&Qw[(long)r32*PQ+d0*16+hi*8]);
  float mhat=0.f,l_reg=0.f;f32x16 o[2];o[0]=f32x16{};o[1]=f32x16{};f32x16 negm=f32x16{};asm volatile("":"+v"(negm));
  #define CMASK(P0,P1,t) do{}while(0)
  bool resc=false;
  #define START(P0,P1) do{ const float rm=rowmax(P0,P1); resc=false; \
    { const float dl=rm; mhat=fadd_s(mhat,dl); \
      _Pragma("unroll") for(int r=0;r<16;++r){P0[r]=fsub_s(P0[r],dl);P1[r]=fsub_s(P1[r],dl);} \
      _Pragma("unroll") for(int r=0;r<16;++r)negm[r]=-mhat; asm volatile("":"+v"(negm)); } \
    _Pragma("unroll") for(int r=0;r<16;++r)P0[r]=__builtin_amdgcn_exp2f(P0[r]); }while(0)
  #define RESC() do{ if(resc){ asm volatile("s_waitcnt lgkmcnt(0)":::"memory"); \
      _Pragma("unroll") for(int d_=0;d_<2;++d_) _Pragma("unroll") for(int r=0;r<16;++r)o[d_][r]*=wsf[crow(r,hi)]; } }while(0)
  f32x16 pA0,pA1,pB0,pB1;
  int sl_prev=0,sl_cur=0,sl_next=SLOTB;
  #define ROT() do{sl_prev=sl_cur;sl_cur=sl_next;sl_next=(sl_next==(NSLOT-1)*SLOTB)?0:sl_next+SLOTB;}while(0)
  DMA_K(2,2*SLOTB);
  WAIT_BAR(3);
  qkt(pA0,pA1,Kbase,qr,negm,r32,hi);asm volatile("s_nop 15\n\ts_nop 7":"+v"(pA0),"+v"(pA1));CMASK(pA0,pA1,0);
  START(pA0,pA1);
  _Pragma("unroll") for(int r=0;r<16;++r)pA1[r]=__builtin_amdgcn_exp2f(pA1[r]);
  WAIT_BAR(0);
  DMA_K(3,0);DMA_V(1,SLOTB);
  ROT();
  kload8(kf,kp0+sl_cur);
  WAIT_BAR(2);
  s16x4 vlo[8],vhi[8]; u32x4 pw0,pw1,pw2,pw3;
  #define PKW(P,B) cvtpk_s(P[B],P[B+1])
  #define PAF(k) __builtin_bit_cast(bf16x8,pw##k)
  #define VFR(i) (bf16x8){vlo[i][0],vlo[i][1],vlo[i][2],vlo[i][3],vhi[i][0],vhi[i][1],vhi[i][2],vhi[i][3]}
  #define PIN(x) asm volatile("":"+v"(x))
  #define MX3(a,b,c) __builtin_fmaxf(__builtin_fmaxf((a),(b)),(c))
  #define GAPA(MF,A0,A1,A2,A3,W0,W1,PW) do{ MF; sacc+=A0; sacc+=A1; sacc+=A2; sacc+=A3; PIN(sacc); W0; W1; PIN(PW); SBAR(); }while(0)
  #define EX(v) __builtin_amdgcn_exp2f(v)
  #define GAPB(MF,X,B) do{ MF; X[B]=EX(X[B]); X[B+1]=EX(X[B+1]); X[B+2]=EX(X[B+2]); X[B+3]=EX(X[B+3]); PIN(X); SBAR(); }while(0)
  #define VRD(i) do{ vlo[i]=vtr(vp_+(((i)>>2)*4096+((i)&3)*1024)); vhi[i]=vtr(vp_+(((i)>>2)*4096+((i)&3)*1024+512)); }while(0)
  #define KRD(G,j) do{ if(G){ kload2(kf,kp0+sl_next,j); SBAR(); } }while(0)
  #define STEP(C0,C1,P0,P1,t,GK,GV,GL) do{ SBAR(); \
    const lds_cptr vp_=vp0+sl_prev; \
    VRD(0); SBAR(); float sacc=(P0[0]+P0[1]); \
    GAPA(C0=__builtin_amdgcn_mfma_f32_32x32x16_bf16(kf[0],qr[0],negm,0,0,0), P0[2],P0[3],P0[4],P0[5],     pw0[0]=PKW(P0,0), pw0[1]=PKW(P0,2), pw0); \
    VRD(4); SBAR(); GAPA(C1=__builtin_amdgcn_mfma_f32_32x32x16_bf16(kf[1],qr[0],negm,0,0,0), P0[6],P0[7],P0[8],P0[9],     pw0[2]=PKW(P0,4), pw0[3]=PKW(P0,6), pw0); \
    VRD(1); SBAR(); GAPA(C0=__builtin_amdgcn_mfma_f32_32x32x16_bf16(kf[2],qr[1],C0,0,0,0),   P0[10],P0[11],P0[12],P0[13], pw1[0]=PKW(P0,8), pw1[1]=PKW(P0,10), pw1); \
    VRD(5); SBAR(); GAPA(C1=__builtin_amdgcn_mfma_f32_32x32x16_bf16(kf[3],qr[1],C1,0,0,0),   P0[14],P0[15],P1[0],P1[1],   pw1[2]=PKW(P0,12),pw1[3]=PKW(P0,14), pw1); \
    VRD(2); SBAR(); GAPA(C0=__builtin_amdgcn_mfma_f32_32x32x16_bf16(kf[4],qr[2],C0,0,0,0),   P1[2],P1[3],P1[4],P1[5],     pw2[0]=PKW(P1,0), pw2[1]=PKW(P1,2), pw2); \
    VRD(6); SBAR(); GAPA(C1=__builtin_amdgcn_mfma_f32_32x32x16_bf16(kf[5],qr[2],C1,0,0,0),   P1[6],P1[7],P1[8],P1[9],     pw2[2]=PKW(P1,4), pw2[3]=PKW(P1,6), pw2); \
    VRD(3); SBAR(); GAPA(C0=__builtin_amdgcn_mfma_f32_32x32x16_bf16(kf[6],qr[3],C0,0,0,0),   P1[10],P1[11],P1[12],P1[13], pw3[0]=PKW(P1,8), pw3[1]=PKW(P1,10), pw3); \
    VRD(7); SBAR(); GAPA(C1=__builtin_amdgcn_mfma_f32_32x32x16_bf16(kf[7],qr[3],C1,0,0,0),   P1[14],P1[15],0.f,0.f,       pw3[2]=PKW(P1,12),pw3[3]=PKW(P1,14), pw3); \
    l_reg+=sacc; \
    if(GK){DMA_K((t)+3,sl_cur);} if(GV){DMA_V((t)+1,sl_next);} \
    CMASK(C0,C1,t); \
    { float a=MX3(C0[0],C0[1],C1[0]),b=MX3(C0[2],C0[3],C1[1]); a=MX3(a,C1[2],C1[3]); \
      _Pragma("unroll") for(int r=4;r<16;r+=4){a=MX3(a,C0[r],C0[r+1]);b=MX3(b,C0[r+2],C0[r+3]);a=MX3(a,C1[r],C1[r+1]);b=MX3(b,C1[r+2],C1[r+3]);} \
      float rm=__builtin_fmaxf(a,b); { auto rr=__builtin_amdgcn_permlane32_swap(__float_as_uint(rm),__float_as_uint(rm),false,false); rm=__builtin_fmaxf(__uint_as_float(rr[0]),__uint_as_float(rr[1])); } \
      resc=false; \
      if(__builtin_expect(__any(rm>(float)THRL),0)){ const float dl=__builtin_fmaxf(rm,0.f); mhat+=dl; \
        _Pragma("unroll") for(int r=0;r<16;++r){C0[r]-=dl;C1[r]-=dl;} \
        _Pragma("unroll") for(int r=0;r<16;++r)negm[r]=-mhat; asm volatile("":"+v"(negm)); \
        const float f=__builtin_amdgcn_exp2f(-dl); l_reg*=f; if(hi==0)wsf[r32]=f; resc=true; } } \
    SBAR(); \
    GAPB(o[0]=__builtin_amdgcn_mfma_f32_32x32x16_bf16(PAF(0),VFR(0),o[0],0,0,0), C0,0); \
    GAPB(o[1]=__builtin_amdgcn_mfma_f32_32x32x16_bf16(PAF(0),VFR(4),o[1],0,0,0), C0,4); \
    KRD(GL,0); GAPB(o[0]=__builtin_amdgcn_mfma_f32_32x32x16_bf16(PAF(1),VFR(1),o[0],0,0,0), C0,8); \
    KRD(GL,1); GAPB(o[1]=__builtin_amdgcn_mfma_f32_32x32x16_bf16(PAF(1),VFR(5),o[1],0,0,0), C0,12); \
    KRD(GL,2); GAPB(o[0]=__builtin_amdgcn_mfma_f32_32x32x16_bf16(PAF(2),VFR(2),o[0],0,0,0), C1,0); \
    KRD(GL,3); GAPB(o[1]=__builtin_amdgcn_mfma_f32_32x32x16_bf16(PAF(2),VFR(6),o[1],0,0,0), C1,4); \
    GAPB(o[0]=__builtin_amdgcn_mfma_f32_32x32x16_bf16(PAF(3),VFR(3),o[0],0,0,0), C1,8); \
    GAPB(o[1]=__builtin_amdgcn_mfma_f32_32x32x16_bf16(PAF(3),VFR(7),o[1],0,0,0), C1,12); \
    }while(0)
  int t=1;
  #undef CMASK
  #define CMASK(P0,P1,t) do{}while(0)
  for(;t+5<NT;t+=2){
    STEP(pB0,pB1,pA0,pA1,t,true,true,true);     WAIT_BAR(2); RESC(); ROT();
    STEP(pA0,pA1,pB0,pB1,t+1,true,true,true);   WAIT_BAR(2); RESC(); ROT();
  }
  #undef CMASK
  #define CMASK(P0,P1,t) do{}while(0)
  #define ENDW(tt) do{ if((tt)+3<NT){WAIT_BAR(2);} else if((tt)+2<NT){WAIT_BAR(1);} else {WAIT_BAR(0);} }while(0)
  for(;t+1<NT;t+=2){
    STEP(pB0,pB1,pA0,pA1,t,(t+3<NT),(t+1<NT),(t+1<NT));       ENDW(t);   RESC(); ROT();
    STEP(pA0,pA1,pB0,pB1,t+1,(t+4<NT),(t+2<NT),(t+2<NT));     ENDW(t+1); RESC(); ROT();
  }
  STEP(pB0,pB1,pA0,pA1,NT-1,false,false,false); RESC();
  { float sacc=pB0[0]+pB0[1]; _Pragma("unroll") for(int r=2;r<16;++r)sacc+=pB0[r]; _Pragma("unroll") for(int r=0;r<16;++r)sacc+=pB1[r]; l_reg+=sacc;
    pw0=(u32x4){PKW(pB0,0),PKW(pB0,2),PKW(pB0,4),PKW(pB0,6)};pw1=(u32x4){PKW(pB0,8),PKW(pB0,10),PKW(pB0,12),PKW(pB0,14)};pw2=(u32x4){PKW(pB1,0),PKW(pB1,2),PKW(pB1,4),PKW(pB1,6)};pw3=(u32x4){PKW(pB1,8),PKW(pB1,10),PKW(pB1,12),PKW(pB1,14)};
    SBAR(); pv(o,vb0+sl_cur,PAF(0),PAF(1),PAF(2),PAF(3)); }
  #undef PKW
  #undef PAF
  #undef VFR
  #undef PIN
  #undef MX3
  #undef GAPA
  #undef GAPB
  #undef EX
  #undef VRD
  #undef KRD
  #undef STEP
  #undef ENDW
  {auto rr=__builtin_amdgcn_permlane32_swap(__float_as_uint(l_reg),__float_as_uint(l_reg),false,false);l_reg=__uint_as_float(rr[0])+__uint_as_float(rr[1]);}
  if(hi==0)wsf[32+r32]=l_reg;asm volatile("s_waitcnt lgkmcnt(0)":::"memory");
  float rli[16];
  #pragma unroll
  for(int r=0;r<16;++r)rli[r]=__builtin_amdgcn_rcpf(wsf[32+crow(r,hi)]);
  bf16*Ow=Op+(long)(q0+wid*QBLK)*PO;
  { bf16*stg=(bf16*)(shm+LDS_OST)+wid*2048;
    #pragma unroll
    for(int r=0;r<16;++r){const int orow=crow(r,hi);
      #pragma unroll
      for(int d0=0;d0<2;++d0)stg[orow*64+d0*32+r32]=__float2bfloat16(o[d0][r]*rli[r]);}
    asm volatile("s_waitcnt lgkmcnt(0)":::"memory");
    #pragma unroll
    for(int i=0;i<4;++i){const int row=i*8+(lane>>3),ch=lane&7; const u32x4 v=*(const u32x4*)(stg+row*64+ch*8); ATTN_STORE16(Ow+(long)row*PO+ch*8,v);} }
  asm volatile("s_waitcnt lgkmcnt(0)\n\ts_barrier":::"memory");
  #undef DMA_K
  #undef TILE_SRC
  #undef DMA_V
  #undef CMASK
  #undef START
  #undef RESC
  #undef ROT
}
#undef SBAR
#undef WAIT_BAR
}

constexpr int SD_CUM = 0, SD_DTV = 1024, SD_XC = 2048, SD_XCS = 144, SD_BC = SD_XC + 128 * SD_XCS, SD_BCS = 272, SD_CC = SD_BC + 128 * SD_BCS, SD_HS = SD_CC + 128 * SD_BCS,
              SD_SSQ = SD_HS + 2 * 64 * SD_BCS, SD_XW = SD_CC;
static_assert(SD_SSQ + 1024 <= RING_BYTES && SD_XW + 2 * 128 * SD_XCS <= RING_BYTES, "SSD LDS map");
DI int chunk_row(int b, int cidx) { return cidx < 2 ? NLAT + b * CTXL + 128 * cidx : b * SEQ + 128 * (cidx - 2); }
DI void ssd_cum(const Frame& F, int l, int b, int cidx, int hd) {
    if (F.wave < 2) {
        const int dir = F.wave; const float* DT = WSP(float, WS_DT) + (size_t)chunk_row(b, cidx) * 16 + dir * 8 + hd;
        const float a = -__expf(F.in[I_ALOG][l * 16 + dir * 8 + hd]);
        const float d0 = DT[(size_t)(2 * F.lane) * 16], d1 = DT[(size_t)(2 * F.lane + 1) * 16];
        const float a0 = d0 * a, a1 = d1 * a, s = a0 + a1; float v = s;
        LAS float* cum = (LAS float*)(F.lds + SD_CUM) + dir * 128; LAS float* dtv = (LAS float*)(F.lds + SD_DTV) + dir * 128;
        if (dir == 0) {
#pragma unroll
            for (int o = 1; o < 64; o <<= 1) { const float t = __shfl_up(v, o); if (F.lane >= o) v += t; }
            cum[2 * F.lane] = v - s + a0; cum[2 * F.lane + 1] = v;
        } else {
#pragma unroll
            for (int o = 1; o < 64; o <<= 1) { const float t = __shfl_down(v, o); if (F.lane + o < 64) v += t; }
            cum[2 * F.lane + 1] = v - s + a1; cum[2 * F.lane] = v;
        }
        dtv[2 * F.lane] = d0; dtv[2 * F.lane + 1] = d1;
    }
}
DI void conv_tile(const Frame& F, int l, LAS unsigned char* dst, int dstride, int ch0, int nchunks, int rowbase, int seqlo, int seqhi) {
    const bf16_t* PRJ = WSP(bf16_t, WS_PRJ); const float* cw = F.in[I_CONVW] + (size_t)l * 5 * 1024; const float* cb = F.in[I_CONVB] + l * 1024;
    for (int item = F.tid; item < nchunks * 16; item += NTHR) {
        const int chunk = item % nchunks, seg = item / nchunks, t0 = seg * 8, c0 = ch0 + chunk * 8;
        float w[5][8], bb[8];
#pragma unroll
        for (int k = 0; k < 5; ++k) { const f32x4 wa = *(const f32x4*)(cw + k * 1024 + c0), wb = *(const f32x4*)(cw + k * 1024 + c0 + 4);
            w[k][0] = wa[0]; w[k][1] = wa[1]; w[k][2] = wa[2]; w[k][3] = wa[3]; w[k][4] = wb[0]; w[k][5] = wb[1]; w[k][6] = wb[2]; w[k][7] = wb[3]; }
        { const f32x4 ba = *(const f32x4*)(cb + c0), b2 = *(const f32x4*)(cb + c0 + 4); bb[0] = ba[0]; bb[1] = ba[1]; bb[2] = ba[2]; bb[3] = ba[3]; bb[4] = b2[0]; bb[5] = b2[1]; bb[6] = b2[2]; bb[7] = b2[3]; }
        u32x4 rows[12];
#pragma unroll
        for (int i = 0; i < 12; ++i) { const int row = rowbase + t0 - 2 + i;
            rows[i] = (row >= seqlo && row < seqhi) ? *(const u32x4*)(PRJ + (size_t)row * PRJW + C_XBC + c0) : (u32x4){0u, 0u, 0u, 0u}; }
#pragma unroll
        for (int j = 0; j < 8; ++j) {
            float y[8];
#pragma unroll
            for (int e = 0; e < 8; ++e) y[e] = bb[e];
#pragma unroll
            for (int k = 0; k < 5; ++k) { const u32x4 rr = rows[j + k];
                y[0] += w[k][0] * bflo(rr.x); y[1] += w[k][1] * bfhi(rr.x); y[2] += w[k][2] * bflo(rr.y); y[3] += w[k][3] * bfhi(rr.y);
                y[4] += w[k][4] * bflo(rr.z); y[5] += w[k][5] * bfhi(rr.z); y[6] += w[k][6] * bflo(rr.w); y[7] += w[k][7] * bfhi(rr.w); }
            u32x4 o; o.x = pk2(silu(y[0]), silu(y[1])); o.y = pk2(silu(y[2]), silu(y[3])); o.z = pk2(silu(y[4]), silu(y[5])); o.w = pk2(silu(y[6]), silu(y[7]));
            *(LAS u32x4*)(dst + (t0 + j) * dstride + chunk * 16) = o;
        }
    }
}
DI void ssd_s1_unit(const Frame& Fin, int l, int b, int cidx, int hd) {
    const Frame F = launder(Fin);
    const int lane = F.lane, wid = F.wave, r = lane & 31, h = lane >> 5;
    const int rowbase = chunk_row(b, cidx), seqlo = cidx < 2 ? NLAT + b * CTXL : b * SEQ, seqhi = cidx < 2 ? seqlo + CTXL : seqlo + SEQ;
    __syncthreads();
    ssd_cum(F, l, b, cidx, hd);
    conv_tile(F, l, F.lds + SD_XC, SD_XCS, 64 * hd, 8, rowbase, seqlo, seqhi);
    conv_tile(F, l, F.lds + SD_BC, SD_BCS, 512 + 128 * (hd >> 2), 16, rowbase, seqlo, seqhi);
    __syncthreads();
    const LAS float* cum = (const LAS float*)(F.lds + SD_CUM); const LAS float* dtv = (const LAS float*)(F.lds + SD_DTV);
    for (int i = F.tid; i < 2 * 128 * 8; i += NTHR) {
        const int dir = i >> 10, t = (i >> 3) & 127, c8 = i & 7;
        const float ce = dir == 0 ? cum[127] : cum[128]; const float wgt = dtv[dir * 128 + t] * __expf(ce - cum[dir * 128 + t]);
        const u32x4 x = *(const LAS u32x4*)(F.lds + SD_XC + t * SD_XCS + c8 * 16);
        u32x4 o; o.x = pk2(bflo(x.x) * wgt, bfhi(x.x) * wgt); o.y = pk2(bflo(x.y) * wgt, bfhi(x.y) * wgt); o.z = pk2(bflo(x.z) * wgt, bfhi(x.z) * wgt); o.w = pk2(bflo(x.w) * wgt, bfhi(x.w) * wgt);
        *(LAS u32x4*)(F.lds + SD_XW + (dir * 128 + t) * SD_XCS + c8 * 16) = o;
    }
    __syncthreads();
    const int dir = wid >> 2, nb = wid & 3, q4 = (lane & 15) >> 2, p4 = lane & 3, blk = (lane >> 4) & 1;
    f32x16 s0, s1;
#pragma unroll
    for (int i = 0; i < 16; ++i) { s0[i] = 0.f; s1[i] = 0.f; }
    const LAS unsigned char* xa = F.lds + SD_XW + (dir * 128 + 8 * h + q4) * SD_XCS + (16 * blk + 4 * p4) * 2;
    const LAS unsigned char* ba = F.lds + SD_BC + (8 * h + q4) * SD_BCS + (32 * nb + 16 * blk + 4 * p4) * 2;
#pragma unroll
    for (int ks = 0; ks < 8; ++ks) {
        const bf16x8 bfr = cat8(tr_read(ba + (16 * ks) * SD_BCS), tr_read(ba + (16 * ks + 4) * SD_BCS));
        const bf16x8 x0 = cat8(tr_read(xa + (16 * ks) * SD_XCS), tr_read(xa + (16 * ks + 4) * SD_XCS));
        const bf16x8 x1 = cat8(tr_read(xa + (16 * ks) * SD_XCS + 64), tr_read(xa + (16 * ks + 4) * SD_XCS + 64));
        s0 = MFMA32(x0, bfr, s0); s1 = MFMA32(x1, bfr, s1);
    }
    float* ST = WSP(float, WS_ST) + ((((size_t)b * NCH + cidx) * 8 + hd) * 2 + dir) * 8192 + 32 * nb + r;
#pragma unroll
    for (int i = 0; i < 16; ++i) { ST[(size_t)crow(i, h) * 128] = s0[i]; ST[(size_t)(32 + crow(i, h)) * 128] = s1[i]; }
    if (F.tid < 2) WSP(float, WS_CDEC)[(((size_t)b * NCH + cidx) * 8 + hd) * 2 + F.tid] = __expf(F.tid == 0 ? cum[127] : cum[128]);
}
DI void phase_scan(const Frame& F) {
    float* ST = WSP(float, WS_ST); const float* CD = WSP(float, WS_CDEC);
    for (int gid = F.vcu * NTHR + F.tid; gid < 64 * 2048; gid += F.G * NTHR) {
        const int chain = gid >> 11, e4 = gid & 2047, b = chain >> 4, hd = (chain >> 1) & 7, dir = chain & 1;
        f32x4 hst = (f32x4){0.f, 0.f, 0.f, 0.f};
#pragma unroll 6
        for (int k = 0; k < NCH; ++k) {
            const int cidx = dir == 0 ? k : (k < 2 ? 1 - k : 67 - k);
            const size_t idx = (((size_t)b * NCH + cidx) * 8 + hd) * 2 + dir;
            f32x4* p = (f32x4*)(ST + idx * 8192) + e4; const f32x4 st = *p; const float dec = CD[idx];
            *p = hst; hst = hst * dec + st;
        }
    }
}
DI void ssd_s3_unit(const Frame& Fin, int l, int b, int cidx, int hd) {
    const Frame F = launder(Fin);
    const int lane = F.lane, wid = F.wave, r = lane & 31, h = lane >> 5;
    const int rowbase = chunk_row(b, cidx), seqlo = cidx < 2 ? NLAT + b * CTXL : b * SEQ, seqhi = cidx < 2 ? seqlo + CTXL : seqlo + SEQ;
    __syncthreads();
    ssd_cum(F, l, b, cidx, hd);
    conv_tile(F, l, F.lds + SD_XC, SD_XCS, 64 * hd, 8, rowbase, seqlo, seqhi);
    conv_tile(F, l, F.lds + SD_BC, SD_BCS, 512 + 128 * (hd >> 2), 16, rowbase, seqlo, seqhi);
    conv_tile(F, l, F.lds + SD_CC, SD_BCS, 768 + 128 * (hd >> 2), 16, rowbase, seqlo, seqhi);
    {
        const float* ST = WSP(float, WS_ST) + (((size_t)b * NCH + cidx) * 8 + hd) * 2 * 8192;
        for (int i = F.tid; i < 2 * 64 * 16; i += NTHR) { const int dp = i >> 4, c8 = i & 15; const f32x4 a = *(const f32x4*)(ST + (size_t)dp * 128 + c8 * 8), c = *(const f32x4*)(ST + (size_t)dp * 128 + c8 * 8 + 4);
            u32x4 o; o.x = pk2(a[0], a[1]); o.y = pk2(a[2], a[3]); o.z = pk2(c[0], c[1]); o.w = pk2(c[2], c[3]); *(LAS u32x4*)(F.lds + SD_HS + dp * SD_BCS + c8 * 16) = o; }
    }
    __syncthreads();
    const LAS float* cum = (const LAS float*)(F.lds + SD_CUM); const LAS float* dtv = (const LAS float*)(F.lds + SD_DTV);
    const int lb = wid & 3, ph = wid >> 2, q4 = (lane & 15) >> 2, p4 = lane & 3, blk = (lane >> 4) & 1;
    const int lidx = 32 * lb + r;
    bf16x8 cf[8];
#pragma unroll
    for (int ks = 0; ks < 8; ++ks) cf[ks] = *(const LAS bf16x8*)(F.lds + SD_CC + lidx * SD_BCS + (16 * ks + 8 * h) * 2);
    f32x16 gt[4];
#pragma unroll
    for (int sb = 0; sb < 4; ++sb) {
#pragma unroll
        for (int i = 0; i < 16; ++i) gt[sb][i] = 0.f;
#pragma unroll
        for (int ks = 0; ks < 8; ++ks) { const bf16x8 bfr = *(const LAS bf16x8*)(F.lds + SD_BC + (32 * sb + r) * SD_BCS + (16 * ks + 8 * h) * 2); gt[sb] = MFMA32(bfr, cf[ks], gt[sb]); }
    }
    f32x16 ytot;
#pragma unroll
    for (int i = 0; i < 16; ++i) ytot[i] = 0.f;
    const LAS unsigned char* xa = F.lds + SD_XC + (4 * h + q4) * SD_XCS + (32 * ph + 16 * blk + 4 * p4) * 2;
#pragma unroll
    for (int dir = 0; dir < 2; ++dir) {
        const float cl = cum[dir * 128 + lidx];
        f32x16 acc;
#pragma unroll
        for (int i = 0; i < 16; ++i) acc[i] = 0.f;
#pragma unroll
        for (int sb = 0; sb < 4; ++sb) {
            const bool relv = dir == 0 ? (sb <= lb) : (sb >= lb);
            if (relv) {
                f32x16 mt; int rl = r; asm volatile("" : "+v"(rl));
#pragma unroll
                for (int i = 0; i < 16; ++i) { const int sl = crow(i, h), s = 32 * sb + sl;
                    const bool ok = (sb != lb) || (dir == 0 ? (sl <= rl) : (sl >= rl));
                    const float e = __expf(cl - cum[dir * 128 + s]) * dtv[dir * 128 + s];
                    mt[i] = ok ? gt[sb][i] * e : 0.f; }
                const bf16x8 pa0 = pack8<0>(mt), pa1 = pack8<1>(mt);
                const bf16x8 x0 = cat8(tr_read(xa + (32 * sb) * SD_XCS), tr_read(xa + (32 * sb + 8) * SD_XCS));
                const bf16x8 x1 = cat8(tr_read(xa + (32 * sb + 16) * SD_XCS), tr_read(xa + (32 * sb + 24) * SD_XCS));
                acc = MFMA32(x0, pa0, acc); acc = MFMA32(x1, pa1, acc);
            }
        }
        f32x16 yo;
#pragma unroll
        for (int i = 0; i < 16; ++i) yo[i] = 0.f;
#pragma unroll
        for (int ks = 0; ks < 8; ++ks) { const bf16x8 hf = *(const LAS bf16x8*)(F.lds + SD_HS + (dir * 64 + 32 * ph + r) * SD_BCS + (16 * ks + 8 * h) * 2); yo = MFMA32(hf, cf[ks], yo); }
        const float el = __expf(cl);
#pragma unroll
        for (int i = 0; i < 16; ++i) ytot[i] += acc[i] + el * yo[i];
    }
    const float dsk = F.in[I_DSKIP][l * 8 + hd];
    const int row = rowbase + lidx;
    const bf16_t* zp = WSP(bf16_t, WS_PRJ) + (size_t)row * PRJW + C_Z + 64 * hd + 32 * ph + 4 * h;
    bf16_t* op = WSP(bf16_t, WS_OC) + (size_t)row * OCW + 1536 + 64 * hd + 32 * ph + 4 * h;
    float ss = 0.f;
#pragma unroll
    for (int g4 = 0; g4 < 4; ++g4) {
        const u32x2 zz = *(const u32x2*)(zp + 8 * g4);
        const u32x2 xx = *(const LAS u32x2*)(F.lds + SD_XC + lidx * SD_XCS + (32 * ph + 8 * g4 + 4 * h) * 2);
        const float v0 = (ytot[4 * g4] + dsk * bflo(xx.x)) * silu(bflo(zz.x)), v1 = (ytot[4 * g4 + 1] + dsk * bfhi(xx.x)) * silu(bfhi(zz.x));
        const float v2 = (ytot[4 * g4 + 2] + dsk * bflo(xx.y)) * silu(bflo(zz.y)), v3 = (ytot[4 * g4 + 3] + dsk * bfhi(xx.y)) * silu(bfhi(zz.y));
        ss += (v0 * v0 + v1 * v1) + (v2 * v2 + v3 * v3);
        u32x2 w; w.x = pk2(v0, v1); w.y = pk2(v2, v3); *(u32x2*)(op + 8 * g4) = w;
    }
    ss += __shfl_xor(ss, 32);
    LAS float* sq = (LAS float*)(F.lds + SD_SSQ);
    if (h == 0) sq[ph * 128 + lidx] = ss;
    __syncthreads();
    if (F.tid < 128) WSP(float, WS_SSQ)[(size_t)(rowbase + F.tid) * 8 + hd] = sq[F.tid] + sq[128 + F.tid];
}

constexpr int PH_PER_LAYER = 11, N_PHASES = 2 + PH_PER_LAYER * DEPTH;
__global__ void __launch_bounds__(NTHR, 2) fwd_kernel(Args args) {
    extern __shared__ __attribute__((aligned(16))) unsigned char smem[];
    Frame F0;
    F0.lds = (LAS unsigned char*)smem;
    F0.tid = threadIdx.x; F0.lane = F0.tid & 63; F0.wave = __builtin_amdgcn_readfirstlane(F0.tid >> 6);
    F0.G = gridDim.x; { const int bx = blockIdx.x; F0.vcu = (F0.G % 8 == 0) ? (bx % 8) * (F0.G / 8) + bx / 8 : bx; }
    F0.in = args.in; F0.out = args.out; F0.ws = args.ws; F0.ctl = (gu32*)(args.ws + WS_CTL);
    volatile LAS unsigned* MISC = (volatile LAS unsigned*)(F0.lds + MISC_OFF);
    for (int u = F0.tid; u < (LDS_BYTES - RING_BYTES) / 4; u += NTHR) ((LAS unsigned*)(F0.lds + RING_BYTES))[u] = 0u;
    __syncthreads();
    XcdBarrier bar; bar.bar = (unsigned*)(F0.ctl + CW_BAR); bar.x = 0; bar.st = nullptr;
    if (!MK_PER_PHASE) bar = xcd_barrier_post((unsigned*)(F0.ctl + CW_BAR), MISC + 8);
    const int lo = args.ph_lo, hi = args.ph_hi;
#define IN(k) (lo <= (k) && (k) < hi)
#define SEAM(k) do { if (IN(k) && IN((k) + 1)) { if (MK_PER_PHASE) { if (F0.tid == 0) __hip_atomic_store(F0.ctl + 0, 0xBADBA0u, __ATOMIC_RELAXED, __HIP_MEMORY_SCOPE_AGENT); } else xcd_barrier(bar); } } while (0)

    if (PHM(11) && IN(0)) { const Frame F = launder(F0); phase_prologue_a(F); } SEAM(0);
    if (PHM(12) && IN(1)) { const Frame F = launder(F0); phase_prologue_b(F); } SEAM(1);

    for (int l = 0; l < DEPTH; ++l) {
        const int pb = 2 + PH_PER_LAYER * l;
        const bool with_ctx = l < DEPTH - 1, moe = l & 1; const int fi = l >> 1;
        const int mrows = with_ctx ? MTOT : NLAT, mtiles = with_ctx ? 132 : 128;
        if (PHM(0) && IN(pb + 0)) { const Frame F = launder(F0);
            pg8::SchedGrid S; S.nMa = mtiles; S.nNa = 34; S.nMb = with_ctx ? 0 : 4; S.nNb = 18; S.total = S.nMa * S.nNa + S.nMb * S.nNb; S.G = F.G; S.c = F.vcu;
            S.A = (const char*)(F.ws + WS_HB); S.B = (const char*)(F.ws + WS_WCOMB + l * SZ_WCOMB); S.lda = DM; S.ldb = DM; S.a_div = 1; S.a_cols = 0; S.pe = nullptr; S.estride = 0;
            pg8::EpiInGate E{WSP(bf16_t, WS_PRJ), WSP(bf16_t, WS_GT), F.in[I_BGATE] + (size_t)l * 4096};
            pg8::gemm_phase(F.lds, F.tid, DM, DM, DM, S, E);
        }
        SEAM(pb + 0);
        if (PHM(1) && IN(pb + 1)) { const Frame F = launder(F0);
            phase_qkprep_rows(F, l);
            for (int u = F.vcu; u < NB * NCH * 8; u += F.G) { const int hd = u & 7, cidx = (u >> 3) % NCH, b = (u >> 3) / NCH; ssd_s1_unit(F, l, b, cidx, hd); }
        }
        SEAM(pb + 1);
        if (PHM(2) && IN(pb + 2)) { const Frame F = launder(F0); phase_scan(F); }
        SEAM(pb + 2);
        if (PHM(3) && IN(pb + 3)) { const Frame F = launder(F0);
            const int nchs = with_ctx ? NCH : NCH - 2, n_s3 = NB * nchs * 8, n_cx = with_ctx ? 96 : 0, total = 3072 + n_s3 + n_cx;
            for (int rep = 0; rep < 1 + ((REP_MASK >> 3) & 1); ++rep) {
            for (int u = F.vcu; u < 1024; u += F.G) {
                const int qblk = u & 31, hg = (u >> 5) & 3, kvh = (u >> 7) & 1, b = u >> 8, hq = kvh * 4 + hg;
                const ga_body::bf16* P = (const ga_body::bf16*)(F.ws + WS_PRJ); const size_t lat0 = (size_t)(b * SEQ) * PRJW, ctx0 = (size_t)(NLAT + b * CTXL) * PRJW;
                ga_body::attn_unit<8>(qblk, P + lat0 + C_GAQ + hq * 64, P + lat0 + C_GAK + kvh * 64, P + lat0 + C_GAV + kvh * 64, P + ctx0 + C_GAK + kvh * 64, P + ctx0 + C_GAV + kvh * 64,
                                      (ga_body::bf16*)(F.ws + WS_OC) + (size_t)(b * SEQ) * OCW + 1024 + hq * 64, (char*)F.lds, F.tid);
            }
            const Frame Fb = launder(F0);
            for (int u = 1024 + Fb.vcu; u < total; u += Fb.G) { const Frame& F = Fb;
                if (u < 2048) { const int v = u - 1024, qblk = v & 31, hq = (v >> 5) & 7, b = v >> 8; attn_unit(F, l, 0, false, b, hq, qblk); }
                else if (u < 3072) { const int v = u - 2048, qblk = v & 31, hg = (v >> 5) & 3, kvh = (v >> 7) & 1, b = v >> 8; attn_unit(F, l, 1, false, b, kvh * 4 + hg, qblk); }
                else if (u < 3072 + n_s3) { const int v = u - 3072, hd = v & 7, cc = (v >> 3) % nchs, b = (v >> 3) / nchs; ssd_s3_unit(F, l, b, with_ctx ? cc : cc + 2, hd); }
                else { const int v = u - 3072 - n_s3, mode = v >> 5, b = (v >> 3) & 3, hq = v & 7; attn_unit(F, l, mode, true, b, hq, 0); }
            }
            }
        }
        SEAM(pb + 3);
        if (PHM(4) && IN(pb + 4)) { const Frame F = launder(F0);
            pg8::SchedGrid S; S.nMa = mtiles; S.nNa = 16; S.nMb = 0; S.nNb = 1; S.total = S.nMa * S.nNa; S.G = F.G; S.c = F.vcu;
            S.A = (const char*)(F.ws + WS_OC); S.B = (const char*)(F.ws + WS_WB + l * SZ_WB); S.lda = OCW; S.ldb = 512; S.a_div = 4; S.a_cols = 512; S.pe = nullptr; S.estride = 0;
            pg8::EpiBranch E{WSP(bf16_t, WS_GT), WSP(float, WS_SSQ)};
            pg8::gemm_phase(F.lds, F.tid, 512, OCW, 512, S, E);
        }
        SEAM(pb + 4);
        if (PHM(5) && IN(pb + 5)) { const Frame F = launder(F0);
            pg8::SchedGrid S; S.nMa = mtiles; S.nNa = 4; S.nMb = 0; S.nNb = 1; S.total = S.nMa * S.nNa; S.G = F.G; S.c = F.vcu;
            S.A = (const char*)(F.ws + WS_GT); S.B = (const char*)(F.ws + WS_WO + l * SZ_WO); S.lda = GTW; S.ldb = 4096; S.a_div = 1; S.a_cols = 0; S.pe = nullptr; S.estride = 0;
            pg8::EpiResid E{WSP(float, WS_XS), WSP(float, WS_MVEC) + (size_t)l * 5 * 6144 + 2048, nullptr};
            pg8::gemm_phase(F.lds, F.tid, 4096, GTW, 4096, S, E);
        }
        SEAM(pb + 5);
        if (PHM(6) && IN(pb + 6)) { const Frame F = launder(F0); phase_ln1(F, l, mrows); }
        SEAM(pb + 6);
        if (moe) { if (PHM(7) && IN(pb + 7)) { const Frame F = launder(F0); phase_gather(F, l, mrows); } SEAM(pb + 7); }
        if (PHM(8) && IN(pb + 8)) { const Frame F = launder(F0);
            pg8::SchedGrid S; S.nMb = 0; S.nNb = 1; S.G = F.G; S.c = F.vcu; S.lda = DM; S.ldb = DM; S.a_div = 1; S.a_cols = 0; S.pe = nullptr; S.estride = 0; int ldh;
            if (!moe) { S.nMa = mtiles; S.nNa = DFF / 128; S.A = (const char*)(F.ws + WS_HB); S.B = (const char*)(F.ws + WS_WUP + fi * SZ_WUP); ldh = DFF; }
            else { const int npad = moe_pad_ends_lds(F, fi); S.pe = (const LAS int*)(F.lds + MISC_OFF + 64); S.nMa = npad / 256; S.nNa = DFFE / 128;
                   S.A = (const char*)(F.ws + WS_XPAD); S.B = (const char*)(F.ws + WS_MUP + fi * SZ_MUP); S.estride = (size_t)2 * DFFE * DM * 2; ldh = DFFE; }
            S.total = S.nMa * S.nNa;
            pg8::EpiSwiGLU E{WSP(bf16_t, WS_HID), ldh};
            pg8::gemm_phase(F.lds, F.tid, DM, DM, DM, S, E);
        }
        SEAM(pb + 8);
        if (PHM(9) && IN(pb + 9)) { const Frame F = launder(F0);
            pg8::SchedGrid S; S.nMb = 0; S.nNb = 1; S.nNa = 4; S.G = F.G; S.c = F.vcu; S.a_div = 1; S.a_cols = 0; S.pe = nullptr; S.estride = 0; S.A = (const char*)(F.ws + WS_HID);
            pg8::EpiResid E{WSP(float, WS_XS), WSP(float, WS_MVEC) + (size_t)l * 5 * 6144 + 5120, nullptr};
            int kk;
            if (!moe) { S.nMa = mtiles; S.B = (const char*)(F.ws + WS_WDN + fi * SZ_WDN); kk = DFF; }
            else { const int npad = moe_pad_ends_lds(F, fi); S.pe = (const LAS int*)(F.lds + MISC_OFF + 64); S.nMa = npad / 256; S.B = (const char*)(F.ws + WS_MDN + fi * SZ_MDN); S.estride = (size_t)DM * DFFE * 2; kk = DFFE; E.plainO = WSP(bf16_t, WS_YPAD); }
            S.lda = kk; S.ldb = kk; S.total = S.nMa * S.nNa;
            pg8::gemm_phase(F.lds, F.tid, kk, kk, kk, S, E);
        }
        SEAM(pb + 9);
        if (PHM(10) && IN(pb + 10)) { const Frame F = launder(F0); phase_ln2(F, l, mrows); }
        if (l + 1 < DEPTH) SEAM(pb + 10);
    }
#undef IN
#undef SEAM
}

extern "C" void kernel_launch(void* const* d_in, const int* in_sizes, int n_in, void* d_out, int out_size, void* d_ws, size_t ws_size, hipStream_t stream) {
    static int grid = 0;
    if (grid == 0) {
        if (n_in != 31 || in_sizes[0] != NLAT * DM || out_size != NLAT * DM || ws_size < WS_END) {
            fprintf(stderr, "kernel_launch: unexpected shapes: n_in %d in0 %d out %d ws %zu (need %zu); nothing launched\n", n_in, n_in > 0 ? in_sizes[0] : -1, out_size, ws_size, (size_t)WS_END); grid = -1; return; }
        int dev = 0, cus = 0, per_cu = 0;
        if (hipGetDevice(&dev) != hipSuccess || hipDeviceGetAttribute(&cus, hipDeviceAttributeMultiprocessorCount, dev) != hipSuccess) { fprintf(stderr, "kernel_launch: device query failed\n"); grid = -1; return; }
        if (hipFuncSetAttribute((const void*)fwd_kernel, hipFuncAttributeMaxDynamicSharedMemorySize, LDS_BYTES) != hipSuccess) { fprintf(stderr, "kernel_launch: hipFuncSetAttribute failed\n"); grid = -1; return; }
        if (hipOccupancyMaxActiveBlocksPerMultiprocessor(&per_cu, (const void*)fwd_kernel, NTHR, LDS_BYTES) != hipSuccess || per_cu < 1)
            fprintf(stderr, "kernel_launch: note: occupancy query reports %d workgroups per CU\n", per_cu);
        (void)hipGetLastError();
        grid = cus;
    }
    if (grid < 0) return;
    if (hipMemsetAsync((char*)d_ws + WS_CTL, 0, CTL_ZERO_BYTES, stream) != hipSuccess) { fprintf(stderr, "kernel_launch: memset failed\n"); return; }
    Args a{};
    for (int i = 0; i < 31; ++i) a.in[i] = (const float*)d_in[i];
    a.out = (float*)d_out; a.ws = (unsigned char*)d_ws;
#if MK_PER_PHASE
    for (int p = 0; p < N_PHASES; ++p) { a.ph_lo = p; a.ph_hi = p + 1; hipLaunchKernelGGL(fwd_kernel, dim3(grid), dim3(NTHR), LDS_BYTES, stream, a); }
#else
    a.ph_lo = 0; a.ph_hi = N_PHASES;
    hipLaunchKernelGGL(fwd_kernel, dim3(grid), dim3(NTHR), LDS_BYTES, stream, a);
#endif
    const hipError_t le = hipPeekAtLastError();
    if (le != hipSuccess) fprintf(stderr, "kernel_launch: launch failed: %s\n", hipGetErrorName(le));
}
```

```cpp
#include <hip/hip_runtime.h>
#include <cstdio>
#include <cstdint>
#include <hip/hip_bf16.h>
#include <cmath>

#define DI __device__ __forceinline__
#define LAS __attribute__((address_space(3)))
#define GAS __attribute__((address_space(1)))
typedef unsigned short bf16_t;
typedef short bf16x8 __attribute__((ext_vector_type(8)));
typedef short s16x4 __attribute__((ext_vector_type(4)));
typedef float f32x2 __attribute__((ext_vector_type(2)));
typedef float f32x4 __attribute__((ext_vector_type(4)));
typedef float f32x16 __attribute__((ext_vector_type(16)));
typedef unsigned u32x2 __attribute__((ext_vector_type(2)));
typedef unsigned u32x4 __attribute__((ext_vector_type(4)));
typedef __bf16 bf16x2_t __attribute__((ext_vector_type(2)));
typedef GAS unsigned gu32;

#ifndef MK_PER_PHASE
#define MK_PER_PHASE 0
#endif
#ifndef PHMASK
#define PHMASK 0xFFFF
#endif
#define PHM(k) ((PHMASK >> (k)) & 1)
#ifndef REP_MASK
#define REP_MASK 0
#endif
#ifndef ABL
#define ABL 0
#endif

constexpr int DM = 1024, NB = 4, SEQ = 8192, CTXL = 256, NLAT = NB * SEQ, NCTX = NB * CTXL, MTOT = NLAT + NCTX;
constexpr int DEPTH = 4, DIN = 4624, PRJW = 4608, GTW = 4096, NCOMB = PRJW + GTW, OCW = 2048;
constexpr int DFF = 2816, DFFE = 3584, NEXP = 8, MOE_ROWS_MAX = 69632;
constexpr int NCH = 66;
constexpr float ALPHA = 1.6817928305074292f;
constexpr float LOG2E = 1.4426950408889634f;
constexpr float C2 = 0.125f * LOG2E;
constexpr float LN_EPS = 1e-5f, RMS_EPS = 1e-6f;
constexpr int C_NAQ = 0, C_NAK = 512, C_NAV = 1024, C_SWQ = 1536, C_SWK = 2048, C_SWV = 2176, C_GAQ = 2304, C_GAK = 2816, C_GAV = 2944, C_Z = 3072, C_XBC = 3584;

constexpr size_t KiB = 1024, MiB = 1u << 20;
constexpr size_t WS_CTL = 0, CTL_ZERO_BYTES = 1 * MiB;
constexpr size_t WS_MVEC = 1 * MiB;
constexpr size_t WS_ROPE = WS_MVEC + 512 * KiB;
constexpr size_t WS_DT = 4 * MiB;
constexpr size_t WS_SSQ = WS_DT + (size_t)MTOT * 16 * 4;
constexpr size_t WS_SLOT = WS_SSQ + (size_t)MTOT * 8 * 4;
constexpr size_t WS_CDEC = WS_SLOT + (size_t)MTOT * 8 * 4;
constexpr size_t WS_W = 10 * MiB;
constexpr size_t SZ_WCOMB = (size_t)NCOMB * DM * 2, SZ_WB = (size_t)4096 * 512 * 2, SZ_WO = (size_t)1024 * 4096 * 2;
constexpr size_t SZ_WUP = (size_t)2 * DFF * DM * 2, SZ_WDN = (size_t)DM * DFF * 2, SZ_MUP = (size_t)NEXP * 2 * DFFE * DM * 2, SZ_MDN = (size_t)NEXP * DM * DFFE * 2;
constexpr size_t WS_WCOMB = WS_W, WS_WB = WS_WCOMB + 4 * SZ_WCOMB, WS_WO = WS_WB + 4 * SZ_WB, WS_WUP = WS_WO + 4 * SZ_WO, WS_WDN = WS_WUP + 2 * SZ_WUP,
                 WS_MUP = WS_WDN + 2 * SZ_WDN, WS_MDN = WS_MUP + 2 * SZ_MUP, WS_WEND = WS_MDN + 2 * SZ_MDN;
constexpr size_t WS_XS = (WS_WEND + 255) & ~(size_t)255;
constexpr size_t WS_HB = WS_XS + (size_t)MTOT * DM * 4;
constexpr size_t WS_U = WS_HB + (size_t)MTOT * DM * 2;
constexpr size_t WS_PRJ = WS_U;
constexpr size_t WS_GT = WS_PRJ + (size_t)MTOT * PRJW * 2;
constexpr size_t WS_OC = WS_GT + (size_t)MTOT * GTW * 2;
constexpr size_t WS_ST = WS_OC + (size_t)MTOT * OCW * 2;
constexpr size_t WS_UEND = WS_ST + (size_t)NB * NCH * 16 * 8192 * 4;
constexpr size_t WS_HID = WS_U;
constexpr size_t WS_XPAD = WS_HID + (size_t)MOE_ROWS_MAX * DFFE * 2;
constexpr size_t WS_YPAD = WS_XPAD + (size_t)MOE_ROWS_MAX * DM * 2;
static_assert(WS_YPAD + (size_t)MOE_ROWS_MAX * DM * 2 <= WS_UEND, "FFN overlay fits the union region");
constexpr size_t WS_END = WS_UEND;
constexpr int CW_BAR = 4096, CW_MOECNT = 16384;

constexpr int RING_BYTES = 131072, MISC_OFF = RING_BYTES + 320, LDS_BYTES = 147456;
constexpr int NWAVES = 8, NTHR = 512;

DI unsigned pk2(float lo, float hi) { f32x2 v = {lo, hi}; bf16x2_t b = __builtin_convertvector(v, bf16x2_t); return __builtin_bit_cast(unsigned, b); }
DI float bflo(unsigned u) { return __uint_as_float(u << 16); }
DI float bfhi(unsigned u) { return __uint_as_float(u & 0xffff0000u); }
DI float sigm(float x) { return __builtin_amdgcn_rcpf(1.f + __expf(-x)); }
DI float silu(float x) { return x * sigm(x); }
DI float wave_sum(float v) {
#pragma unroll
    for (int o = 1; o < 64; o <<= 1) v += __shfl_xor(v, o);
    return v;
}
DI int clampi(int v, int lo, int hi) { return v < lo ? lo : (v > hi ? hi : v); }
#define MFMA32(a, b, c) __builtin_amdgcn_mfma_f32_32x32x16_bf16((a), (b), (c), 0, 0, 0)
DI int crow(int reg, int h) { return (reg & 3) + 8 * (reg >> 2) + 4 * h; }
typedef short v4i16_t __attribute__((ext_vector_type(4)));
DI s16x4 tr_read(const LAS unsigned char* p) { return __builtin_bit_cast(s16x4, __builtin_amdgcn_ds_read_tr16_b64_v4i16((LAS v4i16_t*)p)); }
DI bf16x8 cat8(s16x4 lo, s16x4 hi) { return __builtin_shufflevector(lo, hi, 0, 1, 2, 3, 4, 5, 6, 7); }
template <int S> DI bf16x8 pack8(const f32x16& x) {
    u32x4 w; w.x = pk2(x[8 * S], x[8 * S + 1]); w.y = pk2(x[8 * S + 2], x[8 * S + 3]); w.z = pk2(x[8 * S + 4], x[8 * S + 5]); w.w = pk2(x[8 * S + 6], x[8 * S + 7]);
    return __builtin_bit_cast(bf16x8, w);
}

#define XB_TMO      128
#define XB_XCNT(j)  (256  + 64 * (j))
#define XB_XSUB(j)  (1280 + 64 * (j))
#define XB_XGEN(j)  (2304 + 64 * (j))
#define XB_TOP      3328
#define XB_TOPGEN   3392
#define XCD_BAR_WORDS 3456
#define XB_SPIN_CAP (1u << 18)
DI unsigned xb_ld(unsigned* p)              { return __hip_atomic_load(p, __ATOMIC_RELAXED, __HIP_MEMORY_SCOPE_AGENT); }
DI unsigned xb_add(unsigned* p, unsigned v) { return __hip_atomic_fetch_add(p, v, __ATOMIC_RELAXED, __HIP_MEMORY_SCOPE_AGENT); }
DI unsigned xb_xcc_id() { return (unsigned)__builtin_amdgcn_s_getreg((3 << 11) | 20) & 0xFu; }
#define XB_SPIN(cond, bar) do { unsigned _sp = 0; while (cond) { __builtin_amdgcn_s_sleep(1); \
    if ((++_sp & 255u) == 0u) { if (xb_ld(&(bar)[XB_TMO])) break; if (_sp > XB_SPIN_CAP) { atomicAdd(&(bar)[XB_TMO], 1u); break; } } } } while (0)
struct XcdBarrier { unsigned* bar; unsigned x; volatile LAS unsigned* st; };
DI XcdBarrier xcd_barrier_post(unsigned* bar, volatile LAS unsigned* st) {
    XcdBarrier b; b.bar = bar; b.x = xb_xcc_id(); b.st = st;
    if (threadIdx.x == 0) (void)xb_add(&bar[XB_XCNT(b.x)], 1u);
    return b;
}
DI void xcd_barrier_complete(unsigned* bar, unsigned x, unsigned& nloc, unsigned& nx) {
    const unsigned G = gridDim.x * gridDim.y * gridDim.z;
    unsigned sum, cnt, mine, sp = 0u;
    for (;;) {
        sum = 0u; cnt = 0u; mine = 0u;
#pragma unroll
        for (unsigned j = 0; j < 16; ++j) { const unsigned c = xb_ld(&bar[XB_XCNT(j)]); sum += c; cnt += (c > 0u) ? 1u : 0u; mine = (j == x) ? c : mine; }
        if (sum == G) break;
        __builtin_amdgcn_s_sleep(1);
        if ((++sp & 255u) == 0u) { if (xb_ld(&bar[XB_TMO])) break; if (sp > XB_SPIN_CAP) { atomicAdd(&bar[XB_TMO], 1u); break; } }
    }
    nloc = mine > 0u ? mine : 1u; nx = cnt > 0u ? cnt : 1u;
}
DI void xcd_barrier(const XcdBarrier& b) {
    asm volatile("s_waitcnt vmcnt(0)" ::: "memory");
    __syncthreads();
    if (threadIdx.x == 0) {
        unsigned* bar = b.bar;
        __builtin_amdgcn_s_waitcnt(0);
        unsigned nloc = b.st[0], nx = b.st[1];
        if (nloc == 0u) { xcd_barrier_complete(bar, b.x, nloc, nx); b.st[0] = nloc; b.st[1] = nx; }
        const unsigned old = xb_add(&bar[XB_XSUB(b.x)], 1u);
        const unsigned gen = old / nloc;
        if (old + 1u == (gen + 1u) * nloc) {
            __builtin_amdgcn_fence(__ATOMIC_RELEASE, "agent");
            asm volatile("s_waitcnt vmcnt(0)" ::: "memory");
            const unsigned og = xb_add(&bar[XB_TOP], 1u);
            const unsigned tg = og / nx;
            if (og + 1u == (tg + 1u) * nx) xb_add(&bar[XB_TOPGEN], 1u);
            else XB_SPIN(xb_ld(&bar[XB_TOPGEN]) == tg, bar);
            __builtin_amdgcn_fence(__ATOMIC_ACQUIRE, "agent");
            xb_add(&bar[XB_XGEN(b.x)], 1u);
            asm volatile("s_waitcnt vmcnt(0)" ::: "memory");
        } else {
            XB_SPIN(xb_ld(&bar[XB_XGEN(b.x)]) == gen, bar);
            __builtin_amdgcn_fence(__ATOMIC_ACQUIRE, "agent");
            asm volatile("s_waitcnt vmcnt(0)" ::: "memory");
        }
    }
    __syncthreads();
}

namespace pg8 {
constexpr int BM = 256, BK = 64, HALF = 128, HTB = HALF * BK * 2, STAGE_BYTES = 8 * HTB;
__host__ __device__ __forceinline__ int lds_byte(int r, int c) { const int st = (r >> 4) * 2 + (c >> 5), rr = r & 15, cc = c & 31, ob = rr * 64 + cc * 2; return st * 1024 + (ob ^ (((ob >> 9) & 1) << 5)); }
__host__ __device__ __forceinline__ void stage_rc(int b, int& R, int& C) { const int st = b / 1024, sb = b % 1024, swz = sb ^ (((sb >> 9) & 1) << 5); R = (st >> 1) * 16 + swz / 64; C = (st & 1) * 32 + (swz % 64) / 2; }
__host__ __device__ __forceinline__ int perm32(int rho) { const int n = rho >> 4, i = rho & 15; return 8 * (i >> 2) + 4 * n + (i & 3); }
struct Unit { int pm, pn; const char* A; const char* B; };

template <class Epi, class Sched>
DI void gemm_phase(LAS unsigned char* lds, const int tid, const int K, const int lda, const int ldb, const Sched& S, const Epi& E) {
    const int wid = __builtin_amdgcn_readfirstlane(tid >> 6), lane = tid & 63, wr = wid >> 2, wc = wid & 3, fr = lane & 15, fq = lane >> 4;
    const int nt = K / BK;
    unsigned voffA[2], voffB[2];
#pragma unroll
    for (int i = 0; i < 2; ++i) { int R, C; stage_rc(tid * 16 + i * 8192, R, C); const int Rb = (R & ~31) + perm32(R & 31);
        voffA[i] = (unsigned)(R * lda + C) * 2u; voffB[i] = (unsigned)(Rb * ldb + C) * 2u; }
    const size_t kstep = (size_t)(BK * 2);
    const size_t hstepA = (size_t)HALF * lda * 2, hstepB = (size_t)HALF * ldb * 2;
    const unsigned ldsw = (unsigned)wid * 1024u;
    const int aoff = lds_byte(wr * 64 + fr, fq * 8), boff = lds_byte(wc * 32 + fr, fq * 8);
#define PG8_SA(b, h) (((b) * 2 + (h)) * HTB)
#define PG8_SB(b, h) ((4 + (b) * 2 + (h)) * HTB)
#define PG8_STAGE(bufoff, gbase, voff) do { _Pragma("unroll") for (int _i = 0; _i < 2; ++_i) \
        __builtin_amdgcn_global_load_lds((const unsigned*)((const char*)(gbase) + (voff)[_i]), (LAS unsigned*)(lds + (bufoff) + ldsw + _i * 8192), 16, 0, 0); } while (0)
#define PG8_LDA(dst, b, h) do { _Pragma("unroll") for (int m = 0; m < 4; ++m) _Pragma("unroll") for (int k = 0; k < 2; ++k) dst[m][k] = *(const LAS bf16x8*)(lds + PG8_SA(b, h) + aoff + m * 2048 + k * 1024); } while (0)
#define PG8_LDB(dst, b, h) do { _Pragma("unroll") for (int n = 0; n < 2; ++n) _Pragma("unroll") for (int k = 0; k < 2; ++k) dst[n][k] = *(const LAS bf16x8*)(lds + PG8_SB(b, h) + boff + n * 2048 + k * 1024); } while (0)
#define PG8_MMA(ai, bj, At, Bt) do { __builtin_amdgcn_s_setprio(1); _Pragma("unroll") for (int m = 0; m < 4; ++m) _Pragma("unroll") for (int n = 0; n < 2; ++n) _Pragma("unroll") for (int k = 0; k < 2; ++k) \
        acc[ai][bj][m][n] = __builtin_amdgcn_mfma_f32_16x16x32_bf16(Bt[n][k], At[m][k], acc[ai][bj][m][n], 0, 0, 0); __builtin_amdgcn_s_setprio(0); } while (0)
#define PG8_WAIT_V(n) asm volatile("s_waitcnt vmcnt(" #n ")" ::: "memory")
#define PG8_WAIT_L(n) asm volatile("s_waitcnt lgkmcnt(" #n ")" ::: "memory")
#define PG8_BAR __builtin_amdgcn_s_barrier()
#define PG8_SCHED __builtin_amdgcn_sched_barrier(0)
    Unit cur, nxt; int ui = 0;
    if (!S.next(0, cur)) return;
    f32x4 acc[2][2][4][2];
#pragma unroll
    for (int a = 0; a < 2; ++a)
#pragma unroll
        for (int b = 0; b < 2; ++b)
#pragma unroll
            for (int m = 0; m < 4; ++m)
#pragma unroll
                for (int n = 0; n < 2; ++n) acc[a][b][m][n] = (f32x4){0.f, 0.f, 0.f, 0.f};
    bf16x8 At[4][2], B0[2][2], B1[2][2];
    const char* cA = cur.A; const char* cB = cur.B;
    PG8_STAGE(PG8_SB(0, 0), cB, voffB); PG8_STAGE(PG8_SB(0, 1), cB + hstepB, voffB); PG8_STAGE(PG8_SA(0, 0), cA, voffA); PG8_STAGE(PG8_SA(0, 1), cA + hstepA, voffA);
    if (wr == 1) PG8_BAR;
    PG8_WAIT_V(2); PG8_BAR;
    PG8_STAGE(PG8_SB(1, 0), cB + kstep, voffB); PG8_STAGE(PG8_SA(1, 0), cA + kstep, voffA); PG8_STAGE(PG8_SB(1, 1), cB + hstepB + kstep, voffB);
    PG8_WAIT_V(6); PG8_BAR;
    for (;;) {
        const bool has_next = S.next(ui + 1, nxt);
        const char* nA = has_next ? nxt.A : cA; const char* nB = has_next ? nxt.B : cB;
        for (int t = 0; t < nt; t += 2) {
            const bool last = (t == nt - 2);
            const char* a1 = cA + (size_t)(t + 1) * kstep;
            const char* a2 = last ? nA : cA + (size_t)(t + 2) * kstep; const char* b2 = last ? nB : cB + (size_t)(t + 2) * kstep;
            const char* a3 = a2 + kstep; const char* b3 = b2 + kstep;
            PG8_LDB(B0, 0, 0); PG8_LDB(B1, 0, 1); PG8_SCHED; PG8_LDA(At, 0, 0); PG8_STAGE(PG8_SA(1, 1), a1 + hstepA, voffA);
            PG8_WAIT_V(8); PG8_WAIT_L(0); PG8_BAR; PG8_MMA(0, 0, At, B0); PG8_MMA(0, 1, At, B1); PG8_BAR; PG8_SCHED;
            PG8_LDA(At, 0, 1); PG8_STAGE(PG8_SB(0, 0), b2, voffB); PG8_STAGE(PG8_SB(0, 1), b2 + hstepB, voffB); PG8_STAGE(PG8_SA(0, 0), a2, voffA);
            PG8_WAIT_V(8); PG8_WAIT_L(0); PG8_BAR; PG8_MMA(1, 0, At, B0); PG8_MMA(1, 1, At, B1); PG8_BAR; PG8_SCHED;
            PG8_LDB(B0, 1, 0); PG8_LDB(B1, 1, 1); PG8_SCHED; PG8_LDA(At, 1, 0); PG8_STAGE(PG8_SA(0, 1), a2 + hstepA, voffA);
            PG8_WAIT_V(8); PG8_WAIT_L(0); PG8_BAR; PG8_MMA(0, 0, At, B0); PG8_MMA(0, 1, At, B1); PG8_BAR; PG8_SCHED;
            PG8_LDA(At, 1, 1); PG8_STAGE(PG8_SB(1, 0), b3, voffB); PG8_STAGE(PG8_SB(1, 1), b3 + hstepB, voffB); PG8_STAGE(PG8_SA(1, 0), a3, voffA);
            PG8_WAIT_V(8); PG8_WAIT_L(0); PG8_BAR; PG8_MMA(1, 0, At, B0); PG8_MMA(1, 1, At, B1); PG8_BAR; PG8_SCHED;
        }
        if (wr == 0) PG8_BAR;
        E(acc, cur, wr, wc, fr, fq);
        if (!has_next) break;
#pragma unroll
        for (int a = 0; a < 2; ++a)
#pragma unroll
            for (int b = 0; b < 2; ++b)
#pragma unroll
                for (int m = 0; m < 4; ++m)
#pragma unroll
                    for (int n = 0; n < 2; ++n) acc[a][b][m][n] = (f32x4){0.f, 0.f, 0.f, 0.f};
        cur = nxt; cA = nA; cB = nB; ++ui;
        if (wr == 1) PG8_BAR;
    }
    PG8_WAIT_V(0);
    PG8_BAR;
#undef PG8_SA
#undef PG8_SB
#undef PG8_STAGE
#undef PG8_LDA
#undef PG8_LDB
#undef PG8_MMA
#undef PG8_WAIT_V
#undef PG8_WAIT_L
#undef PG8_BAR
#undef PG8_SCHED
}

struct SchedGrid {
    int nMa, nNa, nMb, nNb, total, G, c; const char* A; const char* B; int lda, ldb, a_div, a_cols; const LAS int* pe; size_t estride;
    DI bool next(int i, Unit& u) const {
        const long L = (long)i * G + c; if (L >= total) return false;
        const int La = nMa * nNa; int pm, pn;
        if (L < La) { pm = (int)L / nNa; pn = (int)L % nNa; } else { const int r = (int)L - La; pm = nMa + r / nNb; pn = r % nNb; }
        size_t eoff = 0;
        if (pe) { int e = 0;
#pragma unroll
            for (int j = 0; j < 7; ++j) e += (pe[j] <= pm * 256) ? 1 : 0;
            eoff = (size_t)__builtin_amdgcn_readfirstlane(e) * estride; }
        u.pm = pm; u.pn = pn; u.A = A + ((size_t)pm * 256 * lda + (size_t)(pn / a_div) * a_cols) * 2; u.B = B + eoff + (size_t)pn * 256 * ldb * 2; return true;
    }
};

struct SchedBranch {
    int T, G, c; const char* A; const char* B;
    DI bool next(int n, Unit& u) const {
        const int tile = c + (n >> 2) * G; if (tile >= T) return false;
        const int i = n & 3, pm = tile >> 2, pc = tile & 3;
        u.pm = pm; u.pn = i * 4 + pc; u.A = A + ((size_t)pm * 256 * OCW + (size_t)i * 512) * 2; u.B = B + (size_t)(i * 1024 + pc * 256) * 512 * 2; return true;
    }
};
struct EpiInGate {
    bf16_t* PRJ; bf16_t* GT; const float* bg;
    DI void operator()(const f32x4 (&acc)[2][2][4][2], const Unit& u, int wr, int wc, int fr, int fq) const {
        const int row0 = u.pm * BM + wr * 64 + fr; const bool sg = u.pn >= 18;
        bf16_t* base = sg ? GT : PRJ; const int ldc = sg ? GTW : PRJW; const int col0 = (sg ? (u.pn - 18) : u.pn) * BM + wc * 32 + 8 * fq;
        f32x4 bv[2][2];
#pragma unroll
        for (int bj = 0; bj < 2; ++bj)
#pragma unroll
            for (int n = 0; n < 2; ++n) bv[bj][n] = sg ? *(const f32x4*)(bg + col0 + bj * HALF + 4 * n) : (f32x4){0.f, 0.f, 0.f, 0.f};
#pragma unroll
        for (int ai = 0; ai < 2; ++ai)
#pragma unroll
            for (int m = 0; m < 4; ++m) { bf16_t* rowp = base + (size_t)(row0 + ai * HALF + m * 16) * ldc + col0;
#pragma unroll
                for (int bj = 0; bj < 2; ++bj) { f32x4 v0 = acc[ai][bj][m][0] + bv[bj][0], v1 = acc[ai][bj][m][1] + bv[bj][1];
                    if (sg) { v0 = (f32x4){sigm(v0[0]), sigm(v0[1]), sigm(v0[2]), sigm(v0[3])}; v1 = (f32x4){sigm(v1[0]), sigm(v1[1]), sigm(v1[2]), sigm(v1[3])}; }
                    u32x4 w; w.x = pk2(v0[0], v0[1]); w.y = pk2(v0[2], v0[3]); w.z = pk2(v1[0], v1[1]); w.w = pk2(v1[2], v1[3]);
                    *(u32x4*)(rowp + bj * HALF) = w; } }
    }
};
struct EpiBranch {
    const bf16_t* GT; const float* SSQ; float* MF; bf16_t* MRG;
    DI void operator()(const f32x4 (&acc)[2][2][4][2], const Unit& u, int wr, int wc, int fr, int fq) const {
        const int i = u.pn >> 2, pc = u.pn & 3;
        const int row0 = u.pm * BM + wr * 64 + fr; const int gcol0 = u.pn * BM + wc * 32 + 8 * fq, col0 = pc * BM + wc * 32 + 8 * fq;
#pragma unroll
        for (int ai = 0; ai < 2; ++ai)
#pragma unroll
            for (int m = 0; m < 4; ++m) { const int row = row0 + ai * HALF + m * 16; const bf16_t* gp = GT + (size_t)row * GTW + gcol0; float* mp = MF + (size_t)row * DM + col0;
                float rs = 1.f;
                if (i == 3) { const f32x4 s0 = *(const f32x4*)(SSQ + (size_t)row * 8), s1 = *(const f32x4*)(SSQ + (size_t)row * 8 + 4);
                    rs = __builtin_amdgcn_rsqf(((s0[0] + s0[1]) + (s0[2] + s0[3]) + (s1[0] + s1[1]) + (s1[2] + s1[3])) * (1.f / 512.f) + RMS_EPS); }
#pragma unroll
                for (int bj = 0; bj < 2; ++bj) { const u32x4 g = *(const u32x4*)(gp + bj * HALF); const f32x4 a0 = acc[ai][bj][m][0] * rs, a1 = acc[ai][bj][m][1] * rs;
                    f32x4 t0 = (f32x4){bflo(g.x) * a0[0], bfhi(g.x) * a0[1], bflo(g.y) * a0[2], bfhi(g.y) * a0[3]}, t1 = (f32x4){bflo(g.z) * a1[0], bfhi(g.z) * a1[1], bflo(g.w) * a1[2], bfhi(g.w) * a1[3]};
                    f32x4* q = (f32x4*)(mp + bj * HALF);
                    if (i != 0) { t0 += q[0]; t1 += q[1]; }
                    if (i != 3) { q[0] = t0; q[1] = t1; }
                    else { u32x4 w; w.x = pk2(t0[0], t0[1]); w.y = pk2(t0[2], t0[3]); w.z = pk2(t1[0], t1[1]); w.w = pk2(t1[2], t1[3]); *(u32x4*)(MRG + (size_t)row * DM + col0 + bj * HALF) = w; } } }
    }
};
struct EpiResid {
    float* XS; const float* mv; bf16_t* plainO;
    DI void operator()(const f32x4 (&acc)[2][2][4][2], const Unit& u, int wr, int wc, int fr, int fq) const {
        const int row0 = u.pm * BM + wr * 64 + fr; const int col0 = u.pn * BM + wc * 32 + 8 * fq;
        if (plainO) {
#pragma unroll
            for (int ai = 0; ai < 2; ++ai)
#pragma unroll
                for (int m = 0; m < 4; ++m) { bf16_t* rowp = plainO + (size_t)(row0 + ai * HALF + m * 16) * DM + col0;
#pragma unroll
                    for (int bj = 0; bj < 2; ++bj) { const f32x4 v0 = acc[ai][bj][m][0], v1 = acc[ai][bj][m][1];
                        u32x4 w; w.x = pk2(v0[0], v0[1]); w.y = pk2(v0[2], v0[3]); w.z = pk2(v1[0], v1[1]); w.w = pk2(v1[2], v1[3]);
                        *(u32x4*)(rowp + bj * HALF) = w; } }
            return;
        }
        const int v = u.pm < 128 ? (u.pm >> 5) : 4;
        const float* g = mv + (size_t)v * 6144 + col0;
        f32x4 gv[2][2];
#pragma unroll
        for (int bj = 0; bj < 2; ++bj)
#pragma unroll
            for (int n = 0; n < 2; ++n) gv[bj][n] = *(const f32x4*)(g + bj * HALF + 4 * n);
#pragma unroll
        for (int ai = 0; ai < 2; ++ai)
#pragma unroll
            for (int m = 0; m < 4; ++m) { float* rowp = XS + (size_t)(row0 + ai * HALF + m * 16) * DM + col0;
#pragma unroll
                for (int bj = 0; bj < 2; ++bj)
#pragma unroll
                    for (int n = 0; n < 2; ++n) { f32x4* p = (f32x4*)(rowp + bj * HALF + 4 * n); const f32x4 x = *p; *p = x * ALPHA + gv[bj][n] * acc[ai][bj][m][n]; } }
    }
};
struct EpiSwiGLU {
    bf16_t* HID; int ldc;
    DI void operator()(const f32x4 (&acc)[2][2][4][2], const Unit& u, int wr, int wc, int fr, int fq) const {
        const int row0 = u.pm * BM + wr * 64 + fr; const int col0 = u.pn * HALF + wc * 32 + 8 * fq;
#pragma unroll
        for (int ai = 0; ai < 2; ++ai)
#pragma unroll
            for (int m = 0; m < 4; ++m) { bf16_t* rowp = HID + (size_t)(row0 + ai * HALF + m * 16) * ldc + col0;
                const f32x4 g0 = acc[ai][0][m][0], g1 = acc[ai][0][m][1], u0 = acc[ai][1][m][0], u1 = acc[ai][1][m][1];
                u32x4 w; w.x = pk2(silu(g0[0]) * u0[0], silu(g0[1]) * u0[1]); w.y = pk2(silu(g0[2]) * u0[2], silu(g0[3]) * u0[3]);
                w.z = pk2(silu(g1[0]) * u1[0], silu(g1[1]) * u1[1]); w.w = pk2(silu(g1[2]) * u1[2], silu(g1[3]) * u1[3]);
                *(u32x4*)rowp = w; }
    }
};
}

struct Args { const float* in[31]; float* out; unsigned char* ws; int ph_lo, ph_hi; };
enum { I_X = 0, I_C, I_CTX, I_CCTX, I_WMOD, I_BMOD, I_WIN, I_WGATE, I_BGATE, I_RPB, I_SINK, I_QGQ, I_QGK, I_CONVW, I_CONVB, I_DTB, I_ALOG, I_DSKIP, I_NORMG,
       I_WBR, I_WOUT, I_LN1G, I_LN1B, I_LN2G, I_LN2B, I_FUP, I_FDN, I_MRW, I_MRB, I_MUP, I_MDN };
struct Frame {
    LAS unsigned char* lds; gu32* ctl; int tid, lane, wave, vcu, G;
    const float* const* in; float* out; unsigned char* ws;
};
#define WSP(T, off) ((T*)(F.ws + (off)))
DI Frame launder(const Frame& F0) {
    Frame F = F0;
    asm volatile("" : "+v"(F.tid), "+v"(F.lane));
    asm volatile("" : "+s"(F.wave), "+s"(F.vcu), "+s"(F.ws), "+s"(F.lds));
    F.ws = (unsigned char*)(GAS unsigned char*)F.ws;
    return F;
}

DI void transpose_item(const float* W, int ld, bf16_t* dst, int ldk, int koff, int map_h, int rowoff, int cscale, const float* kscale, LAS float* scr, int kb, int nb, int lane) {
    const int k0 = 64 * kb, n0 = 32 * nb;
    float tmp[32];
#pragma unroll
    for (int i = 0; i < 32; ++i) tmp[i] = W[(size_t)(k0 + 2 * i + (lane >> 5)) * ld + n0 + (lane & 31)];
#pragma unroll
    for (int i = 0; i < 32; ++i) scr[(2 * i + (lane >> 5)) * 33 + (lane & 31)] = tmp[i];
    asm volatile("s_waitcnt lgkmcnt(0)" ::: "memory");
    const int c = lane & 7;
    float ks[8];
#pragma unroll
    for (int e = 0; e < 8; ++e) ks[e] = kscale ? kscale[k0 + 8 * c + e] : 1.f;
#pragma unroll
    for (int j = 0; j < 4; ++j) { const int nl = (lane >> 3) + 8 * j, n = n0 + nl; const LAS float* s = scr + (8 * c) * 33 + nl;
        float cs = 1.f; if (cscale && (n < 512 || (n >= 1536 && n < 2048))) cs = C2;
        int drow;
        if (map_h == 0) drow = rowoff + n;
        else if (n < map_h) drow = rowoff + 256 * (n >> 7) + (n & 127);
        else { const int n2 = n - map_h; drow = rowoff + 256 * (n2 >> 7) + 128 + (n2 & 127); }
        u32x4 o; o.x = pk2(s[0 * 33] * ks[0] * cs, s[1 * 33] * ks[1] * cs); o.y = pk2(s[2 * 33] * ks[2] * cs, s[3 * 33] * ks[3] * cs);
        o.z = pk2(s[4 * 33] * ks[4] * cs, s[5 * 33] * ks[5] * cs); o.w = pk2(s[6 * 33] * ks[6] * cs, s[7 * 33] * ks[7] * cs);
        *(u32x4*)(dst + (size_t)drow * ldk + koff + k0 + 8 * c) = o; }
    asm volatile("s_waitcnt lgkmcnt(0)" ::: "memory");
}
struct CvtJob { const float* W; int K, N, ld; bf16_t* dst; int ldk, koff, map_h, rowoff, cscale; const float* kscale; };
DI void get_job(const Frame& F, int j, CvtJob& J) {
    J.koff = 0; J.map_h = 0; J.rowoff = 0; J.cscale = 0; J.kscale = nullptr;
    if (j < 52) {
        const int l = j / 13, r = j % 13;
        if (r == 0) { J.W = F.in[I_WIN] + (size_t)l * DM * DIN; J.K = DM; J.N = PRJW; J.ld = DIN; J.dst = WSP(bf16_t, WS_WCOMB + l * SZ_WCOMB); J.ldk = DM; J.cscale = 1; }
        else if (r < 5) { const int i = r - 1; J.W = F.in[I_WGATE] + ((size_t)l * 4 + i) * DM * DM; J.K = DM; J.N = DM; J.ld = DM; J.dst = WSP(bf16_t, WS_WCOMB + l * SZ_WCOMB); J.ldk = DM; J.rowoff = PRJW + 1024 * i; }
        else if (r < 9) { const int i = r - 5; J.W = F.in[I_WBR] + ((size_t)l * 4 + i) * 512 * DM; J.K = 512; J.N = DM; J.ld = DM; J.dst = WSP(bf16_t, WS_WB + l * SZ_WB); J.ldk = 512; J.rowoff = 1024 * i;
            if (i == 3) J.kscale = F.in[I_NORMG] + l * 512; }
        else { J.W = F.in[I_WOUT] + (size_t)l * DM * DM; J.K = (r == 9) ? DM : 0; J.N = DM; J.ld = DM; J.dst = WSP(bf16_t, WS_WO + l * SZ_WO); J.ldk = DM; }
    } else if (j < 56) {
        const int i = (j - 52) >> 1;
        if (((j - 52) & 1) == 0) { J.W = F.in[I_FUP] + (size_t)i * DM * 2 * DFF; J.K = DM; J.N = 2 * DFF; J.ld = 2 * DFF; J.dst = WSP(bf16_t, WS_WUP + i * SZ_WUP); J.ldk = DM; J.map_h = DFF; }
        else { J.W = F.in[I_FDN] + (size_t)i * DFF * DM; J.K = DFF; J.N = DM; J.ld = DM; J.dst = WSP(bf16_t, WS_WDN + i * SZ_WDN); J.ldk = DFF; }
    } else {
        const int q = j - 56, ie = q >> 1, i = ie >> 3, e = ie & 7;
        if ((q & 1) == 0) { J.W = F.in[I_MUP] + ((size_t)i * NEXP + e) * DM * 2 * DFFE; J.K = DM; J.N = 2 * DFFE; J.ld = 2 * DFFE; J.dst = WSP(bf16_t, WS_MUP + i * SZ_MUP); J.ldk = DM; J.map_h = DFFE; J.rowoff = e * 2 * DFFE; }
        else { J.W = F.in[I_MDN] + ((size_t)i * NEXP + e) * DFFE * DM; J.K = DFFE; J.N = DM; J.ld = DM; J.dst = WSP(bf16_t, WS_MDN + i * SZ_MDN); J.ldk = DFFE; J.rowoff = e * DM; }
    }
}
constexpr int NJOBS = 52 + 4 + 32;

DI void phase_prologue_a(const Frame& F) {
    const int NGW = F.G * NWAVES, gw = F.vcu * NWAVES + F.wave;
    {
        LAS float* sv = (LAS float*)(F.lds + 73728);
        LAS float* red = (LAS float*)(F.lds + 73728 + 20480);
        for (int i = F.tid; i < 5 * 1024; i += NTHR) { const int v = i >> 10, k = i & 1023; const float c = v < 4 ? F.in[I_C][v * DM + k] : F.in[I_CCTX][k]; sv[i] = silu(c); }
        __syncthreads();
        float* MV = WSP(float, WS_MVEC);
        for (int item = F.vcu; item < 4 * 96; item += F.G) {
            const int l = item / 96, n0 = (item % 96) * 64, c = F.tid & 63, ks = F.tid >> 6;
            const float* w = F.in[I_WMOD] + (size_t)l * DM * 6144 + n0 + c;
            float a0 = 0.f, a1 = 0.f, a2 = 0.f, a3 = 0.f, a4 = 0.f;
#pragma unroll 8
            for (int k = ks * 128; k < ks * 128 + 128; ++k) { const float wv = w[(size_t)k * 6144]; a0 += sv[k] * wv; a1 += sv[1024 + k] * wv; a2 += sv[2048 + k] * wv; a3 += sv[3072 + k] * wv; a4 += sv[4096 + k] * wv; }
            red[(ks * 5 + 0) * 64 + c] = a0; red[(ks * 5 + 1) * 64 + c] = a1; red[(ks * 5 + 2) * 64 + c] = a2; red[(ks * 5 + 3) * 64 + c] = a3; red[(ks * 5 + 4) * 64 + c] = a4;
            __syncthreads();
            if (F.tid < 320) { const int v = F.tid >> 6, cc = F.tid & 63; float s = F.in[I_BMOD][l * 6144 + n0 + cc];
#pragma unroll
                for (int q = 0; q < 8; ++q) s += red[(q * 5 + v) * 64 + cc];
                MV[((size_t)l * 5 + v) * 6144 + n0 + cc] = s; }
            __syncthreads();
        }
    }
    {
        float* rc = WSP(float, WS_ROPE); float* rs = rc + SEQ * 32;
        for (int i = F.vcu * NTHR + F.tid; i < SEQ * 32; i += F.G * NTHR) {
            const int t = i >> 5, p = i & 31; const float pos = (p < 16) ? (float)(t >> 6) : (float)(t & 63);
            const float invf = exp2f(-(float)(p & 15) * (13.287712379549449f / 16.f));
            const float ang = pos * invf; const float rev = ang * 0.15915494309189535f; const float fr = rev - rintf(rev);
            rc[i] = __builtin_amdgcn_cosf(fr); rs[i] = __builtin_amdgcn_sinf(fr);
        }
    }
    {
        LAS float* scr = (LAS float*)(F.lds + F.wave * 8448);
        int base = 0;
        for (int j = 0; j < NJOBS; ++j) {
            CvtJob J; get_job(F, j, J);
            const int nblk = J.N / 32, nit = (J.K / 64) * nblk;
            int vid = (gw - base) % NGW; if (vid < 0) vid += NGW;
            for (int it = vid; it < nit; it += NGW) transpose_item(J.W, J.ld, J.dst, J.ldk, J.koff, J.map_h, J.rowoff, J.cscale, J.kscale, scr, it / nblk, it % nblk, F.lane);
            base = (base + nit) % NGW;
        }
    }
}

DI void load_wdt(const Frame& F, int l) {
    LAS float* wd = (LAS float*)F.lds; const float* w = F.in[I_WIN] + (size_t)l * DM * DIN + PRJW;
    for (int i = F.tid; i < DM * 16; i += NTHR) wd[i] = w[(size_t)(i >> 4) * DIN + (i & 15)];
}
DI void emit_h_dt(const Frame& F, const f32x4 (&xn)[4], const float* mv, int m, const float* dtb) {
    bf16_t* hb = WSP(bf16_t, WS_HB) + (size_t)m * DM; float* DT = WSP(float, WS_DT);
    const LAS float* wd = (const LAS float*)F.lds;
    float acc[16];
#pragma unroll
    for (int c = 0; c < 16; ++c) acc[c] = 0.f;
#pragma unroll
    for (int j = 0; j < 4; ++j) {
        const int k = 4 * F.lane + 256 * j;
        const f32x4 sh = *(const f32x4*)(mv + k), sc = *(const f32x4*)(mv + 1024 + k);
        const f32x4 h = xn[j] * (sc + 1.f) + sh;
        u32x2 w; w.x = pk2(h[0], h[1]); w.y = pk2(h[2], h[3]); *(u32x2*)(hb + k) = w;
#pragma unroll
        for (int e = 0; e < 4; ++e) {
            const LAS f32x4* wr = (const LAS f32x4*)(wd + (k + e) * 16);
#pragma unroll
            for (int q = 0; q < 4; ++q) { const f32x4 wv = wr[q]; acc[4 * q] += h[e] * wv[0]; acc[4 * q + 1] += h[e] * wv[1]; acc[4 * q + 2] += h[e] * wv[2]; acc[4 * q + 3] += h[e] * wv[3]; }
            asm volatile("" ::: "memory");
        }
    }
    const bool b0 = F.lane & 1, b1 = F.lane & 2, b2 = F.lane & 4, b3 = F.lane & 8;
    float t8[8], t4[4], t2[2], t1;
#pragma unroll
    for (int i = 0; i < 8; ++i) { const float keep = b0 ? acc[2 * i + 1] : acc[2 * i], give = b0 ? acc[2 * i] : acc[2 * i + 1]; t8[i] = keep + __shfl_xor(give, 1); }
#pragma unroll
    for (int i = 0; i < 4; ++i) { const float keep = b1 ? t8[2 * i + 1] : t8[2 * i], give = b1 ? t8[2 * i] : t8[2 * i + 1]; t4[i] = keep + __shfl_xor(give, 2); }
#pragma unroll
    for (int i = 0; i < 2; ++i) { const float keep = b2 ? t4[2 * i + 1] : t4[2 * i], give = b2 ? t4[2 * i] : t4[2 * i + 1]; t2[i] = keep + __shfl_xor(give, 4); }
    { const float keep = b3 ? t2[1] : t2[0], give = b3 ? t2[0] : t2[1]; t1 = keep + __shfl_xor(give, 8); }
    t1 += __shfl_xor(t1, 16); t1 += __shfl_xor(t1, 32);
    if (F.lane < 16) { const float x = t1 + dtb[F.lane]; const float t = __expf(x); const float sp = t < 0.01f ? t * (1.f + t * (-0.5f + t * (1.f / 3.f))) : __logf(1.f + t); DT[(size_t)m * 16 + F.lane] = x > 15.f ? x : sp; }
}
DI void ln_rows(f32x4 (&v)[4], const float* g, const float* b, int lane) {
    float s = 0.f;
#pragma unroll
    for (int j = 0; j < 4; ++j) s += (v[j][0] + v[j][1]) + (v[j][2] + v[j][3]);
    const float mean = wave_sum(s) * (1.f / DM); float s2 = 0.f;
#pragma unroll
    for (int j = 0; j < 4; ++j) { v[j] = v[j] - mean; s2 += (v[j][0] * v[j][0] + v[j][1] * v[j][1]) + (v[j][2] * v[j][2] + v[j][3] * v[j][3]); }
    const float rstd = 1.f / sqrtf(wave_sum(s2) * (1.f / DM) + LN_EPS);
#pragma unroll
    for (int j = 0; j < 4; ++j) { const int k = 4 * lane + 256 * j; v[j] = v[j] * rstd * *(const f32x4*)(g + k) + *(const f32x4*)(b + k); }
}
DI void phase_prologue_b(const Frame& F) {
    load_wdt(F, 0); __syncthreads();
    const int NGW = F.G * NWAVES, gw = F.vcu * NWAVES + F.wave;
    float* XS = WSP(float, WS_XS); const float* MV = WSP(float, WS_MVEC);
    const float* dtb = F.in[I_DTB];
    for (int m = gw; m < MTOT; m += NGW) {
        const float* src = m < NLAT ? F.in[I_X] + (size_t)m * DM : F.in[I_CTX] + (size_t)(m - NLAT) * DM; const int v = m < NLAT ? (m >> 13) : 4;
        f32x4 x[4];
#pragma unroll
        for (int j = 0; j < 4; ++j) { x[j] = *(const f32x4*)(src + 4 * F.lane + 256 * j); *(f32x4*)(XS + (size_t)m * DM + 4 * F.lane + 256 * j) = x[j]; }
        emit_h_dt(F, x, MV + (size_t)v * 6144, m, dtb);
    }
}
DI void phase_ln1(const Frame& F, int l, int mrows) {
    const bool moe = l & 1; const int mi = l >> 1;
    LAS float* wrt = (LAS float*)F.lds;
    if (moe) { const float* w = F.in[I_MRW] + (size_t)mi * DM * 8; for (int i = F.tid; i < DM * 8; i += NTHR) wrt[i] = w[i]; __syncthreads(); }
    const int NGW = F.G * NWAVES, gw = F.vcu * NWAVES + F.wave;
    float* XS = WSP(float, WS_XS); const float* MV = WSP(float, WS_MVEC) + (size_t)l * 5 * 6144; bf16_t* HB = WSP(bf16_t, WS_HB);
    const float* g = F.in[I_LN1G] + l * DM; const float* b = F.in[I_LN1B] + l * DM;
    unsigned* SL = WSP(unsigned, WS_SLOT); unsigned* gcnt = (unsigned*)F.ctl + CW_MOECNT + mi * 1024;
    int cnt = 0, nst = 0; int me0 = 0, me1 = 0, mr0 = 0, mr1 = 0, mm = 0; float mg0 = 0.f, mg1 = 0.f;
    for (int m = gw; m < mrows; m += NGW) {
        const int v = m < NLAT ? (m >> 13) : 4;
        f32x4 x[4];
#pragma unroll
        for (int j = 0; j < 4; ++j) x[j] = *(const f32x4*)(XS + (size_t)m * DM + 4 * F.lane + 256 * j);
        ln_rows(x, g, b, F.lane);
        float acc[8];
#pragma unroll
        for (int c = 0; c < 8; ++c) acc[c] = 0.f;
        const float* mv = MV + (size_t)v * 6144;
#pragma unroll
        for (int j = 0; j < 4; ++j) {
            const int k = 4 * F.lane + 256 * j;
            *(f32x4*)(XS + (size_t)m * DM + k) = x[j];
            const f32x4 sh = *(const f32x4*)(mv + 3072 + k), sc = *(const f32x4*)(mv + 4096 + k);
            const f32x4 h = x[j] * (sc + 1.f) + sh;
            u32x2 w; w.x = pk2(h[0], h[1]); w.y = pk2(h[2], h[3]); *(u32x2*)(HB + (size_t)m * DM + k) = w;
            if (moe) {
#pragma unroll
                for (int e = 0; e < 4; ++e) { const LAS f32x4* wr = (const LAS f32x4*)(wrt + (k + e) * 8);
#pragma unroll
                    for (int q = 0; q < 2; ++q) { const f32x4 wv = wr[q]; acc[4 * q] += h[e] * wv[0]; acc[4 * q + 1] += h[e] * wv[1]; acc[4 * q + 2] += h[e] * wv[2]; acc[4 * q + 3] += h[e] * wv[3]; } }
            }
        }
        if (moe) {
            const bool b0 = F.lane & 1, b1 = F.lane & 2, b2 = F.lane & 4;
            float t4[4], t2[2], t1;
#pragma unroll
            for (int i = 0; i < 4; ++i) { const float keep = b0 ? acc[2 * i + 1] : acc[2 * i], give = b0 ? acc[2 * i] : acc[2 * i + 1]; t4[i] = keep + __shfl_xor(give, 1); }
#pragma unroll
            for (int i = 0; i < 2; ++i) { const float keep = b1 ? t4[2 * i + 1] : t4[2 * i], give = b1 ? t4[2 * i] : t4[2 * i + 1]; t2[i] = keep + __shfl_xor(give, 2); }
            { const float keep = b2 ? t2[1] : t2[0], give = b2 ? t2[0] : t2[1]; t1 = keep + __shfl_xor(give, 4); }
            t1 += __shfl_xor(t1, 8); t1 += __shfl_xor(t1, 16); t1 += __shfl_xor(t1, 32);
            t1 += F.in[I_MRB][mi * 8 + (F.lane & 7)];
            float lg[8];
#pragma unroll
            for (int e = 0; e < 8; ++e) lg[e] = __shfl(t1, e);
            int e0 = 0; float l0 = lg[0];
#pragma unroll
            for (int e = 1; e < 8; ++e) if (lg[e] > l0) { l0 = lg[e]; e0 = e; }
            int e1 = -1; float l1 = -3.0e38f;
#pragma unroll
            for (int e = 0; e < 8; ++e) if (e != e0 && lg[e] > l1) { l1 = lg[e]; e1 = e; }
            const float g1 = 1.f / (1.f + __expf(l0 - l1)), g0 = 1.f - g1;
            const int r0 = __shfl(cnt, e0); if (F.lane == e0) cnt++;
            const int r1 = __shfl(cnt, e1); if (F.lane == e1) cnt++;
            if (F.lane == nst) { me0 = e0; me1 = e1; mr0 = r0; mr1 = r1; mg0 = g0; mg1 = g1; mm = m; }
            ++nst;
        }
        if (moe && (nst == 64 || m + NGW >= mrows)) {
            unsigned base = 0u; if (F.lane < 8) base = __hip_atomic_fetch_add(gcnt + F.lane * 64, (unsigned)cnt, __ATOMIC_RELAXED, __HIP_MEMORY_SCOPE_AGENT);
            const unsigned p0 = __shfl(base, me0) + mr0, p1 = __shfl(base, me1) + mr1;
            if (F.lane < nst) { u32x4 a; a.x = me0; a.y = me1; a.z = p0; a.w = p1; *(u32x4*)(SL + (size_t)mm * 8) = a; u32x2 c; c.x = __float_as_uint(mg0); c.y = __float_as_uint(mg1); *(u32x2*)(SL + (size_t)mm * 8 + 4) = c; }
            cnt = 0; nst = 0;
        }
    }
}
DI void moe_pad_ends(const Frame& F, int mi, int (&pe)[8]) {
    unsigned* gcnt = (unsigned*)F.ctl + CW_MOECNT + mi * 1024; int run = 0;
#pragma unroll
    for (int e = 0; e < 8; ++e) { const int c = (int)__builtin_amdgcn_readfirstlane(__hip_atomic_load(gcnt + e * 64, __ATOMIC_RELAXED, __HIP_MEMORY_SCOPE_AGENT)); run += (c + 255) & ~255; pe[e] = run; }
}
DI int moe_pad_ends_lds(const Frame& F, int mi) {
    int pe[8]; moe_pad_ends(F, mi, pe);
    LAS int* d = (LAS int*)(F.lds + MISC_OFF + 64);
    __syncthreads();
    if (F.tid == 0) {
#pragma unroll
        for (int e = 0; e < 8; ++e) d[e] = pe[e];
    }
    __syncthreads();
    return pe[7];
}
DI void phase_gather(const Frame& F, int l, int mrows) {
    int pe[8]; moe_pad_ends(F, l >> 1, pe);
    const int NGW = F.G * NWAVES, gw = F.vcu * NWAVES + F.wave;
    unsigned* SL = WSP(unsigned, WS_SLOT); const bf16_t* HB = WSP(bf16_t, WS_HB); bf16_t* XP = WSP(bf16_t, WS_XPAD);
    for (int m = gw; m < mrows; m += NGW) {
        const u32x4 a = *(const u32x4*)(SL + (size_t)m * 8);
        int ps0 = 0, ps1 = 0;
#pragma unroll
        for (int e = 1; e < 8; ++e) { if ((int)a.x == e) ps0 = pe[e - 1]; if ((int)a.y == e) ps1 = pe[e - 1]; }
        const int d0 = ps0 + (int)a.z, d1 = ps1 + (int)a.w;
        const u32x4* src = (const u32x4*)(HB + (size_t)m * DM);
        const u32x4 v0 = src[F.lane], v1 = src[64 + F.lane];
        u32x4* q0 = (u32x4*)(XP + (size_t)d0 * DM); u32x4* q1 = (u32x4*)(XP + (size_t)d1 * DM);
        q0[F.lane] = v0; q0[64 + F.lane] = v1; q1[F.lane] = v0; q1[64 + F.lane] = v1;
        if (F.lane == 0) { u32x2 d; d.x = d0; d.y = d1; *(u32x2*)(SL + (size_t)m * 8 + 2) = d; }
    }
}
DI void phase_ln2(const Frame& F, int l, int mrows) {
    const bool moe = l & 1, lastl = (l == DEPTH - 1);
    if (!lastl) { load_wdt(F, l + 1); __syncthreads(); }
    const int NGW = F.G * NWAVES, gw = F.vcu * NWAVES + F.wave;
    float* XS = WSP(float, WS_XS); const float* MVl = WSP(float, WS_MVEC) + (size_t)l * 5 * 6144; const float* MVn = WSP(float, WS_MVEC) + (size_t)(l + 1) * 5 * 6144;
    const float* g = F.in[I_LN2G] + l * DM; const float* b = F.in[I_LN2B] + l * DM;
    const unsigned* SL = WSP(unsigned, WS_SLOT); const bf16_t* YP = WSP(bf16_t, WS_YPAD);
    const float* dtb = F.in[I_DTB] + (lastl ? 0 : (l + 1) * 16);
    for (int m = gw; m < mrows; m += NGW) {
        const int v = m < NLAT ? (m >> 13) : 4;
        f32x4 x[4];
#pragma unroll
        for (int j = 0; j < 4; ++j) x[j] = *(const f32x4*)(XS + (size_t)m * DM + 4 * F.lane + 256 * j);
        if (moe) {
            const u32x4 a = *(const u32x4*)(SL + (size_t)m * 8); const u32x2 gg = *(const u32x2*)(SL + (size_t)m * 8 + 4);
            const float g0 = __uint_as_float(gg.x), g1 = __uint_as_float(gg.y);
            const bf16_t* y0 = YP + (size_t)a.z * DM; const bf16_t* y1 = YP + (size_t)a.w * DM;
#pragma unroll
            for (int j = 0; j < 4; ++j) { const int k = 4 * F.lane + 256 * j; const u32x2 u0 = *(const u32x2*)(y0 + k), u1 = *(const u32x2*)(y1 + k);
                const f32x4 gt = *(const f32x4*)(MVl + (size_t)v * 6144 + 5120 + k);
                f32x4 f; f[0] = g0 * bflo(u0.x) + g1 * bflo(u1.x); f[1] = g0 * bfhi(u0.x) + g1 * bfhi(u1.x); f[2] = g0 * bflo(u0.y) + g1 * bflo(u1.y); f[3] = g0 * bfhi(u0.y) + g1 * bfhi(u1.y);
                if (ABL & 16) f = (f32x4){0.f, 0.f, 0.f, 0.f};
                x[j] = x[j] * ALPHA + gt * f; }
        }
        ln_rows(x, g, b, F.lane);
        if (lastl) {
#pragma unroll
            for (int j = 0; j < 4; ++j) *(f32x4*)(F.out + (size_t)m * DM + 4 * F.lane + 256 * j) = x[j];
        } else {
#pragma unroll
            for (int j = 0; j < 4; ++j) *(f32x4*)(XS + (size_t)m * DM + 4 * F.lane + 256 * j) = x[j];
            emit_h_dt(F, x, MVn + (size_t)v * 6144, m, dtb);
        }
    }
}

DI void phase_qkprep_rows(const Frame& F, int l) {
    const int NGW = F.G * NWAVES, gw = F.vcu * NWAVES + F.wave;
    bf16_t* PRJ = WSP(bf16_t, WS_PRJ); const float* rc = WSP(float, WS_ROPE); const float* rs = rc + SEQ * 32;
    const float* gq = F.in[I_QGQ] + l * 64; const float* gk = F.in[I_QGK] + l * 64;
    const int hs = F.lane >> 4, i2 = 2 * (F.lane & 15);
    for (int m = gw; m < MTOT; m += NGW) {
        const bool lat = m < NLAT; const int t = m & (SEQ - 1);
        float c0 = 1.f, c1 = 1.f, s0 = 0.f, s1 = 0.f;
        if (lat) { const f32x2 cc = *(const f32x2*)(rc + t * 32 + i2), ss = *(const f32x2*)(rs + t * 32 + i2); c0 = cc[0]; c1 = cc[1]; s0 = ss[0]; s1 = ss[1]; }
#pragma unroll
        for (int it = 0; it < 5; ++it) {
            const int hd = it * 4 + hs;
            const int col = hd < 8 ? C_SWQ + 64 * hd : hd < 10 ? C_SWK + 64 * (hd - 8) : hd < 18 ? C_GAQ + 64 * (hd - 10) : C_GAK + 64 * (hd - 18);
            bf16_t* p = PRJ + (size_t)m * PRJW + col + i2;
            const unsigned u1 = *(const unsigned*)p, u2 = *(const unsigned*)(p + 32);
            float a0 = bflo(u1), a1 = bfhi(u1), b0 = bflo(u2), b1 = bfhi(u2);
            if (hd >= 10) {
                float ss = a0 * a0 + a1 * a1 + b0 * b0 + b1 * b1;
                ss += __shfl_xor(ss, 1); ss += __shfl_xor(ss, 2); ss += __shfl_xor(ss, 4); ss += __shfl_xor(ss, 8);
                const float rn = 1.f / sqrtf(ss * (1.f / 64.f) + RMS_EPS); const float* gg = hd < 18 ? gq : gk; const float post = hd < 18 ? C2 : 1.f;
                a0 *= rn * gg[i2] * post; a1 *= rn * gg[i2 + 1] * post; b0 *= rn * gg[32 + i2] * post; b1 *= rn * gg[32 + i2 + 1] * post;
            }
            const float o0 = a0 * c0 - b0 * s0, o1 = a1 * c1 - b1 * s1, q0 = b0 * c0 + a0 * s0, q1 = b1 * c1 + a1 * s1;
            *(unsigned*)p = pk2(o0, o1); *(unsigned*)(p + 32) = pk2(q0, q1);
        }
    }
}

constexpr int AT_KVB = 16384, AT_VOFF = 8192, AT_BIAS = 2 * AT_KVB;
DI void attn_unit(const Frame& Fin, int l, int mode, bool ctxq, int b, int hq, int qblk) {
    const Frame F = launder(Fin);
    const int lane = F.lane, wid = F.wave, tid = F.tid, r = lane & 31, h = lane >> 5;
    const bf16_t* PRJ = WSP(bf16_t, WS_PRJ); bf16_t* OC = WSP(bf16_t, WS_OC);
    int qcol, kcol, vcol, ocol, kvh;
    if (mode == 0) { qcol = C_NAQ; kcol = C_NAK; vcol = C_NAV; ocol = 0; kvh = hq; }
    else if (mode == 1) { qcol = C_SWQ; kcol = C_SWK; vcol = C_SWV; ocol = 512; kvh = hq >> 2; }
    else { qcol = C_GAQ; kcol = C_GAK; vcol = C_GAV; ocol = 1024; kvh = hq >> 2; }
    const int qrow = ctxq ? (NLAT + b * CTXL + 32 * wid + r) : (b * SEQ + 256 * qblk + 32 * wid + r);
    bf16x8 qf[4];
    { const bf16_t* qp = PRJ + (size_t)qrow * PRJW + qcol + hq * 64 + 8 * h;
#pragma unroll
      for (int d0 = 0; d0 < 4; ++d0) qf[d0] = *(const bf16x8*)(qp + 16 * d0); }
    int tl_lo = 0, tl_hi = 0;
    if (!ctxq) {
        if (mode == 0) { tl_lo = clampi(4 * qblk - 4, 0, 120); tl_hi = clampi(4 * qblk - 1, 0, 120) + 8; }
        else if (mode == 1) { tl_lo = 4 * qblk - 2 < 0 ? 0 : 4 * qblk - 2; tl_hi = 4 * qblk + 6 > 128 ? 128 : 4 * qblk + 6; }
        else { tl_lo = 0; tl_hi = 128; }
    }
    const int ntile = 4 + (tl_hi - tl_lo);
    LAS float* biasT = (LAS float*)(F.lds + AT_BIAS);
    __syncthreads();
    if (mode == 0 && !ctxq) { const float* rp = F.in[I_RPB] + ((size_t)l * 8 + hq) * 465; for (int i = tid; i < 465; i += NTHR) biasT[i] = rp[i] * LOG2E; }
    const int lr = tid >> 3, ch = tid & 7;
    const size_t ctxbase = (size_t)(NLAT + b * CTXL), latbase = (size_t)b * SEQ;
    u32x4 kreg, vreg;
#define AT_LOAD(it) do { const size_t rb_ = ((it) < 4 ? ctxbase + 64 * (it) : latbase + 64 * (tl_lo + (it) - 4)) + lr; const bf16_t* rp_ = PRJ + rb_ * PRJW + kvh * 64 + ch * 8; \
        kreg = *(const u32x4*)(rp_ + kcol); vreg = *(const u32x4*)(rp_ + vcol); } while (0)
#define AT_STORE(buf) do { LAS unsigned char* d_ = F.lds + (buf) * AT_KVB; *(LAS u32x4*)(d_ + ch * 1024 + lr * 16) = kreg; *(LAS u32x4*)(d_ + AT_VOFF + (ch >> 2) * 4096 + lr * 64 + (ch & 3) * 16) = vreg; } while (0)
    AT_LOAD(0); AT_STORE(0);
    __syncthreads();
    float mrun = -1e30f, lrun = 0.f;
    if (mode == 1) { mrun = F.in[I_SINK][l * 8 + hq] * LOG2E; lrun = (h == 0) ? 1.f : 0.f; }
    f32x16 o0, o1;
#pragma unroll
    for (int i = 0; i < 16; ++i) { o0[i] = 0.f; o1[i] = 0.f; }
    const int q4 = (lane & 15) >> 2, p4 = lane & 3, blk = (lane >> 4) & 1;
    const int tq = 256 * qblk + 32 * wid + r;
    const int gr = 4 * qblk + (wid >> 1), qc = 32 * (wid & 1) + r, cs = clampi(qc - 8, 0, 48), rsw = clampi(gr - 4, 0, 120);
    for (int it = 0; it < ntile; ++it) {
        const int buf = it & 1;
        if (it + 1 < ntile) AT_LOAD(it + 1);
        const int g = tl_lo + it - 4;
        bool rel = true;
        if (it >= 4) { if (mode == 0) rel = (g >= rsw && g < rsw + 8); else if (mode == 1) rel = (64 * g + 63 >= 256 * qblk + 32 * wid - 128) && (64 * g <= 256 * qblk + 32 * wid + 31 + 128); }
        if (rel) {
            const LAS unsigned char* Kb = F.lds + buf * AT_KVB; const LAS unsigned char* Vb = Kb + AT_VOFF;
            f32x16 p0, p1;
#pragma unroll
            for (int i = 0; i < 16; ++i) { p0[i] = 0.f; p1[i] = 0.f; }
#pragma unroll
            for (int d0 = 0; d0 < 4; ++d0) {
                const bf16x8 k0 = *(const LAS bf16x8*)(Kb + (2 * d0 + h) * 1024 + r * 16);
                const bf16x8 k1 = *(const LAS bf16x8*)(Kb + (2 * d0 + h) * 1024 + 512 + r * 16);
                p0 = MFMA32(k0, qf[d0], p0); p1 = MFMA32(k1, qf[d0], p1);
            }
            if (it >= 4 && mode == 0) {
                int csl = cs; asm volatile("" : "+v"(csl));
                const LAS float* bt = biasT + (g - gr + 7) * 31 + 15 - qc;
#pragma unroll
                for (int i = 0; i < 16; ++i) { const int k0 = crow(i, h), k1 = k0 + 32;
                    p0[i] = (k0 >= csl && k0 < csl + 16) ? p0[i] + bt[k0] : -INFINITY; p1[i] = (k1 >= csl && k1 < csl + 16) ? p1[i] + bt[k1] : -INFINITY; }
            } else if (it >= 4 && mode == 1) {
                const int d0 = 64 * g - tq;
#pragma unroll
                for (int i = 0; i < 16; ++i) { const int dd = d0 + crow(i, h);
                    if (dd > 128 || dd < -128) p0[i] = -INFINITY; if (dd + 32 > 128 || dd + 32 < -128) p1[i] = -INFINITY; }
            }
            float mx = p0[0];
#pragma unroll
            for (int i = 1; i < 16; ++i) mx = fmaxf(mx, p0[i]);
#pragma unroll
            for (int i = 0; i < 16; ++i) mx = fmaxf(mx, p1[i]);
            mx = fmaxf(mx, __shfl_xor(mx, 32));
            const float mnew = fmaxf(mrun, mx), alpha = __builtin_amdgcn_exp2f(mrun - mnew); mrun = mnew;
            float ls = 0.f;
#pragma unroll
            for (int i = 0; i < 16; ++i) { p0[i] = __builtin_amdgcn_exp2f(p0[i] - mnew); p1[i] = __builtin_amdgcn_exp2f(p1[i] - mnew); ls += p0[i] + p1[i]; }
            lrun = lrun * alpha + ls;
            if (__any(alpha != 1.f)) {
#pragma unroll
                for (int i = 0; i < 16; ++i) { o0[i] *= alpha; o1[i] *= alpha; }
            }
            bf16x8 pa[4]; pa[0] = pack8<0>(p0); pa[1] = pack8<1>(p0); pa[2] = pack8<0>(p1); pa[3] = pack8<1>(p1);
            const LAS unsigned char* va = Vb + (4 * h + q4) * 64 + blk * 32 + p4 * 8;
#pragma unroll
            for (int ks = 0; ks < 4; ++ks) {
                const bf16x8 v0 = cat8(tr_read(va + ks * 1024), tr_read(va + ks * 1024 + 512));
                const bf16x8 v1 = cat8(tr_read(va + ks * 1024 + 4096), tr_read(va + ks * 1024 + 4096 + 512));
                o0 = MFMA32(v0, pa[ks], o0); o1 = MFMA32(v1, pa[ks], o1);
            }
        }
        if (it + 1 < ntile) AT_STORE(buf ^ 1);
        __syncthreads();
    }
#undef AT_LOAD
#undef AT_STORE
    const float lt = lrun + __shfl_xor(lrun, 32), inv = 1.f / lt;
    bf16_t* op = OC + (size_t)qrow * OCW + ocol + hq * 64 + 4 * h;
#pragma unroll
    for (int g4 = 0; g4 < 4; ++g4) {
        u32x2 w; w.x = pk2(o0[4 * g4] * inv, o0[4 * g4 + 1] * inv); w.y = pk2(o0[4 * g4 + 2] * inv, o0[4 * g4 + 3] * inv); *(u32x2*)(op + 8 * g4) = w;
        u32x2 w2; w2.x = pk2(o1[4 * g4] * inv, o1[4 * g4 + 1] * inv); w2.y = pk2(o1[4 * g4 + 2] * inv, o1[4 * g4 + 3] * inv); *(u32x2*)(op + 32 + 8 * g4) = w2;
    }
}

namespace ga_body {
using bf16=__hip_bfloat16;
using bf16x8=__attribute__((ext_vector_type(8)))short;
using s16x4=__attribute__((ext_vector_type(4)))short;
using f32x16=__attribute__((ext_vector_type(16)))float;
using u32x4=__attribute__((ext_vector_type(4)))unsigned;
constexpr int SEQ=8192,D=64,PQ=4608,PO=2048,NCTXT=4;
constexpr int NW=8,QBLK=32,QB=QBLK*NW,KVBLK=64,NQB=SEQ/QB;
__device__ __forceinline__ int crow(int r,int hi){return (r&3)+8*(r>>2)+4*hi;}
#define SBAR() __builtin_amdgcn_sched_barrier(0)
__device__ __forceinline__ void cmask(f32x16&p0,f32x16&p1,int jb,int qrel,int hi){
  const float NEG=-INFINITY; int kb=64*jb+4*hi;
  #pragma unroll
  for(int r=0;r<16;++r){int kv=kb+(r&3)+8*(r>>2); if(kv>qrel)p0[r]=NEG; if(kv+32>qrel)p1[r]=NEG;}
}

constexpr int NSLOT=3, SLOTB=8192;
constexpr int LDS_K=0, LDS_V=NSLOT*SLOTB, LDS_WS=2*NSLOT*SLOTB, LDS_OST=LDS_WS+NW*64*4, LDS_BYTES=LDS_OST+NW*4096;
constexpr float C2=0.125f*1.4426950408889634f;
__device__ __forceinline__ void glds16(const void*gsrc,unsigned lds_dst){unsigned keep;
  asm volatile("s_mov_b32 %0, m0\n\ts_mov_b32 m0, %2\n\ts_nop 0\n\tglobal_load_lds_dwordx4 %1, off\n\ts_mov_b32 m0, %0":"=&s"(keep):"v"(gsrc),"s"(lds_dst):"memory");}
__device__ __forceinline__ float max3f(float a,float b,float c){float r;asm("v_max3_f32 %0, %1, %2, %3":"=v"(r):"v"(a),"v"(b),"v"(c));return r;}
__device__ __forceinline__ float max2f(float a,float b){float r;asm("v_max_f32_e32 %0, %1, %2":"=v"(r):"v"(a),"v"(b));return r;}
__device__ __forceinline__ float fadd_s(float a,float b){float r;asm("v_add_f32_e32 %0, %1, %2":"=v"(r):"v"(a),"v"(b));return r;}
__device__ __forceinline__ float fsub_s(float a,float b){float r;asm("v_sub_f32_e32 %0, %1, %2":"=v"(r):"v"(a),"v"(b));return r;}
typedef float f32x2_t __attribute__((ext_vector_type(2))); typedef __bf16 bf16x2_t __attribute__((ext_vector_type(2)));
__device__ __forceinline__ unsigned cvtpk_s(float lo,float hi){f32x2_t v={lo,hi};bf16x2_t b=__builtin_convertvector(v,bf16x2_t);return __builtin_bit_cast(unsigned,b);}
#define WAIT_BAR(N) asm volatile("s_waitcnt vmcnt(" #N ") lgkmcnt(0)\n\ts_barrier":::"memory")

__device__ __forceinline__ void qkt(f32x16&p0,f32x16&p1,const char*Kslot,const bf16x8*qr,const f32x16&negm,int r32,int hi){
  const char*kb=Kslot+hi*1024+r32*16;
  #pragma unroll
  for(int d0=0;d0<4;++d0){
    const bf16x8 b0=*reinterpret_cast<const bf16x8*>(kb+d0*2048);
    const bf16x8 b1=*reinterpret_cast<const bf16x8*>(kb+d0*2048+512);
    if(d0==0){p0=__builtin_amdgcn_mfma_f32_32x32x16_bf16(b0,qr[0],negm,0,0,0);p1=__builtin_amdgcn_mfma_f32_32x32x16_bf16(b1,qr[0],negm,0,0,0);}
    else{p0=__builtin_amdgcn_mfma_f32_32x32x16_bf16(b0,qr[d0],p0,0,0,0);p1=__builtin_amdgcn_mfma_f32_32x32x16_bf16(b1,qr[d0],p1,0,0,0);}}
}
typedef __attribute__((address_space(3))) const char* lds_cptr;
typedef short v4i16_t __attribute__((ext_vector_type(4)));
__device__ __forceinline__ void kload8(bf16x8*kf,lds_cptr kp){
  kf[0]=*(const __attribute__((address_space(3))) bf16x8*)(kp);      kf[1]=*(const __attribute__((address_space(3))) bf16x8*)(kp+512);
  kf[2]=*(const __attribute__((address_space(3))) bf16x8*)(kp+2048); kf[3]=*(const __attribute__((address_space(3))) bf16x8*)(kp+2560);
  kf[4]=*(const __attribute__((address_space(3))) bf16x8*)(kp+4096); kf[5]=*(const __attribute__((address_space(3))) bf16x8*)(kp+4608);
  kf[6]=*(const __attribute__((address_space(3))) bf16x8*)(kp+6144); kf[7]=*(const __attribute__((address_space(3))) bf16x8*)(kp+6656);
}
__device__ __forceinline__ void kload2(bf16x8*kf,lds_cptr kp,int j){ kf[2*j]=*(const __attribute__((address_space(3))) bf16x8*)(kp+j*2048); kf[2*j+1]=*(const __attribute__((address_space(3))) bf16x8*)(kp+j*2048+512); }
__device__ __forceinline__ s16x4 vtr(lds_cptr p){ return __builtin_bit_cast(s16x4,__builtin_amdgcn_ds_read_tr16_b64_v4i16((__attribute__((address_space(3))) v4i16_t*)p)); }
__device__ __forceinline__ float rowmax(const f32x16&p0,const f32x16&p1){
  float a=max3f(p0[0],p0[1],p1[0]),b=max3f(p0[2],p0[3],p1[1]);a=max3f(a,p1[2],p1[3]);
  #pragma unroll
  for(int r=4;r<16;r+=4){a=max3f(a,p0[r],p0[r+1]);b=max3f(b,p0[r+2],p0[r+3]);a=max3f(a,p1[r],p1[r+1]);b=max3f(b,p1[r+2],p1[r+3]);}
  const float m=max2f(a,b);
  auto rr=__builtin_amdgcn_permlane32_swap(__float_as_uint(m),__float_as_uint(m),false,false);
  return max2f(__uint_as_float(rr[0]),__uint_as_float(rr[1]));
}
__device__ __forceinline__ void pv(f32x16*o,int vb,bf16x8 pa0,bf16x8 pa1,bf16x8 pa2,bf16x8 pa3){
  #pragma unroll
  for(int d0=0;d0<2;++d0){s16x4 lo[4],hi[4];
    #pragma unroll
    for(int ks=0;ks<4;++ks){
      asm volatile("ds_read_b64_tr_b16 %0,%1 offset:%c2":"=&v"(lo[ks]):"v"(vb),"i"(d0*4096+ks*1024):"memory");
      asm volatile("ds_read_b64_tr_b16 %0,%1 offset:%c2":"=&v"(hi[ks]):"v"(vb),"i"(d0*4096+ks*1024+512):"memory");}
    asm volatile("s_waitcnt lgkmcnt(0)":::"memory");SBAR();
    #define PK(k) (bf16x8){lo[k][0],lo[k][1],lo[k][2],lo[k][3],hi[k][0],hi[k][1],hi[k][2],hi[k][3]}
    o[d0]=__builtin_amdgcn_mfma_f32_32x32x16_bf16(pa0,PK(0),o[d0],0,0,0);
    o[d0]=__builtin_amdgcn_mfma_f32_32x32x16_bf16(pa1,PK(1),o[d0],0,0,0);
    o[d0]=__builtin_amdgcn_mfma_f32_32x32x16_bf16(pa2,PK(2),o[d0],0,0,0);
    o[d0]=__builtin_amdgcn_mfma_f32_32x32x16_bf16(pa3,PK(3),o[d0],0,0,0);
    #undef PK
  }
}

#ifndef ATTN_STORE16
#define ATTN_STORE16(p,v) (*(u32x4*)(p)=(v))
#endif
template<int THRL> __device__ __forceinline__ void attn_unit(int qb,const bf16*Qp,const bf16*__restrict__ Kl,const bf16*__restrict__ Vl,const bf16*__restrict__ Kc,const bf16*__restrict__ Vc,bf16*Op,char*shm,const int tid){
  const int lane=tid&63,r32=lane&31,hi=lane>>5; const int wid=__builtin_amdgcn_readfirstlane(tid>>6);
  const int q0=qb*QB;
  const bf16*Qw=Qp+(long)(q0+wid*QBLK)*PQ;
  const unsigned lds0=(unsigned)(uintptr_t)shm;
  float*wsf=(float*)(shm+LDS_WS)+wid*64;
  const long koff=(long)lane*PQ+wid*8;
  const long voff=(long)(16*(wid&3)+(lane>>2))*PQ+(wid>>2)*32+(lane&3)*8;
  const unsigned kdst=lds0+LDS_K+wid*1024, vdst=lds0+LDS_V+wid*1024;
  #define TILE_SRC(t,C,L) (((t)<NCTXT?(C)+(long)(t)*KVBLK*PQ:(L)+(long)((t)-NCTXT)*KVBLK*PQ))
  #define DMA_K(t,slot) glds16(TILE_SRC(t,Kc,Kl)+koff,(unsigned)__builtin_amdgcn_readfirstlane(kdst+(slot)))
  #define DMA_V(t,slot) glds16(TILE_SRC(t,Vc,Vl)+voff,(unsigned)__builtin_amdgcn_readfirstlane(vdst+(slot)))
  const int vb0=(int)(lds0+LDS_V)+((lane>>4)&1)*32+(lane&3)*8+(4*hi+((lane&15)>>2))*64;
  const char*Kbase=shm+LDS_K; bf16x8 kf[8];
  const lds_cptr shm3=(lds_cptr)shm; const lds_cptr kp0=shm3+LDS_K+hi*1024+r32*16; const lds_cptr vp0=shm3+LDS_V+((lane>>4)&1)*32+(lane&3)*8+(4*hi+((lane&15)>>2))*64;
  constexpr int NT=NCTXT+SEQ/KVBLK;
  DMA_K(0,0);DMA_V(0,0);DMA_K(1,SLOTB);
  bf16x8 qr[4];
  #pragma unroll
  for(int d0=0;d0<4;++d0)qr[d0]=*reinterpret_cast<const bf16x8*>(&Qw[(long)r32*PQ+d0*16+hi*8]);
  float mhat=0.f,l_reg=0.f;f32x16 o[2];o[0]=f32x16{};o[1]=f32x16{};f32x16 negm=f32x16{};asm volatile("":"+v"(negm));
  #define CMASK(P0,P1,t) do{}while(0)
  bool resc=false;
  #define START(P0,P1) do{ const float rm=rowmax(P0,P1); resc=false; \
    { const float dl=rm; mhat=fadd_s(mhat,dl); \
      _Pragma("unroll") for(int r=0;r<16;++r){P0[r]=fsub_s(P0[r],dl);P1[r]=fsub_s(P1[r],dl);} \
      _Pragma("unroll") for(int r=0;r<16;++r)negm[r]=-mhat; asm volatile("":"+v"(negm)); } \
    _Pragma("unroll") for(int r=0;r<16;++r)P0[r]=__builtin_amdgcn_exp2f(P0[r]); }while(0)
  #define RESC() do{ if(resc){ asm volatile("s_waitcnt lgkmcnt(0)":::"memory"); \
      _Pragma("unroll") for(int d_=0;d_<2;++d_) _Pragma("unroll") for(int r=0;r<16;++r)o[d_][r]*=wsf[crow(r,hi)]; } }while(0)
  f32x16 pA0,pA1,pB0,pB1;
  int sl_prev=0,sl_cur=0,sl_next=SLOTB;
  #define ROT() do{sl_prev=sl_cur;sl_cur=sl_next;sl_next=(sl_next==(NSLOT-1)*SLOTB)?0:sl_next+SLOTB;}while(0)
  DMA_K(2,2*SLOTB);
  WAIT_BAR(3);
  qkt(pA0,pA1,Kbase,qr,negm,r32,hi);asm volatile("s_nop 15\n\ts_nop 7":"+v"(pA0),"+v"(pA1));CMASK(pA0,pA1,0);
  START(pA0,pA1);
  _Pragma("unroll") for(int r=0;r<16;++r)pA1[r]=__builtin_amdgcn_exp2f(pA1[r]);
  WAIT_BAR(0);
  DMA_K(3,0);DMA_V(1,SLOTB);
  ROT();
  kload8(kf,kp0+sl_cur);
  WAIT_BAR(2);
  s16x4 vlo[8],vhi[8]; u32x4 pw0,pw1,pw2,pw3;
  #define PKW(P,B) cvtpk_s(P[B],P[B+1])
  #define PAF(k) __builtin_bit_cast(bf16x8,pw##k)
  #define VFR(i) (bf16x8){vlo[i][0],vlo[i][1],vlo[i][2],vlo[i][3],vhi[i][0],vhi[i][1],vhi[i][2],vhi[i][3]}
  #define PIN(x) asm volatile("":"+v"(x))
  #define MX3(a,b,c) __builtin_fmaxf(__builtin_fmaxf((a),(b)),(c))
  #define GAPA(MF,A0,A1,A2,A3,W0,W1,PW) do{ MF; sacc+=A0; sacc+=A1; sacc+=A2; sacc+=A3; PIN(sacc); W0; W1; PIN(PW); SBAR(); }while(0)
  #define EX(v) __builtin_amdgcn_exp2f(v)
  #define GAPB(MF,X,B) do{ MF; X[B]=EX(X[B]); X[B+1]=EX(X[B+1]); X[B+2]=EX(X[B+2]); X[B+3]=EX(X[B+3]); PIN(X); SBAR(); }while(0)
  #define VRD(i) do{ vlo[i]=vtr(vp_+(((i)>>2)*4096+((i)&3)*1024)); vhi[i]=vtr(vp_+(((i)>>2)*4096+((i)&3)*1024+512)); }while(0)
  #define KRD(G,j) do{ if(G){ kload2(kf,kp0+sl_next,j); SBAR(); } }while(0)
  #define STEP(C0,C1,P0,P1,t,GK,GV,GL) do{ SBAR(); \
    const lds_cptr vp_=vp0+sl_prev; \
    VRD(0); SBAR(); float sacc=(P0[0]+P0[1]); \
    GAPA(C0=__builtin_amdgcn_mfma_f32_32x32x16_bf16(kf[0],qr[0],negm,0,0,0), P0[2],P0[3],P0[4],P0[5],     pw0[0]=PKW(P0,0), pw0[1]=PKW(P0,2), pw0); \
    VRD(4); SBAR(); GAPA(C1=__builtin_amdgcn_mfma_f32_32x32x16_bf16(kf[1],qr[0],negm,0,0,0), P0[6],P0[7],P0[8],P0[9],     pw0[2]=PKW(P0,4), pw0[3]=PKW(P0,6), pw0); \
    VRD(1); SBAR(); GAPA(C0=__builtin_amdgcn_mfma_f32_32x32x16_bf16(kf[2],qr[1],C0,0,0,0),   P0[10],P0[11],P0[12],P0[13], pw1[0]=PKW(P0,8), pw1[1]=PKW(P0,10), pw1); \
    VRD(5); SBAR(); GAPA(C1=__builtin_amdgcn_mfma_f32_32x32x16_bf16(kf[3],qr[1],C1,0,0,0),   P0[14],P0[15],P1[0],P1[1],   pw1[2]=PKW(P0,12),pw1[3]=PKW(P0,14), pw1); \
    VRD(2); SBAR(); GAPA(C0=__builtin_amdgcn_mfma_f32_32x32x16_bf16(kf[4],qr[2],C0,0,0,0),   P1[2],P1[3],P1[4],P1[5],     pw2[0]=PKW(P1,0), pw2[1]=PKW(P1,2), pw2); \
    VRD(6); SBAR(); GAPA(C1=__builtin_amdgcn_mfma_f32_32x32x16_bf16(kf[5],qr[2],C1,0,0,0),   P1[6],P1[7],P1[8],P1[9],     pw2[2]=PKW(P1,4), pw2[3]=PKW(P1,6), pw2); \
    VRD(3); SBAR(); GAPA(C0=__builtin_amdgcn_mfma_f32_32x32x16_bf16(kf[6],qr[3],C0,0,0,0),   P1[10],P1[11],P1[12],P1[13], pw3[0]=PKW(P1,8), pw3[1]=PKW(P1,10), pw3); \
    VRD(7); SBAR(); GAPA(C1=__builtin_amdgcn_mfma_f32_32x32x16_bf16(kf[7],qr[3],C1,0,0,0),   P1[14],P1[15],0.f,0.f,       pw3[2]=PKW(P1,12),pw3[3]=PKW(P1,14), pw3); \
    l_reg+=sacc; \
    if(GK){DMA_K((t)+3,sl_cur);} if(GV){DMA_V((t)+1,sl_next);} \
    CMASK(C0,C1,t); \
    { float a=MX3(C0[0],C0[1],C1[0]),b=MX3(C0[2],C0[3],C1[1]); a=MX3(a,C1[2],C1[3]); \
      _Pragma("unroll") for(int r=4;r<16;r+=4){a=MX3(a,C0[r],C0[r+1]);b=MX3(b,C0[r+2],C0[r+3]);a=MX3(a,C1[r],C1[r+1]);b=MX3(b,C1[r+2],C1[r+3]);} \
      float rm=__builtin_fmaxf(a,b); { auto rr=__builtin_amdgcn_permlane32_swap(__float_as_uint(rm),__float_as_uint(rm),false,false); rm=__builtin_fmaxf(__uint_as_float(rr[0]),__uint_as_float(rr[1])); } \
      resc=false; \
      if(__builtin_expect(__any(rm>(float)THRL),0)){ const float dl=__builtin_fmaxf(rm,0.f); mhat+=dl; \
        _Pragma("unroll") for(int r=0;r<16;++r){C0[r]-=dl;C1[r]-=dl;} \
        _Pragma("unroll") for(int r=0;r<16;++r)negm[r]=-mhat; asm volatile("":"+v"(negm)); \
        const float f=__builtin_amdgcn_exp2f(-dl); l_reg*=f; if(hi==0)wsf[r32]=f; resc=true; } } \
    SBAR(); \
    GAPB(o[0]=__builtin_amdgcn_mfma_f32_32x32x16_bf16(PAF(0),VFR(0),o[0],0,0,0), C0,0); \
    GAPB(o[1]=__builtin_amdgcn_mfma_f32_32x32x16_bf16(PAF(0),VFR(4),o[1],0,0,0), C0,4); \
    KRD(GL,0); GAPB(o[0]=__builtin_amdgcn_mfma_f32_32x32x16_bf16(PAF(1),VFR(1),o[0],0,0,0), C0,8); \
    KRD(GL,1); GAPB(o[1]=__builtin_amdgcn_mfma_f32_32x32x16_bf16(PAF(1),VFR(5),o[1],0,0,0), C0,12); \
    KRD(GL,2); GAPB(o[0]=__builtin_amdgcn_mfma_f32_32x32x16_bf16(PAF(2),VFR(2),o[0],0,0,0), C1,0); \
    KRD(GL,3); GAPB(o[1]=__builtin_amdgcn_mfma_f32_32x32x16_bf16(PAF(2),VFR(6),o[1],0,0,0), C1,4); \
    GAPB(o[0]=__builtin_amdgcn_mfma_f32_32x32x16_bf16(PAF(3),VFR(3),o[0],0,0,0), C1,8); \
    GAPB(o[1]=__builtin_amdgcn_mfma_f32_32x32x16_bf16(PAF(3),VFR(7),o[1],0,0,0), C1,12); \
    }while(0)
  int t=1;
  #undef CMASK
  #define CMASK(P0,P1,t) do{}while(0)
  for(;t+5<NT;t+=2){
    STEP(pB0,pB1,pA0,pA1,t,true,true,true);     WAIT_BAR(2); RESC(); ROT();
    STEP(pA0,pA1,pB0,pB1,t+1,true,true,true);   WAIT_BAR(2); RESC(); ROT();
  }
  #undef CMASK
  #define CMASK(P0,P1,t) do{}while(0)
  #define ENDW(tt) do{ if((tt)+3<NT){WAIT_BAR(2);} else if((tt)+2<NT){WAIT_BAR(1);} else {WAIT_BAR(0);} }while(0)
  for(;t+1<NT;t+=2){
    STEP(pB0,pB1,pA0,pA1,t,(t+3<NT),(t+1<NT),(t+1<NT));       ENDW(t);   RESC(); ROT();
    STEP(pA0,pA1,pB0,pB1,t+1,(t+4<NT),(t+2<NT),(t+2<NT));     ENDW(t+1); RESC(); ROT();
  }
  STEP(pB0,pB1,pA0,pA1,NT-1,false,false,false); RESC();
  { float sacc=pB0[0]+pB0[1]; _Pragma("unroll") for(int r=2;r<16;++r)sacc+=pB0[r]; _Pragma("unroll") for(int r=0;r<16;++r)sacc+=pB1[r]; l_reg+=sacc;
    pw0=(u32x4){PKW(pB0,0),PKW(pB0,2),PKW(pB0,4),PKW(pB0,6)};pw1=(u32x4){PKW(pB0,8),PKW(pB0,10),PKW(pB0,12),PKW(pB0,14)};pw2=(u32x4){PKW(pB1,0),PKW(pB1,2),PKW(pB1,4),PKW(pB1,6)};pw3=(u32x4){PKW(pB1,8),PKW(pB1,10),PKW(pB1,12),PKW(pB1,14)};
    SBAR(); pv(o,vb0+sl_cur,PAF(0),PAF(1),PAF(2),PAF(3)); }
  #undef PKW
  #undef PAF
  #undef VFR
  #undef PIN
  #undef MX3
  #undef GAPA
  #undef GAPB
  #undef EX
  #undef VRD
  #undef KRD
  #undef STEP
  #undef ENDW
  {auto rr=__builtin_amdgcn_permlane32_swap(__float_as_uint(l_reg),__float_as_uint(l_reg),false,false);l_reg=__uint_as_float(rr[0])+__uint_as_float(rr[1]);}
  if(hi==0)wsf[32+r32]=l_reg;asm volatile("s_waitcnt lgkmcnt(0)":::"memory");
  float rli[16];
  #pragma unroll
  for(int r=0;r<16;++r)rli[r]=__builtin_amdgcn_rcpf(wsf[32+crow(r,hi)]);
  bf16*Ow=Op+(long)(q0+wid*QBLK)*PO;
  { bf16*stg=(bf16*)(shm+LDS_OST)+wid*2048;
    #pragma unroll
    for(int r=0;r<16;++r){const int orow=crow(r,hi);
      #pragma unroll
      for(int d0=0;d0<2;++d0)stg[orow*64+d0*32+r32]=__float2bfloat16(o[d0][r]*rli[r]);}
    asm volatile("s_waitcnt lgkmcnt(0)":::"memory");
    #pragma unroll
    for(int i=0;i<4;++i){const int row=i*8+(lane>>3),ch=lane&7; const u32x4 v=*(const u32x4*)(stg+row*64+ch*8); ATTN_STORE16(Ow+(long)row*PO+ch*8,v);} }
  asm volatile("s_waitcnt lgkmcnt(0)\n\ts_barrier":::"memory");
  #undef DMA_K
  #undef TILE_SRC
  #undef DMA_V
  #undef CMASK
  #undef START
  #undef RESC
  #undef ROT
}
#undef SBAR
#undef WAIT_BAR
}

constexpr int SD_CUM = 0, SD_DTV = 1024, SD_XC = 2048, SD_XCS = 144, SD_BC = SD_XC + 128 * SD_XCS, SD_BCS = 272, SD_CC = SD_BC + 128 * SD_BCS, SD_HS = SD_CC + 128 * SD_BCS,
              SD_SSQ = SD_HS + 2 * 64 * SD_BCS, SD_XW = SD_CC;
static_assert(SD_SSQ + 1024 <= RING_BYTES && SD_XW + 2 * 128 * SD_XCS <= RING_BYTES, "SSD LDS map");
DI int chunk_row(int b, int cidx) { return cidx < 2 ? NLAT + b * CTXL + 128 * cidx : b * SEQ + 128 * (cidx - 2); }
DI void ssd_cum(const Frame& F, int l, int b, int cidx, int hd) {
    if (F.wave < 2) {
        const int dir = F.wave; const float* DT = WSP(float, WS_DT) + (size_t)chunk_row(b, cidx) * 16 + dir * 8 + hd;
        const float a = -__expf(F.in[I_ALOG][l * 16 + dir * 8 + hd]);
        const float d0 = DT[(size_t)(2 * F.lane) * 16], d1 = DT[(size_t)(2 * F.lane + 1) * 16];
        const float a0 = d0 * a, a1 = d1 * a, s = a0 + a1; float v = s;
        LAS float* cum = (LAS float*)(F.lds + SD_CUM) + dir * 128; LAS float* dtv = (LAS float*)(F.lds + SD_DTV) + dir * 128;
        if (dir == 0) {
#pragma unroll
            for (int o = 1; o < 64; o <<= 1) { const float t = __shfl_up(v, o); if (F.lane >= o) v += t; }
            cum[2 * F.lane] = v - s + a0; cum[2 * F.lane + 1] = v;
        } else {
#pragma unroll
            for (int o = 1; o < 64; o <<= 1) { const float t = __shfl_down(v, o); if (F.lane + o < 64) v += t; }
            cum[2 * F.lane + 1] = v - s + a1; cum[2 * F.lane] = v;
        }
        dtv[2 * F.lane] = d0; dtv[2 * F.lane + 1] = d1;
    }
}
DI void conv_tile(const Frame& F, int l, LAS unsigned char* dst, int dstride, int ch0, int nchunks, int rowbase, int seqlo, int seqhi) {
    const bf16_t* PRJ = WSP(bf16_t, WS_PRJ); const float* cw = F.in[I_CONVW] + (size_t)l * 5 * 1024; const float* cb = F.in[I_CONVB] + l * 1024;
    for (int item = F.tid; item < nchunks * 16; item += NTHR) {
        const int chunk = item % nchunks, seg = item / nchunks, t0 = seg * 8, c0 = ch0 + chunk * 8;
        float w[5][8], bb[8];
#pragma unroll
        for (int k = 0; k < 5; ++k) { const f32x4 wa = *(const f32x4*)(cw + k * 1024 + c0), wb = *(const f32x4*)(cw + k * 1024 + c0 + 4);
            w[k][0] = wa[0]; w[k][1] = wa[1]; w[k][2] = wa[2]; w[k][3] = wa[3]; w[k][4] = wb[0]; w[k][5] = wb[1]; w[k][6] = wb[2]; w[k][7] = wb[3]; }
        { const f32x4 ba = *(const f32x4*)(cb + c0), b2 = *(const f32x4*)(cb + c0 + 4); bb[0] = ba[0]; bb[1] = ba[1]; bb[2] = ba[2]; bb[3] = ba[3]; bb[4] = b2[0]; bb[5] = b2[1]; bb[6] = b2[2]; bb[7] = b2[3]; }
        u32x4 rows[12];
#pragma unroll
        for (int i = 0; i < 12; ++i) { const int row = rowbase + t0 - 2 + i;
            rows[i] = (row >= seqlo && row < seqhi) ? *(const u32x4*)(PRJ + (size_t)row * PRJW + C_XBC + c0) : (u32x4){0u, 0u, 0u, 0u}; }
#pragma unroll
        for (int j = 0; j < 8; ++j) {
            float y[8];
#pragma unroll
            for (int e = 0; e < 8; ++e) y[e] = bb[e];
#pragma unroll
            for (int k = 0; k < 5; ++k) { const u32x4 rr = rows[j + k];
                y[0] += w[k][0] * bflo(rr.x); y[1] += w[k][1] * bfhi(rr.x); y[2] += w[k][2] * bflo(rr.y); y[3] += w[k][3] * bfhi(rr.y);
                y[4] += w[k][4] * bflo(rr.z); y[5] += w[k][5] * bfhi(rr.z); y[6] += w[k][6] * bflo(rr.w); y[7] += w[k][7] * bfhi(rr.w); }
            u32x4 o; o.x = pk2(silu(y[0]), silu(y[1])); o.y = pk2(silu(y[2]), silu(y[3])); o.z = pk2(silu(y[4]), silu(y[5])); o.w = pk2(silu(y[6]), silu(y[7]));
            *(LAS u32x4*)(dst + (t0 + j) * dstride + chunk * 16) = o;
        }
    }
}
DI void ssd_s1_unit(const Frame& Fin, int l, int b, int cidx, int hd) {
    const Frame F = launder(Fin);
    const int lane = F.lane, wid = F.wave, r = lane & 31, h = lane >> 5;
    const int rowbase = chunk_row(b, cidx), seqlo = cidx < 2 ? NLAT + b * CTXL : b * SEQ, seqhi = cidx < 2 ? seqlo + CTXL : seqlo + SEQ;
    __syncthreads();
    ssd_cum(F, l, b, cidx, hd);
    conv_tile(F, l, F.lds + SD_XC, SD_XCS, 64 * hd, 8, rowbase, seqlo, seqhi);
    conv_tile(F, l, F.lds + SD_BC, SD_BCS, 512 + 128 * (hd >> 2), 16, rowbase, seqlo, seqhi);
    __syncthreads();
    const LAS float* cum = (const LAS float*)(F.lds + SD_CUM); const LAS float* dtv = (const LAS float*)(F.lds + SD_DTV);
    for (int i = F.tid; i < 2 * 128 * 8; i += NTHR) {
        const int dir = i >> 10, t = (i >> 3) & 127, c8 = i & 7;
        const float ce = dir == 0 ? cum[127] : cum[128]; const float wgt = dtv[dir * 128 + t] * __expf(ce - cum[dir * 128 + t]);
        const u32x4 x = *(const LAS u32x4*)(F.lds + SD_XC + t * SD_XCS + c8 * 16);
        u32x4 o; o.x = pk2(bflo(x.x) * wgt, bfhi(x.x) * wgt); o.y = pk2(bflo(x.y) * wgt, bfhi(x.y) * wgt); o.z = pk2(bflo(x.z) * wgt, bfhi(x.z) * wgt); o.w = pk2(bflo(x.w) * wgt, bfhi(x.w) * wgt);
        *(LAS u32x4*)(F.lds + SD_XW + (dir * 128 + t) * SD_XCS + c8 * 16) = o;
    }
    __syncthreads();
    const int dir = wid >> 2, nb = wid & 3, q4 = (lane & 15) >> 2, p4 = lane & 3, blk = (lane >> 4) & 1;
    f32x16 s0, s1;
#pragma unroll
    for (int i = 0; i < 16; ++i) { s0[i] = 0.f; s1[i] = 0.f; }
    const LAS unsigned char* xa = F.lds + SD_XW + (dir * 128 + 8 * h + q4) * SD_XCS + (16 * blk + 4 * p4) * 2;
    const LAS unsigned char* ba = F.lds + SD_BC + (8 * h + q4) * SD_BCS + (32 * nb + 16 * blk + 4 * p4) * 2;
#pragma unroll
    for (int ks = 0; ks < 8; ++ks) {
        const bf16x8 bfr = cat8(tr_read(ba + (16 * ks) * SD_BCS), tr_read(ba + (16 * ks + 4) * SD_BCS));
        const bf16x8 x0 = cat8(tr_read(xa + (16 * ks) * SD_XCS), tr_read(xa + (16 * ks + 4) * SD_XCS));
        const bf16x8 x1 = cat8(tr_read(xa + (16 * ks) * SD_XCS + 64), tr_read(xa + (16 * ks + 4) * SD_XCS + 64));
        s0 = MFMA32(x0, bfr, s0); s1 = MFMA32(x1, bfr, s1);
    }
    float* ST = WSP(float, WS_ST) + ((((size_t)b * NCH + cidx) * 8 + hd) * 2 + dir) * 8192 + 32 * nb + r;
#pragma unroll
    for (int i = 0; i < 16; ++i) { ST[(size_t)crow(i, h) * 128] = s0[i]; ST[(size_t)(32 + crow(i, h)) * 128] = s1[i]; }
    if (F.tid < 2) WSP(float, WS_CDEC)[(((size_t)b * NCH + cidx) * 8 + hd) * 2 + F.tid] = __expf(F.tid == 0 ? cum[127] : cum[128]);
}
DI void phase_scan(const Frame& F) {
    float* ST = WSP(float, WS_ST); const float* CD = WSP(float, WS_CDEC);
    for (int gid = F.vcu * NTHR + F.tid; gid < 64 * 2048; gid += F.G * NTHR) {
        const int chain = gid >> 11, e4 = gid & 2047, b = chain >> 4, hd = (chain >> 1) & 7, dir = chain & 1;
        f32x4 hst = (f32x4){0.f, 0.f, 0.f, 0.f};
#pragma unroll 6
        for (int k = 0; k < NCH; ++k) {
            const int cidx = dir == 0 ? k : (k < 2 ? 1 - k : 67 - k);
            const size_t idx = (((size_t)b * NCH + cidx) * 8 + hd) * 2 + dir;
            f32x4* p = (f32x4*)(ST + idx * 8192) + e4; const f32x4 st = *p; const float dec = CD[idx];
            *p = hst; hst = hst * dec + st;
        }
    }
}
DI void ssd_s3_unit(const Frame& Fin, int l, int b, int cidx, int hd) {
    const Frame F = launder(Fin);
    const int lane = F.lane, wid = F.wave, r = lane & 31, h = lane >> 5;
    const int rowbase = chunk_row(b, cidx), seqlo = cidx < 2 ? NLAT + b * CTXL : b * SEQ, seqhi = cidx < 2 ? seqlo + CTXL : seqlo + SEQ;
    __syncthreads();
    ssd_cum(F, l, b, cidx, hd);
    conv_tile(F, l, F.lds + SD_XC, SD_XCS, 64 * hd, 8, rowbase, seqlo, seqhi);
    conv_tile(F, l, F.lds + SD_BC, SD_BCS, 512 + 128 * (hd >> 2), 16, rowbase, seqlo, seqhi);
    conv_tile(F, l, F.lds + SD_CC, SD_BCS, 768 + 128 * (hd >> 2), 16, rowbase, seqlo, seqhi);
    {
        const float* ST = WSP(float, WS_ST) + (((size_t)b * NCH + cidx) * 8 + hd) * 2 * 8192;
        for (int i = F.tid; i < 2 * 64 * 16; i += NTHR) { const int dp = i >> 4, c8 = i & 15; const f32x4 a = *(const f32x4*)(ST + (size_t)dp * 128 + c8 * 8), c = *(const f32x4*)(ST + (size_t)dp * 128 + c8 * 8 + 4);
            u32x4 o; o.x = pk2(a[0], a[1]); o.y = pk2(a[2], a[3]); o.z = pk2(c[0], c[1]); o.w = pk2(c[2], c[3]); *(LAS u32x4*)(F.lds + SD_HS + dp * SD_BCS + c8 * 16) = o; }
    }
    __syncthreads();
    const LAS float* cum = (const LAS float*)(F.lds + SD_CUM); const LAS float* dtv = (const LAS float*)(F.lds + SD_DTV);
    const int lb = wid & 3, ph = wid >> 2, q4 = (lane & 15) >> 2, p4 = lane & 3, blk = (lane >> 4) & 1;
    const int lidx = 32 * lb + r;
    bf16x8 cf[8];
#pragma unroll
    for (int ks = 0; ks < 8; ++ks) cf[ks] = *(const LAS bf16x8*)(F.lds + SD_CC + lidx * SD_BCS + (16 * ks + 8 * h) * 2);
    f32x16 gt[4];
#pragma unroll
    for (int sb = 0; sb < 4; ++sb) {
#pragma unroll
        for (int i = 0; i < 16; ++i) gt[sb][i] = 0.f;
#pragma unroll
        for (int ks = 0; ks < 8; ++ks) { const bf16x8 bfr = *(const LAS bf16x8*)(F.lds + SD_BC + (32 * sb + r) * SD_BCS + (16 * ks + 8 * h) * 2); gt[sb] = MFMA32(bfr, cf[ks], gt[sb]); }
    }
    f32x16 ytot;
#pragma unroll
    for (int i = 0; i < 16; ++i) ytot[i] = 0.f;
    const LAS unsigned char* xa = F.lds + SD_XC + (4 * h + q4) * SD_XCS + (32 * ph + 16 * blk + 4 * p4) * 2;
#pragma unroll
    for (int dir = 0; dir < 2; ++dir) {
        const float cl = cum[dir * 128 + lidx];
        f32x16 acc;
#pragma unroll
        for (int i = 0; i < 16; ++i) acc[i] = 0.f;
#pragma unroll
        for (int sb = 0; sb < 4; ++sb) {
            const bool relv = dir == 0 ? (sb <= lb) : (sb >= lb);
            if (relv) {
                f32x16 mt; int rl = r; asm volatile("" : "+v"(rl));
#pragma unroll
                for (int i = 0; i < 16; ++i) { const int sl = crow(i, h), s = 32 * sb + sl;
                    const bool ok = (sb != lb) || (dir == 0 ? (sl <= rl) : (sl >= rl));
                    const float e = __expf(cl - cum[dir * 128 + s]) * dtv[dir * 128 + s];
                    mt[i] = ok ? gt[sb][i] * e : 0.f; }
                const bf16x8 pa0 = pack8<0>(mt), pa1 = pack8<1>(mt);
                const bf16x8 x0 = cat8(tr_read(xa + (32 * sb) * SD_XCS), tr_read(xa + (32 * sb + 8) * SD_XCS));
                const bf16x8 x1 = cat8(tr_read(xa + (32 * sb + 16) * SD_XCS), tr_read(xa + (32 * sb + 24) * SD_XCS));
                acc = MFMA32(x0, pa0, acc); acc = MFMA32(x1, pa1, acc);
            }
        }
        f32x16 yo;
#pragma unroll
        for (int i = 0; i < 16; ++i) yo[i] = 0.f;
#pragma unroll
        for (int ks = 0; ks < 8; ++ks) { const bf16x8 hf = *(const LAS bf16x8*)(F.lds + SD_HS + (dir * 64 + 32 * ph + r) * SD_BCS + (16 * ks + 8 * h) * 2); yo = MFMA32(hf, cf[ks], yo); }
        const float el = __expf(cl);
#pragma unroll
        for (int i = 0; i < 16; ++i) ytot[i] += acc[i] + el * yo[i];
    }
    const float dsk = F.in[I_DSKIP][l * 8 + hd];
    const int row = rowbase + lidx;
    const bf16_t* zp = WSP(bf16_t, WS_PRJ) + (size_t)row * PRJW + C_Z + 64 * hd + 32 * ph + 4 * h;
    bf16_t* op = WSP(bf16_t, WS_OC) + (size_t)row * OCW + 1536 + 64 * hd + 32 * ph + 4 * h;
    float ss = 0.f;
#pragma unroll
    for (int g4 = 0; g4 < 4; ++g4) {
        const u32x2 zz = *(const u32x2*)(zp + 8 * g4);
        const u32x2 xx = *(const LAS u32x2*)(F.lds + SD_XC + lidx * SD_XCS + (32 * ph + 8 * g4 + 4 * h) * 2);
        const float v0 = (ytot[4 * g4] + dsk * bflo(xx.x)) * silu(bflo(zz.x)), v1 = (ytot[4 * g4 + 1] + dsk * bfhi(xx.x)) * silu(bfhi(zz.x));
        const float v2 = (ytot[4 * g4 + 2] + dsk * bflo(xx.y)) * silu(bflo(zz.y)), v3 = (ytot[4 * g4 + 3] + dsk * bfhi(xx.y)) * silu(bfhi(zz.y));
        ss += (v0 * v0 + v1 * v1) + (v2 * v2 + v3 * v3);
        u32x2 w; w.x = pk2(v0, v1); w.y = pk2(v2, v3); *(u32x2*)(op + 8 * g4) = w;
    }
    ss += __shfl_xor(ss, 32);
    LAS float* sq = (LAS float*)(F.lds + SD_SSQ);
    if (h == 0) sq[ph * 128 + lidx] = ss;
    __syncthreads();
    if (F.tid < 128) WSP(float, WS_SSQ)[(size_t)(rowbase + F.tid) * 8 + hd] = sq[F.tid] + sq[128 + F.tid];
}

constexpr int PH_PER_LAYER = 11, N_PHASES = 2 + PH_PER_LAYER * DEPTH;
__global__ void __launch_bounds__(NTHR, 2) fwd_kernel(Args args) {
    extern __shared__ __attribute__((aligned(16))) unsigned char smem[];
    Frame F0;
    F0.lds = (LAS unsigned char*)smem;
    F0.tid = threadIdx.x; F0.lane = F0.tid & 63; F0.wave = __builtin_amdgcn_readfirstlane(F0.tid >> 6);
    F0.G = gridDim.x; { const int bx = blockIdx.x; F0.vcu = (F0.G % 8 == 0) ? (bx % 8) * (F0.G / 8) + bx / 8 : bx; }
    F0.in = args.in; F0.out = args.out; F0.ws = args.ws; F0.ctl = (gu32*)(args.ws + WS_CTL);
    volatile LAS unsigned* MISC = (volatile LAS unsigned*)(F0.lds + MISC_OFF);
    for (int u = F0.tid; u < (LDS_BYTES - RING_BYTES) / 4; u += NTHR) ((LAS unsigned*)(F0.lds + RING_BYTES))[u] = 0u;
    __syncthreads();
    XcdBarrier bar; bar.bar = (unsigned*)(F0.ctl + CW_BAR); bar.x = 0; bar.st = nullptr;
    if (!MK_PER_PHASE) bar = xcd_barrier_post((unsigned*)(F0.ctl + CW_BAR), MISC + 8);
    const int lo = args.ph_lo, hi = args.ph_hi;
#define IN(k) (lo <= (k) && (k) < hi)
#define SEAM(k) do { if (IN(k) && IN((k) + 1)) { if (MK_PER_PHASE) { if (F0.tid == 0) __hip_atomic_store(F0.ctl + 0, 0xBADBA0u, __ATOMIC_RELAXED, __HIP_MEMORY_SCOPE_AGENT); } else xcd_barrier(bar); } } while (0)

    if (PHM(11) && IN(0)) { const Frame F = launder(F0); phase_prologue_a(F); } SEAM(0);
    if (PHM(12) && IN(1)) { const Frame F = launder(F0); phase_prologue_b(F); } SEAM(1);

    for (int l = 0; l < DEPTH; ++l) {
        const int pb = 2 + PH_PER_LAYER * l;
        const bool with_ctx = l < DEPTH - 1, moe = l & 1; const int fi = l >> 1;
        const int mrows = with_ctx ? MTOT : NLAT, mtiles = with_ctx ? 132 : 128;
        if (PHM(0) && IN(pb + 0)) { const Frame F = launder(F0);
            pg8::SchedGrid S; S.nMa = mtiles; S.nNa = 34; S.nMb = with_ctx ? 0 : 4; S.nNb = 18; S.total = S.nMa * S.nNa + S.nMb * S.nNb; S.G = F.G; S.c = F.vcu;
            S.A = (const char*)(F.ws + WS_HB); S.B = (const char*)(F.ws + WS_WCOMB + l * SZ_WCOMB); S.lda = DM; S.ldb = DM; S.a_div = 1; S.a_cols = 0; S.pe = nullptr; S.estride = 0;
            pg8::EpiInGate E{WSP(bf16_t, WS_PRJ), WSP(bf16_t, WS_GT), F.in[I_BGATE] + (size_t)l * 4096};
            pg8::gemm_phase(F.lds, F.tid, DM, DM, DM, S, E);
        }
        SEAM(pb + 0);
        if (PHM(1) && IN(pb + 1)) { const Frame F = launder(F0);
            phase_qkprep_rows(F, l);
            for (int u = F.vcu; u < NB * NCH * 8; u += F.G) { const int hd = u & 7, cidx = (u >> 3) % NCH, b = (u >> 3) / NCH; ssd_s1_unit(F, l, b, cidx, hd); }
        }
        SEAM(pb + 1);
        if (PHM(2) && IN(pb + 2)) { const Frame F = launder(F0); phase_scan(F); }
        SEAM(pb + 2);
        if (PHM(3) && IN(pb + 3)) { const Frame F = launder(F0);
            const int nchs = with_ctx ? NCH : NCH - 2, n_s3 = NB * nchs * 8, n_cx = with_ctx ? 96 : 0, total = 3072 + n_s3 + n_cx;
            for (int rep = 0; rep < 1 + ((REP_MASK >> 3) & 1); ++rep) {
            for (int u = F.vcu; u < 1024; u += F.G) {
                const int qblk = u & 31, hg = (u >> 5) & 3, kvh = (u >> 7) & 1, b = u >> 8, hq = kvh * 4 + hg;
                const ga_body::bf16* P = (const ga_body::bf16*)(F.ws + WS_PRJ); const size_t lat0 = (size_t)(b * SEQ) * PRJW, ctx0 = (size_t)(NLAT + b * CTXL) * PRJW;
                ga_body::attn_unit<8>(qblk, P + lat0 + C_GAQ + hq * 64, P + lat0 + C_GAK + kvh * 64, P + lat0 + C_GAV + kvh * 64, P + ctx0 + C_GAK + kvh * 64, P + ctx0 + C_GAV + kvh * 64,
                                      (ga_body::bf16*)(F.ws + WS_OC) + (size_t)(b * SEQ) * OCW + 1024 + hq * 64, (char*)F.lds, F.tid);
            }
            const Frame Fb = launder(F0);
            for (int u = 1024 + Fb.vcu; u < total; u += Fb.G) { const Frame& F = Fb;
                if (u < 2048) { const int v = u - 1024, qblk = v & 31, hq = (v >> 5) & 7, b = v >> 8; attn_unit(F, l, 0, false, b, hq, qblk); }
                else if (u < 3072) { const int v = u - 2048, qblk = v & 31, hg = (v >> 5) & 3, kvh = (v >> 7) & 1, b = v >> 8; attn_unit(F, l, 1, false, b, kvh * 4 + hg, qblk); }
                else if (u < 3072 + n_s3) { const int v = u - 3072, hd = v & 7, cc = (v >> 3) % nchs, b = (v >> 3) / nchs; ssd_s3_unit(F, l, b, with_ctx ? cc : cc + 2, hd); }
                else { const int v = u - 3072 - n_s3, mode = v >> 5, b = (v >> 3) & 3, hq = v & 7; attn_unit(F, l, mode, true, b, hq, 0); }
            }
            }
        }
        SEAM(pb + 3);
        if (PHM(4) && IN(pb + 4)) { const Frame F = launder(F0);
            pg8::SchedBranch S; S.T = mtiles * 4; S.G = F.G; S.c = F.vcu; S.A = (const char*)(F.ws + WS_OC); S.B = (const char*)(F.ws + WS_WB + l * SZ_WB);
            pg8::EpiBranch E{WSP(bf16_t, WS_GT), WSP(float, WS_SSQ), WSP(float, WS_ST), WSP(bf16_t, WS_PRJ)};
            pg8::gemm_phase(F.lds, F.tid, 512, OCW, 512, S, E);
        }
        SEAM(pb + 4);
        if (PHM(5) && IN(pb + 5)) { const Frame F = launder(F0);
            pg8::SchedGrid S; S.nMa = mtiles; S.nNa = 4; S.nMb = 0; S.nNb = 1; S.total = S.nMa * S.nNa; S.G = F.G; S.c = F.vcu;
            S.A = (const char*)(F.ws + WS_PRJ); S.B = (const char*)(F.ws + WS_WO + l * SZ_WO); S.lda = DM; S.ldb = DM; S.a_div = 1; S.a_cols = 0; S.pe = nullptr; S.estride = 0;
            pg8::EpiResid E{WSP(float, WS_XS), WSP(float, WS_MVEC) + (size_t)l * 5 * 6144 + 2048, nullptr};
            pg8::gemm_phase(F.lds, F.tid, DM, DM, DM, S, E);
        }
        SEAM(pb + 5);
        if (PHM(6) && IN(pb + 6)) { const Frame F = launder(F0); phase_ln1(F, l, mrows); }
        SEAM(pb + 6);
        if (moe) { if (PHM(7) && IN(pb + 7)) { const Frame F = launder(F0); phase_gather(F, l, mrows); } SEAM(pb + 7); }
        if (PHM(8) && IN(pb + 8)) { const Frame F = launder(F0);
            pg8::SchedGrid S; S.nMb = 0; S.nNb = 1; S.G = F.G; S.c = F.vcu; S.lda = DM; S.ldb = DM; S.a_div = 1; S.a_cols = 0; S.pe = nullptr; S.estride = 0; int ldh;
            if (!moe) { S.nMa = mtiles; S.nNa = DFF / 128; S.A = (const char*)(F.ws + WS_HB); S.B = (const char*)(F.ws + WS_WUP + fi * SZ_WUP); ldh = DFF; }
            else { const int npad = moe_pad_ends_lds(F, fi); S.pe = (const LAS int*)(F.lds + MISC_OFF + 64); S.nMa = npad / 256; S.nNa = DFFE / 128;
                   S.A = (const char*)(F.ws + WS_XPAD); S.B = (const char*)(F.ws + WS_MUP + fi * SZ_MUP); S.estride = (size_t)2 * DFFE * DM * 2; ldh = DFFE; }
            S.total = S.nMa * S.nNa;
            pg8::EpiSwiGLU E{WSP(bf16_t, WS_HID), ldh};
            pg8::gemm_phase(F.lds, F.tid, DM, DM, DM, S, E);
        }
        SEAM(pb + 8);
        if (PHM(9) && IN(pb + 9)) { const Frame F = launder(F0);
            pg8::SchedGrid S; S.nMb = 0; S.nNb = 1; S.nNa = 4; S.G = F.G; S.c = F.vcu; S.a_div = 1; S.a_cols = 0; S.pe = nullptr; S.estride = 0; S.A = (const char*)(F.ws + WS_HID);
            pg8::EpiResid E{WSP(float, WS_XS), WSP(float, WS_MVEC) + (size_t)l * 5 * 6144 + 5120, nullptr};
            int kk;
            if (!moe) { S.nMa = mtiles; S.B = (const char*)(F.ws + WS_WDN + fi * SZ_WDN); kk = DFF; }
            else { const int npad = moe_pad_ends_lds(F, fi); S.pe = (const LAS int*)(F.lds + MISC_OFF + 64); S.nMa = npad / 256; S.B = (const char*)(F.ws + WS_MDN + fi * SZ_MDN); S.estride = (size_t)DM * DFFE * 2; kk = DFFE; E.plainO = WSP(bf16_t, WS_YPAD); }
            S.lda = kk; S.ldb = kk; S.total = S.nMa * S.nNa;
            pg8::gemm_phase(F.lds, F.tid, kk, kk, kk, S, E);
        }
        SEAM(pb + 9);
        if (PHM(10) && IN(pb + 10)) { const Frame F = launder(F0); phase_ln2(F, l, mrows); }
        if (l + 1 < DEPTH) SEAM(pb + 10);
    }
#undef IN
#undef SEAM
}

extern "C" void kernel_launch(void* const* d_in, const int* in_sizes, int n_in, void* d_out, int out_size, void* d_ws, size_t ws_size, hipStream_t stream) {
    static int grid = 0;
    if (grid == 0) {
        if (n_in != 31 || in_sizes[0] != NLAT * DM || out_size != NLAT * DM || ws_size < WS_END) {
            fprintf(stderr, "kernel_launch: unexpected shapes: n_in %d in0 %d out %d ws %zu (need %zu); nothing launched\n", n_in, n_in > 0 ? in_sizes[0] : -1, out_size, ws_size, (size_t)WS_END); grid = -1; return; }
        int dev = 0, cus = 0, per_cu = 0;
        if (hipGetDevice(&dev) != hipSuccess || hipDeviceGetAttribute(&cus, hipDeviceAttributeMultiprocessorCount, dev) != hipSuccess) { fprintf(stderr, "kernel_launch: device query failed\n"); grid = -1; return; }
        if (hipFuncSetAttribute((const void*)fwd_kernel, hipFuncAttributeMaxDynamicSharedMemorySize, LDS_BYTES) != hipSuccess) { fprintf(stderr, "kernel_launch: hipFuncSetAttribute failed\n"); grid = -1; return; }
        if (hipOccupancyMaxActiveBlocksPerMultiprocessor(&per_cu, (const void*)fwd_kernel, NTHR, LDS_BYTES) != hipSuccess || per_cu < 1)
            fprintf(stderr, "kernel_launch: note: occupancy query reports %d workgroups per CU\n", per_cu);
        (void)hipGetLastError();
        grid = cus;
    }
    if (grid < 0) return;
    if (hipMemsetAsync((char*)d_ws + WS_CTL, 0, CTL_ZERO_BYTES, stream) != hipSuccess) { fprintf(stderr, "kernel_launch: memset failed\n"); return; }
    Args a{};
    for (int i = 0; i < 31; ++i) a.in[i] = (const float*)d_in[i];
    a.out = (float*)d_out; a.ws = (unsigned char*)d_ws;
#if MK_PER_PHASE
    for (int p = 0; p < N_PHASES; ++p) { a.ph_lo = p; a.ph_hi = p + 1; hipLaunchKernelGGL(fwd_kernel, dim3(grid), dim3(NTHR), LDS_BYTES, stream, a); }
#else
    a.ph_lo = 0; a.ph_hi = N_PHASES;
    hipLaunchKernelGGL(fwd_kernel, dim3(grid), dim3(NTHR), LDS_BYTES, stream, a);
#endif
    const hipError_t le = hipPeekAtLastError();
    if (le != hipSuccess) fprintf(stderr, "kernel_launch: launch failed: %s\n", hipGetErrorName(le));
}
```

```cpp
#include <hip/hip_runtime.h>
#include <cstdio>
#include <cstdint>
#include <hip/hip_bf16.h>
#include <cmath>

#define DI __device__ __forceinline__
#define LAS __attribute__((address_space(3)))
#define GAS __attribute__((address_space(1)))
typedef unsigned short bf16_t;
typedef short bf16x8 __attribute__((ext_vector_type(8)));
typedef short s16x4 __attribute__((ext_vector_type(4)));
typedef float f32x2 __attribute__((ext_vector_type(2)));
typedef float f32x4 __attribute__((ext_vector_type(4)));
typedef float f32x16 __attribute__((ext_vector_type(16)));
typedef unsigned u32x2 __attribute__((ext_vector_type(2)));
typedef unsigned u32x4 __attribute__((ext_vector_type(4)));
typedef __bf16 bf16x2_t __attribute__((ext_vector_type(2)));
typedef GAS unsigned gu32;

#ifndef MK_PER_PHASE
#define MK_PER_PHASE 0
#endif
#ifndef PHMASK
#define PHMASK 0xFFFF
#endif
#define PHM(k) ((PHMASK >> (k)) & 1)
#ifndef REP_MASK
#define REP_MASK 0
#endif
#define REPB(k) ((REP_MASK >> (k)) & 1)
#ifndef ABL
#define ABL 0
#endif

constexpr int DM = 1024, NB = 4, SEQ = 8192, CTXL = 256, NLAT = NB * SEQ, NCTX = NB * CTXL, MTOT = NLAT + NCTX;
constexpr int DEPTH = 4, DIN = 4624, PRJW = 4608, GTW = 4096, NCOMB = PRJW + GTW, OCW = 2048;
constexpr int DFF = 2816, DFFE = 3584, NEXP = 8, MOE_ROWS_MAX = 69632;
constexpr int NCH = 66;
constexpr float ALPHA = 1.6817928305074292f;
constexpr float LOG2E = 1.4426950408889634f;
constexpr float C2 = 0.125f * LOG2E;
constexpr float LN_EPS = 1e-5f, RMS_EPS = 1e-6f;
constexpr int C_NAQ = 0, C_NAK = 512, C_NAV = 1024, C_SWQ = 1536, C_SWK = 2048, C_SWV = 2176, C_GAQ = 2304, C_GAK = 2816, C_GAV = 2944, C_Z = 3072, C_XBC = 3584;

constexpr size_t KiB = 1024, MiB = 1u << 20;
constexpr size_t WS_CTL = 0, CTL_ZERO_BYTES = 1 * MiB;
constexpr size_t WS_MVEC = 1 * MiB;
constexpr size_t WS_ROPE = WS_MVEC + 512 * KiB;
constexpr size_t WS_DT = 4 * MiB;
constexpr size_t WS_SSQ = WS_DT + (size_t)MTOT * 16 * 4;
constexpr size_t WS_SLOT = WS_SSQ + (size_t)MTOT * 8 * 4;
constexpr size_t WS_CDEC = WS_SLOT + (size_t)MTOT * 8 * 4;
constexpr size_t WS_W = 10 * MiB;
constexpr size_t SZ_WCOMB = (size_t)NCOMB * DM * 2, SZ_WB = (size_t)4096 * 512 * 2, SZ_WO = (size_t)1024 * 4096 * 2;
constexpr size_t SZ_WUP = (size_t)2 * DFF * DM * 2, SZ_WDN = (size_t)DM * DFF * 2, SZ_MUP = (size_t)NEXP * 2 * DFFE * DM * 2, SZ_MDN = (size_t)NEXP * DM * DFFE * 2;
constexpr size_t WS_WCOMB = WS_W, WS_WB = WS_WCOMB + 4 * SZ_WCOMB, WS_WO = WS_WB + 4 * SZ_WB, WS_WUP = WS_WO + 4 * SZ_WO, WS_WDN = WS_WUP + 2 * SZ_WUP,
                 WS_MUP = WS_WDN + 2 * SZ_WDN, WS_MDN = WS_MUP + 2 * SZ_MUP, WS_WEND = WS_MDN + 2 * SZ_MDN;
constexpr size_t WS_XS = (WS_WEND + 255) & ~(size_t)255;
constexpr size_t WS_HB = WS_XS + (size_t)MTOT * DM * 4;
constexpr size_t WS_U = WS_HB + (size_t)MTOT * DM * 2;
constexpr size_t WS_PRJ = WS_U;
constexpr size_t WS_GT = WS_PRJ + (size_t)MTOT * PRJW * 2;
constexpr size_t WS_OC = WS_GT + (size_t)MTOT * GTW * 2;
constexpr size_t WS_ST = WS_OC + (size_t)MTOT * OCW * 2;
constexpr size_t WS_UEND = WS_ST + (size_t)NB * NCH * 16 * 8192 * 4;
constexpr size_t WS_HID = WS_U;
constexpr size_t WS_XPAD = WS_HID + (size_t)MOE_ROWS_MAX * DFFE * 2;
constexpr size_t WS_YPAD = WS_XPAD + (size_t)MOE_ROWS_MAX * DM * 2;
static_assert(WS_YPAD + (size_t)MOE_ROWS_MAX * DM * 2 <= WS_UEND, "FFN overlay fits the union region");
constexpr size_t WS_END = WS_UEND;
constexpr int CW_BAR = 4096, CW_MOECNT = 16384;

constexpr int RING_BYTES = 131072, MISC_OFF = RING_BYTES + 320, LDS_BYTES = 147456;
constexpr int NWAVES = 8, NTHR = 512;

DI unsigned pk2(float lo, float hi) { f32x2 v = {lo, hi}; bf16x2_t b = __builtin_convertvector(v, bf16x2_t); return __builtin_bit_cast(unsigned, b); }
DI float bflo(unsigned u) { return __uint_as_float(u << 16); }
DI float bfhi(unsigned u) { return __uint_as_float(u & 0xffff0000u); }
DI float sigm(float x) { return __builtin_amdgcn_rcpf(1.f + __expf(-x)); }
DI float silu(float x) { return x * sigm(x); }
DI float wave_sum(float v) {
#pragma unroll
    for (int o = 1; o < 64; o <<= 1) v += __shfl_xor(v, o);
    return v;
}
DI int clampi(int v, int lo, int hi) { return v < lo ? lo : (v > hi ? hi : v); }
#define MFMA32(a, b, c) __builtin_amdgcn_mfma_f32_32x32x16_bf16((a), (b), (c), 0, 0, 0)
DI int crow(int reg, int h) { return (reg & 3) + 8 * (reg >> 2) + 4 * h; }
typedef short v4i16_t __attribute__((ext_vector_type(4)));
DI s16x4 tr_read(const LAS unsigned char* p) { return __builtin_bit_cast(s16x4, __builtin_amdgcn_ds_read_tr16_b64_v4i16((LAS v4i16_t*)p)); }
DI bf16x8 cat8(s16x4 lo, s16x4 hi) { return __builtin_shufflevector(lo, hi, 0, 1, 2, 3, 4, 5, 6, 7); }
template <int S> DI bf16x8 pack8(const f32x16& x) {
    u32x4 w; w.x = pk2(x[8 * S], x[8 * S + 1]); w.y = pk2(x[8 * S + 2], x[8 * S + 3]); w.z = pk2(x[8 * S + 4], x[8 * S + 5]); w.w = pk2(x[8 * S + 6], x[8 * S + 7]);
    return __builtin_bit_cast(bf16x8, w);
}

#define XB_TMO      128
#define XB_XCNT(j)  (256  + 64 * (j))
#define XB_XSUB(j)  (1280 + 64 * (j))
#define XB_XGEN(j)  (2304 + 64 * (j))
#define XB_TOP      3328
#define XB_TOPGEN   3392
#define XCD_BAR_WORDS 3456
#define XB_SPIN_CAP (1u << 18)
DI unsigned xb_ld(unsigned* p)              { return __hip_atomic_load(p, __ATOMIC_RELAXED, __HIP_MEMORY_SCOPE_AGENT); }
DI unsigned xb_add(unsigned* p, unsigned v) { return __hip_atomic_fetch_add(p, v, __ATOMIC_RELAXED, __HIP_MEMORY_SCOPE_AGENT); }
DI unsigned xb_xcc_id() { return (unsigned)__builtin_amdgcn_s_getreg((3 << 11) | 20) & 0xFu; }
#define XB_SPIN(cond, bar) do { unsigned _sp = 0; while (cond) { __builtin_amdgcn_s_sleep(1); \
    if ((++_sp & 255u) == 0u) { if (xb_ld(&(bar)[XB_TMO])) break; if (_sp > XB_SPIN_CAP) { atomicAdd(&(bar)[XB_TMO], 1u); break; } } } } while (0)
struct XcdBarrier { unsigned* bar; unsigned x; volatile LAS unsigned* st; };
DI XcdBarrier xcd_barrier_post(unsigned* bar, volatile LAS unsigned* st) {
    XcdBarrier b; b.bar = bar; b.x = xb_xcc_id(); b.st = st;
    if (threadIdx.x == 0) (void)xb_add(&bar[XB_XCNT(b.x)], 1u);
    return b;
}
DI void xcd_barrier_complete(unsigned* bar, unsigned x, unsigned& nloc, unsigned& nx) {
    const unsigned G = gridDim.x * gridDim.y * gridDim.z;
    unsigned sum, cnt, mine, sp = 0u;
    for (;;) {
        sum = 0u; cnt = 0u; mine = 0u;
#pragma unroll
        for (unsigned j = 0; j < 16; ++j) { const unsigned c = xb_ld(&bar[XB_XCNT(j)]); sum += c; cnt += (c > 0u) ? 1u : 0u; mine = (j == x) ? c : mine; }
        if (sum == G) break;
        __builtin_amdgcn_s_sleep(1);
        if ((++sp & 255u) == 0u) { if (xb_ld(&bar[XB_TMO])) break; if (sp > XB_SPIN_CAP) { atomicAdd(&bar[XB_TMO], 1u); break; } }
    }
    nloc = mine > 0u ? mine : 1u; nx = cnt > 0u ? cnt : 1u;
}
DI void xcd_barrier(const XcdBarrier& b) {
    asm volatile("s_waitcnt vmcnt(0)" ::: "memory");
    __syncthreads();
    if (threadIdx.x == 0) {
        unsigned* bar = b.bar;
        __builtin_amdgcn_s_waitcnt(0);
        unsigned nloc = b.st[0], nx = b.st[1];
        if (nloc == 0u) { xcd_barrier_complete(bar, b.x, nloc, nx); b.st[0] = nloc; b.st[1] = nx; }
        const unsigned old = xb_add(&bar[XB_XSUB(b.x)], 1u);
        const unsigned gen = old / nloc;
        if (old + 1u == (gen + 1u) * nloc) {
            __builtin_amdgcn_fence(__ATOMIC_RELEASE, "agent");
            asm volatile("s_waitcnt vmcnt(0)" ::: "memory");
            const unsigned og = xb_add(&bar[XB_TOP], 1u);
            const unsigned tg = og / nx;
            if (og + 1u == (tg + 1u) * nx) xb_add(&bar[XB_TOPGEN], 1u);
            else XB_SPIN(xb_ld(&bar[XB_TOPGEN]) == tg, bar);
            __builtin_amdgcn_fence(__ATOMIC_ACQUIRE, "agent");
            xb_add(&bar[XB_XGEN(b.x)], 1u);
            asm volatile("s_waitcnt vmcnt(0)" ::: "memory");
        } else {
            XB_SPIN(xb_ld(&bar[XB_XGEN(b.x)]) == gen, bar);
            __builtin_amdgcn_fence(__ATOMIC_ACQUIRE, "agent");
            asm volatile("s_waitcnt vmcnt(0)" ::: "memory");
        }
    }
    __syncthreads();
}

namespace pg8 {
constexpr int BM = 256, BK = 64, HALF = 128, HTB = HALF * BK * 2, STAGE_BYTES = 8 * HTB;
__host__ __device__ __forceinline__ int lds_byte(int r, int c) { const int st = (r >> 4) * 2 + (c >> 5), rr = r & 15, cc = c & 31, ob = rr * 64 + cc * 2; return st * 1024 + (ob ^ (((ob >> 9) & 1) << 5)); }
__host__ __device__ __forceinline__ void stage_rc(int b, int& R, int& C) { const int st = b / 1024, sb = b % 1024, swz = sb ^ (((sb >> 9) & 1) << 5); R = (st >> 1) * 16 + swz / 64; C = (st & 1) * 32 + (swz % 64) / 2; }
__host__ __device__ __forceinline__ int perm32(int rho) { const int n = rho >> 4, i = rho & 15; return 8 * (i >> 2) + 4 * n + (i & 3); }
struct Unit { int pm, pn, dup; const char* A; const char* B; };

template <class Epi, class Sched>
DI void gemm_phase(LAS unsigned char* lds, const int tid, const int K, const int lda, const int ldb, const Sched& S, const Epi& E) {
    const int wid = __builtin_amdgcn_readfirstlane(tid >> 6), lane = tid & 63, wr = wid >> 2, wc = wid & 3, fr = lane & 15, fq = lane >> 4;
    const int nt = K / BK;
    unsigned voffA[2], voffB[2];
#pragma unroll
    for (int i = 0; i < 2; ++i) { int R, C; stage_rc(tid * 16 + i * 8192, R, C); const int Rb = (R & ~31) + perm32(R & 31);
        voffA[i] = (unsigned)(R * lda + C) * 2u; voffB[i] = (unsigned)(Rb * ldb + C) * 2u; }
    const size_t kstep = (size_t)(BK * 2);
    const size_t hstepA = (size_t)HALF * lda * 2, hstepB = (size_t)HALF * ldb * 2;
    const unsigned ldsw = (unsigned)wid * 1024u;
    const int aoff = lds_byte(wr * 64 + fr, fq * 8), boff = lds_byte(wc * 32 + fr, fq * 8);
#define PG8_SA(b, h) (((b) * 2 + (h)) * HTB)
#define PG8_SB(b, h) ((4 + (b) * 2 + (h)) * HTB)
#define PG8_STAGE(bufoff, gbase, voff) do { _Pragma("unroll") for (int _i = 0; _i < 2; ++_i) \
        __builtin_amdgcn_global_load_lds((const unsigned*)((const char*)(gbase) + (voff)[_i]), (LAS unsigned*)(lds + (bufoff) + ldsw + _i * 8192), 16, 0, 0); } while (0)
#define PG8_LDA(dst, b, h) do { _Pragma("unroll") for (int m = 0; m < 4; ++m) _Pragma("unroll") for (int k = 0; k < 2; ++k) dst[m][k] = *(const LAS bf16x8*)(lds + PG8_SA(b, h) + aoff + m * 2048 + k * 1024); } while (0)
#define PG8_LDB(dst, b, h) do { _Pragma("unroll") for (int n = 0; n < 2; ++n) _Pragma("unroll") for (int k = 0; k < 2; ++k) dst[n][k] = *(const LAS bf16x8*)(lds + PG8_SB(b, h) + boff + n * 2048 + k * 1024); } while (0)
#define PG8_MMA(ai, bj, At, Bt) do { __builtin_amdgcn_s_setprio(1); _Pragma("unroll") for (int m = 0; m < 4; ++m) _Pragma("unroll") for (int n = 0; n < 2; ++n) _Pragma("unroll") for (int k = 0; k < 2; ++k) \
        acc[ai][bj][m][n] = __builtin_amdgcn_mfma_f32_16x16x32_bf16(Bt[n][k], At[m][k], acc[ai][bj][m][n], 0, 0, 0); __builtin_amdgcn_s_setprio(0); } while (0)
#define PG8_WAIT_V(n) asm volatile("s_waitcnt vmcnt(" #n ")" ::: "memory")
#define PG8_WAIT_L(n) asm volatile("s_waitcnt lgkmcnt(" #n ")" ::: "memory")
#define PG8_BAR __builtin_amdgcn_s_barrier()
#define PG8_SCHED __builtin_amdgcn_sched_barrier(0)
    Unit cur, nxt; int ui = 0;
    if (!S.next(0, cur)) return;
    f32x4 acc[2][2][4][2];
#pragma unroll
    for (int a = 0; a < 2; ++a)
#pragma unroll
        for (int b = 0; b < 2; ++b)
#pragma unroll
            for (int m = 0; m < 4; ++m)
#pragma unroll
                for (int n = 0; n < 2; ++n) acc[a][b][m][n] = (f32x4){0.f, 0.f, 0.f, 0.f};
    bf16x8 At[4][2], B0[2][2], B1[2][2];
    const char* cA = cur.A; const char* cB = cur.B;
    PG8_STAGE(PG8_SB(0, 0), cB, voffB); PG8_STAGE(PG8_SB(0, 1), cB + hstepB, voffB); PG8_STAGE(PG8_SA(0, 0), cA, voffA); PG8_STAGE(PG8_SA(0, 1), cA + hstepA, voffA);
    if (wr == 1) PG8_BAR;
    PG8_WAIT_V(2); PG8_BAR;
    PG8_STAGE(PG8_SB(1, 0), cB + kstep, voffB); PG8_STAGE(PG8_SA(1, 0), cA + kstep, voffA); PG8_STAGE(PG8_SB(1, 1), cB + hstepB + kstep, voffB);
    PG8_WAIT_V(6); PG8_BAR;
    for (;;) {
        const bool has_next = S.next(ui + 1, nxt);
        const char* nA = has_next ? nxt.A : cA; const char* nB = has_next ? nxt.B : cB;
        for (int t = 0; t < nt; t += 2) {
            const bool last = (t == nt - 2);
            const char* a1 = cA + (size_t)(t + 1) * kstep;
            const char* a2 = last ? nA : cA + (size_t)(t + 2) * kstep; const char* b2 = last ? nB : cB + (size_t)(t + 2) * kstep;
            const char* a3 = a2 + kstep; const char* b3 = b2 + kstep;
            PG8_LDB(B0, 0, 0); PG8_LDB(B1, 0, 1); PG8_SCHED; PG8_LDA(At, 0, 0); PG8_STAGE(PG8_SA(1, 1), a1 + hstepA, voffA);
            PG8_WAIT_V(8); PG8_WAIT_L(0); PG8_BAR; PG8_MMA(0, 0, At, B0); PG8_MMA(0, 1, At, B1); PG8_BAR; PG8_SCHED;
            PG8_LDA(At, 0, 1); PG8_STAGE(PG8_SB(0, 0), b2, voffB); PG8_STAGE(PG8_SB(0, 1), b2 + hstepB, voffB); PG8_STAGE(PG8_SA(0, 0), a2, voffA);
            PG8_WAIT_V(8); PG8_WAIT_L(0); PG8_BAR; PG8_MMA(1, 0, At, B0); PG8_MMA(1, 1, At, B1); PG8_BAR; PG8_SCHED;
            PG8_LDB(B0, 1, 0); PG8_LDB(B1, 1, 1); PG8_SCHED; PG8_LDA(At, 1, 0); PG8_STAGE(PG8_SA(0, 1), a2 + hstepA, voffA);
            PG8_WAIT_V(8); PG8_WAIT_L(0); PG8_BAR; PG8_MMA(0, 0, At, B0); PG8_MMA(0, 1, At, B1); PG8_BAR; PG8_SCHED;
            PG8_LDA(At, 1, 1); PG8_STAGE(PG8_SB(1, 0), b3, voffB); PG8_STAGE(PG8_SB(1, 1), b3 + hstepB, voffB); PG8_STAGE(PG8_SA(1, 0), a3, voffA);
            PG8_WAIT_V(8); PG8_WAIT_L(0); PG8_BAR; PG8_MMA(1, 0, At, B0); PG8_MMA(1, 1, At, B1); PG8_BAR; PG8_SCHED;
        }
        if (wr == 0) PG8_BAR;
        E(acc, cur, wr, wc, fr, fq);
        if (!has_next) break;
#pragma unroll
        for (int a = 0; a < 2; ++a)
#pragma unroll
            for (int b = 0; b < 2; ++b)
#pragma unroll
                for (int m = 0; m < 4; ++m)
#pragma unroll
                    for (int n = 0; n < 2; ++n) acc[a][b][m][n] = (f32x4){0.f, 0.f, 0.f, 0.f};
        cur = nxt; cA = nA; cB = nB; ++ui;
        if (wr == 1) PG8_BAR;
    }
    PG8_WAIT_V(0);
    PG8_BAR;
#undef PG8_SA
#undef PG8_SB
#undef PG8_STAGE
#undef PG8_LDA
#undef PG8_LDB
#undef PG8_MMA
#undef PG8_WAIT_V
#undef PG8_WAIT_L
#undef PG8_BAR
#undef PG8_SCHED
}

struct SchedGrid {
    int nMa, nNa, nMb, nNb, total, G, c; const char* A; const char* B; int lda, ldb, a_div, a_cols; const LAS int* pe; size_t estride; int rep;
    DI bool next(int i, Unit& u) const {
        const long L = (long)(i >> rep) * G + c; if (L >= total) return false;
        u.dup = i & rep;
        const int La = nMa * nNa; int pm, pn;
        if (L < La) { pm = (int)L / nNa; pn = (int)L % nNa; } else { const int r = (int)L - La; pm = nMa + r / nNb; pn = r % nNb; }
        size_t eoff = 0;
        if (pe) { int e = 0;
#pragma unroll
            for (int j = 0; j < 7; ++j) e += (pe[j] <= pm * 256) ? 1 : 0;
            eoff = (size_t)__builtin_amdgcn_readfirstlane(e) * estride; }
        u.pm = pm; u.pn = pn; u.A = A + ((size_t)pm * 256 * lda + (size_t)(pn / a_div) * a_cols) * 2; u.B = B + eoff + (size_t)pn * 256 * ldb * 2; return true;
    }
};

struct SchedBranch {
    int T, G, c; const char* A; const char* B; int rep;
    DI bool next(int n, Unit& u) const {
        const int tile = c + (n >> (2 + rep)) * G; if (tile >= T) return false;
        u.dup = 0;
        const int i = n & 3, pm = tile >> 2, pc = tile & 3;
        u.pm = pm; u.pn = i * 4 + pc; u.A = A + ((size_t)pm * 256 * OCW + (size_t)i * 512) * 2; u.B = B + (size_t)(i * 1024 + pc * 256) * 512 * 2; return true;
    }
};
struct EpiInGate {
    bf16_t* PRJ; bf16_t* GT; const float* bg;
    DI void operator()(const f32x4 (&acc)[2][2][4][2], const Unit& u, int wr, int wc, int fr, int fq) const {
        const int row0 = u.pm * BM + wr * 64 + fr; const bool sg = u.pn >= 18;
        bf16_t* base = sg ? GT : PRJ; const int ldc = sg ? GTW : PRJW; const int col0 = (sg ? (u.pn - 18) : u.pn) * BM + wc * 32 + 8 * fq;
        f32x4 bv[2][2];
#pragma unroll
        for (int bj = 0; bj < 2; ++bj)
#pragma unroll
            for (int n = 0; n < 2; ++n) bv[bj][n] = sg ? *(const f32x4*)(bg + col0 + bj * HALF + 4 * n) : (f32x4){0.f, 0.f, 0.f, 0.f};
#pragma unroll
        for (int ai = 0; ai < 2; ++ai)
#pragma unroll
            for (int m = 0; m < 4; ++m) { bf16_t* rowp = base + (size_t)(row0 + ai * HALF + m * 16) * ldc + col0;
#pragma unroll
                for (int bj = 0; bj < 2; ++bj) { f32x4 v0 = acc[ai][bj][m][0] + bv[bj][0], v1 = acc[ai][bj][m][1] + bv[bj][1];
                    if (sg) { v0 = (f32x4){sigm(v0[0]), sigm(v0[1]), sigm(v0[2]), sigm(v0[3])}; v1 = (f32x4){sigm(v1[0]), sigm(v1[1]), sigm(v1[2]), sigm(v1[3])}; }
                    u32x4 w; w.x = pk2(v0[0], v0[1]); w.y = pk2(v0[2], v0[3]); w.z = pk2(v1[0], v1[1]); w.w = pk2(v1[2], v1[3]);
                    *(u32x4*)(rowp + bj * HALF) = w; } }
    }
};
struct EpiBranch {
    const bf16_t* GT; const float* SSQ; float* MF; bf16_t* MRG;
    DI void operator()(const f32x4 (&acc)[2][2][4][2], const Unit& u, int wr, int wc, int fr, int fq) const {
        const int i = u.pn >> 2, pc = u.pn & 3;
        const int row0 = u.pm * BM + wr * 64 + fr; const int gcol0 = u.pn * BM + wc * 32 + 8 * fq, col0 = pc * BM + wc * 32 + 8 * fq;
#pragma unroll
        for (int ai = 0; ai < 2; ++ai)
#pragma unroll
            for (int mp = 0; mp < 4; ++mp) {
                u32x4 g[1][2]; f32x4 q[1][2][2]; float rs[1];
#pragma unroll
                for (int mm = 0; mm < 1; ++mm) { const int row = row0 + ai * HALF + (mp + mm) * 16; const bf16_t* gp = GT + (size_t)row * GTW + gcol0; const float* mpt = MF + (size_t)row * DM + col0;
                    rs[mm] = 1.f;
                    if (i == 3) { const f32x4 s0 = *(const f32x4*)(SSQ + (size_t)row * 8), s1 = *(const f32x4*)(SSQ + (size_t)row * 8 + 4);
                        rs[mm] = __builtin_amdgcn_rsqf(((s0[0] + s0[1]) + (s0[2] + s0[3]) + (s1[0] + s1[1]) + (s1[2] + s1[3])) * (1.f / 512.f) + RMS_EPS); }
#pragma unroll
                    for (int bj = 0; bj < 2; ++bj) { g[mm][bj] = *(const u32x4*)(gp + bj * HALF);
                        if (i != 0) { q[mm][bj][0] = *(const f32x4*)(mpt + bj * HALF); q[mm][bj][1] = *(const f32x4*)(mpt + bj * HALF + 4); }
                        else { q[mm][bj][0] = (f32x4){0.f, 0.f, 0.f, 0.f}; q[mm][bj][1] = (f32x4){0.f, 0.f, 0.f, 0.f}; } } }
#pragma unroll
                for (int mm = 0; mm < 1; ++mm) { const int m = mp + mm; const int row = row0 + ai * HALF + m * 16; float* mpt = MF + (size_t)row * DM + col0;
#pragma unroll
                    for (int bj = 0; bj < 2; ++bj) { const u32x4 gg = g[mm][bj]; const f32x4 a0 = acc[ai][bj][m][0] * rs[mm], a1 = acc[ai][bj][m][1] * rs[mm];
                        const f32x4 t0 = q[mm][bj][0] + (f32x4){bflo(gg.x) * a0[0], bfhi(gg.x) * a0[1], bflo(gg.y) * a0[2], bfhi(gg.y) * a0[3]};
                        const f32x4 t1 = q[mm][bj][1] + (f32x4){bflo(gg.z) * a1[0], bfhi(gg.z) * a1[1], bflo(gg.w) * a1[2], bfhi(gg.w) * a1[3]};
                        if (i != 3) { *(f32x4*)(mpt + bj * HALF) = t0; *(f32x4*)(mpt + bj * HALF + 4) = t1; }
                        else { u32x4 w; w.x = pk2(t0[0], t0[1]); w.y = pk2(t0[2], t0[3]); w.z = pk2(t1[0], t1[1]); w.w = pk2(t1[2], t1[3]); *(u32x4*)(MRG + (size_t)row * DM + col0 + bj * HALF) = w; } } }
            }
    }
};
struct EpiResid {
    float* XS; const float* mv; bf16_t* plainO; bf16_t* dummy;
    DI void operator()(const f32x4 (&acc)[2][2][4][2], const Unit& u, int wr, int wc, int fr, int fq) const {
        const int row0 = u.pm * BM + wr * 64 + fr; const int col0 = u.pn * BM + wc * 32 + 8 * fq;
        if (plainO || u.dup) { bf16_t* const po = plainO ? plainO : dummy;
#pragma unroll
            for (int ai = 0; ai < 2; ++ai)
#pragma unroll
                for (int m = 0; m < 4; ++m) { bf16_t* rowp = po + (size_t)(row0 + ai * HALF + m * 16) * DM + col0;
#pragma unroll
                    for (int bj = 0; bj < 2; ++bj) { const f32x4 v0 = acc[ai][bj][m][0], v1 = acc[ai][bj][m][1];
                        u32x4 w; w.x = pk2(v0[0], v0[1]); w.y = pk2(v0[2], v0[3]); w.z = pk2(v1[0], v1[1]); w.w = pk2(v1[2], v1[3]);
                        *(u32x4*)(rowp + bj * HALF) = w; } }
            return;
        }
        const int v = u.pm < 128 ? (u.pm >> 5) : 4;
        const float* g = mv + (size_t)v * 6144 + col0;
        f32x4 gv[2][2];
#pragma unroll
        for (int bj = 0; bj < 2; ++bj)
#pragma unroll
            for (int n = 0; n < 2; ++n) gv[bj][n] = *(const f32x4*)(g + bj * HALF + 4 * n);
#pragma unroll
        for (int ai = 0; ai < 2; ++ai)
#pragma unroll
            for (int mp = 0; mp < 2; ++mp) {
                f32x4 x[2][2][2];
#pragma unroll
                for (int mm = 0; mm < 2; ++mm) { const float* rowp = XS + (size_t)(row0 + ai * HALF + (2 * mp + mm) * 16) * DM + col0;
#pragma unroll
                    for (int bj = 0; bj < 2; ++bj)
#pragma unroll
                        for (int n = 0; n < 2; ++n) x[mm][bj][n] = *(const f32x4*)(rowp + bj * HALF + 4 * n); }
#pragma unroll
                for (int mm = 0; mm < 2; ++mm) { const int m = 2 * mp + mm; float* rowp = XS + (size_t)(row0 + ai * HALF + m * 16) * DM + col0;
#pragma unroll
                    for (int bj = 0; bj < 2; ++bj)
#pragma unroll
                        for (int n = 0; n < 2; ++n) *(f32x4*)(rowp + bj * HALF + 4 * n) = x[mm][bj][n] * ALPHA + gv[bj][n] * acc[ai][bj][m][n]; }
            }
    }
};
struct EpiSwiGLU {
    bf16_t* HID; int ldc;
    DI void operator()(const f32x4 (&acc)[2][2][4][2], const Unit& u, int wr, int wc, int fr, int fq) const {
        const int row0 = u.pm * BM + wr * 64 + fr; const int col0 = u.pn * HALF + wc * 32 + 8 * fq;
#pragma unroll
        for (int ai = 0; ai < 2; ++ai)
#pragma unroll
            for (int m = 0; m < 4; ++m) { bf16_t* rowp = HID + (size_t)(row0 + ai * HALF + m * 16) * ldc + col0;
                const f32x4 g0 = acc[ai][0][m][0], g1 = acc[ai][0][m][1], u0 = acc[ai][1][m][0], u1 = acc[ai][1][m][1];
                u32x4 w; w.x = pk2(silu(g0[0]) * u0[0], silu(g0[1]) * u0[1]); w.y = pk2(silu(g0[2]) * u0[2], silu(g0[3]) * u0[3]);
                w.z = pk2(silu(g1[0]) * u1[0], silu(g1[1]) * u1[1]); w.w = pk2(silu(g1[2]) * u1[2], silu(g1[3]) * u1[3]);
                *(u32x4*)rowp = w; }
    }
};
}

struct Args { const float* in[31]; float* out; unsigned char* ws; int ph_lo, ph_hi; };
enum { I_X = 0, I_C, I_CTX, I_CCTX, I_WMOD, I_BMOD, I_WIN, I_WGATE, I_BGATE, I_RPB, I_SINK, I_QGQ, I_QGK, I_CONVW, I_CONVB, I_DTB, I_ALOG, I_DSKIP, I_NORMG,
       I_WBR, I_WOUT, I_LN1G, I_LN1B, I_LN2G, I_LN2B, I_FUP, I_FDN, I_MRW, I_MRB, I_MUP, I_MDN };
struct Frame {
    LAS unsigned char* lds; gu32* ctl; int tid, lane, wave, vcu, G;
    const float* const* in; float* out; unsigned char* ws;
};
#define WSP(T, off) ((T*)(F.ws + (off)))
DI Frame launder(const Frame& F0) {
    Frame F = F0;
    asm volatile("" : "+v"(F.tid), "+v"(F.lane));
    asm volatile("" : "+s"(F.wave), "+s"(F.vcu), "+s"(F.ws), "+s"(F.lds));
    F.ws = (unsigned char*)(GAS unsigned char*)F.ws;
    return F;
}

DI void transpose_item(const float* W, int ld, bf16_t* dst, int ldk, int koff, int map_h, int rowoff, int cscale, const float* kscale, LAS float* scr, int kb, int nb, int lane) {
    const int k0 = 64 * kb, n0 = 32 * nb;
    float tmp[32];
#pragma unroll
    for (int i = 0; i < 32; ++i) tmp[i] = W[(size_t)(k0 + 2 * i + (lane >> 5)) * ld + n0 + (lane & 31)];
#pragma unroll
    for (int i = 0; i < 32; ++i) scr[(2 * i + (lane >> 5)) * 33 + (lane & 31)] = tmp[i];
    asm volatile("s_waitcnt lgkmcnt(0)" ::: "memory");
    const int c = lane & 7;
    float ks[8];
#pragma unroll
    for (int e = 0; e < 8; ++e) ks[e] = kscale ? kscale[k0 + 8 * c + e] : 1.f;
#pragma unroll
    for (int j = 0; j < 4; ++j) { const int nl = (lane >> 3) + 8 * j, n = n0 + nl; const LAS float* s = scr + (8 * c) * 33 + nl;
        float cs = 1.f; if (cscale && (n < 512 || (n >= 1536 && n < 2048))) cs = C2;
        int drow;
        if (map_h == 0) drow = rowoff + n;
        else if (n < map_h) drow = rowoff + 256 * (n >> 7) + (n & 127);
        else { const int n2 = n - map_h; drow = rowoff + 256 * (n2 >> 7) + 128 + (n2 & 127); }
        u32x4 o; o.x = pk2(s[0 * 33] * ks[0] * cs, s[1 * 33] * ks[1] * cs); o.y = pk2(s[2 * 33] * ks[2] * cs, s[3 * 33] * ks[3] * cs);
        o.z = pk2(s[4 * 33] * ks[4] * cs, s[5 * 33] * ks[5] * cs); o.w = pk2(s[6 * 33] * ks[6] * cs, s[7 * 33] * ks[7] * cs);
        *(u32x4*)(dst + (size_t)drow * ldk + koff + k0 + 8 * c) = o; }
    asm volatile("s_waitcnt lgkmcnt(0)" ::: "memory");
}
struct CvtJob { const float* W; int K, N, ld; bf16_t* dst; int ldk, koff, map_h, rowoff, cscale; const float* kscale; };
DI void get_job(const Frame& F, int j, CvtJob& J) {
    J.koff = 0; J.map_h = 0; J.rowoff = 0; J.cscale = 0; J.kscale = nullptr;
    if (j < 52) {
        const int l = j / 13, r = j % 13;
        if (r == 0) { J.W = F.in[I_WIN] + (size_t)l * DM * DIN; J.K = DM; J.N = PRJW; J.ld = DIN; J.dst = WSP(bf16_t, WS_WCOMB + l * SZ_WCOMB); J.ldk = DM; J.cscale = 1; }
        else if (r < 5) { const int i = r - 1; J.W = F.in[I_WGATE] + ((size_t)l * 4 + i) * DM * DM; J.K = DM; J.N = DM; J.ld = DM; J.dst = WSP(bf16_t, WS_WCOMB + l * SZ_WCOMB); J.ldk = DM; J.rowoff = PRJW + 1024 * i; }
        else if (r < 9) { const int i = r - 5; J.W = F.in[I_WBR] + ((size_t)l * 4 + i) * 512 * DM; J.K = 512; J.N = DM; J.ld = DM; J.dst = WSP(bf16_t, WS_WB + l * SZ_WB); J.ldk = 512; J.rowoff = 1024 * i;
            if (i == 3) J.kscale = F.in[I_NORMG] + l * 512; }
        else { J.W = F.in[I_WOUT] + (size_t)l * DM * DM; J.K = (r == 9) ? DM : 0; J.N = DM; J.ld = DM; J.dst = WSP(bf16_t, WS_WO + l * SZ_WO); J.ldk = DM; }
    } else if (j < 56) {
        const int i = (j - 52) >> 1;
        if (((j - 52) & 1) == 0) { J.W = F.in[I_FUP] + (size_t)i * DM * 2 * DFF; J.K = DM; J.N = 2 * DFF; J.ld = 2 * DFF; J.dst = WSP(bf16_t, WS_WUP + i * SZ_WUP); J.ldk = DM; J.map_h = DFF; }
        else { J.W = F.in[I_FDN] + (size_t)i * DFF * DM; J.K = DFF; J.N = DM; J.ld = DM; J.dst = WSP(bf16_t, WS_WDN + i * SZ_WDN); J.ldk = DFF; }
    } else {
        const int q = j - 56, ie = q >> 1, i = ie >> 3, e = ie & 7;
        if ((q & 1) == 0) { J.W = F.in[I_MUP] + ((size_t)i * NEXP + e) * DM * 2 * DFFE; J.K = DM; J.N = 2 * DFFE; J.ld = 2 * DFFE; J.dst = WSP(bf16_t, WS_MUP + i * SZ_MUP); J.ldk = DM; J.map_h = DFFE; J.rowoff = e * 2 * DFFE; }
        else { J.W = F.in[I_MDN] + ((size_t)i * NEXP + e) * DFFE * DM; J.K = DFFE; J.N = DM; J.ld = DM; J.dst = WSP(bf16_t, WS_MDN + i * SZ_MDN); J.ldk = DFFE; J.rowoff = e * DM; }
    }
}
constexpr int NJOBS = 52 + 4 + 32;

DI void phase_prologue_a(const Frame& F) {
    const int NGW = F.G * NWAVES, gw = F.vcu * NWAVES + F.wave;
    {
        LAS float* sv = (LAS float*)(F.lds + 73728);
        LAS float* red = (LAS float*)(F.lds + 73728 + 20480);
        for (int i = F.tid; i < 5 * 1024; i += NTHR) { const int v = i >> 10, k = i & 1023; const float c = v < 4 ? F.in[I_C][v * DM + k] : F.in[I_CCTX][k]; sv[i] = silu(c); }
        __syncthreads();
        float* MV = WSP(float, WS_MVEC);
        for (int item = F.vcu; item < 4 * 96; item += F.G) {
            const int l = item / 96, n0 = (item % 96) * 64, c = F.tid & 63, ks = F.tid >> 6;
            const float* w = F.in[I_WMOD] + (size_t)l * DM * 6144 + n0 + c;
            float a0 = 0.f, a1 = 0.f, a2 = 0.f, a3 = 0.f, a4 = 0.f;
#pragma unroll 8
            for (int k = ks * 128; k < ks * 128 + 128; ++k) { const float wv = w[(size_t)k * 6144]; a0 += sv[k] * wv; a1 += sv[1024 + k] * wv; a2 += sv[2048 + k] * wv; a3 += sv[3072 + k] * wv; a4 += sv[4096 + k] * wv; }
            red[(ks * 5 + 0) * 64 + c] = a0; red[(ks * 5 + 1) * 64 + c] = a1; red[(ks * 5 + 2) * 64 + c] = a2; red[(ks * 5 + 3) * 64 + c] = a3; red[(ks * 5 + 4) * 64 + c] = a4;
            __syncthreads();
            if (F.tid < 320) { const int v = F.tid >> 6, cc = F.tid & 63; float s = F.in[I_BMOD][l * 6144 + n0 + cc];
#pragma unroll
                for (int q = 0; q < 8; ++q) s += red[(q * 5 + v) * 64 + cc];
                MV[((size_t)l * 5 + v) * 6144 + n0 + cc] = s; }
            __syncthreads();
        }
    }
    {
        float* rc = WSP(float, WS_ROPE); float* rs = rc + SEQ * 32;
        for (int i = F.vcu * NTHR + F.tid; i < SEQ * 32; i += F.G * NTHR) {
            const int t = i >> 5, p = i & 31; const float pos = (p < 16) ? (float)(t >> 6) : (float)(t & 63);
            const float invf = exp2f(-(float)(p & 15) * (13.287712379549449f / 16.f));
            const float ang = pos * invf; const float rev = ang * 0.15915494309189535f; const float fr = rev - rintf(rev);
            rc[i] = __builtin_amdgcn_cosf(fr); rs[i] = __builtin_amdgcn_sinf(fr);
        }
    }
    {
        LAS float* scr = (LAS float*)(F.lds + F.wave * 8448);
        int base = 0;
        for (int j = 0; j < NJOBS; ++j) {
            CvtJob J; get_job(F, j, J);
            const int nblk = J.N / 32, nit = (J.K / 64) * nblk;
            int vid = (gw - base) % NGW; if (vid < 0) vid += NGW;
            for (int it = vid; it < nit; it += NGW) transpose_item(J.W, J.ld, J.dst, J.ldk, J.koff, J.map_h, J.rowoff, J.cscale, J.kscale, scr, it / nblk, it % nblk, F.lane);
            base = (base + nit) % NGW;
        }
    }
}

DI void load_wdt(const Frame& F, int l) {
    LAS float* wd = (LAS float*)F.lds; const float* w = F.in[I_WIN] + (size_t)l * DM * DIN + PRJW;
    for (int i = F.tid; i < DM * 16; i += NTHR) wd[i] = w[(size_t)(i >> 4) * DIN + (i & 15)];
}
DI void emit_h_dt(const Frame& F, const f32x4 (&xn)[4], const float* mv, int m, const float* dtb) {
    bf16_t* hb = WSP(bf16_t, WS_HB) + (size_t)m * DM; float* DT = WSP(float, WS_DT);
    const LAS float* wd = (const LAS float*)F.lds;
    float acc[16];
#pragma unroll
    for (int c = 0; c < 16; ++c) acc[c] = 0.f;
#pragma unroll
    for (int j = 0; j < 4; ++j) {
        const int k = 4 * F.lane + 256 * j;
        const f32x4 sh = *(const f32x4*)(mv + k), sc = *(const f32x4*)(mv + 1024 + k);
        const f32x4 h = xn[j] * (sc + 1.f) + sh;
        u32x2 w; w.x = pk2(h[0], h[1]); w.y = pk2(h[2], h[3]); *(u32x2*)(hb + k) = w;
#pragma unroll
        for (int e = 0; e < 4; ++e) {
            const LAS f32x4* wr = (const LAS f32x4*)(wd + (k + e) * 16);
#pragma unroll
            for (int q = 0; q < 4; ++q) { const f32x4 wv = wr[q]; acc[4 * q] += h[e] * wv[0]; acc[4 * q + 1] += h[e] * wv[1]; acc[4 * q + 2] += h[e] * wv[2]; acc[4 * q + 3] += h[e] * wv[3]; }
            asm volatile("" ::: "memory");
        }
    }
    const bool b0 = F.lane & 1, b1 = F.lane & 2, b2 = F.lane & 4, b3 = F.lane & 8;
    float t8[8], t4[4], t2[2], t1;
#pragma unroll
    for (int i = 0; i < 8; ++i) { const float keep = b0 ? acc[2 * i + 1] : acc[2 * i], give = b0 ? acc[2 * i] : acc[2 * i + 1]; t8[i] = keep + __shfl_xor(give, 1); }
#pragma unroll
    for (int i = 0; i < 4; ++i) { const float keep = b1 ? t8[2 * i + 1] : t8[2 * i], give = b1 ? t8[2 * i] : t8[2 * i + 1]; t4[i] = keep + __shfl_xor(give, 2); }
#pragma unroll
    for (int i = 0; i < 2; ++i) { const float keep = b2 ? t4[2 * i + 1] : t4[2 * i], give = b2 ? t4[2 * i] : t4[2 * i + 1]; t2[i] = keep + __shfl_xor(give, 4); }
    { const float keep = b3 ? t2[1] : t2[0], give = b3 ? t2[0] : t2[1]; t1 = keep + __shfl_xor(give, 8); }
    t1 += __shfl_xor(t1, 16); t1 += __shfl_xor(t1, 32);
    if (F.lane < 16) { const float x = t1 + dtb[F.lane]; const float t = __expf(x); const float sp = t < 0.01f ? t * (1.f + t * (-0.5f + t * (1.f / 3.f))) : __logf(1.f + t); DT[(size_t)m * 16 + F.lane] = x > 15.f ? x : sp; }
}
DI void ln_rows(f32x4 (&v)[4], const float* g, const float* b, int lane) {
    float s = 0.f;
#pragma unroll
    for (int j = 0; j < 4; ++j) s += (v[j][0] + v[j][1]) + (v[j][2] + v[j][3]);
    const float mean = wave_sum(s) * (1.f / DM); float s2 = 0.f;
#pragma unroll
    for (int j = 0; j < 4; ++j) { v[j] = v[j] - mean; s2 += (v[j][0] * v[j][0] + v[j][1] * v[j][1]) + (v[j][2] * v[j][2] + v[j][3] * v[j][3]); }
    const float rstd = 1.f / sqrtf(wave_sum(s2) * (1.f / DM) + LN_EPS);
#pragma unroll
    for (int j = 0; j < 4; ++j) { const int k = 4 * lane + 256 * j; v[j] = v[j] * rstd * *(const f32x4*)(g + k) + *(const f32x4*)(b + k); }
}
DI void phase_prologue_b(const Frame& F) {
    load_wdt(F, 0); __syncthreads();
    const int NGW = F.G * NWAVES, gw = F.vcu * NWAVES + F.wave;
    float* XS = WSP(float, WS_XS); const float* MV = WSP(float, WS_MVEC);
    const float* dtb = F.in[I_DTB];
    for (int m = gw; m < MTOT; m += NGW) {
        const float* src = m < NLAT ? F.in[I_X] + (size_t)m * DM : F.in[I_CTX] + (size_t)(m - NLAT) * DM; const int v = m < NLAT ? (m >> 13) : 4;
        f32x4 x[4];
#pragma unroll
        for (int j = 0; j < 4; ++j) { x[j] = *(const f32x4*)(src + 4 * F.lane + 256 * j); *(f32x4*)(XS + (size_t)m * DM + 4 * F.lane + 256 * j) = x[j]; }
        emit_h_dt(F, x, MV + (size_t)v * 6144, m, dtb);
    }
}
DI void phase_ln1(const Frame& F, int l, int mrows) {
    const bool moe = l & 1; const int mi = l >> 1;
    LAS float* wrt = (LAS float*)F.lds;
    if (moe) { const float* w = F.in[I_MRW] + (size_t)mi * DM * 8; for (int i = F.tid; i < DM * 8; i += NTHR) wrt[i] = w[i]; __syncthreads(); }
    const int NGW = F.G * NWAVES, gw = F.vcu * NWAVES + F.wave;
    float* XS = WSP(float, WS_XS); const float* MV = WSP(float, WS_MVEC) + (size_t)l * 5 * 6144; bf16_t* HB = WSP(bf16_t, WS_HB);
    const float* g = F.in[I_LN1G] + l * DM; const float* b = F.in[I_LN1B] + l * DM;
    unsigned* SL = WSP(unsigned, WS_SLOT); unsigned* gcnt = (unsigned*)F.ctl + CW_MOECNT + mi * 1024;
    int cnt = 0, nst = 0; int me0 = 0, me1 = 0, mr0 = 0, mr1 = 0, mm = 0; float mg0 = 0.f, mg1 = 0.f;
    for (int m = gw; m < mrows; m += NGW) {
        const int v = m < NLAT ? (m >> 13) : 4;
        f32x4 x[4];
#pragma unroll
        for (int j = 0; j < 4; ++j) x[j] = *(const f32x4*)(XS + (size_t)m * DM + 4 * F.lane + 256 * j);
        ln_rows(x, g, b, F.lane);
        float acc[8];
#pragma unroll
        for (int c = 0; c < 8; ++c) acc[c] = 0.f;
        const float* mv = MV + (size_t)v * 6144;
#pragma unroll
        for (int j = 0; j < 4; ++j) {
            const int k = 4 * F.lane + 256 * j;
            *(f32x4*)(XS + (size_t)m * DM + k) = x[j];
            const f32x4 sh = *(const f32x4*)(mv + 3072 + k), sc = *(const f32x4*)(mv + 4096 + k);
            const f32x4 h = x[j] * (sc + 1.f) + sh;
            u32x2 w; w.x = pk2(h[0], h[1]); w.y = pk2(h[2], h[3]); *(u32x2*)(HB + (size_t)m * DM + k) = w;
            if (moe) {
#pragma unroll
                for (int e = 0; e < 4; ++e) { const LAS f32x4* wr = (const LAS f32x4*)(wrt + (k + e) * 8);
#pragma unroll
                    for (int q = 0; q < 2; ++q) { const f32x4 wv = wr[q]; acc[4 * q] += h[e] * wv[0]; acc[4 * q + 1] += h[e] * wv[1]; acc[4 * q + 2] += h[e] * wv[2]; acc[4 * q + 3] += h[e] * wv[3]; } }
            }
        }
        if (moe) {
            const bool b0 = F.lane & 1, b1 = F.lane & 2, b2 = F.lane & 4;
            float t4[4], t2[2], t1;
#pragma unroll
            for (int i = 0; i < 4; ++i) { const float keep = b0 ? acc[2 * i + 1] : acc[2 * i], give = b0 ? acc[2 * i] : acc[2 * i + 1]; t4[i] = keep + __shfl_xor(give, 1); }
#pragma unroll
            for (int i = 0; i < 2; ++i) { const float keep = b1 ? t4[2 * i + 1] : t4[2 * i], give = b1 ? t4[2 * i] : t4[2 * i + 1]; t2[i] = keep + __shfl_xor(give, 2); }
            { const float keep = b2 ? t2[1] : t2[0], give = b2 ? t2[0] : t2[1]; t1 = keep + __shfl_xor(give, 4); }
            t1 += __shfl_xor(t1, 8); t1 += __shfl_xor(t1, 16); t1 += __shfl_xor(t1, 32);
            t1 += F.in[I_MRB][mi * 8 + (F.lane & 7)];
            float lg[8];
#pragma unroll
            for (int e = 0; e < 8; ++e) lg[e] = __shfl(t1, e);
            int e0 = 0; float l0 = lg[0];
#pragma unroll
            for (int e = 1; e < 8; ++e) if (lg[e] > l0) { l0 = lg[e]; e0 = e; }
            int e1 = -1; float l1 = -3.0e38f;
#pragma unroll
            for (int e = 0; e < 8; ++e) if (e != e0 && lg[e] > l1) { l1 = lg[e]; e1 = e; }
            const float g1 = 1.f / (1.f + __expf(l0 - l1)), g0 = 1.f - g1;
            const int r0 = __shfl(cnt, e0); if (F.lane == e0) cnt++;
            const int r1 = __shfl(cnt, e1); if (F.lane == e1) cnt++;
            if (F.lane == nst) { me0 = e0; me1 = e1; mr0 = r0; mr1 = r1; mg0 = g0; mg1 = g1; mm = m; }
            ++nst;
        }
        if (moe && (nst == 64 || m + NGW >= mrows)) {
            unsigned base = 0u; if (F.lane < 8) base = __hip_atomic_fetch_add(gcnt + F.lane * 64, (unsigned)cnt, __ATOMIC_RELAXED, __HIP_MEMORY_SCOPE_AGENT);
            const unsigned p0 = __shfl(base, me0) + mr0, p1 = __shfl(base, me1) + mr1;
            if (F.lane < nst) { u32x4 a; a.x = me0; a.y = me1; a.z = p0; a.w = p1; *(u32x4*)(SL + (size_t)mm * 8) = a; u32x2 c; c.x = __float_as_uint(mg0); c.y = __float_as_uint(mg1); *(u32x2*)(SL + (size_t)mm * 8 + 4) = c; }
            cnt = 0; nst = 0;
        }
    }
}
DI void moe_pad_ends(const Frame& F, int mi, int (&pe)[8]) {
    unsigned* gcnt = (unsigned*)F.ctl + CW_MOECNT + mi * 1024; int run = 0;
#pragma unroll
    for (int e = 0; e < 8; ++e) { const int c = (int)__builtin_amdgcn_readfirstlane(__hip_atomic_load(gcnt + e * 64, __ATOMIC_RELAXED, __HIP_MEMORY_SCOPE_AGENT)); run += (c + 255) & ~255; pe[e] = run; }
}
DI int moe_pad_ends_lds(const Frame& F, int mi) {
    int pe[8]; moe_pad_ends(F, mi, pe);
    LAS int* d = (LAS int*)(F.lds + MISC_OFF + 64);
    __syncthreads();
    if (F.tid == 0) {
#pragma unroll
        for (int e = 0; e < 8; ++e) d[e] = pe[e];
    }
    __syncthreads();
    return pe[7];
}
DI void phase_gather(const Frame& F, int l, int mrows) {
    int pe[8]; moe_pad_ends(F, l >> 1, pe);
    const int NGW = F.G * NWAVES, gw = F.vcu * NWAVES + F.wave;
    unsigned* SL = WSP(unsigned, WS_SLOT); const bf16_t* HB = WSP(bf16_t, WS_HB); bf16_t* XP = WSP(bf16_t, WS_XPAD);
    for (int m = gw; m < mrows; m += NGW) {
        const u32x4 a = *(const u32x4*)(SL + (size_t)m * 8);
        int ps0 = 0, ps1 = 0;
#pragma unroll
        for (int e = 1; e < 8; ++e) { if ((int)a.x == e) ps0 = pe[e - 1]; if ((int)a.y == e) ps1 = pe[e - 1]; }
        const int d0 = ps0 + (int)a.z, d1 = ps1 + (int)a.w;
        const u32x4* src = (const u32x4*)(HB + (size_t)m * DM);
        const u32x4 v0 = src[F.lane], v1 = src[64 + F.lane];
        u32x4* q0 = (u32x4*)(XP + (size_t)d0 * DM); u32x4* q1 = (u32x4*)(XP + (size_t)d1 * DM);
        q0[F.lane] = v0; q0[64 + F.lane] = v1; q1[F.lane] = v0; q1[64 + F.lane] = v1;
        if (F.lane == 0) { u32x2 d; d.x = d0; d.y = d1; *(u32x2*)(SL + (size_t)m * 8 + 2) = d; }
    }
}
DI void phase_ln2(const Frame& F, int l, int mrows) {
    const bool moe = l & 1, lastl = (l == DEPTH - 1);
    if (!lastl) { load_wdt(F, l + 1); __syncthreads(); }
    const int NGW = F.G * NWAVES, gw = F.vcu * NWAVES + F.wave;
    float* XS = WSP(float, WS_XS); const float* MVl = WSP(float, WS_MVEC) + (size_t)l * 5 * 6144; const float* MVn = WSP(float, WS_MVEC) + (size_t)(l + 1) * 5 * 6144;
    const float* g = F.in[I_LN2G] + l * DM; const float* b = F.in[I_LN2B] + l * DM;
    const unsigned* SL = WSP(unsigned, WS_SLOT); const bf16_t* YP = WSP(bf16_t, WS_YPAD);
    const float* dtb = F.in[I_DTB] + (lastl ? 0 : (l + 1) * 16);
    for (int m = gw; m < mrows; m += NGW) {
        const int v = m < NLAT ? (m >> 13) : 4;
        f32x4 x[4];
#pragma unroll
        for (int j = 0; j < 4; ++j) x[j] = *(const f32x4*)(XS + (size_t)m * DM + 4 * F.lane + 256 * j);
        if (moe) {
            const u32x4 a = *(const u32x4*)(SL + (size_t)m * 8); const u32x2 gg = *(const u32x2*)(SL + (size_t)m * 8 + 4);
            const float g0 = __uint_as_float(gg.x), g1 = __uint_as_float(gg.y);
            const bf16_t* y0 = YP + (size_t)a.z * DM; const bf16_t* y1 = YP + (size_t)a.w * DM;
#pragma unroll
            for (int j = 0; j < 4; ++j) { const int k = 4 * F.lane + 256 * j; const u32x2 u0 = *(const u32x2*)(y0 + k), u1 = *(const u32x2*)(y1 + k);
                const f32x4 gt = *(const f32x4*)(MVl + (size_t)v * 6144 + 5120 + k);
                f32x4 f; f[0] = g0 * bflo(u0.x) + g1 * bflo(u1.x); f[1] = g0 * bfhi(u0.x) + g1 * bfhi(u1.x); f[2] = g0 * bflo(u0.y) + g1 * bflo(u1.y); f[3] = g0 * bfhi(u0.y) + g1 * bfhi(u1.y);
                if (ABL & 16) f = (f32x4){0.f, 0.f, 0.f, 0.f};
                x[j] = x[j] * ALPHA + gt * f; }
        }
        ln_rows(x, g, b, F.lane);
        if (lastl) {
#pragma unroll
            for (int j = 0; j < 4; ++j) *(f32x4*)(F.out + (size_t)m * DM + 4 * F.lane + 256 * j) = x[j];
        } else {
#pragma unroll
            for (int j = 0; j < 4; ++j) *(f32x4*)(XS + (size_t)m * DM + 4 * F.lane + 256 * j) = x[j];
            emit_h_dt(F, x, MVn + (size_t)v * 6144, m, dtb);
        }
    }
}

DI void phase_qkprep_rows(const Frame& F, int l) {
    const int NGW = F.G * NWAVES, gw = F.vcu * NWAVES + F.wave;
    bf16_t* PRJ = WSP(bf16_t, WS_PRJ); const float* rc = WSP(float, WS_ROPE); const float* rs = rc + SEQ * 32;
    const float* gq = F.in[I_QGQ] + l * 64; const float* gk = F.in[I_QGK] + l * 64;
    const int hs = F.lane >> 4, i2 = 2 * (F.lane & 15);
    for (int m = gw; m < MTOT; m += NGW) {
        const bool lat = m < NLAT; const int t = m & (SEQ - 1);
        float c0 = 1.f, c1 = 1.f, s0 = 0.f, s1 = 0.f;
        if (lat) { const f32x2 cc = *(const f32x2*)(rc + t * 32 + i2), ss = *(const f32x2*)(rs + t * 32 + i2); c0 = cc[0]; c1 = cc[1]; s0 = ss[0]; s1 = ss[1]; }
#pragma unroll
        for (int it = 0; it < 5; ++it) {
            const int hd = it * 4 + hs;
            const int col = hd < 8 ? C_SWQ + 64 * hd : hd < 10 ? C_SWK + 64 * (hd - 8) : hd < 18 ? C_GAQ + 64 * (hd - 10) : C_GAK + 64 * (hd - 18);
            bf16_t* p = PRJ + (size_t)m * PRJW + col + i2;
            const unsigned u1 = *(const unsigned*)p, u2 = *(const unsigned*)(p + 32);
            float a0 = bflo(u1), a1 = bfhi(u1), b0 = bflo(u2), b1 = bfhi(u2);
            if (hd >= 10) {
                float ss = a0 * a0 + a1 * a1 + b0 * b0 + b1 * b1;
                ss += __shfl_xor(ss, 1); ss += __shfl_xor(ss, 2); ss += __shfl_xor(ss, 4); ss += __shfl_xor(ss, 8);
                const float rn = 1.f / sqrtf(ss * (1.f / 64.f) + RMS_EPS); const float* gg = hd < 18 ? gq : gk; const float post = hd < 18 ? C2 : 1.f;
                a0 *= rn * gg[i2] * post; a1 *= rn * gg[i2 + 1] * post; b0 *= rn * gg[32 + i2] * post; b1 *= rn * gg[32 + i2 + 1] * post;
            }
            const float o0 = a0 * c0 - b0 * s0, o1 = a1 * c1 - b1 * s1, q0 = b0 * c0 + a0 * s0, q1 = b1 * c1 + a1 * s1;
            *(unsigned*)p = pk2(o0, o1); *(unsigned*)(p + 32) = pk2(q0, q1);
        }
    }
}

constexpr int AT_KVB = 16384, AT_VOFF = 8192, AT_BIAS = 2 * AT_KVB;
DI void attn_unit(const Frame& Fin, int l, int mode, bool ctxq, int b, int hq, int qblk) {
    const Frame F = launder(Fin);
    const int lane = F.lane, wid = F.wave, tid = F.tid, r = lane & 31, h = lane >> 5;
    const bf16_t* PRJ = WSP(bf16_t, WS_PRJ); bf16_t* OC = WSP(bf16_t, WS_OC);
    int qcol, kcol, vcol, ocol, kvh;
    if (mode == 0) { qcol = C_NAQ; kcol = C_NAK; vcol = C_NAV; ocol = 0; kvh = hq; }
    else if (mode == 1) { qcol = C_SWQ; kcol = C_SWK; vcol = C_SWV; ocol = 512; kvh = hq >> 2; }
    else { qcol = C_GAQ; kcol = C_GAK; vcol = C_GAV; ocol = 1024; kvh = hq >> 2; }
    const int qrow = ctxq ? (NLAT + b * CTXL + 32 * wid + r) : (b * SEQ + 256 * qblk + 32 * wid + r);
    bf16x8 qf[4];
    { const bf16_t* qp = PRJ + (size_t)qrow * PRJW + qcol + hq * 64 + 8 * h;
#pragma unroll
      for (int d0 = 0; d0 < 4; ++d0) qf[d0] = *(const bf16x8*)(qp + 16 * d0); }
    int tl_lo = 0, tl_hi = 0;
    if (!ctxq) {
        if (mode == 0) { tl_lo = clampi(4 * qblk - 4, 0, 120); tl_hi = clampi(4 * qblk - 1, 0, 120) + 8; }
        else if (mode == 1) { tl_lo = 4 * qblk - 2 < 0 ? 0 : 4 * qblk - 2; tl_hi = 4 * qblk + 6 > 128 ? 128 : 4 * qblk + 6; }
        else { tl_lo = 0; tl_hi = 128; }
    }
    const int ntile = 4 + (tl_hi - tl_lo);
    LAS float* biasT = (LAS float*)(F.lds + AT_BIAS);
    __syncthreads();
    if (mode == 0 && !ctxq) { const float* rp = F.in[I_RPB] + ((size_t)l * 8 + hq) * 465; for (int i = tid; i < 465; i += NTHR) biasT[i] = rp[i] * LOG2E; }
    const int lr = tid >> 3, ch = tid & 7;
    const size_t ctxbase = (size_t)(NLAT + b * CTXL), latbase = (size_t)b * SEQ;
    u32x4 kreg, vreg;
#define AT_LOAD(it) do { const size_t rb_ = ((it) < 4 ? ctxbase + 64 * (it) : latbase + 64 * (tl_lo + (it) - 4)) + lr; const bf16_t* rp_ = PRJ + rb_ * PRJW + kvh * 64 + ch * 8; \
        kreg = *(const u32x4*)(rp_ + kcol); vreg = *(const u32x4*)(rp_ + vcol); } while (0)
#define AT_STORE(buf) do { LAS unsigned char* d_ = F.lds + (buf) * AT_KVB; *(LAS u32x4*)(d_ + ch * 1024 + lr * 16) = kreg; *(LAS u32x4*)(d_ + AT_VOFF + (ch >> 2) * 4096 + lr * 64 + (ch & 3) * 16) = vreg; } while (0)
    AT_LOAD(0); AT_STORE(0);
    __syncthreads();
    float mrun = -1e30f, lrun = 0.f;
    if (mode == 1) { mrun = F.in[I_SINK][l * 8 + hq] * LOG2E; lrun = (h == 0) ? 1.f : 0.f; }
    f32x16 o0, o1;
#pragma unroll
    for (int i = 0; i < 16; ++i) { o0[i] = 0.f; o1[i] = 0.f; }
    const int q4 = (lane & 15) >> 2, p4 = lane & 3, blk = (lane >> 4) & 1;
    const int tq = 256 * qblk + 32 * wid + r;
    const int gr = 4 * qblk + (wid >> 1), qc = 32 * (wid & 1) + r, cs = clampi(qc - 8, 0, 48), rsw = clampi(gr - 4, 0, 120);
    for (int it = 0; it < ntile; ++it) {
        const int buf = it & 1;
        if (it + 1 < ntile) AT_LOAD(it + 1);
        const int g = tl_lo + it - 4;
        bool rel = true;
        if (it >= 4) { if (mode == 0) rel = (g >= rsw && g < rsw + 8); else if (mode == 1) rel = (64 * g + 63 >= 256 * qblk + 32 * wid - 128) && (64 * g <= 256 * qblk + 32 * wid + 31 + 128); }
        if (rel) {
            const LAS unsigned char* Kb = F.lds + buf * AT_KVB; const LAS unsigned char* Vb = Kb + AT_VOFF;
            f32x16 p0, p1;
#pragma unroll
            for (int i = 0; i < 16; ++i) { p0[i] = 0.f; p1[i] = 0.f; }
#pragma unroll
            for (int d0 = 0; d0 < 4; ++d0) {
                const bf16x8 k0 = *(const LAS bf16x8*)(Kb + (2 * d0 + h) * 1024 + r * 16);
                const bf16x8 k1 = *(const LAS bf16x8*)(Kb + (2 * d0 + h) * 1024 + 512 + r * 16);
                p0 = MFMA32(k0, qf[d0], p0); p1 = MFMA32(k1, qf[d0], p1);
            }
            if (it >= 4 && mode == 0) {
                int csl = cs; asm volatile("" : "+v"(csl));
                const LAS float* bt = biasT + (g - gr + 7) * 31 + 15 - qc;
#pragma unroll
                for (int i = 0; i < 16; ++i) { const int k0 = crow(i, h), k1 = k0 + 32;
                    p0[i] = (k0 >= csl && k0 < csl + 16) ? p0[i] + bt[k0] : -INFINITY; p1[i] = (k1 >= csl && k1 < csl + 16) ? p1[i] + bt[k1] : -INFINITY; }
            } else if (it >= 4 && mode == 1) {
                const int d0 = 64 * g - tq;
#pragma unroll
                for (int i = 0; i < 16; ++i) { const int dd = d0 + crow(i, h);
                    if (dd > 128 || dd < -128) p0[i] = -INFINITY; if (dd + 32 > 128 || dd + 32 < -128) p1[i] = -INFINITY; }
            }
            float mx = p0[0];
#pragma unroll
            for (int i = 1; i < 16; ++i) mx = fmaxf(mx, p0[i]);
#pragma unroll
            for (int i = 0; i < 16; ++i) mx = fmaxf(mx, p1[i]);
            mx = fmaxf(mx, __shfl_xor(mx, 32));
            const float mnew = fmaxf(mrun, mx), alpha = __builtin_amdgcn_exp2f(mrun - mnew); mrun = mnew;
            float ls = 0.f;
#pragma unroll
            for (int i = 0; i < 16; ++i) { p0[i] = __builtin_amdgcn_exp2f(p0[i] - mnew); p1[i] = __builtin_amdgcn_exp2f(p1[i] - mnew); ls += p0[i] + p1[i]; }
            lrun = lrun * alpha + ls;
            if (__any(alpha != 1.f)) {
#pragma unroll
                for (int i = 0; i < 16; ++i) { o0[i] *= alpha; o1[i] *= alpha; }
            }
            bf16x8 pa[4]; pa[0] = pack8<0>(p0); pa[1] = pack8<1>(p0); pa[2] = pack8<0>(p1); pa[3] = pack8<1>(p1);
            const LAS unsigned char* va = Vb + (4 * h + q4) * 64 + blk * 32 + p4 * 8;
#pragma unroll
            for (int ks = 0; ks < 4; ++ks) {
                const bf16x8 v0 = cat8(tr_read(va + ks * 1024), tr_read(va + ks * 1024 + 512));
                const bf16x8 v1 = cat8(tr_read(va + ks * 1024 + 4096), tr_read(va + ks * 1024 + 4096 + 512));
                o0 = MFMA32(v0, pa[ks], o0); o1 = MFMA32(v1, pa[ks], o1);
            }
        }
        if (it + 1 < ntile) AT_STORE(buf ^ 1);
        __syncthreads();
    }
#undef AT_LOAD
#undef AT_STORE
    const float lt = lrun + __shfl_xor(lrun, 32), inv = 1.f / lt;
    bf16_t* op = OC + (size_t)qrow * OCW + ocol + hq * 64 + 4 * h;
#pragma unroll
    for (int g4 = 0; g4 < 4; ++g4) {
        u32x2 w; w.x = pk2(o0[4 * g4] * inv, o0[4 * g4 + 1] * inv); w.y = pk2(o0[4 * g4 + 2] * inv, o0[4 * g4 + 3] * inv); *(u32x2*)(op + 8 * g4) = w;
        u32x2 w2; w2.x = pk2(o1[4 * g4] * inv, o1[4 * g4 + 1] * inv); w2.y = pk2(o1[4 * g4 + 2] * inv, o1[4 * g4 + 3] * inv); *(u32x2*)(op + 32 + 8 * g4) = w2;
    }
}

namespace ga_body {
using bf16=__hip_bfloat16;
using bf16x8=__attribute__((ext_vector_type(8)))short;
using s16x4=__attribute__((ext_vector_type(4)))short;
using f32x16=__attribute__((ext_vector_type(16)))float;
using u32x4=__attribute__((ext_vector_type(4)))unsigned;
constexpr int SEQ=8192,D=64,PQ=4608,PO=2048,NCTXT=4;
constexpr int NW=8,QBLK=32,QB=QBLK*NW,KVBLK=64,NQB=SEQ/QB;
__device__ __forceinline__ int crow(int r,int hi){return (r&3)+8*(r>>2)+4*hi;}
#define SBAR() __builtin_amdgcn_sched_barrier(0)
__device__ __forceinline__ void cmask(f32x16&p0,f32x16&p1,int jb,int qrel,int hi){
  const float NEG=-INFINITY; int kb=64*jb+4*hi;
  #pragma unroll
  for(int r=0;r<16;++r){int kv=kb+(r&3)+8*(r>>2); if(kv>qrel)p0[r]=NEG; if(kv+32>qrel)p1[r]=NEG;}
}

constexpr int NSLOT=3, SLOTB=8192;
constexpr int LDS_K=0, LDS_V=NSLOT*SLOTB, LDS_WS=2*NSLOT*SLOTB, LDS_OST=LDS_WS+NW*64*4, LDS_BYTES=LDS_OST+NW*4096;
constexpr float C2=0.125f*1.4426950408889634f;
__device__ __forceinline__ void glds16(const void*gsrc,unsigned lds_dst){unsigned keep;
  asm volatile("s_mov_b32 %0, m0\n\ts_mov_b32 m0, %2\n\ts_nop 0\n\tglobal_load_lds_dwordx4 %1, off\n\ts_mov_b32 m0, %0":"=&s"(keep):"v"(gsrc),"s"(lds_dst):"memory");}
__device__ __forceinline__ float max3f(float a,float b,float c){float r;asm("v_max3_f32 %0, %1, %2, %3":"=v"(r):"v"(a),"v"(b),"v"(c));return r;}
__device__ __forceinline__ float max2f(float a,float b){float r;asm("v_max_f32_e32 %0, %1, %2":"=v"(r):"v"(a),"v"(b));return r;}
__device__ __forceinline__ float fadd_s(float a,float b){float r;asm("v_add_f32_e32 %0, %1, %2":"=v"(r):"v"(a),"v"(b));return r;}
__device__ __forceinline__ float fsub_s(float a,float b){float r;asm("v_sub_f32_e32 %0, %1, %2":"=v"(r):"v"(a),"v"(b));return r;}
typedef float f32x2_t __attribute__((ext_vector_type(2))); typedef __bf16 bf16x2_t __attribute__((ext_vector_type(2)));
__device__ __forceinline__ unsigned cvtpk_s(float lo,float hi){f32x2_t v={lo,hi};bf16x2_t b=__builtin_convertvector(v,bf16x2_t);return __builtin_bit_cast(unsigned,b);}
#define WAIT_BAR(N) asm volatile("s_waitcnt vmcnt(" #N ") lgkmcnt(0)\n\ts_barrier":::"memory")

__device__ __forceinline__ void qkt(f32x16&p0,f32x16&p1,const char*Kslot,const bf16x8*qr,const f32x16&negm,int r32,int hi){
  const char*kb=Kslot+hi*1024+r32*16;
  #pragma unroll
  for(int d0=0;d0<4;++d0){
    const bf16x8 b0=*reinterpret_cast<const bf16x8*>(kb+d0*2048);
    const bf16x8 b1=*reinterpret_cast<const bf16x8*>(kb+d0*2048+512);
    if(d0==0){p0=__builtin_amdgcn_mfma_f32_32x32x16_bf16(b0,qr[0],negm,0,0,0);p1=__builtin_amdgcn_mfma_f32_32x32x16_bf16(b1,qr[0],negm,0,0,0);}
    else{p0=__builtin_amdgcn_mfma_f32_32x32x16_bf16(b0,qr[d0],p0,0,0,0);p1=__builtin_amdgcn_mfma_f32_32x32x16_bf16(b1,qr[d0],p1,0,0,0);}}
}
typedef __attribute__((address_space(3))) const char* lds_cptr;
typedef short v4i16_t __attribute__((ext_vector_type(4)));
__device__ __forceinline__ void kload8(bf16x8*kf,lds_cptr kp){
  kf[0]=*(const __attribute__((address_space(3))) bf16x8*)(kp);      kf[1]=*(const __attribute__((address_space(3))) bf16x8*)(kp+512);
  kf[2]=*(const __attribute__((address_space(3))) bf16x8*)(kp+2048); kf[3]=*(const __attribute__((address_space(3))) bf16x8*)(kp+2560);
  kf[4]=*(const __attribute__((address_space(3))) bf16x8*)(kp+4096); kf[5]=*(const __attribute__((address_space(3))) bf16x8*)(kp+4608);
  kf[6]=*(const __attribute__((address_space(3))) bf16x8*)(kp+6144); kf[7]=*(const __attribute__((address_space(3))) bf16x8*)(kp+6656);
}
__device__ __forceinline__ void kload2(bf16x8*kf,lds_cptr kp,int j){ kf[2*j]=*(const __attribute__((address_space(3))) bf16x8*)(kp+j*2048); kf[2*j+1]=*(const __attribute__((address_space(3))) bf16x8*)(kp+j*2048+512); }
__device__ __forceinline__ s16x4 vtr(lds_cptr p){ return __builtin_bit_cast(s16x4,__builtin_amdgcn_ds_read_tr16_b64_v4i16((__attribute__((address_space(3))) v4i16_t*)p)); }
__device__ __forceinline__ float rowmax(const f32x16&p0,const f32x16&p1){
  float a=max3f(p0[0],p0[1],p1[0]),b=max3f(p0[2],p0[3],p1[1]);a=max3f(a,p1[2],p1[3]);
  #pragma unroll
  for(int r=4;r<16;r+=4){a=max3f(a,p0[r],p0[r+1]);b=max3f(b,p0[r+2],p0[r+3]);a=max3f(a,p1[r],p1[r+1]);b=max3f(b,p1[r+2],p1[r+3]);}
  const float m=max2f(a,b);
  auto rr=__builtin_amdgcn_permlane32_swap(__float_as_uint(m),__float_as_uint(m),false,false);
  return max2f(__uint_as_float(rr[0]),__uint_as_float(rr[1]));
}
__device__ __forceinline__ void pv(f32x16*o,int vb,bf16x8 pa0,bf16x8 pa1,bf16x8 pa2,bf16x8 pa3){
  #pragma unroll
  for(int d0=0;d0<2;++d0){s16x4 lo[4],hi[4];
    #pragma unroll
    for(int ks=0;ks<4;++ks){
      asm volatile("ds_read_b64_tr_b16 %0,%1 offset:%c2":"=&v"(lo[ks]):"v"(vb),"i"(d0*4096+ks*1024):"memory");
      asm volatile("ds_read_b64_tr_b16 %0,%1 offset:%c2":"=&v"(hi[ks]):"v"(vb),"i"(d0*4096+ks*1024+512):"memory");}
    asm volatile("s_waitcnt lgkmcnt(0)":::"memory");SBAR();
    #define PK(k) (bf16x8){lo[k][0],lo[k][1],lo[k][2],lo[k][3],hi[k][0],hi[k][1],hi[k][2],hi[k][3]}
    o[d0]=__builtin_amdgcn_mfma_f32_32x32x16_bf16(pa0,PK(0),o[d0],0,0,0);
    o[d0]=__builtin_amdgcn_mfma_f32_32x32x16_bf16(pa1,PK(1),o[d0],0,0,0);
    o[d0]=__builtin_amdgcn_mfma_f32_32x32x16_bf16(pa2,PK(2),o[d0],0,0,0);
    o[d0]=__builtin_amdgcn_mfma_f32_32x32x16_bf16(pa3,PK(3),o[d0],0,0,0);
    #undef PK
  }
}

#ifndef ATTN_STORE16
#define ATTN_STORE16(p,v) (*(u32x4*)(p)=(v))
#endif
template<int THRL> __device__ __forceinline__ void attn_unit(int qb,const bf16*Qp,const bf16*__restrict__ Kl,const bf16*__restrict__ Vl,const bf16*__restrict__ Kc,const bf16*__restrict__ Vc,bf16*Op,char*shm,const int tid){
  const int lane=tid&63,r32=lane&31,hi=lane>>5; const int wid=__builtin_amdgcn_readfirstlane(tid>>6);
  const int q0=qb*QB;
  const bf16*Qw=Qp+(long)(q0+wid*QBLK)*PQ;
  const unsigned lds0=(unsigned)(uintptr_t)shm;
  float*wsf=(float*)(shm+LDS_WS)+wid*64;
  const long koff=(long)lane*PQ+wid*8;
  const long voff=(long)(16*(wid&3)+(lane>>2))*PQ+(wid>>2)*32+(lane&3)*8;
  const unsigned kdst=lds0+LDS_K+wid*1024, vdst=lds0+LDS_V+wid*1024;
  #define TILE_SRC(t,C,L) (((t)<NCTXT?(C)+(long)(t)*KVBLK*PQ:(L)+(long)((t)-NCTXT)*KVBLK*PQ))
  #define DMA_K(t,slot) glds16(TILE_SRC(t,Kc,Kl)+koff,(unsigned)__builtin_amdgcn_readfirstlane(kdst+(slot)))
  #define DMA_V(t,slot) glds16(TILE_SRC(t,Vc,Vl)+voff,(unsigned)__builtin_amdgcn_readfirstlane(vdst+(slot)))
  const int vb0=(int)(lds0+LDS_V)+((lane>>4)&1)*32+(lane&3)*8+(4*hi+((lane&15)>>2))*64;
  const char*Kbase=shm+LDS_K; bf16x8 kf[8];
  const lds_cptr shm3=(lds_cptr)shm; const lds_cptr kp0=shm3+LDS_K+hi*1024+r32*16; const lds_cptr vp0=shm3+LDS_V+((lane>>4)&1)*32+(lane&3)*8+(4*hi+((lane&15)>>2))*64;
  constexpr int NT=NCTXT+SEQ/KVBLK;
  DMA_K(0,0);DMA_V(0,0);DMA_K(1,SLOTB);
  bf16x8 qr[4];
  #pragma unroll
  for(int d0=0;d0<4;++d0)qr[d0]=*reinterpret_cast<const bf16x8*>(&Qw[(long)r32*PQ+d0*16+hi*8]);
  float mhat=0.f,l_reg=0.f;f32x16 o[2];o[0]=f32x16{};o[1]=f32x16{};f32x16 negm=f32x16{};asm volatile("":"+v"(negm));
  #define CMASK(P0,P1,t) do{}while(0)
  bool resc=false;
  #define START(P0,P1) do{ const float rm=rowmax(P0,P1); resc=false; \
    { const float dl=rm; mhat=fadd_s(mhat,dl); \
      _Pragma("unroll") for(int r=0;r<16;++r){P0[r]=fsub_s(P0[r],dl);P1[r]=fsub_s(P1[r],dl);} \
      _Pragma("unroll") for(int r=0;r<16;++r)negm[r]=-mhat; asm volatile("":"+v"(negm)); } \
    _Pragma("unroll") for(int r=0;r<16;++r)P0[r]=__builtin_amdgcn_exp2f(P0[r]); }while(0)
  #define RESC() do{ if(resc){ asm volatile("s_waitcnt lgkmcnt(0)":::"memory"); \
      _Pragma("unroll") for(int d_=0;d_<2;++d_) _Pragma("unroll") for(int r=0;r<16;++r)o[d_][r]*=wsf[crow(r,hi)]; } }while(0)
  f32x16 pA0,pA1,pB0,pB1;
  int sl_prev=0,sl_cur=0,sl_next=SLOTB;
  #define ROT() do{sl_prev=sl_cur;sl_cur=sl_next;sl_next=(sl_next==(NSLOT-1)*SLOTB)?0:sl_next+SLOTB;}while(0)
  DMA_K(2,2*SLOTB);
  WAIT_BAR(3);
  qkt(pA0,pA1,Kbase,qr,negm,r32,hi);asm volatile("s_nop 15\n\ts_nop 7":"+v"(pA0),"+v"(pA1));CMASK(pA0,pA1,0);
  START(pA0,pA1);
  _Pragma("unroll") for(int r=0;r<16;++r)pA1[r]=__builtin_amdgcn_exp2f(pA1[r]);
  WAIT_BAR(0);
  DMA_K(3,0);DMA_V(1,SLOTB);
  ROT();
  kload8(kf,kp0+sl_cur);
  WAIT_BAR(2);
  s16x4 vlo[8],vhi[8]; u32x4 pw0,pw1,pw2,pw3;
  #define PKW(P,B) cvtpk_s(P[B],P[B+1])
  #define PAF(k) __builtin_bit_cast(bf16x8,pw##k)
  #define VFR(i) (bf16x8){vlo[i][0],vlo[i][1],vlo[i][2],vlo[i][3],vhi[i][0],vhi[i][1],vhi[i][2],vhi[i][3]}
  #define PIN(x) asm volatile("":"+v"(x))
  #define MX3(a,b,c) __builtin_fmaxf(__builtin_fmaxf((a),(b)),(c))
  #define GAPA(MF,A0,A1,A2,A3,W0,W1,PW) do{ MF; sacc+=A0; sacc+=A1; sacc+=A2; sacc+=A3; PIN(sacc); W0; W1; PIN(PW); SBAR(); }while(0)
  #define EX(v) __builtin_amdgcn_exp2f(v)
  #define GAPB(MF,X,B) do{ MF; X[B]=EX(X[B]); X[B+1]=EX(X[B+1]); X[B+2]=EX(X[B+2]); X[B+3]=EX(X[B+3]); PIN(X); SBAR(); }while(0)
  #define VRD(i) do{ vlo[i]=vtr(vp_+(((i)>>2)*4096+((i)&3)*1024)); vhi[i]=vtr(vp_+(((i)>>2)*4096+((i)&3)*1024+512)); }while(0)
  #define KRD(G,j) do{ if(G){ kload2(kf,kp0+sl_next,j); SBAR(); } }while(0)
  #define STEP(C0,C1,P0,P1,t,GK,GV,GL) do{ SBAR(); \
    const lds_cptr vp_=vp0+sl_prev; \
    VRD(0); SBAR(); float sacc=(P0[0]+P0[1]); \
    GAPA(C0=__builtin_amdgcn_mfma_f32_32x32x16_bf16(kf[0],qr[0],negm,0,0,0), P0[2],P0[3],P0[4],P0[5],     pw0[0]=PKW(P0,0), pw0[1]=PKW(P0,2), pw0); \
    VRD(4); SBAR(); GAPA(C1=__builtin_amdgcn_mfma_f32_32x32x16_bf16(kf[1],qr[0],negm,0,0,0), P0[6],P0[7],P0[8],P0[9],     pw0[2]=PKW(P0,4), pw0[3]=PKW(P0,6), pw0); \
    VRD(1); SBAR(); GAPA(C0=__builtin_amdgcn_mfma_f32_32x32x16_bf16(kf[2],qr[1],C0,0,0,0),   P0[10],P0[11],P0[12],P0[13], pw1[0]=PKW(P0,8), pw1[1]=PKW(P0,10), pw1); \
    VRD(5); SBAR(); GAPA(C1=__builtin_amdgcn_mfma_f32_32x32x16_bf16(kf[3],qr[1],C1,0,0,0),   P0[14],P0[15],P1[0],P1[1],   pw1[2]=PKW(P0,12),pw1[3]=PKW(P0,14), pw1); \
    VRD(2); SBAR(); GAPA(C0=__builtin_amdgcn_mfma_f32_32x32x16_bf16(kf[4],qr[2],C0,0,0,0),   P1[2],P1[3],P1[4],P1[5],     pw2[0]=PKW(P1,0), pw2[1]=PKW(P1,2), pw2); \
    VRD(6); SBAR(); GAPA(C1=__builtin_amdgcn_mfma_f32_32x32x16_bf16(kf[5],qr[2],C1,0,0,0),   P1[6],P1[7],P1[8],P1[9],     pw2[2]=PKW(P1,4), pw2[3]=PKW(P1,6), pw2); \
    VRD(3); SBAR(); GAPA(C0=__builtin_amdgcn_mfma_f32_32x32x16_bf16(kf[6],qr[3],C0,0,0,0),   P1[10],P1[11],P1[12],P1[13], pw3[0]=PKW(P1,8), pw3[1]=PKW(P1,10), pw3); \
    VRD(7); SBAR(); GAPA(C1=__builtin_amdgcn_mfma_f32_32x32x16_bf16(kf[7],qr[3],C1,0,0,0),   P1[14],P1[15],0.f,0.f,       pw3[2]=PKW(P1,12),pw3[3]=PKW(P1,14), pw3); \
    l_reg+=sacc; \
    if(GK){DMA_K((t)+3,sl_cur);} if(GV){DMA_V((t)+1,sl_next);} \
    CMASK(C0,C1,t); \
    { float a=MX3(C0[0],C0[1],C1[0]),b=MX3(C0[2],C0[3],C1[1]); a=MX3(a,C1[2],C1[3]); \
      _Pragma("unroll") for(int r=4;r<16;r+=4){a=MX3(a,C0[r],C0[r+1]);b=MX3(b,C0[r+2],C0[r+3]);a=MX3(a,C1[r],C1[r+1]);b=MX3(b,C1[r+2],C1[r+3]);} \
      float rm=__builtin_fmaxf(a,b); { auto rr=__builtin_amdgcn_permlane32_swap(__float_as_uint(rm),__float_as_uint(rm),false,false); rm=__builtin_fmaxf(__uint_as_float(rr[0]),__uint_as_float(rr[1])); } \
      resc=false; \
      if(__builtin_expect(__any(rm>(float)THRL),0)){ const float dl=__builtin_fmaxf(rm,0.f); mhat+=dl; \
        _Pragma("unroll") for(int r=0;r<16;++r){C0[r]-=dl;C1[r]-=dl;} \
        _Pragma("unroll") for(int r=0;r<16;++r)negm[r]=-mhat; asm volatile("":"+v"(negm)); \
        const float f=__builtin_amdgcn_exp2f(-dl); l_reg*=f; if(hi==0)wsf[r32]=f; resc=true; } } \
    SBAR(); \
    GAPB(o[0]=__builtin_amdgcn_mfma_f32_32x32x16_bf16(PAF(0),VFR(0),o[0],0,0,0), C0,0); \
    GAPB(o[1]=__builtin_amdgcn_mfma_f32_32x32x16_bf16(PAF(0),VFR(4),o[1],0,0,0), C0,4); \
    KRD(GL,0); GAPB(o[0]=__builtin_amdgcn_mfma_f32_32x32x16_bf16(PAF(1),VFR(1),o[0],0,0,0), C0,8); \
    KRD(GL,1); GAPB(o[1]=__builtin_amdgcn_mfma_f32_32x32x16_bf16(PAF(1),VFR(5),o[1],0,0,0), C0,12); \
    KRD(GL,2); GAPB(o[0]=__builtin_amdgcn_mfma_f32_32x32x16_bf16(PAF(2),VFR(2),o[0],0,0,0), C1,0); \
    KRD(GL,3); GAPB(o[1]=__builtin_amdgcn_mfma_f32_32x32x16_bf16(PAF(2),VFR(6),o[1],0,0,0), C1,4); \
    GAPB(o[0]=__builtin_amdgcn_mfma_f32_32x32x16_bf16(PAF(3),VFR(3),o[0],0,0,0), C1,8); \
    GAPB(o[1]=__builtin_amdgcn_mfma_f32_32x32x16_bf16(PAF(3),VFR(7),o[1],0,0,0), C1,12); \
    }while(0)
  int t=1;
  #undef CMASK
  #define CMASK(P0,P1,t) do{}while(0)
  for(;t+5<NT;t+=2){
    STEP(pB0,pB1,pA0,pA1,t,true,true,true);     WAIT_BAR(2); RESC(); ROT();
    STEP(pA0,pA1,pB0,pB1,t+1,true,true,true);   WAIT_BAR(2); RESC(); ROT();
  }
  #undef CMASK
  #define CMASK(P0,P1,t) do{}while(0)
  #define ENDW(tt) do{ if((tt)+3<NT){WAIT_BAR(2);} else if((tt)+2<NT){WAIT_BAR(1);} else {WAIT_BAR(0);} }while(0)
  for(;t+1<NT;t+=2){
    STEP(pB0,pB1,pA0,pA1,t,(t+3<NT),(t+1<NT),(t+1<NT));       ENDW(t);   RESC(); ROT();
    STEP(pA0,pA1,pB0,pB1,t+1,(t+4<NT),(t+2<NT),(t+2<NT));     ENDW(t+1); RESC(); ROT();
  }
  STEP(pB0,pB1,pA0,pA1,NT-1,false,false,false); RESC();
  { float sacc=pB0[0]+pB0[1]; _Pragma("unroll") for(int r=2;r<16;++r)sacc+=pB0[r]; _Pragma("unroll") for(int r=0;r<16;++r)sacc+=pB1[r]; l_reg+=sacc;
    pw0=(u32x4){PKW(pB0,0),PKW(pB0,2),PKW(pB0,4),PKW(pB0,6)};pw1=(u32x4){PKW(pB0,8),PKW(pB0,10),PKW(pB0,12),PKW(pB0,14)};pw2=(u32x4){PKW(pB1,0),PKW(pB1,2),PKW(pB1,4),PKW(pB1,6)};pw3=(u32x4){PKW(pB1,8),PKW(pB1,10),PKW(pB1,12),PKW(pB1,14)};
    SBAR(); pv(o,vb0+sl_cur,PAF(0),PAF(1),PAF(2),PAF(3)); }
  #undef PKW
  #undef PAF
  #undef VFR
  #undef PIN
  #undef MX3
  #undef GAPA
  #undef GAPB
  #undef EX
  #undef VRD
  #undef KRD
  #undef STEP
  #undef ENDW
  {auto rr=__builtin_amdgcn_permlane32_swap(__float_as_uint(l_reg),__float_as_uint(l_reg),false,false);l_reg=__uint_as_float(rr[0])+__uint_as_float(rr[1]);}
  if(hi==0)wsf[32+r32]=l_reg;asm volatile("s_waitcnt lgkmcnt(0)":::"memory");
  float rli[16];
  #pragma unroll
  for(int r=0;r<16;++r)rli[r]=__builtin_amdgcn_rcpf(wsf[32+crow(r,hi)]);
  bf16*Ow=Op+(long)(q0+wid*QBLK)*PO;
  { bf16*stg=(bf16*)(shm+LDS_OST)+wid*2048;
    #pragma unroll
    for(int r=0;r<16;++r){const int orow=crow(r,hi);
      #pragma unroll
      for(int d0=0;d0<2;++d0)stg[orow*64+d0*32+r32]=__float2bfloat16(o[d0][r]*rli[r]);}
    asm volatile("s_waitcnt lgkmcnt(0)":::"memory");
    #pragma unroll
    for(int i=0;i<4;++i){const int row=i*8+(lane>>3),ch=lane&7; const u32x4 v=*(const u32x4*)(stg+row*64+ch*8); ATTN_STORE16(Ow+(long)row*PO+ch*8,v);} }
  asm volatile("s_waitcnt lgkmcnt(0)\n\ts_barrier":::"memory");
  #undef DMA_K
  #undef TILE_SRC
  #undef DMA_V
  #undef CMASK
  #undef START
  #undef RESC
  #undef ROT
}
#undef SBAR
#undef WAIT_BAR
}

constexpr int SD_CUM = 0, SD_DTV = 1024, SD_XC = 2048, SD_XCS = 144, SD_BC = SD_XC + 128 * SD_XCS, SD_BCS = 272, SD_CC = SD_BC + 128 * SD_BCS, SD_HS = SD_CC + 128 * SD_BCS,
              SD_SSQ = SD_HS + 2 * 64 * SD_BCS, SD_XW = SD_CC;
static_assert(SD_SSQ + 1024 <= RING_BYTES && SD_XW + 2 * 128 * SD_XCS <= RING_BYTES, "SSD LDS map");
DI int chunk_row(int b, int cidx) { return cidx < 2 ? NLAT + b * CTXL + 128 * cidx : b * SEQ + 128 * (cidx - 2); }
DI void ssd_cum(const Frame& F, int l, int b, int cidx, int hd) {
    if (F.wave < 2) {
        const int dir = F.wave; const float* DT = WSP(float, WS_DT) + (size_t)chunk_row(b, cidx) * 16 + dir * 8 + hd;
        const float a = -__expf(F.in[I_ALOG][l * 16 + dir * 8 + hd]);
        const float d0 = DT[(size_t)(2 * F.lane) * 16], d1 = DT[(size_t)(2 * F.lane + 1) * 16];
        const float a0 = d0 * a, a1 = d1 * a, s = a0 + a1; float v = s;
        LAS float* cum = (LAS float*)(F.lds + SD_CUM) + dir * 128; LAS float* dtv = (LAS float*)(F.lds + SD_DTV) + dir * 128;
        if (dir == 0) {
#pragma unroll
            for (int o = 1; o < 64; o <<= 1) { const float t = __shfl_up(v, o); if (F.lane >= o) v += t; }
            cum[2 * F.lane] = v - s + a0; cum[2 * F.lane + 1] = v;
        } else {
#pragma unroll
            for (int o = 1; o < 64; o <<= 1) { const float t = __shfl_down(v, o); if (F.lane + o < 64) v += t; }
            cum[2 * F.lane + 1] = v - s + a1; cum[2 * F.lane] = v;
        }
        dtv[2 * F.lane] = d0; dtv[2 * F.lane + 1] = d1;
    }
}
DI void conv_tile(const Frame& F, int l, LAS unsigned char* dst, int dstride, int ch0, int nchunks, int rowbase, int seqlo, int seqhi) {
    const bf16_t* PRJ = WSP(bf16_t, WS_PRJ); const float* cw = F.in[I_CONVW] + (size_t)l * 5 * 1024; const float* cb = F.in[I_CONVB] + l * 1024;
    for (int item = F.tid; item < nchunks * 16; item += NTHR) {
        const int chunk = item % nchunks, seg = item / nchunks, t0 = seg * 8, c0 = ch0 + chunk * 8;
        float w[5][8], bb[8];
#pragma unroll
        for (int k = 0; k < 5; ++k) { const f32x4 wa = *(const f32x4*)(cw + k * 1024 + c0), wb = *(const f32x4*)(cw + k * 1024 + c0 + 4);
            w[k][0] = wa[0]; w[k][1] = wa[1]; w[k][2] = wa[2]; w[k][3] = wa[3]; w[k][4] = wb[0]; w[k][5] = wb[1]; w[k][6] = wb[2]; w[k][7] = wb[3]; }
        { const f32x4 ba = *(const f32x4*)(cb + c0), b2 = *(const f32x4*)(cb + c0 + 4); bb[0] = ba[0]; bb[1] = ba[1]; bb[2] = ba[2]; bb[3] = ba[3]; bb[4] = b2[0]; bb[5] = b2[1]; bb[6] = b2[2]; bb[7] = b2[3]; }
        u32x4 rows[12];
#pragma unroll
        for (int i = 0; i < 12; ++i) { const int row = rowbase + t0 - 2 + i;
            rows[i] = (row >= seqlo && row < seqhi) ? *(const u32x4*)(PRJ + (size_t)row * PRJW + C_XBC + c0) : (u32x4){0u, 0u, 0u, 0u}; }
#pragma unroll
        for (int j = 0; j < 8; ++j) {
            float y[8];
#pragma unroll
            for (int e = 0; e < 8; ++e) y[e] = bb[e];
#pragma unroll
            for (int k = 0; k < 5; ++k) { const u32x4 rr = rows[j + k];
                y[0] += w[k][0] * bflo(rr.x); y[1] += w[k][1] * bfhi(rr.x); y[2] += w[k][2] * bflo(rr.y); y[3] += w[k][3] * bfhi(rr.y);
                y[4] += w[k][4] * bflo(rr.z); y[5] += w[k][5] * bfhi(rr.z); y[6] += w[k][6] * bflo(rr.w); y[7] += w[k][7] * bfhi(rr.w); }
            u32x4 o; o.x = pk2(silu(y[0]), silu(y[1])); o.y = pk2(silu(y[2]), silu(y[3])); o.z = pk2(silu(y[4]), silu(y[5])); o.w = pk2(silu(y[6]), silu(y[7]));
            *(LAS u32x4*)(dst + (t0 + j) * dstride + chunk * 16) = o;
        }
    }
}
DI void ssd_s1_unit(const Frame& Fin, int l, int b, int cidx, int hd) {
    const Frame F = launder(Fin);
    const int lane = F.lane, wid = F.wave, r = lane & 31, h = lane >> 5;
    const int rowbase = chunk_row(b, cidx), seqlo = cidx < 2 ? NLAT + b * CTXL : b * SEQ, seqhi = cidx < 2 ? seqlo + CTXL : seqlo + SEQ;
    __syncthreads();
    ssd_cum(F, l, b, cidx, hd);
    conv_tile(F, l, F.lds + SD_XC, SD_XCS, 64 * hd, 8, rowbase, seqlo, seqhi);
    conv_tile(F, l, F.lds + SD_BC, SD_BCS, 512 + 128 * (hd >> 2), 16, rowbase, seqlo, seqhi);
    __syncthreads();
    const LAS float* cum = (const LAS float*)(F.lds + SD_CUM); const LAS float* dtv = (const LAS float*)(F.lds + SD_DTV);
    for (int i = F.tid; i < 2 * 128 * 8; i += NTHR) {
        const int dir = i >> 10, t = (i >> 3) & 127, c8 = i & 7;
        const float ce = dir == 0 ? cum[127] : cum[128]; const float wgt = dtv[dir * 128 + t] * __expf(ce - cum[dir * 128 + t]);
        const u32x4 x = *(const LAS u32x4*)(F.lds + SD_XC + t * SD_XCS + c8 * 16);
        u32x4 o; o.x = pk2(bflo(x.x) * wgt, bfhi(x.x) * wgt); o.y = pk2(bflo(x.y) * wgt, bfhi(x.y) * wgt); o.z = pk2(bflo(x.z) * wgt, bfhi(x.z) * wgt); o.w = pk2(bflo(x.w) * wgt, bfhi(x.w) * wgt);
        *(LAS u32x4*)(F.lds + SD_XW + (dir * 128 + t) * SD_XCS + c8 * 16) = o;
    }
    __syncthreads();
    const int dir = wid >> 2, nb = wid & 3, q4 = (lane & 15) >> 2, p4 = lane & 3, blk = (lane >> 4) & 1;
    f32x16 s0, s1;
#pragma unroll
    for (int i = 0; i < 16; ++i) { s0[i] = 0.f; s1[i] = 0.f; }
    const LAS unsigned char* xa = F.lds + SD_XW + (dir * 128 + 8 * h + q4) * SD_XCS + (16 * blk + 4 * p4) * 2;
    const LAS unsigned char* ba = F.lds + SD_BC + (8 * h + q4) * SD_BCS + (32 * nb + 16 * blk + 4 * p4) * 2;
#pragma unroll
    for (int ks = 0; ks < 8; ++ks) {
        const bf16x8 bfr = cat8(tr_read(ba + (16 * ks) * SD_BCS), tr_read(ba + (16 * ks + 4) * SD_BCS));
        const bf16x8 x0 = cat8(tr_read(xa + (16 * ks) * SD_XCS), tr_read(xa + (16 * ks + 4) * SD_XCS));
        const bf16x8 x1 = cat8(tr_read(xa + (16 * ks) * SD_XCS + 64), tr_read(xa + (16 * ks + 4) * SD_XCS + 64));
        s0 = MFMA32(x0, bfr, s0); s1 = MFMA32(x1, bfr, s1);
    }
    float* ST = WSP(float, WS_ST) + ((((size_t)b * NCH + cidx) * 8 + hd) * 2 + dir) * 8192 + 32 * nb + r;
#pragma unroll
    for (int i = 0; i < 16; ++i) { ST[(size_t)crow(i, h) * 128] = s0[i]; ST[(size_t)(32 + crow(i, h)) * 128] = s1[i]; }
    if (F.tid < 2) WSP(float, WS_CDEC)[(((size_t)b * NCH + cidx) * 8 + hd) * 2 + F.tid] = __expf(F.tid == 0 ? cum[127] : cum[128]);
}
DI void phase_scan(const Frame& F) {
    float* ST = WSP(float, WS_ST); const float* CD = WSP(float, WS_CDEC);
    for (int gid = F.vcu * NTHR + F.tid; gid < 64 * 2048; gid += F.G * NTHR) {
        const int chain = gid >> 11, e4 = gid & 2047, b = chain >> 4, hd = (chain >> 1) & 7, dir = chain & 1;
        f32x4 hst = (f32x4){0.f, 0.f, 0.f, 0.f};
        for (int k0 = 0; k0 < NCH; k0 += 11) {
            f32x4 st[11]; float dec[11];
#pragma unroll
            for (int j = 0; j < 11; ++j) { const int k = k0 + j, cidx = dir == 0 ? k : (k < 2 ? 1 - k : 67 - k); const size_t idx = (((size_t)b * NCH + cidx) * 8 + hd) * 2 + dir;
                st[j] = *((const f32x4*)(ST + idx * 8192) + e4); dec[j] = CD[idx]; }
#pragma unroll
            for (int j = 0; j < 11; ++j) { const int k = k0 + j, cidx = dir == 0 ? k : (k < 2 ? 1 - k : 67 - k); const size_t idx = (((size_t)b * NCH + cidx) * 8 + hd) * 2 + dir;
                *((f32x4*)(ST + idx * 8192) + e4) = hst; hst = hst * dec[j] + st[j]; }
        }
    }
}
DI void ssd_s3_unit(const Frame& Fin, int l, int b, int cidx, int hd) {
    const Frame F = launder(Fin);
    const int lane = F.lane, wid = F.wave, r = lane & 31, h = lane >> 5;
    const int rowbase = chunk_row(b, cidx), seqlo = cidx < 2 ? NLAT + b * CTXL : b * SEQ, seqhi = cidx < 2 ? seqlo + CTXL : seqlo + SEQ;
    __syncthreads();
    ssd_cum(F, l, b, cidx, hd);
    conv_tile(F, l, F.lds + SD_XC, SD_XCS, 64 * hd, 8, rowbase, seqlo, seqhi);
    conv_tile(F, l, F.lds + SD_BC, SD_BCS, 512 + 128 * (hd >> 2), 16, rowbase, seqlo, seqhi);
    conv_tile(F, l, F.lds + SD_CC, SD_BCS, 768 + 128 * (hd >> 2), 16, rowbase, seqlo, seqhi);
    {
        const float* ST = WSP(float, WS_ST) + (((size_t)b * NCH + cidx) * 8 + hd) * 2 * 8192;
        for (int i = F.tid; i < 2 * 64 * 16; i += NTHR) { const int dp = i >> 4, c8 = i & 15; const f32x4 a = *(const f32x4*)(ST + (size_t)dp * 128 + c8 * 8), c = *(const f32x4*)(ST + (size_t)dp * 128 + c8 * 8 + 4);
            u32x4 o; o.x = pk2(a[0], a[1]); o.y = pk2(a[2], a[3]); o.z = pk2(c[0], c[1]); o.w = pk2(c[2], c[3]); *(LAS u32x4*)(F.lds + SD_HS + dp * SD_BCS + c8 * 16) = o; }
    }
    __syncthreads();
    const LAS float* cum = (const LAS float*)(F.lds + SD_CUM); const LAS float* dtv = (const LAS float*)(F.lds + SD_DTV);
    const int lb = wid & 3, ph = wid >> 2, q4 = (lane & 15) >> 2, p4 = lane & 3, blk = (lane >> 4) & 1;
    const int lidx = 32 * lb + r;
    bf16x8 cf[8];
#pragma unroll
    for (int ks = 0; ks < 8; ++ks) cf[ks] = *(const LAS bf16x8*)(F.lds + SD_CC + lidx * SD_BCS + (16 * ks + 8 * h) * 2);
    f32x16 gt[4];
#pragma unroll
    for (int sb = 0; sb < 4; ++sb) {
#pragma unroll
        for (int i = 0; i < 16; ++i) gt[sb][i] = 0.f;
#pragma unroll
        for (int ks = 0; ks < 8; ++ks) { const bf16x8 bfr = *(const LAS bf16x8*)(F.lds + SD_BC + (32 * sb + r) * SD_BCS + (16 * ks + 8 * h) * 2); gt[sb] = MFMA32(bfr, cf[ks], gt[sb]); }
    }
    f32x16 ytot;
#pragma unroll
    for (int i = 0; i < 16; ++i) ytot[i] = 0.f;
    const LAS unsigned char* xa = F.lds + SD_XC + (4 * h + q4) * SD_XCS + (32 * ph + 16 * blk + 4 * p4) * 2;
#pragma unroll
    for (int dir = 0; dir < 2; ++dir) {
        const float cl = cum[dir * 128 + lidx];
        f32x16 acc;
#pragma unroll
        for (int i = 0; i < 16; ++i) acc[i] = 0.f;
#pragma unroll
        for (int sb = 0; sb < 4; ++sb) {
            const bool relv = dir == 0 ? (sb <= lb) : (sb >= lb);
            if (relv) {
                f32x16 mt; int rl = r; asm volatile("" : "+v"(rl));
#pragma unroll
                for (int i = 0; i < 16; ++i) { const int sl = crow(i, h), s = 32 * sb + sl;
                    const bool ok = (sb != lb) || (dir == 0 ? (sl <= rl) : (sl >= rl));
                    const float e = __expf(cl - cum[dir * 128 + s]) * dtv[dir * 128 + s];
                    mt[i] = ok ? gt[sb][i] * e : 0.f; }
                const bf16x8 pa0 = pack8<0>(mt), pa1 = pack8<1>(mt);
                const bf16x8 x0 = cat8(tr_read(xa + (32 * sb) * SD_XCS), tr_read(xa + (32 * sb + 8) * SD_XCS));
                const bf16x8 x1 = cat8(tr_read(xa + (32 * sb + 16) * SD_XCS), tr_read(xa + (32 * sb + 24) * SD_XCS));
                acc = MFMA32(x0, pa0, acc); acc = MFMA32(x1, pa1, acc);
            }
        }
        f32x16 yo;
#pragma unroll
        for (int i = 0; i < 16; ++i) yo[i] = 0.f;
#pragma unroll
        for (int ks = 0; ks < 8; ++ks) { const bf16x8 hf = *(const LAS bf16x8*)(F.lds + SD_HS + (dir * 64 + 32 * ph + r) * SD_BCS + (16 * ks + 8 * h) * 2); yo = MFMA32(hf, cf[ks], yo); }
        const float el = __expf(cl);
#pragma unroll
        for (int i = 0; i < 16; ++i) ytot[i] += acc[i] + el * yo[i];
    }
    const float dsk = F.in[I_DSKIP][l * 8 + hd];
    const int row = rowbase + lidx;
    const bf16_t* zp = WSP(bf16_t, WS_PRJ) + (size_t)row * PRJW + C_Z + 64 * hd + 32 * ph + 4 * h;
    bf16_t* op = WSP(bf16_t, WS_OC) + (size_t)row * OCW + 1536 + 64 * hd + 32 * ph + 4 * h;
    float ss = 0.f;
#pragma unroll
    for (int g4 = 0; g4 < 4; ++g4) {
        const u32x2 zz = *(const u32x2*)(zp + 8 * g4);
        const u32x2 xx = *(const LAS u32x2*)(F.lds + SD_XC + lidx * SD_XCS + (32 * ph + 8 * g4 + 4 * h) * 2);
        const float v0 = (ytot[4 * g4] + dsk * bflo(xx.x)) * silu(bflo(zz.x)), v1 = (ytot[4 * g4 + 1] + dsk * bfhi(xx.x)) * silu(bfhi(zz.x));
        const float v2 = (ytot[4 * g4 + 2] + dsk * bflo(xx.y)) * silu(bflo(zz.y)), v3 = (ytot[4 * g4 + 3] + dsk * bfhi(xx.y)) * silu(bfhi(zz.y));
        ss += (v0 * v0 + v1 * v1) + (v2 * v2 + v3 * v3);
        u32x2 w; w.x = pk2(v0, v1); w.y = pk2(v2, v3); *(u32x2*)(op + 8 * g4) = w;
    }
    ss += __shfl_xor(ss, 32);
    LAS float* sq = (LAS float*)(F.lds + SD_SSQ);
    if (h == 0) sq[ph * 128 + lidx] = ss;
    __syncthreads();
    if (F.tid < 128) WSP(float, WS_SSQ)[(size_t)(rowbase + F.tid) * 8 + hd] = sq[F.tid] + sq[128 + F.tid];
}

constexpr int PH_PER_LAYER = 11, N_PHASES = 2 + PH_PER_LAYER * DEPTH;
__global__ void __launch_bounds__(NTHR, 2) fwd_kernel(Args args) {
    extern __shared__ __attribute__((aligned(16))) unsigned char smem[];
    Frame F0;
    F0.lds = (LAS unsigned char*)smem;
    F0.tid = threadIdx.x; F0.lane = F0.tid & 63; F0.wave = __builtin_amdgcn_readfirstlane(F0.tid >> 6);
    F0.G = gridDim.x; { const int bx = blockIdx.x; F0.vcu = (F0.G % 8 == 0) ? (bx % 8) * (F0.G / 8) + bx / 8 : bx; }
    F0.in = args.in; F0.out = args.out; F0.ws = args.ws; F0.ctl = (gu32*)(args.ws + WS_CTL);
    volatile LAS unsigned* MISC = (volatile LAS unsigned*)(F0.lds + MISC_OFF);
    for (int u = F0.tid; u < (LDS_BYTES - RING_BYTES) / 4; u += NTHR) ((LAS unsigned*)(F0.lds + RING_BYTES))[u] = 0u;
    __syncthreads();
    XcdBarrier bar; bar.bar = (unsigned*)(F0.ctl + CW_BAR); bar.x = 0; bar.st = nullptr;
    if (!MK_PER_PHASE) bar = xcd_barrier_post((unsigned*)(F0.ctl + CW_BAR), MISC + 8);
    const int lo = args.ph_lo, hi = args.ph_hi;
#define IN(k) (lo <= (k) && (k) < hi)
#define SEAM(k) do { if (IN(k) && IN((k) + 1)) { if (MK_PER_PHASE) { if (F0.tid == 0) __hip_atomic_store(F0.ctl + 0, 0xBADBA0u, __ATOMIC_RELAXED, __HIP_MEMORY_SCOPE_AGENT); } else xcd_barrier(bar); } } while (0)

    if (PHM(11) && IN(0)) { const Frame F = launder(F0); _Pragma("nounroll") for (int rep = 0; rep < 1 + REPB(11); ++rep) { phase_prologue_a(F); __syncthreads(); } } SEAM(0);
    if (PHM(12) && IN(1)) { const Frame F = launder(F0); _Pragma("nounroll") for (int rep = 0; rep < 1 + REPB(12); ++rep) { phase_prologue_b(F); __syncthreads(); } } SEAM(1);

    for (int l = 0; l < DEPTH; ++l) {
        const int pb = 2 + PH_PER_LAYER * l;
        const bool with_ctx = l < DEPTH - 1, moe = l & 1; const int fi = l >> 1;
        const int mrows = with_ctx ? MTOT : NLAT, mtiles = with_ctx ? 132 : 128;
        if (PHM(0) && IN(pb + 0)) { const Frame F = launder(F0);
            pg8::SchedGrid S; S.nMa = mtiles; S.nNa = 34; S.nMb = with_ctx ? 0 : 4; S.nNb = 18; S.total = S.nMa * S.nNa + S.nMb * S.nNb; S.G = F.G; S.c = F.vcu;
            S.A = (const char*)(F.ws + WS_HB); S.B = (const char*)(F.ws + WS_WCOMB + l * SZ_WCOMB); S.lda = DM; S.ldb = DM; S.a_div = 1; S.a_cols = 0; S.pe = nullptr; S.estride = 0; S.rep = REPB(0);
            pg8::EpiInGate E{WSP(bf16_t, WS_PRJ), WSP(bf16_t, WS_GT), F.in[I_BGATE] + (size_t)l * 4096};
            pg8::gemm_phase(F.lds, F.tid, DM, DM, DM, S, E);
        }
        SEAM(pb + 0);
        if (PHM(1) && IN(pb + 1)) { const Frame F = launder(F0);
            phase_qkprep_rows(F, l);
            for (int u = F.vcu; u < NB * NCH * 8; u += F.G) { const int hd = u & 7, cidx = (u >> 3) % NCH, b = (u >> 3) / NCH; ssd_s1_unit(F, l, b, cidx, hd); }
        }
        SEAM(pb + 1);
        if (PHM(2) && IN(pb + 2)) { const Frame F = launder(F0); phase_scan(F); }
        SEAM(pb + 2);
        if (PHM(3) && IN(pb + 3)) { const Frame F = launder(F0);
            const int nchs = with_ctx ? NCH : NCH - 2, n_s3 = NB * nchs * 8, n_cx = with_ctx ? 96 : 0, total = 3072 + n_s3 + n_cx;
            _Pragma("nounroll") for (int rep = 0; rep < 1 + REPB(3); ++rep) {
            for (int u = F.vcu; u < 1024; u += F.G) {
                const int qblk = u & 31, hg = (u >> 5) & 3, kvh = (u >> 7) & 1, b = u >> 8, hq = kvh * 4 + hg;
                const ga_body::bf16* P = (const ga_body::bf16*)(F.ws + WS_PRJ); const size_t lat0 = (size_t)(b * SEQ) * PRJW, ctx0 = (size_t)(NLAT + b * CTXL) * PRJW;
                ga_body::attn_unit<8>(qblk, P + lat0 + C_GAQ + hq * 64, P + lat0 + C_GAK + kvh * 64, P + lat0 + C_GAV + kvh * 64, P + ctx0 + C_GAK + kvh * 64, P + ctx0 + C_GAV + kvh * 64,
                                      (ga_body::bf16*)(F.ws + WS_OC) + (size_t)(b * SEQ) * OCW + 1024 + hq * 64, (char*)F.lds, F.tid);
            }
            const Frame Fb = launder(F0);
            for (int u = 1024 + Fb.vcu; u < total; u += Fb.G) { const Frame& F = Fb;
                if (u < 2048) { const int v = u - 1024, qblk = v & 31, hq = (v >> 5) & 7, b = v >> 8; attn_unit(F, l, 0, false, b, hq, qblk); }
                else if (u < 3072) { const int v = u - 2048, qblk = v & 31, hg = (v >> 5) & 3, kvh = (v >> 7) & 1, b = v >> 8; attn_unit(F, l, 1, false, b, kvh * 4 + hg, qblk); }
                else if (u < 3072 + n_s3) { const int v = u - 3072, hd = v & 7, cc = (v >> 3) % nchs, b = (v >> 3) / nchs; ssd_s3_unit(F, l, b, with_ctx ? cc : cc + 2, hd); }
                else { const int v = u - 3072 - n_s3, mode = v >> 5, b = (v >> 3) & 3, hq = v & 7; attn_unit(F, l, mode, true, b, hq, 0); }
            }
            }
        }
        SEAM(pb + 3);
        if (PHM(4) && IN(pb + 4)) { const Frame F = launder(F0);
            pg8::SchedBranch S; S.rep = REPB(4); S.T = mtiles * 4; S.G = F.G; S.c = F.vcu; S.A = (const char*)(F.ws + WS_OC); S.B = (const char*)(F.ws + WS_WB + l * SZ_WB);
            pg8::EpiBranch E{WSP(bf16_t, WS_GT), WSP(float, WS_SSQ), WSP(float, WS_ST), WSP(bf16_t, WS_PRJ)};
            pg8::gemm_phase(F.lds, F.tid, 512, OCW, 512, S, E);
        }
        SEAM(pb + 4);
        if (PHM(5) && IN(pb + 5)) { const Frame F = launder(F0);
            pg8::SchedGrid S; S.nMa = mtiles; S.nNa = 4; S.nMb = 0; S.nNb = 1; S.total = S.nMa * S.nNa; S.G = F.G; S.c = F.vcu;
            S.A = (const char*)(F.ws + WS_PRJ); S.B = (const char*)(F.ws + WS_WO + l * SZ_WO); S.lda = DM; S.ldb = DM; S.a_div = 1; S.a_cols = 0; S.pe = nullptr; S.estride = 0; S.rep = REPB(5);
            pg8::EpiResid E{WSP(float, WS_XS), WSP(float, WS_MVEC) + (size_t)l * 5 * 6144 + 2048, nullptr, WSP(bf16_t, WS_END)};
            pg8::gemm_phase(F.lds, F.tid, DM, DM, DM, S, E);
        }
        SEAM(pb + 5);
        if (PHM(6) && IN(pb + 6)) { const Frame F = launder(F0); phase_ln1(F, l, mrows); }
        SEAM(pb + 6);
        if (moe) { if (PHM(7) && IN(pb + 7)) { const Frame F = launder(F0); phase_gather(F, l, mrows); } SEAM(pb + 7); }
        if (PHM(8) && IN(pb + 8)) { const Frame F = launder(F0);
            pg8::SchedGrid S; S.rep = REPB(8); S.nMb = 0; S.nNb = 1; S.G = F.G; S.c = F.vcu; S.lda = DM; S.ldb = DM; S.a_div = 1; S.a_cols = 0; S.pe = nullptr; S.estride = 0; int ldh;
            if (!moe) { S.nMa = mtiles; S.nNa = DFF / 128; S.A = (const char*)(F.ws + WS_HB); S.B = (const char*)(F.ws + WS_WUP + fi * SZ_WUP); ldh = DFF; }
            else { const int npad = moe_pad_ends_lds(F, fi); S.pe = (const LAS int*)(F.lds + MISC_OFF + 64); S.nMa = npad / 256; S.nNa = DFFE / 128;
                   S.A = (const char*)(F.ws + WS_XPAD); S.B = (const char*)(F.ws + WS_MUP + fi * SZ_MUP); S.estride = (size_t)2 * DFFE * DM * 2; ldh = DFFE; }
            S.total = S.nMa * S.nNa;
            pg8::EpiSwiGLU E{WSP(bf16_t, WS_HID), ldh};
            pg8::gemm_phase(F.lds, F.tid, DM, DM, DM, S, E);
        }
        SEAM(pb + 8);
        if (PHM(9) && IN(pb + 9)) { const Frame F = launder(F0);
            pg8::SchedGrid S; S.rep = REPB(9); S.nMb = 0; S.nNb = 1; S.nNa = 4; S.G = F.G; S.c = F.vcu; S.a_div = 1; S.a_cols = 0; S.pe = nullptr; S.estride = 0; S.A = (const char*)(F.ws + WS_HID);
            pg8::EpiResid E{WSP(float, WS_XS), WSP(float, WS_MVEC) + (size_t)l * 5 * 6144 + 5120, nullptr, WSP(bf16_t, WS_END)};
            int kk;
            if (!moe) { S.nMa = mtiles; S.B = (const char*)(F.ws + WS_WDN + fi * SZ_WDN); kk = DFF; }
            else { const int npad = moe_pad_ends_lds(F, fi); S.pe = (const LAS int*)(F.lds + MISC_OFF + 64); S.nMa = npad / 256; S.B = (const char*)(F.ws + WS_MDN + fi * SZ_MDN); S.estride = (size_t)DM * DFFE * 2; kk = DFFE; E.plainO = WSP(bf16_t, WS_YPAD); }
            S.lda = kk; S.ldb = kk; S.total = S.nMa * S.nNa;
            pg8::gemm_phase(F.lds, F.tid, kk, kk, kk, S, E);
        }
        SEAM(pb + 9);
        if (PHM(10) && IN(pb + 10)) { const Frame F = launder(F0); phase_ln2(F, l, mrows); }
        if (l + 1 < DEPTH) SEAM(pb + 10);
    }
#undef IN
#undef SEAM
}

extern "C" void kernel_launch(void* const* d_in, const int* in_sizes, int n_in, void* d_out, int out_size, void* d_ws, size_t ws_size, hipStream_t stream) {
    static int grid = 0;
    if (grid == 0) {
        if (n_in != 31 || in_sizes[0] != NLAT * DM || out_size != NLAT * DM || ws_size < WS_END) {
            fprintf(stderr, "kernel_launch: unexpected shapes: n_in %d in0 %d out %d ws %zu (need %zu); nothing launched\n", n_in, n_in > 0 ? in_sizes[0] : -1, out_size, ws_size, (size_t)WS_END); grid = -1; return; }
        int dev = 0, cus = 0, per_cu = 0;
        if (hipGetDevice(&dev) != hipSuccess || hipDeviceGetAttribute(&cus, hipDeviceAttributeMultiprocessorCount, dev) != hipSuccess) { fprintf(stderr, "kernel_launch: device query failed\n"); grid = -1; return; }
        if (hipFuncSetAttribute((const void*)fwd_kernel, hipFuncAttributeMaxDynamicSharedMemorySize, LDS_BYTES) != hipSuccess) { fprintf(stderr, "kernel_launch: hipFuncSetAttribute failed\n"); grid = -1; return; }
        if (hipOccupancyMaxActiveBlocksPerMultiprocessor(&per_cu, (const void*)fwd_kernel, NTHR, LDS_BYTES) != hipSuccess || per_cu < 1)
            fprintf(stderr, "kernel_launch: note: occupancy query reports %d workgroups per CU\n", per_cu);
        (void)hipGetLastError();
        grid = cus;
    }
    if (grid < 0) return;
    if (hipMemsetAsync((char*)d_ws + WS_CTL, 0, CTL_ZERO_BYTES, stream) != hipSuccess) { fprintf(stderr, "kernel_launch: memset failed\n"); return; }
    Args a{};
    for (int i = 0; i < 31; ++i) a.in[i] = (const float*)d_in[i];
    a.out = (float*)d_out; a.ws = (unsigned char*)d_ws;
#if MK_PER_PHASE
    for (int p = 0; p < N_PHASES; ++p) { a.ph_lo = p; a.ph_hi = p + 1; hipLaunchKernelGGL(fwd_kernel, dim3(grid), dim3(NTHR), LDS_BYTES, stream, a); }
#else
    a.ph_lo = 0; a.ph_hi = N_PHASES;
    hipLaunchKernelGGL(fwd_kernel, dim3(grid), dim3(NTHR), LDS_BYTES, stream, a);
#endif
    const hipError_t le = hipPeekAtLastError();
    if (le != hipSuccess) fprintf(stderr, "kernel_launch: launch failed: %s\n", hipGetErrorName(le));
}
```

```cpp
#include <hip/hip_runtime.h>
#include <cstdio>
#include <cstdint>
#include <hip/hip_bf16.h>
#include <cmath>

#define DI __device__ __forceinline__
#define LAS __attribute__((address_space(3)))
#define GAS __attribute__((address_space(1)))
typedef unsigned short bf16_t;
typedef short bf16x8 __attribute__((ext_vector_type(8)));
typedef short s16x4 __attribute__((ext_vector_type(4)));
typedef float f32x2 __attribute__((ext_vector_type(2)));
typedef float f32x4 __attribute__((ext_vector_type(4)));
typedef float f32x16 __attribute__((ext_vector_type(16)));
typedef unsigned u32x2 __attribute__((ext_vector_type(2)));
typedef unsigned u32x4 __attribute__((ext_vector_type(4)));
typedef __bf16 bf16x2_t __attribute__((ext_vector_type(2)));
typedef GAS unsigned gu32;

#ifndef MK_PER_PHASE
#define MK_PER_PHASE 0
#endif
#ifndef PHMASK
#define PHMASK 0xFFFF
#endif
#define PHM(k) ((PHMASK >> (k)) & 1)
#ifndef REP_MASK
#define REP_MASK 0
#endif
#define REPB(k) ((REP_MASK >> (k)) & 1)
#ifndef ABL
#define ABL 0
#endif

constexpr int DM = 1024, NB = 4, SEQ = 8192, CTXL = 256, NLAT = NB * SEQ, NCTX = NB * CTXL, MTOT = NLAT + NCTX;
constexpr int DEPTH = 4, DIN = 4624, PRJW = 4608, GTW = 4096, NCOMB = PRJW + GTW, OCW = 2048;
constexpr int DFF = 2816, DFFE = 3584, NEXP = 8, MOE_ROWS_MAX = 69632;
constexpr int NCH = 66;
constexpr float ALPHA = 1.6817928305074292f;
constexpr float LOG2E = 1.4426950408889634f;
constexpr float C2 = 0.125f * LOG2E;
constexpr float LN_EPS = 1e-5f, RMS_EPS = 1e-6f;
constexpr int C_NAQ = 0, C_NAK = 512, C_NAV = 1024, C_SWQ = 1536, C_SWK = 2048, C_SWV = 2176, C_GAQ = 2304, C_GAK = 2816, C_GAV = 2944, C_Z = 3072, C_XBC = 3584;

constexpr size_t KiB = 1024, MiB = 1u << 20;
constexpr size_t WS_CTL = 0, CTL_ZERO_BYTES = 1 * MiB;
constexpr size_t WS_MVEC = 1 * MiB;
constexpr size_t WS_ROPE = WS_MVEC + 512 * KiB;
constexpr size_t WS_DT = 4 * MiB;
constexpr size_t WS_SSQ = WS_DT + (size_t)MTOT * 16 * 4;
constexpr size_t WS_SLOT = WS_SSQ + (size_t)MTOT * 8 * 4;
constexpr size_t WS_CDEC = WS_SLOT + (size_t)MTOT * 8 * 4;
constexpr size_t WS_W = 10 * MiB;
constexpr size_t SZ_WCOMB = (size_t)NCOMB * DM * 2, SZ_WB = (size_t)4096 * 512 * 2, SZ_WO = (size_t)1024 * 4096 * 2;
constexpr size_t SZ_WUP = (size_t)2 * DFF * DM * 2, SZ_WDN = (size_t)DM * DFF * 2, SZ_MUP = (size_t)NEXP * 2 * DFFE * DM * 2, SZ_MDN = (size_t)NEXP * DM * DFFE * 2;
constexpr size_t WS_WCOMB = WS_W, WS_WB = WS_WCOMB + 4 * SZ_WCOMB, WS_WO = WS_WB + 4 * SZ_WB, WS_WUP = WS_WO + 4 * SZ_WO, WS_WDN = WS_WUP + 2 * SZ_WUP,
                 WS_MUP = WS_WDN + 2 * SZ_WDN, WS_MDN = WS_MUP + 2 * SZ_MUP, WS_WEND = WS_MDN + 2 * SZ_MDN;
constexpr size_t WS_XS = (WS_WEND + 255) & ~(size_t)255;
constexpr size_t WS_HB = WS_XS + (size_t)MTOT * DM * 4;
constexpr size_t WS_U = WS_HB + (size_t)MTOT * DM * 2;
constexpr size_t WS_PRJ = WS_U;
constexpr size_t WS_GT = WS_PRJ + (size_t)MTOT * PRJW * 2;
constexpr size_t WS_OC = WS_GT + (size_t)MTOT * GTW * 2;
constexpr size_t WS_ST = WS_OC + (size_t)MTOT * OCW * 2;
constexpr size_t WS_UEND = WS_ST + (size_t)NB * NCH * 16 * 8192 * 4;
constexpr size_t WS_HID = WS_U;
constexpr size_t WS_XPAD = WS_HID + (size_t)MOE_ROWS_MAX * DFFE * 2;
constexpr size_t WS_YPAD = WS_XPAD + (size_t)MOE_ROWS_MAX * DM * 2;
static_assert(WS_YPAD + (size_t)MOE_ROWS_MAX * DM * 2 <= WS_UEND, "FFN overlay fits the union region");
constexpr size_t WS_END = WS_UEND;
constexpr int CW_BAR = 4096, CW_MOECNT = 16384;

constexpr int RING_BYTES = 131072, MISC_OFF = RING_BYTES + 320, LDS_BYTES = 147456;
constexpr int NWAVES = 8, NTHR = 512;

DI unsigned pk2(float lo, float hi) { f32x2 v = {lo, hi}; bf16x2_t b = __builtin_convertvector(v, bf16x2_t); return __builtin_bit_cast(unsigned, b); }
DI float bflo(unsigned u) { return __uint_as_float(u << 16); }
DI float bfhi(unsigned u) { return __uint_as_float(u & 0xffff0000u); }
DI float sigm(float x) { return __builtin_amdgcn_rcpf(1.f + __expf(-x)); }
DI float silu(float x) { return x * sigm(x); }
DI float wave_sum(float v) {
#pragma unroll
    for (int o = 1; o < 64; o <<= 1) v += __shfl_xor(v, o);
    return v;
}
DI int clampi(int v, int lo, int hi) { return v < lo ? lo : (v > hi ? hi : v); }
#define MFMA32(a, b, c) __builtin_amdgcn_mfma_f32_32x32x16_bf16((a), (b), (c), 0, 0, 0)
DI int crow(int reg, int h) { return (reg & 3) + 8 * (reg >> 2) + 4 * h; }
typedef short v4i16_t __attribute__((ext_vector_type(4)));
DI s16x4 tr_read(const LAS unsigned char* p) { return __builtin_bit_cast(s16x4, __builtin_amdgcn_ds_read_tr16_b64_v4i16((LAS v4i16_t*)p)); }
DI bf16x8 cat8(s16x4 lo, s16x4 hi) { return __builtin_shufflevector(lo, hi, 0, 1, 2, 3, 4, 5, 6, 7); }
template <int S> DI bf16x8 pack8(const f32x16& x) {
    u32x4 w; w.x = pk2(x[8 * S], x[8 * S + 1]); w.y = pk2(x[8 * S + 2], x[8 * S + 3]); w.z = pk2(x[8 * S + 4], x[8 * S + 5]); w.w = pk2(x[8 * S + 6], x[8 * S + 7]);
    return __builtin_bit_cast(bf16x8, w);
}

#define XB_TMO      128
#define XB_XCNT(j)  (256  + 64 * (j))
#define XB_XSUB(j)  (1280 + 64 * (j))
#define XB_XGEN(j)  (2304 + 64 * (j))
#define XB_TOP      3328
#define XB_TOPGEN   3392
#define XCD_BAR_WORDS 3456
#define XB_SPIN_CAP (1u << 18)
DI unsigned xb_ld(unsigned* p)              { return __hip_atomic_load(p, __ATOMIC_RELAXED, __HIP_MEMORY_SCOPE_AGENT); }
DI unsigned xb_add(unsigned* p, unsigned v) { return __hip_atomic_fetch_add(p, v, __ATOMIC_RELAXED, __HIP_MEMORY_SCOPE_AGENT); }
DI unsigned xb_xcc_id() { return (unsigned)__builtin_amdgcn_s_getreg((3 << 11) | 20) & 0xFu; }
#define XB_SPIN(cond, bar) do { unsigned _sp = 0; while (cond) { __builtin_amdgcn_s_sleep(1); \
    if ((++_sp & 255u) == 0u) { if (xb_ld(&(bar)[XB_TMO])) break; if (_sp > XB_SPIN_CAP) { atomicAdd(&(bar)[XB_TMO], 1u); break; } } } } while (0)
struct XcdBarrier { unsigned* bar; unsigned x; volatile LAS unsigned* st; };
DI XcdBarrier xcd_barrier_post(unsigned* bar, volatile LAS unsigned* st) {
    XcdBarrier b; b.bar = bar; b.x = xb_xcc_id(); b.st = st;
    if (threadIdx.x == 0) (void)xb_add(&bar[XB_XCNT(b.x)], 1u);
    return b;
}
DI void xcd_barrier_complete(unsigned* bar, unsigned x, unsigned& nloc, unsigned& nx) {
    const unsigned G = gridDim.x * gridDim.y * gridDim.z;
    unsigned sum, cnt, mine, sp = 0u;
    for (;;) {
        sum = 0u; cnt = 0u; mine = 0u;
#pragma unroll
        for (unsigned j = 0; j < 16; ++j) { const unsigned c = xb_ld(&bar[XB_XCNT(j)]); sum += c; cnt += (c > 0u) ? 1u : 0u; mine = (j == x) ? c : mine; }
        if (sum == G) break;
        __builtin_amdgcn_s_sleep(1);
        if ((++sp & 255u) == 0u) { if (xb_ld(&bar[XB_TMO])) break; if (sp > XB_SPIN_CAP) { atomicAdd(&bar[XB_TMO], 1u); break; } }
    }
    nloc = mine > 0u ? mine : 1u; nx = cnt > 0u ? cnt : 1u;
}
DI void xcd_barrier(const XcdBarrier& b) {
    asm volatile("s_waitcnt vmcnt(0)" ::: "memory");
    __syncthreads();
    if (threadIdx.x == 0) {
        unsigned* bar = b.bar;
        __builtin_amdgcn_s_waitcnt(0);
        unsigned nloc = b.st[0], nx = b.st[1];
        if (nloc == 0u) { xcd_barrier_complete(bar, b.x, nloc, nx); b.st[0] = nloc; b.st[1] = nx; }
        const unsigned old = xb_add(&bar[XB_XSUB(b.x)], 1u);
        const unsigned gen = old / nloc;
        if (old + 1u == (gen + 1u) * nloc) {
            __builtin_amdgcn_fence(__ATOMIC_RELEASE, "agent");
            asm volatile("s_waitcnt vmcnt(0)" ::: "memory");
            const unsigned og = xb_add(&bar[XB_TOP], 1u);
            const unsigned tg = og / nx;
            if (og + 1u == (tg + 1u) * nx) xb_add(&bar[XB_TOPGEN], 1u);
            else XB_SPIN(xb_ld(&bar[XB_TOPGEN]) == tg, bar);
            __builtin_amdgcn_fence(__ATOMIC_ACQUIRE, "agent");
            xb_add(&bar[XB_XGEN(b.x)], 1u);
            asm volatile("s_waitcnt vmcnt(0)" ::: "memory");
        } else {
            XB_SPIN(xb_ld(&bar[XB_XGEN(b.x)]) == gen, bar);
            __builtin_amdgcn_fence(__ATOMIC_ACQUIRE, "agent");
            asm volatile("s_waitcnt vmcnt(0)" ::: "memory");
        }
    }
    __syncthreads();
}

namespace pg8 {
constexpr int BM = 256, BK = 64, HALF = 128, HTB = HALF * BK * 2, STAGE_BYTES = 8 * HTB;
__host__ __device__ __forceinline__ int lds_byte(int r, int c) { const int st = (r >> 4) * 2 + (c >> 5), rr = r & 15, cc = c & 31, ob = rr * 64 + cc * 2; return st * 1024 + (ob ^ (((ob >> 9) & 1) << 5)); }
__host__ __device__ __forceinline__ void stage_rc(int b, int& R, int& C) { const int st = b / 1024, sb = b % 1024, swz = sb ^ (((sb >> 9) & 1) << 5); R = (st >> 1) * 16 + swz / 64; C = (st & 1) * 32 + (swz % 64) / 2; }
__host__ __device__ __forceinline__ int perm32(int rho) { const int n = rho >> 4, i = rho & 15; return 8 * (i >> 2) + 4 * n + (i & 3); }
struct Unit { int pm, pn, dup; const char* A; const char* B; };

template <class Epi, class Sched, bool HM = false>
DI void gemm_phase(LAS unsigned char* lds, const int tid, const int K, const int lda, const int ldb, const Sched& S, const Epi& E) {
    const int wid = __builtin_amdgcn_readfirstlane(tid >> 6), lane = tid & 63, wr = wid >> 2, wc = wid & 3, fr = lane & 15, fq = lane >> 4;
    const int nt = K / BK;
    unsigned voffA[2], voffB[2];
#pragma unroll
    for (int i = 0; i < 2; ++i) { int R, C; stage_rc(tid * 16 + i * 8192, R, C); const int Rb = (R & ~31) + perm32(R & 31);
        voffA[i] = (unsigned)(R * lda + C) * 2u; voffB[i] = (unsigned)(Rb * ldb + C) * 2u; }
    const size_t kstep = (size_t)(BK * 2);
    const size_t hstepA = (size_t)HALF * lda * 2, hstepB = (size_t)HALF * ldb * 2;
    const unsigned ldsw = (unsigned)wid * 1024u;
    const int aoff = lds_byte(wr * 64 + fr, fq * 8), boff = lds_byte(wc * 32 + fr, fq * 8);
#define PG8_SA(b, h) (((b) * 2 + (h)) * HTB)
#define PG8_SB(b, h) ((4 + (b) * 2 + (h)) * HTB)
#define PG8_STAGE(bufoff, gbase, voff) do { _Pragma("unroll") for (int _i = 0; _i < 2; ++_i) \
        __builtin_amdgcn_global_load_lds((const unsigned*)((const char*)(gbase) + (voff)[_i]), (LAS unsigned*)(lds + (bufoff) + ldsw + _i * 8192), 16, 0, 0); } while (0)
#define PG8_LDA(dst, b, h) do { _Pragma("unroll") for (int m = 0; m < 4; ++m) _Pragma("unroll") for (int k = 0; k < 2; ++k) dst[m][k] = *(const LAS bf16x8*)(lds + PG8_SA(b, h) + aoff + m * 2048 + k * 1024); } while (0)
#define PG8_LDB(dst, b, h) do { _Pragma("unroll") for (int n = 0; n < 2; ++n) _Pragma("unroll") for (int k = 0; k < 2; ++k) dst[n][k] = *(const LAS bf16x8*)(lds + PG8_SB(b, h) + boff + n * 2048 + k * 1024); } while (0)
#define PG8_MMA(ai, bj, At, Bt) do { __builtin_amdgcn_s_setprio(1); _Pragma("unroll") for (int m = 0; m < 4; ++m) _Pragma("unroll") for (int n = 0; n < 2; ++n) _Pragma("unroll") for (int k = 0; k < 2; ++k) \
        acc[ai][bj][m][n] = __builtin_amdgcn_mfma_f32_16x16x32_bf16(Bt[n][k], At[m][k], acc[ai][bj][m][n], 0, 0, 0); __builtin_amdgcn_s_setprio(0); } while (0)
#define PG8_WAIT_V(n) asm volatile("s_waitcnt vmcnt(" #n ")" ::: "memory")
#define PG8_WAIT_L(n) asm volatile("s_waitcnt lgkmcnt(" #n ")" ::: "memory")
#define PG8_BAR __builtin_amdgcn_s_barrier()
#define PG8_SCHED __builtin_amdgcn_sched_barrier(0)
    Unit cur, nxt; int ui = 0;
    if (!S.next(0, cur)) return;
    f32x4 acc[2][2][4][2];
#pragma unroll
    for (int a = 0; a < 2; ++a)
#pragma unroll
        for (int b = 0; b < 2; ++b)
#pragma unroll
            for (int m = 0; m < 4; ++m)
#pragma unroll
                for (int n = 0; n < 2; ++n) acc[a][b][m][n] = (f32x4){0.f, 0.f, 0.f, 0.f};
    bf16x8 At[4][2], B0[2][2], B1[2][2];
    const char* cA = cur.A; const char* cB = cur.B;
    PG8_STAGE(PG8_SB(0, 0), cB, voffB); PG8_STAGE(PG8_SB(0, 1), cB + hstepB, voffB); PG8_STAGE(PG8_SA(0, 0), cA, voffA); PG8_STAGE(PG8_SA(0, 1), cA + hstepA, voffA);
    if (wr == 1) PG8_BAR;
    PG8_WAIT_V(2); PG8_BAR;
    PG8_STAGE(PG8_SB(1, 0), cB + kstep, voffB); PG8_STAGE(PG8_SA(1, 0), cA + kstep, voffA); PG8_STAGE(PG8_SB(1, 1), cB + hstepB + kstep, voffB);
    PG8_WAIT_V(6); PG8_BAR;
    for (;;) {
        const bool has_next = S.next(ui + 1, nxt);
        const char* nA = has_next ? nxt.A : cA; const char* nB = has_next ? nxt.B : cB;
        for (int t = 0; t < nt; t += 2) {
            const bool last = (t == nt - 2);
            const char* a1 = cA + (size_t)(t + 1) * kstep;
            const char* a2 = last ? nA : cA + (size_t)(t + 2) * kstep; const char* b2 = last ? nB : cB + (size_t)(t + 2) * kstep;
            const char* a3 = a2 + kstep; const char* b3 = b2 + kstep;
            PG8_LDB(B0, 0, 0); PG8_LDB(B1, 0, 1); PG8_SCHED; PG8_LDA(At, 0, 0); PG8_STAGE(PG8_SA(1, 1), a1 + hstepA, voffA);
            PG8_WAIT_V(8); PG8_WAIT_L(0); PG8_BAR; PG8_MMA(0, 0, At, B0); PG8_MMA(0, 1, At, B1); PG8_BAR; PG8_SCHED;
            PG8_LDA(At, 0, 1); PG8_STAGE(PG8_SB(0, 0), b2, voffB); PG8_STAGE(PG8_SB(0, 1), b2 + hstepB, voffB); PG8_STAGE(PG8_SA(0, 0), a2, voffA);
            PG8_WAIT_V(8); PG8_WAIT_L(0); PG8_BAR; if constexpr (!HM) { PG8_MMA(1, 0, At, B0); PG8_MMA(1, 1, At, B1); } PG8_BAR; PG8_SCHED;
            PG8_LDB(B0, 1, 0); PG8_LDB(B1, 1, 1); PG8_SCHED; PG8_LDA(At, 1, 0); PG8_STAGE(PG8_SA(0, 1), a2 + hstepA, voffA);
            PG8_WAIT_V(8); PG8_WAIT_L(0); PG8_BAR; PG8_MMA(0, 0, At, B0); PG8_MMA(0, 1, At, B1); PG8_BAR; PG8_SCHED;
            PG8_LDA(At, 1, 1); PG8_STAGE(PG8_SB(1, 0), b3, voffB); PG8_STAGE(PG8_SB(1, 1), b3 + hstepB, voffB); PG8_STAGE(PG8_SA(1, 0), a3, voffA);
            PG8_WAIT_V(8); PG8_WAIT_L(0); PG8_BAR; if constexpr (!HM) { PG8_MMA(1, 0, At, B0); PG8_MMA(1, 1, At, B1); } PG8_BAR; PG8_SCHED;
        }
        if (wr == 0) PG8_BAR;
        E(acc, cur, wr, wc, fr, fq);
        if (!has_next) break;
#pragma unroll
        for (int a = 0; a < (HM ? 1 : 2); ++a)
#pragma unroll
            for (int b = 0; b < 2; ++b)
#pragma unroll
                for (int m = 0; m < 4; ++m)
#pragma unroll
                    for (int n = 0; n < 2; ++n) acc[a][b][m][n] = (f32x4){0.f, 0.f, 0.f, 0.f};
        cur = nxt; cA = nA; cB = nB; ++ui;
        if (wr == 1) PG8_BAR;
    }
    PG8_WAIT_V(0);
    PG8_BAR;
#undef PG8_SA
#undef PG8_SB
#undef PG8_STAGE
#undef PG8_LDA
#undef PG8_LDB
#undef PG8_MMA
#undef PG8_WAIT_V
#undef PG8_WAIT_L
#undef PG8_BAR
#undef PG8_SCHED
}

struct SchedGrid {
    int nMa, nNa, nMb, nNb, total, G, c; const char* A; const char* B; int lda, ldb, a_div, a_cols; const LAS int* pe; size_t estride; int rep;
    DI bool next(int i, Unit& u) const {
        const long L = (long)(i >> rep) * G + c; if (L >= total) return false;
        u.dup = i & rep;
        const int La = nMa * nNa; int pm, pn;
        if (L < La) { pm = (int)L / nNa; pn = (int)L % nNa; } else { const int r = (int)L - La; pm = nMa + r / nNb; pn = r % nNb; }
        size_t eoff = 0;
        if (pe) { int e = 0;
#pragma unroll
            for (int j = 0; j < 7; ++j) e += (pe[j] <= pm * 256) ? 1 : 0;
            eoff = (size_t)__builtin_amdgcn_readfirstlane(e) * estride; }
        u.pm = pm; u.pn = pn; u.A = A + ((size_t)pm * 256 * lda + (size_t)(pn / a_div) * a_cols) * 2; u.B = B + eoff + (size_t)pn * 256 * ldb * 2; return true;
    }
};

struct SchedBranch {
    int T, G, c; const char* A; const char* B; int rep;
    DI bool next(int n, Unit& u) const {
        const int tile = c + (n >> (2 + rep)) * G; if (tile >= T) return false;
        const int i = n & 3, pm = tile >> 2, pc = tile & 3;
        u.dup = 0; u.pm = pm; u.pn = i * 4 + pc; u.A = A + ((size_t)pm * 128 * OCW + (size_t)i * 512) * 2; u.B = B + (size_t)(i * 1024 + pc * 256) * 512 * 2; return true;
    }
};
struct EpiInGate {
    bf16_t* PRJ; bf16_t* GT; const float* bg;
    DI void operator()(f32x4 (&acc)[2][2][4][2], const Unit& u, int wr, int wc, int fr, int fq) const {
        const int row0 = u.pm * BM + wr * 64 + fr; const bool sg = u.pn >= 18;
        bf16_t* base = sg ? GT : PRJ; const int ldc = sg ? GTW : PRJW; const int col0 = (sg ? (u.pn - 18) : u.pn) * BM + wc * 32 + 8 * fq;
        f32x4 bv[2][2];
#pragma unroll
        for (int bj = 0; bj < 2; ++bj)
#pragma unroll
            for (int n = 0; n < 2; ++n) bv[bj][n] = sg ? *(const f32x4*)(bg + col0 + bj * HALF + 4 * n) : (f32x4){0.f, 0.f, 0.f, 0.f};
#pragma unroll
        for (int ai = 0; ai < 2; ++ai)
#pragma unroll
            for (int m = 0; m < 4; ++m) { bf16_t* rowp = base + (size_t)(row0 + ai * HALF + m * 16) * ldc + col0;
#pragma unroll
                for (int bj = 0; bj < 2; ++bj) { f32x4 v0 = acc[ai][bj][m][0] + bv[bj][0], v1 = acc[ai][bj][m][1] + bv[bj][1];
                    if (sg) { v0 = (f32x4){sigm(v0[0]), sigm(v0[1]), sigm(v0[2]), sigm(v0[3])}; v1 = (f32x4){sigm(v1[0]), sigm(v1[1]), sigm(v1[2]), sigm(v1[3])}; }
                    u32x4 w; w.x = pk2(v0[0], v0[1]); w.y = pk2(v0[2], v0[3]); w.z = pk2(v1[0], v1[1]); w.w = pk2(v1[2], v1[3]);
                    *(u32x4*)(rowp + bj * HALF) = w; } }
    }
};
struct EpiBranch {
    const bf16_t* GT; const float* SSQ; bf16_t* MRG;
    DI void operator()(f32x4 (&acc)[2][2][4][2], const Unit& u, int wr, int wc, int fr, int fq) const {
        const int i = u.pn >> 2, pc = u.pn & 3;
        const int row0 = u.pm * HALF + wr * 64 + fr; const int gcol0 = u.pn * BM + wc * 32 + 8 * fq, col0 = pc * BM + wc * 32 + 8 * fq;
#pragma unroll
        for (int mp = 0; mp < 4; ++mp) {
            u32x4 g[1][2]; float rs[1];
#pragma unroll
            for (int mm = 0; mm < 1; ++mm) { const int row = row0 + (mp + mm) * 16; const bf16_t* gp = GT + (size_t)row * GTW + gcol0;
                g[mm][0] = *(const u32x4*)gp; g[mm][1] = *(const u32x4*)(gp + HALF); rs[mm] = 1.f;
                if (i == 3) { const f32x4 s0 = *(const f32x4*)(SSQ + (size_t)row * 8), s1 = *(const f32x4*)(SSQ + (size_t)row * 8 + 4);
                    rs[mm] = __builtin_amdgcn_rsqf(((s0[0] + s0[1]) + (s0[2] + s0[3]) + (s1[0] + s1[1]) + (s1[2] + s1[3])) * (1.f / 512.f) + RMS_EPS); } }
#pragma unroll
            for (int mm = 0; mm < 1; ++mm) { const int m = mp + mm;
#pragma unroll
                for (int bj = 0; bj < 2; ++bj) { const u32x4 gg = g[mm][bj]; const f32x4 a0 = acc[0][bj][m][0] * rs[mm], a1 = acc[0][bj][m][1] * rs[mm];
                    acc[1][bj][m][0] += (f32x4){bflo(gg.x) * a0[0], bfhi(gg.x) * a0[1], bflo(gg.y) * a0[2], bfhi(gg.y) * a0[3]};
                    acc[1][bj][m][1] += (f32x4){bflo(gg.z) * a1[0], bfhi(gg.z) * a1[1], bflo(gg.w) * a1[2], bfhi(gg.w) * a1[3]}; } }
        }
        if (i == 3) {
#pragma unroll
            for (int m = 0; m < 4; ++m)
#pragma unroll
                for (int bj = 0; bj < 2; ++bj) { const f32x4 t0 = acc[1][bj][m][0], t1 = acc[1][bj][m][1];
                    u32x4 w; w.x = pk2(t0[0], t0[1]); w.y = pk2(t0[2], t0[3]); w.z = pk2(t1[0], t1[1]); w.w = pk2(t1[2], t1[3]);
                    *(u32x4*)(MRG + (size_t)(row0 + m * 16) * DM + col0 + bj * HALF) = w;
                    acc[1][bj][m][0] = (f32x4){0.f, 0.f, 0.f, 0.f}; acc[1][bj][m][1] = (f32x4){0.f, 0.f, 0.f, 0.f}; }
        }
    }
};
struct EpiResid {
    float* XS; const float* mv; bf16_t* plainO; bf16_t* dummy;
    DI void operator()(f32x4 (&acc)[2][2][4][2], const Unit& u, int wr, int wc, int fr, int fq) const {
        const int row0 = u.pm * BM + wr * 64 + fr; const int col0 = u.pn * BM + wc * 32 + 8 * fq;
        if (plainO || u.dup) { bf16_t* const po = plainO ? plainO : dummy;
#pragma unroll
            for (int ai = 0; ai < 2; ++ai)
#pragma unroll
                for (int m = 0; m < 4; ++m) { bf16_t* rowp = po + (size_t)(row0 + ai * HALF + m * 16) * DM + col0;
#pragma unroll
                    for (int bj = 0; bj < 2; ++bj) { const f32x4 v0 = acc[ai][bj][m][0], v1 = acc[ai][bj][m][1];
                        u32x4 w; w.x = pk2(v0[0], v0[1]); w.y = pk2(v0[2], v0[3]); w.z = pk2(v1[0], v1[1]); w.w = pk2(v1[2], v1[3]);
                        *(u32x4*)(rowp + bj * HALF) = w; } }
            return;
        }
        const int v = u.pm < 128 ? (u.pm >> 5) : 4;
        const float* g = mv + (size_t)v * 6144 + col0;
        f32x4 gv[2][2];
#pragma unroll
        for (int bj = 0; bj < 2; ++bj)
#pragma unroll
            for (int n = 0; n < 2; ++n) gv[bj][n] = *(const f32x4*)(g + bj * HALF + 4 * n);
#pragma unroll
        for (int ai = 0; ai < 2; ++ai)
#pragma unroll
            for (int mp = 0; mp < 2; ++mp) {
                f32x4 x[2][2][2];
#pragma unroll
                for (int mm = 0; mm < 2; ++mm) { const float* rowp = XS + (size_t)(row0 + ai * HALF + (2 * mp + mm) * 16) * DM + col0;
#pragma unroll
                    for (int bj = 0; bj < 2; ++bj)
#pragma unroll
                        for (int n = 0; n < 2; ++n) x[mm][bj][n] = *(const f32x4*)(rowp + bj * HALF + 4 * n); }
#pragma unroll
                for (int mm = 0; mm < 2; ++mm) { const int m = 2 * mp + mm; float* rowp = XS + (size_t)(row0 + ai * HALF + m * 16) * DM + col0;
#pragma unroll
                    for (int bj = 0; bj < 2; ++bj)
#pragma unroll
                        for (int n = 0; n < 2; ++n) *(f32x4*)(rowp + bj * HALF + 4 * n) = x[mm][bj][n] * ALPHA + gv[bj][n] * acc[ai][bj][m][n]; }
            }
    }
};
struct EpiSwiGLU {
    bf16_t* HID; int ldc;
    DI void operator()(f32x4 (&acc)[2][2][4][2], const Unit& u, int wr, int wc, int fr, int fq) const {
        const int row0 = u.pm * BM + wr * 64 + fr; const int col0 = u.pn * HALF + wc * 32 + 8 * fq;
#pragma unroll
        for (int ai = 0; ai < 2; ++ai)
#pragma unroll
            for (int m = 0; m < 4; ++m) { bf16_t* rowp = HID + (size_t)(row0 + ai * HALF + m * 16) * ldc + col0;
                const f32x4 g0 = acc[ai][0][m][0], g1 = acc[ai][0][m][1], u0 = acc[ai][1][m][0], u1 = acc[ai][1][m][1];
                u32x4 w; w.x = pk2(silu(g0[0]) * u0[0], silu(g0[1]) * u0[1]); w.y = pk2(silu(g0[2]) * u0[2], silu(g0[3]) * u0[3]);
                w.z = pk2(silu(g1[0]) * u1[0], silu(g1[1]) * u1[1]); w.w = pk2(silu(g1[2]) * u1[2], silu(g1[3]) * u1[3]);
                *(u32x4*)rowp = w; }
    }
};
}

struct Args { const float* in[31]; float* out; unsigned char* ws; int ph_lo, ph_hi; };
enum { I_X = 0, I_C, I_CTX, I_CCTX, I_WMOD, I_BMOD, I_WIN, I_WGATE, I_BGATE, I_RPB, I_SINK, I_QGQ, I_QGK, I_CONVW, I_CONVB, I_DTB, I_ALOG, I_DSKIP, I_NORMG,
       I_WBR, I_WOUT, I_LN1G, I_LN1B, I_LN2G, I_LN2B, I_FUP, I_FDN, I_MRW, I_MRB, I_MUP, I_MDN };
struct Frame {
    LAS unsigned char* lds; gu32* ctl; int tid, lane, wave, vcu, G;
    const float* const* in; float* out; unsigned char* ws;
};
#define WSP(T, off) ((T*)(F.ws + (off)))
DI Frame launder(const Frame& F0) {
    Frame F = F0;
    asm volatile("" : "+v"(F.tid), "+v"(F.lane));
    asm volatile("" : "+s"(F.wave), "+s"(F.vcu), "+s"(F.ws), "+s"(F.lds));
    F.ws = (unsigned char*)(GAS unsigned char*)F.ws;
    return F;
}

DI void transpose_item(const float* W, int ld, bf16_t* dst, int ldk, int koff, int map_h, int rowoff, int cscale, const float* kscale, LAS float* scr, int kb, int nb, int lane) {
    const int k0 = 64 * kb, n0 = 32 * nb;
    float tmp[32];
#pragma unroll
    for (int i = 0; i < 32; ++i) tmp[i] = W[(size_t)(k0 + 2 * i + (lane >> 5)) * ld + n0 + (lane & 31)];
#pragma unroll
    for (int i = 0; i < 32; ++i) scr[(2 * i + (lane >> 5)) * 33 + (lane & 31)] = tmp[i];
    asm volatile("s_waitcnt lgkmcnt(0)" ::: "memory");
    const int c = lane & 7;
    float ks[8];
#pragma unroll
    for (int e = 0; e < 8; ++e) ks[e] = kscale ? kscale[k0 + 8 * c + e] : 1.f;
#pragma unroll
    for (int j = 0; j < 4; ++j) { const int nl = (lane >> 3) + 8 * j, n = n0 + nl; const LAS float* s = scr + (8 * c) * 33 + nl;
        float cs = 1.f; if (cscale && (n < 512 || (n >= 1536 && n < 2048))) cs = C2;
        int drow;
        if (map_h == 0) drow = rowoff + n;
        else if (n < map_h) drow = rowoff + 256 * (n >> 7) + (n & 127);
        else { const int n2 = n - map_h; drow = rowoff + 256 * (n2 >> 7) + 128 + (n2 & 127); }
        u32x4 o; o.x = pk2(s[0 * 33] * ks[0] * cs, s[1 * 33] * ks[1] * cs); o.y = pk2(s[2 * 33] * ks[2] * cs, s[3 * 33] * ks[3] * cs);
        o.z = pk2(s[4 * 33] * ks[4] * cs, s[5 * 33] * ks[5] * cs); o.w = pk2(s[6 * 33] * ks[6] * cs, s[7 * 33] * ks[7] * cs);
        *(u32x4*)(dst + (size_t)drow * ldk + koff + k0 + 8 * c) = o; }
    asm volatile("s_waitcnt lgkmcnt(0)" ::: "memory");
}
struct CvtJob { const float* W; int K, N, ld; bf16_t* dst; int ldk, koff, map_h, rowoff, cscale; const float* kscale; };
DI void get_job(const Frame& F, int j, CvtJob& J) {
    J.koff = 0; J.map_h = 0; J.rowoff = 0; J.cscale = 0; J.kscale = nullptr;
    if (j < 52) {
        const int l = j / 13, r = j % 13;
        if (r == 0) { J.W = F.in[I_WIN] + (size_t)l * DM * DIN; J.K = DM; J.N = PRJW; J.ld = DIN; J.dst = WSP(bf16_t, WS_WCOMB + l * SZ_WCOMB); J.ldk = DM; J.cscale = 1; }
        else if (r < 5) { const int i = r - 1; J.W = F.in[I_WGATE] + ((size_t)l * 4 + i) * DM * DM; J.K = DM; J.N = DM; J.ld = DM; J.dst = WSP(bf16_t, WS_WCOMB + l * SZ_WCOMB); J.ldk = DM; J.rowoff = PRJW + 1024 * i; }
        else if (r < 9) { const int i = r - 5; J.W = F.in[I_WBR] + ((size_t)l * 4 + i) * 512 * DM; J.K = 512; J.N = DM; J.ld = DM; J.dst = WSP(bf16_t, WS_WB + l * SZ_WB); J.ldk = 512; J.rowoff = 1024 * i;
            if (i == 3) J.kscale = F.in[I_NORMG] + l * 512; }
        else { J.W = F.in[I_WOUT] + (size_t)l * DM * DM; J.K = (r == 9) ? DM : 0; J.N = DM; J.ld = DM; J.dst = WSP(bf16_t, WS_WO + l * SZ_WO); J.ldk = DM; }
    } else if (j < 56) {
        const int i = (j - 52) >> 1;
        if (((j - 52) & 1) == 0) { J.W = F.in[I_FUP] + (size_t)i * DM * 2 * DFF; J.K = DM; J.N = 2 * DFF; J.ld = 2 * DFF; J.dst = WSP(bf16_t, WS_WUP + i * SZ_WUP); J.ldk = DM; J.map_h = DFF; }
        else { J.W = F.in[I_FDN] + (size_t)i * DFF * DM; J.K = DFF; J.N = DM; J.ld = DM; J.dst = WSP(bf16_t, WS_WDN + i * SZ_WDN); J.ldk = DFF; }
    } else {
        const int q = j - 56, ie = q >> 1, i = ie >> 3, e = ie & 7;
        if ((q & 1) == 0) { J.W = F.in[I_MUP] + ((size_t)i * NEXP + e) * DM * 2 * DFFE; J.K = DM; J.N = 2 * DFFE; J.ld = 2 * DFFE; J.dst = WSP(bf16_t, WS_MUP + i * SZ_MUP); J.ldk = DM; J.map_h = DFFE; J.rowoff = e * 2 * DFFE; }
        else { J.W = F.in[I_MDN] + ((size_t)i * NEXP + e) * DFFE * DM; J.K = DFFE; J.N = DM; J.ld = DM; J.dst = WSP(bf16_t, WS_MDN + i * SZ_MDN); J.ldk = DFFE; J.rowoff = e * DM; }
    }
}
constexpr int NJOBS = 52 + 4 + 32;

DI void phase_prologue_a(const Frame& F) {
    const int NGW = F.G * NWAVES, gw = F.vcu * NWAVES + F.wave;
    {
        LAS float* sv = (LAS float*)(F.lds + 73728);
        LAS float* red = (LAS float*)(F.lds + 73728 + 20480);
        for (int i = F.tid; i < 5 * 1024; i += NTHR) { const int v = i >> 10, k = i & 1023; const float c = v < 4 ? F.in[I_C][v * DM + k] : F.in[I_CCTX][k]; sv[i] = silu(c); }
        __syncthreads();
        float* MV = WSP(float, WS_MVEC);
        for (int item = F.vcu; item < 4 * 96; item += F.G) {
            const int l = item / 96, n0 = (item % 96) * 64, c = F.tid & 63, ks = F.tid >> 6;
            const float* w = F.in[I_WMOD] + (size_t)l * DM * 6144 + n0 + c;
            float a0 = 0.f, a1 = 0.f, a2 = 0.f, a3 = 0.f, a4 = 0.f;
#pragma unroll 8
            for (int k = ks * 128; k < ks * 128 + 128; ++k) { const float wv = w[(size_t)k * 6144]; a0 += sv[k] * wv; a1 += sv[1024 + k] * wv; a2 += sv[2048 + k] * wv; a3 += sv[3072 + k] * wv; a4 += sv[4096 + k] * wv; }
            red[(ks * 5 + 0) * 64 + c] = a0; red[(ks * 5 + 1) * 64 + c] = a1; red[(ks * 5 + 2) * 64 + c] = a2; red[(ks * 5 + 3) * 64 + c] = a3; red[(ks * 5 + 4) * 64 + c] = a4;
            __syncthreads();
            if (F.tid < 320) { const int v = F.tid >> 6, cc = F.tid & 63; float s = F.in[I_BMOD][l * 6144 + n0 + cc];
#pragma unroll
                for (int q = 0; q < 8; ++q) s += red[(q * 5 + v) * 64 + cc];
                MV[((size_t)l * 5 + v) * 6144 + n0 + cc] = s; }
            __syncthreads();
        }
    }
    {
        float* rc = WSP(float, WS_ROPE); float* rs = rc + SEQ * 32;
        for (int i = F.vcu * NTHR + F.tid; i < SEQ * 32; i += F.G * NTHR) {
            const int t = i >> 5, p = i & 31; const float pos = (p < 16) ? (float)(t >> 6) : (float)(t & 63);
            const float invf = exp2f(-(float)(p & 15) * (13.287712379549449f / 16.f));
            const float ang = pos * invf; const float rev = ang * 0.15915494309189535f; const float fr = rev - rintf(rev);
            rc[i] = __builtin_amdgcn_cosf(fr); rs[i] = __builtin_amdgcn_sinf(fr);
        }
    }
    {
        LAS float* scr = (LAS float*)(F.lds + F.wave * 8448);
        int base = 0;
        for (int j = 0; j < NJOBS; ++j) {
            CvtJob J; get_job(F, j, J);
            const int nblk = J.N / 32, nit = (J.K / 64) * nblk;
            int vid = (gw - base) % NGW; if (vid < 0) vid += NGW;
            for (int it = vid; it < nit; it += NGW) transpose_item(J.W, J.ld, J.dst, J.ldk, J.koff, J.map_h, J.rowoff, J.cscale, J.kscale, scr, it / nblk, it % nblk, F.lane);
            base = (base + nit) % NGW;
        }
    }
}

DI void load_wdt(const Frame& F, int l) {
    LAS float* wd = (LAS float*)F.lds; const float* w = F.in[I_WIN] + (size_t)l * DM * DIN + PRJW;
    for (int i = F.tid; i < DM * 16; i += NTHR) { const int k = i >> 4; wd[(((k & 3) << 8) + (k >> 2)) * 20 + (i & 15)] = w[(size_t)k * DIN + (i & 15)]; }
}
DI void emit_h_dt(const Frame& F, const f32x4 (&xn)[4], const float* mv, int m, const float* dtb) {
    bf16_t* hb = WSP(bf16_t, WS_HB) + (size_t)m * DM; float* DT = WSP(float, WS_DT);
    const LAS float* wd = (const LAS float*)F.lds;
    float acc[16];
#pragma unroll
    for (int c = 0; c < 16; ++c) acc[c] = 0.f;
#pragma unroll
    for (int j = 0; j < 4; ++j) {
        const int k = 4 * F.lane + 256 * j;
        const f32x4 sh = *(const f32x4*)(mv + k), sc = *(const f32x4*)(mv + 1024 + k);
        const f32x4 h = xn[j] * (sc + 1.f) + sh;
        u32x2 w; w.x = pk2(h[0], h[1]); w.y = pk2(h[2], h[3]); *(u32x2*)(hb + k) = w;
#pragma unroll
        for (int e = 0; e < 4; ++e) {
            const LAS f32x4* wr = (const LAS f32x4*)(wd + ((e << 8) + (k >> 2)) * 20);
#pragma unroll
            for (int q = 0; q < 4; ++q) { const f32x4 wv = wr[q]; acc[4 * q] += h[e] * wv[0]; acc[4 * q + 1] += h[e] * wv[1]; acc[4 * q + 2] += h[e] * wv[2]; acc[4 * q + 3] += h[e] * wv[3]; }
            asm volatile("" ::: "memory");
        }
    }
    const bool b0 = F.lane & 1, b1 = F.lane & 2, b2 = F.lane & 4, b3 = F.lane & 8;
    float t8[8], t4[4], t2[2], t1;
#pragma unroll
    for (int i = 0; i < 8; ++i) { const float keep = b0 ? acc[2 * i + 1] : acc[2 * i], give = b0 ? acc[2 * i] : acc[2 * i + 1]; t8[i] = keep + __shfl_xor(give, 1); }
#pragma unroll
    for (int i = 0; i < 4; ++i) { const float keep = b1 ? t8[2 * i + 1] : t8[2 * i], give = b1 ? t8[2 * i] : t8[2 * i + 1]; t4[i] = keep + __shfl_xor(give, 2); }
#pragma unroll
    for (int i = 0; i < 2; ++i) { const float keep = b2 ? t4[2 * i + 1] : t4[2 * i], give = b2 ? t4[2 * i] : t4[2 * i + 1]; t2[i] = keep + __shfl_xor(give, 4); }
    { const float keep = b3 ? t2[1] : t2[0], give = b3 ? t2[0] : t2[1]; t1 = keep + __shfl_xor(give, 8); }
    t1 += __shfl_xor(t1, 16); t1 += __shfl_xor(t1, 32);
    if (F.lane < 16) { const float x = t1 + dtb[F.lane]; const float t = __expf(x); const float sp = t < 0.01f ? t * (1.f + t * (-0.5f + t * (1.f / 3.f))) : __logf(1.f + t); DT[(size_t)m * 16 + F.lane] = x > 15.f ? x : sp; }
}
DI void ln_rows(f32x4 (&v)[4], const float* g, const float* b, int lane) {
    float s = 0.f;
#pragma unroll
    for (int j = 0; j < 4; ++j) s += (v[j][0] + v[j][1]) + (v[j][2] + v[j][3]);
    const float mean = wave_sum(s) * (1.f / DM); float s2 = 0.f;
#pragma unroll
    for (int j = 0; j < 4; ++j) { v[j] = v[j] - mean; s2 += (v[j][0] * v[j][0] + v[j][1] * v[j][1]) + (v[j][2] * v[j][2] + v[j][3] * v[j][3]); }
    const float rstd = 1.f / sqrtf(wave_sum(s2) * (1.f / DM) + LN_EPS);
#pragma unroll
    for (int j = 0; j < 4; ++j) { const int k = 4 * lane + 256 * j; v[j] = v[j] * rstd * *(const f32x4*)(g + k) + *(const f32x4*)(b + k); }
}
DI void phase_prologue_b(const Frame& F) {
    load_wdt(F, 0); __syncthreads();
    const int NGW = F.G * NWAVES, gw = F.vcu * NWAVES + F.wave;
    float* XS = WSP(float, WS_XS); const float* MV = WSP(float, WS_MVEC);
    const float* dtb = F.in[I_DTB];
    for (int m = gw; m < MTOT; m += NGW) {
        const float* src = m < NLAT ? F.in[I_X] + (size_t)m * DM : F.in[I_CTX] + (size_t)(m - NLAT) * DM; const int v = m < NLAT ? (m >> 13) : 4;
        f32x4 x[4];
#pragma unroll
        for (int j = 0; j < 4; ++j) { x[j] = *(const f32x4*)(src + 4 * F.lane + 256 * j); *(f32x4*)(XS + (size_t)m * DM + 4 * F.lane + 256 * j) = x[j]; }
        emit_h_dt(F, x, MV + (size_t)v * 6144, m, dtb);
    }
}
DI void phase_ln1(const Frame& F, int l, int mrows) {
    const bool moe = l & 1; const int mi = l >> 1;
    LAS float* wrt = (LAS float*)F.lds;
    if (moe) { const float* w = F.in[I_MRW] + (size_t)mi * DM * 8; for (int i = F.tid; i < DM * 8; i += NTHR) { const int k = i >> 3; wrt[(((k & 3) << 8) + (k >> 2)) * 12 + (i & 7)] = w[i]; } __syncthreads(); }
    const int NGW = F.G * NWAVES, gw = F.vcu * NWAVES + F.wave;
    float* XS = WSP(float, WS_XS); const float* MV = WSP(float, WS_MVEC) + (size_t)l * 5 * 6144; bf16_t* HB = WSP(bf16_t, WS_HB);
    const float* g = F.in[I_LN1G] + l * DM; const float* b = F.in[I_LN1B] + l * DM;
    unsigned* SL = WSP(unsigned, WS_SLOT); unsigned* gcnt = (unsigned*)F.ctl + CW_MOECNT + mi * 1024;
    int cnt = 0, nst = 0; int me0 = 0, me1 = 0, mr0 = 0, mr1 = 0, mm = 0; float mg0 = 0.f, mg1 = 0.f;
    for (int m = gw; m < mrows; m += NGW) {
        const int v = m < NLAT ? (m >> 13) : 4;
        f32x4 x[4];
#pragma unroll
        for (int j = 0; j < 4; ++j) x[j] = *(const f32x4*)(XS + (size_t)m * DM + 4 * F.lane + 256 * j);
        ln_rows(x, g, b, F.lane);
        float acc[8];
#pragma unroll
        for (int c = 0; c < 8; ++c) acc[c] = 0.f;
        const float* mv = MV + (size_t)v * 6144;
#pragma unroll
        for (int j = 0; j < 4; ++j) {
            const int k = 4 * F.lane + 256 * j;
            *(f32x4*)(XS + (size_t)m * DM + k) = x[j];
            const f32x4 sh = *(const f32x4*)(mv + 3072 + k), sc = *(const f32x4*)(mv + 4096 + k);
            const f32x4 h = x[j] * (sc + 1.f) + sh;
            u32x2 w; w.x = pk2(h[0], h[1]); w.y = pk2(h[2], h[3]); *(u32x2*)(HB + (size_t)m * DM + k) = w;
            if (moe) {
#pragma unroll
                for (int e = 0; e < 4; ++e) { const LAS f32x4* wr = (const LAS f32x4*)(wrt + ((e << 8) + (k >> 2)) * 12);
#pragma unroll
                    for (int q = 0; q < 2; ++q) { const f32x4 wv = wr[q]; acc[4 * q] += h[e] * wv[0]; acc[4 * q + 1] += h[e] * wv[1]; acc[4 * q + 2] += h[e] * wv[2]; acc[4 * q + 3] += h[e] * wv[3]; } }
            }
        }
        if (moe) {
            const bool b0 = F.lane & 1, b1 = F.lane & 2, b2 = F.lane & 4;
            float t4[4], t2[2], t1;
#pragma unroll
            for (int i = 0; i < 4; ++i) { const float keep = b0 ? acc[2 * i + 1] : acc[2 * i], give = b0 ? acc[2 * i] : acc[2 * i + 1]; t4[i] = keep + __shfl_xor(give, 1); }
#pragma unroll
            for (int i = 0; i < 2; ++i) { const float keep = b1 ? t4[2 * i + 1] : t4[2 * i], give = b1 ? t4[2 * i] : t4[2 * i + 1]; t2[i] = keep + __shfl_xor(give, 2); }
            { const float keep = b2 ? t2[1] : t2[0], give = b2 ? t2[0] : t2[1]; t1 = keep + __shfl_xor(give, 4); }
            t1 += __shfl_xor(t1, 8); t1 += __shfl_xor(t1, 16); t1 += __shfl_xor(t1, 32);
            t1 += F.in[I_MRB][mi * 8 + (F.lane & 7)];
            float lg[8];
#pragma unroll
            for (int e = 0; e < 8; ++e) lg[e] = __shfl(t1, e);
            int e0 = 0; float l0 = lg[0];
#pragma unroll
            for (int e = 1; e < 8; ++e) if (lg[e] > l0) { l0 = lg[e]; e0 = e; }
            int e1 = -1; float l1 = -3.0e38f;
#pragma unroll
            for (int e = 0; e < 8; ++e) if (e != e0 && lg[e] > l1) { l1 = lg[e]; e1 = e; }
            const float g1 = 1.f / (1.f + __expf(l0 - l1)), g0 = 1.f - g1;
            const int r0 = __shfl(cnt, e0); if (F.lane == e0) cnt++;
            const int r1 = __shfl(cnt, e1); if (F.lane == e1) cnt++;
            if (F.lane == nst) { me0 = e0; me1 = e1; mr0 = r0; mr1 = r1; mg0 = g0; mg1 = g1; mm = m; }
            ++nst;
        }
        if (moe && (nst == 64 || m + NGW >= mrows)) {
            unsigned base = 0u; if (F.lane < 8) base = __hip_atomic_fetch_add(gcnt + F.lane * 64, (unsigned)cnt, __ATOMIC_RELAXED, __HIP_MEMORY_SCOPE_AGENT);
            const unsigned p0 = __shfl(base, me0) + mr0, p1 = __shfl(base, me1) + mr1;
            if (F.lane < nst) { u32x4 a; a.x = me0; a.y = me1; a.z = p0; a.w = p1; *(u32x4*)(SL + (size_t)mm * 8) = a; u32x2 c; c.x = __float_as_uint(mg0); c.y = __float_as_uint(mg1); *(u32x2*)(SL + (size_t)mm * 8 + 4) = c; }
            cnt = 0; nst = 0;
        }
    }
}
DI void moe_pad_ends(const Frame& F, int mi, int (&pe)[8]) {
    unsigned* gcnt = (unsigned*)F.ctl + CW_MOECNT + mi * 1024; int run = 0;
#pragma unroll
    for (int e = 0; e < 8; ++e) { const int c = (int)__builtin_amdgcn_readfirstlane(__hip_atomic_load(gcnt + e * 64, __ATOMIC_RELAXED, __HIP_MEMORY_SCOPE_AGENT)); run += (c + 255) & ~255; pe[e] = run; }
}
DI int moe_pad_ends_lds(const Frame& F, int mi) {
    int pe[8]; moe_pad_ends(F, mi, pe);
    LAS int* d = (LAS int*)(F.lds + MISC_OFF + 64);
    __syncthreads();
    if (F.tid == 0) {
#pragma unroll
        for (int e = 0; e < 8; ++e) d[e] = pe[e];
    }
    __syncthreads();
    return pe[7];
}
DI void phase_gather(const Frame& F, int l, int mrows) {
    int pe[8]; moe_pad_ends(F, l >> 1, pe);
    const int NGW = F.G * NWAVES, gw = F.vcu * NWAVES + F.wave;
    unsigned* SL = WSP(unsigned, WS_SLOT); const bf16_t* HB = WSP(bf16_t, WS_HB); bf16_t* XP = WSP(bf16_t, WS_XPAD);
    for (int m = gw; m < mrows; m += NGW) {
        const u32x4 a = *(const u32x4*)(SL + (size_t)m * 8);
        int ps0 = 0, ps1 = 0;
#pragma unroll
        for (int e = 1; e < 8; ++e) { if ((int)a.x == e) ps0 = pe[e - 1]; if ((int)a.y == e) ps1 = pe[e - 1]; }
        const int d0 = ps0 + (int)a.z, d1 = ps1 + (int)a.w;
        const u32x4* src = (const u32x4*)(HB + (size_t)m * DM);
        const u32x4 v0 = src[F.lane], v1 = src[64 + F.lane];
        u32x4* q0 = (u32x4*)(XP + (size_t)d0 * DM); u32x4* q1 = (u32x4*)(XP + (size_t)d1 * DM);
        q0[F.lane] = v0; q0[64 + F.lane] = v1; q1[F.lane] = v0; q1[64 + F.lane] = v1;
        if (F.lane == 0) { u32x2 d; d.x = d0; d.y = d1; *(u32x2*)(SL + (size_t)m * 8 + 2) = d; }
    }
}
DI void phase_ln2(const Frame& F, int l, int mrows) {
    const bool moe = l & 1, lastl = (l == DEPTH - 1);
    if (!lastl) { load_wdt(F, l + 1); __syncthreads(); }
    const int NGW = F.G * NWAVES, gw = F.vcu * NWAVES + F.wave;
    float* XS = WSP(float, WS_XS); const float* MVl = WSP(float, WS_MVEC) + (size_t)l * 5 * 6144; const float* MVn = WSP(float, WS_MVEC) + (size_t)(l + 1) * 5 * 6144;
    const float* g = F.in[I_LN2G] + l * DM; const float* b = F.in[I_LN2B] + l * DM;
    const unsigned* SL = WSP(unsigned, WS_SLOT); const bf16_t* YP = WSP(bf16_t, WS_YPAD);
    const float* dtb = F.in[I_DTB] + (lastl ? 0 : (l + 1) * 16);
    for (int m = gw; m < mrows; m += NGW) {
        const int v = m < NLAT ? (m >> 13) : 4;
        f32x4 x[4];
#pragma unroll
        for (int j = 0; j < 4; ++j) x[j] = *(const f32x4*)(XS + (size_t)m * DM + 4 * F.lane + 256 * j);
        if (moe) {
            const u32x4 a = *(const u32x4*)(SL + (size_t)m * 8); const u32x2 gg = *(const u32x2*)(SL + (size_t)m * 8 + 4);
            const float g0 = __uint_as_float(gg.x), g1 = __uint_as_float(gg.y);
            const bf16_t* y0 = YP + (size_t)a.z * DM; const bf16_t* y1 = YP + (size_t)a.w * DM;
#pragma unroll
            for (int j = 0; j < 4; ++j) { const int k = 4 * F.lane + 256 * j; const u32x2 u0 = *(const u32x2*)(y0 + k), u1 = *(const u32x2*)(y1 + k);
                const f32x4 gt = *(const f32x4*)(MVl + (size_t)v * 6144 + 5120 + k);
                f32x4 f; f[0] = g0 * bflo(u0.x) + g1 * bflo(u1.x); f[1] = g0 * bfhi(u0.x) + g1 * bfhi(u1.x); f[2] = g0 * bflo(u0.y) + g1 * bflo(u1.y); f[3] = g0 * bfhi(u0.y) + g1 * bfhi(u1.y);
                if (ABL & 16) f = (f32x4){0.f, 0.f, 0.f, 0.f};
                x[j] = x[j] * ALPHA + gt * f; }
        }
        ln_rows(x, g, b, F.lane);
        if (lastl) {
#pragma unroll
            for (int j = 0; j < 4; ++j) *(f32x4*)(F.out + (size_t)m * DM + 4 * F.lane + 256 * j) = x[j];
        } else {
#pragma unroll
            for (int j = 0; j < 4; ++j) *(f32x4*)(XS + (size_t)m * DM + 4 * F.lane + 256 * j) = x[j];
            emit_h_dt(F, x, MVn + (size_t)v * 6144, m, dtb);
        }
    }
}

DI void phase_qkprep_rows(const Frame& F, int l) {
    const int NGW = F.G * NWAVES, gw = F.vcu * NWAVES + F.wave;
    bf16_t* PRJ = WSP(bf16_t, WS_PRJ); const float* rc = WSP(float, WS_ROPE); const float* rs = rc + SEQ * 32;
    const float* gq = F.in[I_QGQ] + l * 64; const float* gk = F.in[I_QGK] + l * 64;
    const int hs = F.lane >> 4, i2 = 2 * (F.lane & 15);
    for (int m = gw; m < MTOT; m += NGW) {
        const bool lat = m < NLAT; const int t = m & (SEQ - 1);
        float c0 = 1.f, c1 = 1.f, s0 = 0.f, s1 = 0.f;
        if (lat) { const f32x2 cc = *(const f32x2*)(rc + t * 32 + i2), ss = *(const f32x2*)(rs + t * 32 + i2); c0 = cc[0]; c1 = cc[1]; s0 = ss[0]; s1 = ss[1]; }
#pragma unroll
        for (int it = 0; it < 5; ++it) {
            const int hd = it * 4 + hs;
            const int col = hd < 8 ? C_SWQ + 64 * hd : hd < 10 ? C_SWK + 64 * (hd - 8) : hd < 18 ? C_GAQ + 64 * (hd - 10) : C_GAK + 64 * (hd - 18);
            bf16_t* p = PRJ + (size_t)m * PRJW + col + i2;
            const unsigned u1 = *(const unsigned*)p, u2 = *(const unsigned*)(p + 32);
            float a0 = bflo(u1), a1 = bfhi(u1), b0 = bflo(u2), b1 = bfhi(u2);
            if (hd >= 10) {
                float ss = a0 * a0 + a1 * a1 + b0 * b0 + b1 * b1;
                ss += __shfl_xor(ss, 1); ss += __shfl_xor(ss, 2); ss += __shfl_xor(ss, 4); ss += __shfl_xor(ss, 8);
                const float rn = 1.f / sqrtf(ss * (1.f / 64.f) + RMS_EPS); const float* gg = hd < 18 ? gq : gk; const float post = hd < 18 ? C2 : 1.f;
                a0 *= rn * gg[i2] * post; a1 *= rn * gg[i2 + 1] * post; b0 *= rn * gg[32 + i2] * post; b1 *= rn * gg[32 + i2 + 1] * post;
            }
            const float o0 = a0 * c0 - b0 * s0, o1 = a1 * c1 - b1 * s1, q0 = b0 * c0 + a0 * s0, q1 = b1 * c1 + a1 * s1;
            *(unsigned*)p = pk2(o0, o1); *(unsigned*)(p + 32) = pk2(q0, q1);
        }
    }
}

constexpr int AT_KVB = 16384, AT_VOFF = 8192, AT_BIAS = 2 * AT_KVB;
DI void attn_unit(const Frame& Fin, int l, int mode, bool ctxq, int b, int hq, int qblk) {
    const Frame F = launder(Fin);
    const int lane = F.lane, wid = F.wave, tid = F.tid, r = lane & 31, h = lane >> 5;
    const bf16_t* PRJ = WSP(bf16_t, WS_PRJ); bf16_t* OC = WSP(bf16_t, WS_OC);
    int qcol, kcol, vcol, ocol, kvh;
    if (mode == 0) { qcol = C_NAQ; kcol = C_NAK; vcol = C_NAV; ocol = 0; kvh = hq; }
    else if (mode == 1) { qcol = C_SWQ; kcol = C_SWK; vcol = C_SWV; ocol = 512; kvh = hq >> 2; }
    else { qcol = C_GAQ; kcol = C_GAK; vcol = C_GAV; ocol = 1024; kvh = hq >> 2; }
    const int qrow = ctxq ? (NLAT + b * CTXL + 32 * wid + r) : (b * SEQ + 256 * qblk + 32 * wid + r);
    bf16x8 qf[4];
    { const bf16_t* qp = PRJ + (size_t)qrow * PRJW + qcol + hq * 64 + 8 * h;
#pragma unroll
      for (int d0 = 0; d0 < 4; ++d0) qf[d0] = *(const bf16x8*)(qp + 16 * d0); }
    int tl_lo = 0, tl_hi = 0;
    if (!ctxq) {
        if (mode == 0) { tl_lo = clampi(4 * qblk - 4, 0, 120); tl_hi = clampi(4 * qblk - 1, 0, 120) + 8; }
        else if (mode == 1) { tl_lo = 4 * qblk - 2 < 0 ? 0 : 4 * qblk - 2; tl_hi = 4 * qblk + 6 > 128 ? 128 : 4 * qblk + 6; }
        else { tl_lo = 0; tl_hi = 128; }
    }
    const int ntile = 4 + (tl_hi - tl_lo);
    LAS float* biasT = (LAS float*)(F.lds + AT_BIAS);
    __syncthreads();
    if (mode == 0 && !ctxq) { const float* rp = F.in[I_RPB] + ((size_t)l * 8 + hq) * 465; for (int i = tid; i < 465; i += NTHR) biasT[i] = rp[i] * LOG2E; }
    const int lr = tid >> 3, ch = tid & 7;
    const size_t ctxbase = (size_t)(NLAT + b * CTXL), latbase = (size_t)b * SEQ;
    u32x4 kreg, vreg;
#define AT_LOAD(it) do { const size_t rb_ = ((it) < 4 ? ctxbase + 64 * (it) : latbase + 64 * (tl_lo + (it) - 4)) + lr; const bf16_t* rp_ = PRJ + rb_ * PRJW + kvh * 64 + ch * 8; \
        kreg = *(const u32x4*)(rp_ + kcol); vreg = *(const u32x4*)(rp_ + vcol); } while (0)
#define AT_STORE(buf) do { LAS unsigned char* d_ = F.lds + (buf) * AT_KVB; *(LAS u32x4*)(d_ + ch * 1024 + lr * 16) = kreg; *(LAS u32x4*)(d_ + AT_VOFF + (ch >> 2) * 4096 + lr * 64 + (ch & 3) * 16) = vreg; } while (0)
    AT_LOAD(0); AT_STORE(0);
    __syncthreads();
    float mrun = -1e30f, lrun = 0.f;
    if (mode == 1) { mrun = F.in[I_SINK][l * 8 + hq] * LOG2E; lrun = (h == 0) ? 1.f : 0.f; }
    f32x16 o0, o1;
#pragma unroll
    for (int i = 0; i < 16; ++i) { o0[i] = 0.f; o1[i] = 0.f; }
    const int q4 = (lane & 15) >> 2, p4 = lane & 3, blk = (lane >> 4) & 1;
    const int tq = 256 * qblk + 32 * wid + r;
    const int gr = 4 * qblk + (wid >> 1), qc = 32 * (wid & 1) + r, cs = clampi(qc - 8, 0, 48), rsw = clampi(gr - 4, 0, 120);
    for (int it = 0; it < ntile; ++it) {
        const int buf = it & 1;
        if (it + 1 < ntile) AT_LOAD(it + 1);
        const int g = tl_lo + it - 4;
        bool rel = true;
        if (it >= 4) { if (mode == 0) rel = (g >= rsw && g < rsw + 8); else if (mode == 1) rel = (64 * g + 63 >= 256 * qblk + 32 * wid - 128) && (64 * g <= 256 * qblk + 32 * wid + 31 + 128); }
        if (rel) {
            const LAS unsigned char* Kb = F.lds + buf * AT_KVB; const LAS unsigned char* Vb = Kb + AT_VOFF;
            f32x16 p0, p1;
#pragma unroll
            for (int i = 0; i < 16; ++i) { p0[i] = 0.f; p1[i] = 0.f; }
#pragma unroll
            for (int d0 = 0; d0 < 4; ++d0) {
                const bf16x8 k0 = *(const LAS bf16x8*)(Kb + (2 * d0 + h) * 1024 + r * 16);
                const bf16x8 k1 = *(const LAS bf16x8*)(Kb + (2 * d0 + h) * 1024 + 512 + r * 16);
                p0 = MFMA32(k0, qf[d0], p0); p1 = MFMA32(k1, qf[d0], p1);
            }
            if (it >= 4 && mode == 0) {
                int csl = cs; asm volatile("" : "+v"(csl));
                const LAS float* bt = biasT + (g - gr + 7) * 31 + 15 - qc;
#pragma unroll
                for (int i = 0; i < 16; ++i) { const int k0 = crow(i, h), k1 = k0 + 32;
                    p0[i] = (k0 >= csl && k0 < csl + 16) ? p0[i] + bt[k0] : -INFINITY; p1[i] = (k1 >= csl && k1 < csl + 16) ? p1[i] + bt[k1] : -INFINITY; }
            } else if (it >= 4 && mode == 1) {
                const int d0 = 64 * g - tq;
#pragma unroll
                for (int i = 0; i < 16; ++i) { const int dd = d0 + crow(i, h);
                    if (dd > 128 || dd < -128) p0[i] = -INFINITY; if (dd + 32 > 128 || dd + 32 < -128) p1[i] = -INFINITY; }
            }
            float mx = p0[0];
#pragma unroll
            for (int i = 1; i < 16; ++i) mx = fmaxf(mx, p0[i]);
#pragma unroll
            for (int i = 0; i < 16; ++i) mx = fmaxf(mx, p1[i]);
            mx = fmaxf(mx, __shfl_xor(mx, 32));
            const float mnew = fmaxf(mrun, mx), alpha = __builtin_amdgcn_exp2f(mrun - mnew); mrun = mnew;
            float ls = 0.f;
#pragma unroll
            for (int i = 0; i < 16; ++i) { p0[i] = __builtin_amdgcn_exp2f(p0[i] - mnew); p1[i] = __builtin_amdgcn_exp2f(p1[i] - mnew); ls += p0[i] + p1[i]; }
            lrun = lrun * alpha + ls;
            if (__any(alpha != 1.f)) {
#pragma unroll
                for (int i = 0; i < 16; ++i) { o0[i] *= alpha; o1[i] *= alpha; }
            }
            bf16x8 pa[4]; pa[0] = pack8<0>(p0); pa[1] = pack8<1>(p0); pa[2] = pack8<0>(p1); pa[3] = pack8<1>(p1);
            const LAS unsigned char* va = Vb + (4 * h + q4) * 64 + blk * 32 + p4 * 8;
#pragma unroll
            for (int ks = 0; ks < 4; ++ks) {
                const bf16x8 v0 = cat8(tr_read(va + ks * 1024), tr_read(va + ks * 1024 + 512));
                const bf16x8 v1 = cat8(tr_read(va + ks * 1024 + 4096), tr_read(va + ks * 1024 + 4096 + 512));
                o0 = MFMA32(v0, pa[ks], o0); o1 = MFMA32(v1, pa[ks], o1);
            }
        }
        if (it + 1 < ntile) AT_STORE(buf ^ 1);
        __syncthreads();
    }
#undef AT_LOAD
#undef AT_STORE
    const float lt = lrun + __shfl_xor(lrun, 32), inv = 1.f / lt;
    bf16_t* op = OC + (size_t)qrow * OCW + ocol + hq * 64 + 4 * h;
#pragma unroll
    for (int g4 = 0; g4 < 4; ++g4) {
        u32x2 w; w.x = pk2(o0[4 * g4] * inv, o0[4 * g4 + 1] * inv); w.y = pk2(o0[4 * g4 + 2] * inv, o0[4 * g4 + 3] * inv); *(u32x2*)(op + 8 * g4) = w;
        u32x2 w2; w2.x = pk2(o1[4 * g4] * inv, o1[4 * g4 + 1] * inv); w2.y = pk2(o1[4 * g4 + 2] * inv, o1[4 * g4 + 3] * inv); *(u32x2*)(op + 32 + 8 * g4) = w2;
    }
}

namespace ga_body {
using bf16=__hip_bfloat16;
using bf16x8=__attribute__((ext_vector_type(8)))short;
using s16x4=__attribute__((ext_vector_type(4)))short;
using f32x16=__attribute__((ext_vector_type(16)))float;
using u32x4=__attribute__((ext_vector_type(4)))unsigned;
constexpr int SEQ=8192,D=64,PQ=4608,PO=2048,NCTXT=4;
constexpr int NW=8,QBLK=32,QB=QBLK*NW,KVBLK=64,NQB=SEQ/QB;
__device__ __forceinline__ int crow(int r,int hi){return (r&3)+8*(r>>2)+4*hi;}
#define SBAR() __builtin_amdgcn_sched_barrier(0)
__device__ __forceinline__ void cmask(f32x16&p0,f32x16&p1,int jb,int qrel,int hi){
  const float NEG=-INFINITY; int kb=64*jb+4*hi;
  #pragma unroll
  for(int r=0;r<16;++r){int kv=kb+(r&3)+8*(r>>2); if(kv>qrel)p0[r]=NEG; if(kv+32>qrel)p1[r]=NEG;}
}

constexpr int NSLOT=3, SLOTB=8192;
constexpr int LDS_K=0, LDS_V=NSLOT*SLOTB, LDS_WS=2*NSLOT*SLOTB, LDS_OST=LDS_WS+NW*64*4, LDS_BYTES=LDS_OST+NW*4096;
constexpr float C2=0.125f*1.4426950408889634f;
__device__ __forceinline__ void glds16(const void*gsrc,unsigned lds_dst){unsigned keep;
  asm volatile("s_mov_b32 %0, m0\n\ts_mov_b32 m0, %2\n\ts_nop 0\n\tglobal_load_lds_dwordx4 %1, off\n\ts_mov_b32 m0, %0":"=&s"(keep):"v"(gsrc),"s"(lds_dst):"memory");}
__device__ __forceinline__ float max3f(float a,float b,float c){float r;asm("v_max3_f32 %0, %1, %2, %3":"=v"(r):"v"(a),"v"(b),"v"(c));return r;}
__device__ __forceinline__ float max2f(float a,float b){float r;asm("v_max_f32_e32 %0, %1, %2":"=v"(r):"v"(a),"v"(b));return r;}
__device__ __forceinline__ float fadd_s(float a,float b){float r;asm("v_add_f32_e32 %0, %1, %2":"=v"(r):"v"(a),"v"(b));return r;}
__device__ __forceinline__ float fsub_s(float a,float b){float r;asm("v_sub_f32_e32 %0, %1, %2":"=v"(r):"v"(a),"v"(b));return r;}
typedef float f32x2_t __attribute__((ext_vector_type(2))); typedef __bf16 bf16x2_t __attribute__((ext_vector_type(2)));
__device__ __forceinline__ unsigned cvtpk_s(float lo,float hi){f32x2_t v={lo,hi};bf16x2_t b=__builtin_convertvector(v,bf16x2_t);return __builtin_bit_cast(unsigned,b);}
#define WAIT_BAR(N) asm volatile("s_waitcnt vmcnt(" #N ") lgkmcnt(0)\n\ts_barrier":::"memory")

__device__ __forceinline__ void qkt(f32x16&p0,f32x16&p1,const char*Kslot,const bf16x8*qr,const f32x16&negm,int r32,int hi){
  const char*kb=Kslot+hi*1024+r32*16;
  #pragma unroll
  for(int d0=0;d0<4;++d0){
    const bf16x8 b0=*reinterpret_cast<const bf16x8*>(kb+d0*2048);
    const bf16x8 b1=*reinterpret_cast<const bf16x8*>(kb+d0*2048+512);
    if(d0==0){p0=__builtin_amdgcn_mfma_f32_32x32x16_bf16(b0,qr[0],negm,0,0,0);p1=__builtin_amdgcn_mfma_f32_32x32x16_bf16(b1,qr[0],negm,0,0,0);}
    else{p0=__builtin_amdgcn_mfma_f32_32x32x16_bf16(b0,qr[d0],p0,0,0,0);p1=__builtin_amdgcn_mfma_f32_32x32x16_bf16(b1,qr[d0],p1,0,0,0);}}
}
typedef __attribute__((address_space(3))) const char* lds_cptr;
typedef short v4i16_t __attribute__((ext_vector_type(4)));
__device__ __forceinline__ void kload8(bf16x8*kf,lds_cptr kp){
  kf[0]=*(const __attribute__((address_space(3))) bf16x8*)(kp);      kf[1]=*(const __attribute__((address_space(3))) bf16x8*)(kp+512);
  kf[2]=*(const __attribute__((address_space(3))) bf16x8*)(kp+2048); kf[3]=*(const __attribute__((address_space(3))) bf16x8*)(kp+2560);
  kf[4]=*(const __attribute__((address_space(3))) bf16x8*)(kp+4096); kf[5]=*(const __attribute__((address_space(3))) bf16x8*)(kp+4608);
  kf[6]=*(const __attribute__((address_space(3))) bf16x8*)(kp+6144); kf[7]=*(const __attribute__((address_space(3))) bf16x8*)(kp+6656);
}
__device__ __forceinline__ void kload2(bf16x8*kf,lds_cptr kp,int j){ kf[2*j]=*(const __attribute__((address_space(3))) bf16x8*)(kp+j*2048); kf[2*j+1]=*(const __attribute__((address_space(3))) bf16x8*)(kp+j*2048+512); }
__device__ __forceinline__ s16x4 vtr(lds_cptr p){ return __builtin_bit_cast(s16x4,__builtin_amdgcn_ds_read_tr16_b64_v4i16((__attribute__((address_space(3))) v4i16_t*)p)); }
__device__ __forceinline__ float rowmax(const f32x16&p0,const f32x16&p1){
  float a=max3f(p0[0],p0[1],p1[0]),b=max3f(p0[2],p0[3],p1[1]);a=max3f(a,p1[2],p1[3]);
  #pragma unroll
  for(int r=4;r<16;r+=4){a=max3f(a,p0[r],p0[r+1]);b=max3f(b,p0[r+2],p0[r+3]);a=max3f(a,p1[r],p1[r+1]);b=max3f(b,p1[r+2],p1[r+3]);}
  const float m=max2f(a,b);
  auto rr=__builtin_amdgcn_permlane32_swap(__float_as_uint(m),__float_as_uint(m),false,false);
  return max2f(__uint_as_float(rr[0]),__uint_as_float(rr[1]));
}
__device__ __forceinline__ void pv(f32x16*o,int vb,bf16x8 pa0,bf16x8 pa1,bf16x8 pa2,bf16x8 pa3){
  #pragma unroll
  for(int d0=0;d0<2;++d0){s16x4 lo[4],hi[4];
    #pragma unroll
    for(int ks=0;ks<4;++ks){
      asm volatile("ds_read_b64_tr_b16 %0,%1 offset:%c2":"=&v"(lo[ks]):"v"(vb),"i"(d0*4096+ks*1024):"memory");
      asm volatile("ds_read_b64_tr_b16 %0,%1 offset:%c2":"=&v"(hi[ks]):"v"(vb),"i"(d0*4096+ks*1024+512):"memory");}
    asm volatile("s_waitcnt lgkmcnt(0)":::"memory");SBAR();
    #define PK(k) (bf16x8){lo[k][0],lo[k][1],lo[k][2],lo[k][3],hi[k][0],hi[k][1],hi[k][2],hi[k][3]}
    o[d0]=__builtin_amdgcn_mfma_f32_32x32x16_bf16(pa0,PK(0),o[d0],0,0,0);
    o[d0]=__builtin_amdgcn_mfma_f32_32x32x16_bf16(pa1,PK(1),o[d0],0,0,0);
    o[d0]=__builtin_amdgcn_mfma_f32_32x32x16_bf16(pa2,PK(2),o[d0],0,0,0);
    o[d0]=__builtin_amdgcn_mfma_f32_32x32x16_bf16(pa3,PK(3),o[d0],0,0,0);
    #undef PK
  }
}

#ifndef ATTN_STORE16
#define ATTN_STORE16(p,v) (*(u32x4*)(p)=(v))
#endif
template<int THRL> __device__ __forceinline__ void attn_unit(int qb,const bf16*Qp,const bf16*__restrict__ Kl,const bf16*__restrict__ Vl,const bf16*__restrict__ Kc,const bf16*__restrict__ Vc,bf16*Op,char*shm,const int tid){
  const int lane=tid&63,r32=lane&31,hi=lane>>5; const int wid=__builtin_amdgcn_readfirstlane(tid>>6);
  const int q0=qb*QB;
  const bf16*Qw=Qp+(long)(q0+wid*QBLK)*PQ;
  const unsigned lds0=(unsigned)(uintptr_t)shm;
  float*wsf=(float*)(shm+LDS_WS)+wid*64;
  const long koff=(long)lane*PQ+wid*8;
  const long voff=(long)(16*(wid&3)+(lane>>2))*PQ+(wid>>2)*32+(lane&3)*8;
  const unsigned kdst=lds0+LDS_K+wid*1024, vdst=lds0+LDS_V+wid*1024;
  #define TILE_SRC(t,C,L) (((t)<NCTXT?(C)+(long)(t)*KVBLK*PQ:(L)+(long)((t)-NCTXT)*KVBLK*PQ))
  #define DMA_K(t,slot) glds16(TILE_SRC(t,Kc,Kl)+koff,(unsigned)__builtin_amdgcn_readfirstlane(kdst+(slot)))
  #define DMA_V(t,slot) glds16(TILE_SRC(t,Vc,Vl)+voff,(unsigned)__builtin_amdgcn_readfirstlane(vdst+(slot)))
  const int vb0=(int)(lds0+LDS_V)+((lane>>4)&1)*32+(lane&3)*8+(4*hi+((lane&15)>>2))*64;
  const char*Kbase=shm+LDS_K; bf16x8 kf[8];
  const lds_cptr shm3=(lds_cptr)shm; const lds_cptr kp0=shm3+LDS_K+hi*1024+r32*16; const lds_cptr vp0=shm3+LDS_V+((lane>>4)&1)*32+(lane&3)*8+(4*hi+((lane&15)>>2))*64;
  constexpr int NT=NCTXT+SEQ/KVBLK;
  DMA_K(0,0);DMA_V(0,0);DMA_K(1,SLOTB);
  bf16x8 qr[4];
  #pragma unroll
  for(int d0=0;d0<4;++d0)qr[d0]=*reinterpret_cast<const bf16x8*>(&Qw[(long)r32*PQ+d0*16+hi*8]);
  float mhat=0.f,l_reg=0.f;f32x16 o[2],negm; { float zz=0.f; asm volatile("":"+v"(zz)); _Pragma("unroll") for(int r=0;r<16;++r){o[0][r]=zz;o[1][r]=zz;negm[r]=zz;} } asm volatile("":"+v"(negm));
  #define CMASK(P0,P1,t) do{}while(0)
  bool resc=false;
  #define START(P0,P1) do{ const float rm=rowmax(P0,P1); resc=false; \
    { const float dl=rm; mhat=fadd_s(mhat,dl); \
      _Pragma("unroll") for(int r=0;r<16;++r){P0[r]=fsub_s(P0[r],dl);P1[r]=fsub_s(P1[r],dl);} \
      _Pragma("unroll") for(int r=0;r<16;++r)negm[r]=-mhat; asm volatile("":"+v"(negm)); } \
    _Pragma("unroll") for(int r=0;r<16;++r)P0[r]=__builtin_amdgcn_exp2f(P0[r]); }while(0)
  #define RESC() do{ if(resc){ asm volatile("s_waitcnt lgkmcnt(0)":::"memory"); \
      _Pragma("unroll") for(int d_=0;d_<2;++d_) _Pragma("unroll") for(int r=0;r<16;++r)o[d_][r]*=wsf[crow(r,hi)]; } }while(0)
  f32x16 pA0,pA1,pB0,pB1;
  int sl_prev=0,sl_cur=0,sl_next=SLOTB;
  #define ROT() do{sl_prev=sl_cur;sl_cur=sl_next;sl_next=(sl_next==(NSLOT-1)*SLOTB)?0:sl_next+SLOTB;}while(0)
  DMA_K(2,2*SLOTB);
  WAIT_BAR(3);
  qkt(pA0,pA1,Kbase,qr,negm,r32,hi);asm volatile("s_nop 15\n\ts_nop 7":"+v"(pA0),"+v"(pA1));CMASK(pA0,pA1,0);
  START(pA0,pA1);
  _Pragma("unroll") for(int r=0;r<16;++r)pA1[r]=__builtin_amdgcn_exp2f(pA1[r]);
  WAIT_BAR(0);
  DMA_K(3,0);DMA_V(1,SLOTB);
  ROT();
  kload8(kf,kp0+sl_cur);
  WAIT_BAR(2);
  s16x4 vlo[8],vhi[8]; u32x4 pw0,pw1,pw2,pw3;
  #define PKW(P,B) cvtpk_s(P[B],P[B+1])
  #define PAF(k) __builtin_bit_cast(bf16x8,pw##k)
  #define VFR(i) (bf16x8){vlo[i][0],vlo[i][1],vlo[i][2],vlo[i][3],vhi[i][0],vhi[i][1],vhi[i][2],vhi[i][3]}
  #define PIN(x) asm volatile("":"+v"(x))
  #define MX3(a,b,c) __builtin_fmaxf(__builtin_fmaxf((a),(b)),(c))
  #define GAPA(MF,A0,A1,A2,A3,W0,W1,PW) do{ MF; sacc+=A0; sacc+=A1; sacc+=A2; sacc+=A3; PIN(sacc); W0; W1; PIN(PW); SBAR(); }while(0)
  #define EX(v) __builtin_amdgcn_exp2f(v)
  #define GAPB(MF,X,B) do{ MF; X[B]=EX(X[B]); X[B+1]=EX(X[B+1]); X[B+2]=EX(X[B+2]); X[B+3]=EX(X[B+3]); PIN(X); SBAR(); }while(0)
  #define VRD(i) do{ vlo[i]=vtr(vp_+(((i)>>2)*4096+((i)&3)*1024)); vhi[i]=vtr(vp_+(((i)>>2)*4096+((i)&3)*1024+512)); }while(0)
  #define KRD(G,j) do{ if(G){ kload2(kf,kp0+sl_next,j); SBAR(); } }while(0)
  #define STEP(C0,C1,P0,P1,t,GK,GV,GL) do{ SBAR(); \
    const lds_cptr vp_=vp0+sl_prev; \
    VRD(0); SBAR(); float sacc=(P0[0]+P0[1]); \
    GAPA(C0=__builtin_amdgcn_mfma_f32_32x32x16_bf16(kf[0],qr[0],negm,0,0,0), P0[2],P0[3],P0[4],P0[5],     pw0[0]=PKW(P0,0), pw0[1]=PKW(P0,2), pw0); \
    VRD(4); SBAR(); GAPA(C1=__builtin_amdgcn_mfma_f32_32x32x16_bf16(kf[1],qr[0],negm,0,0,0), P0[6],P0[7],P0[8],P0[9],     pw0[2]=PKW(P0,4), pw0[3]=PKW(P0,6), pw0); \
    VRD(1); SBAR(); GAPA(C0=__builtin_amdgcn_mfma_f32_32x32x16_bf16(kf[2],qr[1],C0,0,0,0),   P0[10],P0[11],P0[12],P0[13], pw1[0]=PKW(P0,8), pw1[1]=PKW(P0,10), pw1); \
    VRD(5); SBAR(); GAPA(C1=__builtin_amdgcn_mfma_f32_32x32x16_bf16(kf[3],qr[1],C1,0,0,0),   P0[14],P0[15],P1[0],P1[1],   pw1[2]=PKW(P0,12),pw1[3]=PKW(P0,14), pw1); \
    VRD(2); SBAR(); GAPA(C0=__builtin_amdgcn_mfma_f32_32x32x16_bf16(kf[4],qr[2],C0,0,0,0),   P1[2],P1[3],P1[4],P1[5],     pw2[0]=PKW(P1,0), pw2[1]=PKW(P1,2), pw2); \
    VRD(6); SBAR(); GAPA(C1=__builtin_amdgcn_mfma_f32_32x32x16_bf16(kf[5],qr[2],C1,0,0,0),   P1[6],P1[7],P1[8],P1[9],     pw2[2]=PKW(P1,4), pw2[3]=PKW(P1,6), pw2); \
    VRD(3); SBAR(); GAPA(C0=__builtin_amdgcn_mfma_f32_32x32x16_bf16(kf[6],qr[3],C0,0,0,0),   P1[10],P1[11],P1[12],P1[13], pw3[0]=PKW(P1,8), pw3[1]=PKW(P1,10), pw3); \
    VRD(7); SBAR(); GAPA(C1=__builtin_amdgcn_mfma_f32_32x32x16_bf16(kf[7],qr[3],C1,0,0,0),   P1[14],P1[15],0.f,0.f,       pw3[2]=PKW(P1,12),pw3[3]=PKW(P1,14), pw3); \
    l_reg+=sacc; \
    if(GK){DMA_K((t)+3,sl_cur);} if(GV){DMA_V((t)+1,sl_next);} \
    CMASK(C0,C1,t); \
    { float a=MX3(C0[0],C0[1],C1[0]),b=MX3(C0[2],C0[3],C1[1]); a=MX3(a,C1[2],C1[3]); \
      _Pragma("unroll") for(int r=4;r<16;r+=4){a=MX3(a,C0[r],C0[r+1]);b=MX3(b,C0[r+2],C0[r+3]);a=MX3(a,C1[r],C1[r+1]);b=MX3(b,C1[r+2],C1[r+3]);} \
      float rm=__builtin_fmaxf(a,b); { auto rr=__builtin_amdgcn_permlane32_swap(__float_as_uint(rm),__float_as_uint(rm),false,false); rm=__builtin_fmaxf(__uint_as_float(rr[0]),__uint_as_float(rr[1])); } \
      resc=false; \
      if(__builtin_expect(__any(rm>(float)THRL),0)){ const float dl=__builtin_fmaxf(rm,0.f); mhat+=dl; \
        _Pragma("unroll") for(int r=0;r<16;++r){C0[r]-=dl;C1[r]-=dl;} \
        _Pragma("unroll") for(int r=0;r<16;++r)negm[r]=-mhat; asm volatile("":"+v"(negm)); \
        const float f=__builtin_amdgcn_exp2f(-dl); l_reg*=f; if(hi==0)wsf[r32]=f; resc=true; } } \
    SBAR(); \
    GAPB(o[0]=__builtin_amdgcn_mfma_f32_32x32x16_bf16(PAF(0),VFR(0),o[0],0,0,0), C0,0); \
    GAPB(o[1]=__builtin_amdgcn_mfma_f32_32x32x16_bf16(PAF(0),VFR(4),o[1],0,0,0), C0,4); \
    KRD(GL,0); GAPB(o[0]=__builtin_amdgcn_mfma_f32_32x32x16_bf16(PAF(1),VFR(1),o[0],0,0,0), C0,8); \
    KRD(GL,1); GAPB(o[1]=__builtin_amdgcn_mfma_f32_32x32x16_bf16(PAF(1),VFR(5),o[1],0,0,0), C0,12); \
    KRD(GL,2); GAPB(o[0]=__builtin_amdgcn_mfma_f32_32x32x16_bf16(PAF(2),VFR(2),o[0],0,0,0), C1,0); \
    KRD(GL,3); GAPB(o[1]=__builtin_amdgcn_mfma_f32_32x32x16_bf16(PAF(2),VFR(6),o[1],0,0,0), C1,4); \
    GAPB(o[0]=__builtin_amdgcn_mfma_f32_32x32x16_bf16(PAF(3),VFR(3),o[0],0,0,0), C1,8); \
    GAPB(o[1]=__builtin_amdgcn_mfma_f32_32x32x16_bf16(PAF(3),VFR(7),o[1],0,0,0), C1,12); \
    }while(0)
  int t=1;
  #undef CMASK
  #define CMASK(P0,P1,t) do{}while(0)
  for(;t+5<NT;t+=2){
    STEP(pB0,pB1,pA0,pA1,t,true,true,true);     WAIT_BAR(2); RESC(); ROT();
    STEP(pA0,pA1,pB0,pB1,t+1,true,true,true);   WAIT_BAR(2); RESC(); ROT();
  }
  #undef CMASK
  #define CMASK(P0,P1,t) do{}while(0)
  #define ENDW(tt) do{ if((tt)+3<NT){WAIT_BAR(2);} else if((tt)+2<NT){WAIT_BAR(1);} else {WAIT_BAR(0);} }while(0)
  for(;t+1<NT;t+=2){
    STEP(pB0,pB1,pA0,pA1,t,(t+3<NT),(t+1<NT),(t+1<NT));       ENDW(t);   RESC(); ROT();
    STEP(pA0,pA1,pB0,pB1,t+1,(t+4<NT),(t+2<NT),(t+2<NT));     ENDW(t+1); RESC(); ROT();
  }
  STEP(pB0,pB1,pA0,pA1,NT-1,false,false,false); RESC();
  { float sacc=pB0[0]+pB0[1]; _Pragma("unroll") for(int r=2;r<16;++r)sacc+=pB0[r]; _Pragma("unroll") for(int r=0;r<16;++r)sacc+=pB1[r]; l_reg+=sacc;
    pw0=(u32x4){PKW(pB0,0),PKW(pB0,2),PKW(pB0,4),PKW(pB0,6)};pw1=(u32x4){PKW(pB0,8),PKW(pB0,10),PKW(pB0,12),PKW(pB0,14)};pw2=(u32x4){PKW(pB1,0),PKW(pB1,2),PKW(pB1,4),PKW(pB1,6)};pw3=(u32x4){PKW(pB1,8),PKW(pB1,10),PKW(pB1,12),PKW(pB1,14)};
    SBAR(); pv(o,vb0+sl_cur,PAF(0),PAF(1),PAF(2),PAF(3)); }
  #undef PKW
  #undef PAF
  #undef VFR
  #undef PIN
  #undef MX3
  #undef GAPA
  #undef GAPB
  #undef EX
  #undef VRD
  #undef KRD
  #undef STEP
  #undef ENDW
  {auto rr=__builtin_amdgcn_permlane32_swap(__float_as_uint(l_reg),__float_as_uint(l_reg),false,false);l_reg=__uint_as_float(rr[0])+__uint_as_float(rr[1]);}
  if(hi==0)wsf[32+r32]=l_reg;asm volatile("s_waitcnt lgkmcnt(0)":::"memory");
  float rli[16];
  #pragma unroll
  for(int r=0;r<16;++r)rli[r]=__builtin_amdgcn_rcpf(wsf[32+crow(r,hi)]);
  bf16*Ow=Op+(long)(q0+wid*QBLK)*PO;
  { bf16*stg=(bf16*)(shm+LDS_OST)+wid*2048;
    #pragma unroll
    for(int r=0;r<16;++r){const int orow=crow(r,hi);
      #pragma unroll
      for(int d0=0;d0<2;++d0)stg[orow*64+d0*32+r32]=__float2bfloat16(o[d0][r]*rli[r]);}
    asm volatile("s_waitcnt lgkmcnt(0)":::"memory");
    #pragma unroll
    for(int i=0;i<4;++i){const int row=i*8+(lane>>3),ch=lane&7; const u32x4 v=*(const u32x4*)(stg+row*64+ch*8); ATTN_STORE16(Ow+(long)row*PO+ch*8,v);} }
  asm volatile("s_waitcnt lgkmcnt(0)\n\ts_barrier":::"memory");
  #undef DMA_K
  #undef TILE_SRC
  #undef DMA_V
  #undef CMASK
  #undef START
  #undef RESC
  #undef ROT
}
#undef SBAR
#undef WAIT_BAR
}

constexpr int SD_CUM = 0, SD_DTV = 1024, SD_XC = 2048, SD_XCS = 144, SD_BC = SD_XC + 128 * SD_XCS, SD_BCS = 272, SD_CC = SD_BC + 128 * SD_BCS, SD_HS = SD_CC + 128 * SD_BCS,
              SD_SSQ = SD_HS + 2 * 64 * SD_BCS, SD_XW = SD_CC;
static_assert(SD_SSQ + 1024 <= RING_BYTES && SD_XW + 2 * 128 * SD_XCS <= RING_BYTES, "SSD LDS map");
DI int chunk_row(int b, int cidx) { return cidx < 2 ? NLAT + b * CTXL + 128 * cidx : b * SEQ + 128 * (cidx - 2); }
DI void ssd_cum(const Frame& F, int l, int b, int cidx, int hd) {
    if (F.wave < 2) {
        const int dir = F.wave; const float* DT = WSP(float, WS_DT) + (size_t)chunk_row(b, cidx) * 16 + dir * 8 + hd;
        const float a = -__expf(F.in[I_ALOG][l * 16 + dir * 8 + hd]);
        const float d0 = DT[(size_t)(2 * F.lane) * 16], d1 = DT[(size_t)(2 * F.lane + 1) * 16];
        const float a0 = d0 * a, a1 = d1 * a, s = a0 + a1; float v = s;
        LAS float* cum = (LAS float*)(F.lds + SD_CUM) + dir * 128; LAS float* dtv = (LAS float*)(F.lds + SD_DTV) + dir * 128;
        if (dir == 0) {
#pragma unroll
            for (int o = 1; o < 64; o <<= 1) { const float t = __shfl_up(v, o); if (F.lane >= o) v += t; }
            cum[2 * F.lane] = v - s + a0; cum[2 * F.lane + 1] = v;
        } else {
#pragma unroll
            for (int o = 1; o < 64; o <<= 1) { const float t = __shfl_down(v, o); if (F.lane + o < 64) v += t; }
            cum[2 * F.lane + 1] = v - s + a1; cum[2 * F.lane] = v;
        }
        dtv[2 * F.lane] = d0; dtv[2 * F.lane + 1] = d1;
    }
}
DI void conv_tile(const Frame& F, int l, LAS unsigned char* dst, int dstride, int ch0, int nchunks, int rowbase, int seqlo, int seqhi) {
    const bf16_t* PRJ = WSP(bf16_t, WS_PRJ); const float* cw = F.in[I_CONVW] + (size_t)l * 5 * 1024; const float* cb = F.in[I_CONVB] + l * 1024;
    for (int item = F.tid; item < nchunks * 16; item += NTHR) {
        const int chunk = item % nchunks, seg = item / nchunks, t0 = seg * 8, c0 = ch0 + chunk * 8;
        float w[5][8], bb[8];
#pragma unroll
        for (int k = 0; k < 5; ++k) { const f32x4 wa = *(const f32x4*)(cw + k * 1024 + c0), wb = *(const f32x4*)(cw + k * 1024 + c0 + 4);
            w[k][0] = wa[0]; w[k][1] = wa[1]; w[k][2] = wa[2]; w[k][3] = wa[3]; w[k][4] = wb[0]; w[k][5] = wb[1]; w[k][6] = wb[2]; w[k][7] = wb[3]; }
        { const f32x4 ba = *(const f32x4*)(cb + c0), b2 = *(const f32x4*)(cb + c0 + 4); bb[0] = ba[0]; bb[1] = ba[1]; bb[2] = ba[2]; bb[3] = ba[3]; bb[4] = b2[0]; bb[5] = b2[1]; bb[6] = b2[2]; bb[7] = b2[3]; }
        u32x4 rows[12];
#pragma unroll
        for (int i = 0; i < 12; ++i) { const int row = rowbase + t0 - 2 + i;
            rows[i] = (row >= seqlo && row < seqhi) ? *(const u32x4*)(PRJ + (size_t)row * PRJW + C_XBC + c0) : (u32x4){0u, 0u, 0u, 0u}; }
#pragma unroll
        for (int j = 0; j < 8; ++j) {
            float y[8];
#pragma unroll
            for (int e = 0; e < 8; ++e) y[e] = bb[e];
#pragma unroll
            for (int k = 0; k < 5; ++k) { const u32x4 rr = rows[j + k];
                y[0] += w[k][0] * bflo(rr.x); y[1] += w[k][1] * bfhi(rr.x); y[2] += w[k][2] * bflo(rr.y); y[3] += w[k][3] * bfhi(rr.y);
                y[4] += w[k][4] * bflo(rr.z); y[5] += w[k][5] * bfhi(rr.z); y[6] += w[k][6] * bflo(rr.w); y[7] += w[k][7] * bfhi(rr.w); }
            u32x4 o; o.x = pk2(silu(y[0]), silu(y[1])); o.y = pk2(silu(y[2]), silu(y[3])); o.z = pk2(silu(y[4]), silu(y[5])); o.w = pk2(silu(y[6]), silu(y[7]));
            *(LAS u32x4*)(dst + (t0 + j) * dstride + chunk * 16) = o;
        }
    }
}
DI void ssd_s1_unit(const Frame& Fin, int l, int b, int cidx, int hd) {
    const Frame F = launder(Fin);
    const int lane = F.lane, wid = F.wave, r = lane & 31, h = lane >> 5;
    const int rowbase = chunk_row(b, cidx), seqlo = cidx < 2 ? NLAT + b * CTXL : b * SEQ, seqhi = cidx < 2 ? seqlo + CTXL : seqlo + SEQ;
    __syncthreads();
    ssd_cum(F, l, b, cidx, hd);
    conv_tile(F, l, F.lds + SD_XC, SD_XCS, 64 * hd, 8, rowbase, seqlo, seqhi);
    conv_tile(F, l, F.lds + SD_BC, SD_BCS, 512 + 128 * (hd >> 2), 16, rowbase, seqlo, seqhi);
    __syncthreads();
    const LAS float* cum = (const LAS float*)(F.lds + SD_CUM); const LAS float* dtv = (const LAS float*)(F.lds + SD_DTV);
    for (int i = F.tid; i < 2 * 128 * 8; i += NTHR) {
        const int dir = i >> 10, t = (i >> 3) & 127, c8 = i & 7;
        const float ce = dir == 0 ? cum[127] : cum[128]; const float wgt = dtv[dir * 128 + t] * __expf(ce - cum[dir * 128 + t]);
        const u32x4 x = *(const LAS u32x4*)(F.lds + SD_XC + t * SD_XCS + c8 * 16);
        u32x4 o; o.x = pk2(bflo(x.x) * wgt, bfhi(x.x) * wgt); o.y = pk2(bflo(x.y) * wgt, bfhi(x.y) * wgt); o.z = pk2(bflo(x.z) * wgt, bfhi(x.z) * wgt); o.w = pk2(bflo(x.w) * wgt, bfhi(x.w) * wgt);
        *(LAS u32x4*)(F.lds + SD_XW + (dir * 128 + t) * SD_XCS + c8 * 16) = o;
    }
    __syncthreads();
    const int dir = wid >> 2, nb = wid & 3, q4 = (lane & 15) >> 2, p4 = lane & 3, blk = (lane >> 4) & 1;
    f32x16 s0, s1;
#pragma unroll
    for (int i = 0; i < 16; ++i) { s0[i] = 0.f; s1[i] = 0.f; }
    const LAS unsigned char* xa = F.lds + SD_XW + (dir * 128 + 8 * h + q4) * SD_XCS + (16 * blk + 4 * p4) * 2;
    const LAS unsigned char* ba = F.lds + SD_BC + (8 * h + q4) * SD_BCS + (32 * nb + 16 * blk + 4 * p4) * 2;
#pragma unroll
    for (int ks = 0; ks < 8; ++ks) {
        const bf16x8 bfr = cat8(tr_read(ba + (16 * ks) * SD_BCS), tr_read(ba + (16 * ks + 4) * SD_BCS));
        const bf16x8 x0 = cat8(tr_read(xa + (16 * ks) * SD_XCS), tr_read(xa + (16 * ks + 4) * SD_XCS));
        const bf16x8 x1 = cat8(tr_read(xa + (16 * ks) * SD_XCS + 64), tr_read(xa + (16 * ks + 4) * SD_XCS + 64));
        s0 = MFMA32(x0, bfr, s0); s1 = MFMA32(x1, bfr, s1);
    }
    float* ST = WSP(float, WS_ST) + ((((size_t)b * NCH + cidx) * 8 + hd) * 2 + dir) * 8192 + 32 * nb + r;
#pragma unroll
    for (int i = 0; i < 16; ++i) { ST[(size_t)crow(i, h) * 128] = s0[i]; ST[(size_t)(32 + crow(i, h)) * 128] = s1[i]; }
    if (F.tid < 2) WSP(float, WS_CDEC)[(((size_t)b * NCH + cidx) * 8 + hd) * 2 + F.tid] = __expf(F.tid == 0 ? cum[127] : cum[128]);
}
DI void phase_scan(const Frame& F) {
    float* ST = WSP(float, WS_ST); const float* CD = WSP(float, WS_CDEC);
    for (int gid = F.vcu * NTHR + F.tid; gid < 64 * 2048; gid += F.G * NTHR) {
        const int chain = gid >> 11, e4 = gid & 2047, b = chain >> 4, hd = (chain >> 1) & 7, dir = chain & 1;
        f32x4 hst = (f32x4){0.f, 0.f, 0.f, 0.f};
        for (int k0 = 0; k0 < NCH; k0 += 11) {
            f32x4 st[11]; float dec[11];
#pragma unroll
            for (int j = 0; j < 11; ++j) { const int k = k0 + j, cidx = dir == 0 ? k : (k < 2 ? 1 - k : 67 - k); const size_t idx = (((size_t)b * NCH + cidx) * 8 + hd) * 2 + dir;
                st[j] = *((const f32x4*)(ST + idx * 8192) + e4); dec[j] = CD[idx]; }
#pragma unroll
            for (int j = 0; j < 11; ++j) { const int k = k0 + j, cidx = dir == 0 ? k : (k < 2 ? 1 - k : 67 - k); const size_t idx = (((size_t)b * NCH + cidx) * 8 + hd) * 2 + dir;
                *((f32x4*)(ST + idx * 8192) + e4) = hst; hst = hst * dec[j] + st[j]; }
        }
    }
}
DI void ssd_s3_unit(const Frame& Fin, int l, int b, int cidx, int hd) {
    const Frame F = launder(Fin);
    const int lane = F.lane, wid = F.wave, r = lane & 31, h = lane >> 5;
    const int rowbase = chunk_row(b, cidx), seqlo = cidx < 2 ? NLAT + b * CTXL : b * SEQ, seqhi = cidx < 2 ? seqlo + CTXL : seqlo + SEQ;
    __syncthreads();
    ssd_cum(F, l, b, cidx, hd);
    conv_tile(F, l, F.lds + SD_XC, SD_XCS, 64 * hd, 8, rowbase, seqlo, seqhi);
    conv_tile(F, l, F.lds + SD_BC, SD_BCS, 512 + 128 * (hd >> 2), 16, rowbase, seqlo, seqhi);
    conv_tile(F, l, F.lds + SD_CC, SD_BCS, 768 + 128 * (hd >> 2), 16, rowbase, seqlo, seqhi);
    {
        const float* ST = WSP(float, WS_ST) + (((size_t)b * NCH + cidx) * 8 + hd) * 2 * 8192;
        for (int i = F.tid; i < 2 * 64 * 16; i += NTHR) { const int dp = i >> 4, c8 = i & 15; const f32x4 a = *(const f32x4*)(ST + (size_t)dp * 128 + c8 * 8), c = *(const f32x4*)(ST + (size_t)dp * 128 + c8 * 8 + 4);
            u32x4 o; o.x = pk2(a[0], a[1]); o.y = pk2(a[2], a[3]); o.z = pk2(c[0], c[1]); o.w = pk2(c[2], c[3]); *(LAS u32x4*)(F.lds + SD_HS + dp * SD_BCS + c8 * 16) = o; }
    }
    __syncthreads();
    const LAS float* cum = (const LAS float*)(F.lds + SD_CUM); const LAS float* dtv = (const LAS float*)(F.lds + SD_DTV);
    const int lb = wid & 3, ph = wid >> 2, q4 = (lane & 15) >> 2, p4 = lane & 3, blk = (lane >> 4) & 1;
    const int lidx = 32 * lb + r;
    bf16x8 cf[8];
#pragma unroll
    for (int ks = 0; ks < 8; ++ks) cf[ks] = *(const LAS bf16x8*)(F.lds + SD_CC + lidx * SD_BCS + (16 * ks + 8 * h) * 2);
    f32x16 gt[4];
#pragma unroll
    for (int sb = 0; sb < 4; ++sb) {
#pragma unroll
        for (int i = 0; i < 16; ++i) gt[sb][i] = 0.f;
#pragma unroll
        for (int ks = 0; ks < 8; ++ks) { const bf16x8 bfr = *(const LAS bf16x8*)(F.lds + SD_BC + (32 * sb + r) * SD_BCS + (16 * ks + 8 * h) * 2); gt[sb] = MFMA32(bfr, cf[ks], gt[sb]); }
    }
    f32x16 ytot;
#pragma unroll
    for (int i = 0; i < 16; ++i) ytot[i] = 0.f;
    const LAS unsigned char* xa = F.lds + SD_XC + (4 * h + q4) * SD_XCS + (32 * ph + 16 * blk + 4 * p4) * 2;
#pragma unroll
    for (int dir = 0; dir < 2; ++dir) {
        const float cl = cum[dir * 128 + lidx];
        f32x16 acc;
#pragma unroll
        for (int i = 0; i < 16; ++i) acc[i] = 0.f;
#pragma unroll
        for (int sb = 0; sb < 4; ++sb) {
            const bool relv = dir == 0 ? (sb <= lb) : (sb >= lb);
            if (relv) {
                f32x16 mt; int rl = r; asm volatile("" : "+v"(rl));
#pragma unroll
                for (int i = 0; i < 16; ++i) { const int sl = crow(i, h), s = 32 * sb + sl;
                    const bool ok = (sb != lb) || (dir == 0 ? (sl <= rl) : (sl >= rl));
                    const float e = __expf(cl - cum[dir * 128 + s]) * dtv[dir * 128 + s];
                    mt[i] = ok ? gt[sb][i] * e : 0.f; }
                const bf16x8 pa0 = pack8<0>(mt), pa1 = pack8<1>(mt);
                const bf16x8 x0 = cat8(tr_read(xa + (32 * sb) * SD_XCS), tr_read(xa + (32 * sb + 8) * SD_XCS));
                const bf16x8 x1 = cat8(tr_read(xa + (32 * sb + 16) * SD_XCS), tr_read(xa + (32 * sb + 24) * SD_XCS));
                acc = MFMA32(x0, pa0, acc); acc = MFMA32(x1, pa1, acc);
            }
        }
        f32x16 yo;
#pragma unroll
        for (int i = 0; i < 16; ++i) yo[i] = 0.f;
#pragma unroll
        for (int ks = 0; ks < 8; ++ks) { const bf16x8 hf = *(const LAS bf16x8*)(F.lds + SD_HS + (dir * 64 + 32 * ph + r) * SD_BCS + (16 * ks + 8 * h) * 2); yo = MFMA32(hf, cf[ks], yo); }
        const float el = __expf(cl);
#pragma unroll
        for (int i = 0; i < 16; ++i) ytot[i] += acc[i] + el * yo[i];
    }
    const float dsk = F.in[I_DSKIP][l * 8 + hd];
    const int row = rowbase + lidx;
    const bf16_t* zp = WSP(bf16_t, WS_PRJ) + (size_t)row * PRJW + C_Z + 64 * hd + 32 * ph + 4 * h;
    bf16_t* op = WSP(bf16_t, WS_OC) + (size_t)row * OCW + 1536 + 64 * hd + 32 * ph + 4 * h;
    float ss = 0.f;
#pragma unroll
    for (int g4 = 0; g4 < 4; ++g4) {
        const u32x2 zz = *(const u32x2*)(zp + 8 * g4);
        const u32x2 xx = *(const LAS u32x2*)(F.lds + SD_XC + lidx * SD_XCS + (32 * ph + 8 * g4 + 4 * h) * 2);
        const float v0 = (ytot[4 * g4] + dsk * bflo(xx.x)) * silu(bflo(zz.x)), v1 = (ytot[4 * g4 + 1] + dsk * bfhi(xx.x)) * silu(bfhi(zz.x));
        const float v2 = (ytot[4 * g4 + 2] + dsk * bflo(xx.y)) * silu(bflo(zz.y)), v3 = (ytot[4 * g4 + 3] + dsk * bfhi(xx.y)) * silu(bfhi(zz.y));
        ss += (v0 * v0 + v1 * v1) + (v2 * v2 + v3 * v3);
        u32x2 w; w.x = pk2(v0, v1); w.y = pk2(v2, v3); *(u32x2*)(op + 8 * g4) = w;
    }
    ss += __shfl_xor(ss, 32);
    LAS float* sq = (LAS float*)(F.lds + SD_SSQ);
    if (h == 0) sq[ph * 128 + lidx] = ss;
    __syncthreads();
    if (F.tid < 128) WSP(float, WS_SSQ)[(size_t)(rowbase + F.tid) * 8 + hd] = sq[F.tid] + sq[128 + F.tid];
}

constexpr int PH_PER_LAYER = 11, N_PHASES = 2 + PH_PER_LAYER * DEPTH;
__global__ void __launch_bounds__(NTHR, 2) fwd_kernel(Args args) {
    extern __shared__ __attribute__((aligned(16))) unsigned char smem[];
    Frame F0;
    F0.lds = (LAS unsigned char*)smem;
    F0.tid = threadIdx.x; F0.lane = F0.tid & 63; F0.wave = __builtin_amdgcn_readfirstlane(F0.tid >> 6);
    F0.G = gridDim.x; { const int bx = blockIdx.x; F0.vcu = (F0.G % 8 == 0) ? (bx % 8) * (F0.G / 8) + bx / 8 : bx; }
    F0.in = args.in; F0.out = args.out; F0.ws = args.ws; F0.ctl = (gu32*)(args.ws + WS_CTL);
    volatile LAS unsigned* MISC = (volatile LAS unsigned*)(F0.lds + MISC_OFF);
    for (int u = F0.tid; u < (LDS_BYTES - RING_BYTES) / 4; u += NTHR) ((LAS unsigned*)(F0.lds + RING_BYTES))[u] = 0u;
    __syncthreads();
    XcdBarrier bar; bar.bar = (unsigned*)(F0.ctl + CW_BAR); bar.x = 0; bar.st = nullptr;
    if (!MK_PER_PHASE) bar = xcd_barrier_post((unsigned*)(F0.ctl + CW_BAR), MISC + 8);
    const int lo = args.ph_lo, hi = args.ph_hi;
#define IN(k) (lo <= (k) && (k) < hi)
#define SEAM(k) do { if (IN(k) && IN((k) + 1)) { if (MK_PER_PHASE) { if (F0.tid == 0) __hip_atomic_store(F0.ctl + 0, 0xBADBA0u, __ATOMIC_RELAXED, __HIP_MEMORY_SCOPE_AGENT); } else xcd_barrier(bar); } } while (0)

    if (PHM(11) && IN(0)) { const Frame F = launder(F0); _Pragma("nounroll") for (int rep = 0; rep < 1 + REPB(11); ++rep) { phase_prologue_a(F); __syncthreads(); } } SEAM(0);
    if (PHM(12) && IN(1)) { const Frame F = launder(F0); _Pragma("nounroll") for (int rep = 0; rep < 1 + REPB(12); ++rep) { phase_prologue_b(F); __syncthreads(); } } SEAM(1);

    for (int l = 0; l < DEPTH; ++l) {
        const int pb = 2 + PH_PER_LAYER * l;
        const bool with_ctx = l < DEPTH - 1, moe = l & 1; const int fi = l >> 1;
        const int mrows = with_ctx ? MTOT : NLAT, mtiles = with_ctx ? 132 : 128;
        if (PHM(0) && IN(pb + 0)) { const Frame F = launder(F0);
            pg8::SchedGrid S; S.nMa = mtiles; S.nNa = 34; S.nMb = with_ctx ? 0 : 4; S.nNb = 18; S.total = S.nMa * S.nNa + S.nMb * S.nNb; S.G = F.G; S.c = F.vcu;
            S.A = (const char*)(F.ws + WS_HB); S.B = (const char*)(F.ws + WS_WCOMB + l * SZ_WCOMB); S.lda = DM; S.ldb = DM; S.a_div = 1; S.a_cols = 0; S.pe = nullptr; S.estride = 0; S.rep = REPB(0);
            pg8::EpiInGate E{WSP(bf16_t, WS_PRJ), WSP(bf16_t, WS_GT), F.in[I_BGATE] + (size_t)l * 4096};
            pg8::gemm_phase(F.lds, F.tid, DM, DM, DM, S, E);
        }
        SEAM(pb + 0);
        if (PHM(1) && IN(pb + 1)) { const Frame F = launder(F0);
            phase_qkprep_rows(F, l);
            for (int u = F.vcu; u < NB * NCH * 8; u += F.G) { const int hd = u & 7, cidx = (u >> 3) % NCH, b = (u >> 3) / NCH; ssd_s1_unit(F, l, b, cidx, hd); }
        }
        SEAM(pb + 1);
        if (PHM(2) && IN(pb + 2)) { const Frame F = launder(F0); phase_scan(F); }
        SEAM(pb + 2);
        if (PHM(3) && IN(pb + 3)) { const Frame F = launder(F0);
            const int nchs = with_ctx ? NCH : NCH - 2, n_s3 = NB * nchs * 8, n_cx = with_ctx ? 96 : 0, total = 3072 + n_s3 + n_cx;
            _Pragma("nounroll") for (int rep = 0; rep < 1 + REPB(3); ++rep) {
            for (int u = F.vcu; u < 1024; u += F.G) {
                const int qblk = u & 31, hg = (u >> 5) & 3, kvh = (u >> 7) & 1, b = u >> 8, hq = kvh * 4 + hg;
                const ga_body::bf16* P = (const ga_body::bf16*)(F.ws + WS_PRJ); const size_t lat0 = (size_t)(b * SEQ) * PRJW, ctx0 = (size_t)(NLAT + b * CTXL) * PRJW;
                ga_body::attn_unit<8>(qblk, P + lat0 + C_GAQ + hq * 64, P + lat0 + C_GAK + kvh * 64, P + lat0 + C_GAV + kvh * 64, P + ctx0 + C_GAK + kvh * 64, P + ctx0 + C_GAV + kvh * 64,
                                      (ga_body::bf16*)(F.ws + WS_OC) + (size_t)(b * SEQ) * OCW + 1024 + hq * 64, (char*)F.lds, F.tid);
            }
            const Frame Fb = launder(F0);
            for (int u = 1024 + Fb.vcu; u < total; u += Fb.G) { const Frame& F = Fb;
                if (u < 2048) { const int v = u - 1024, qblk = v & 31, hq = (v >> 5) & 7, b = v >> 8; attn_unit(F, l, 0, false, b, hq, qblk); }
                else if (u < 3072) { const int v = u - 2048, qblk = v & 31, hg = (v >> 5) & 3, kvh = (v >> 7) & 1, b = v >> 8; attn_unit(F, l, 1, false, b, kvh * 4 + hg, qblk); }
                else if (u < 3072 + n_s3) { const int v = u - 3072, hd = v & 7, cc = (v >> 3) % nchs, b = (v >> 3) / nchs; ssd_s3_unit(F, l, b, with_ctx ? cc : cc + 2, hd); }
                else { const int v = u - 3072 - n_s3, mode = v >> 5, b = (v >> 3) & 3, hq = v & 7; attn_unit(F, l, mode, true, b, hq, 0); }
            }
            }
        }
        SEAM(pb + 3);
        if (PHM(4) && IN(pb + 4)) { const Frame F = launder(F0);
            pg8::SchedBranch S; S.rep = REPB(4); S.T = mtiles * 8; S.G = F.G; S.c = F.vcu; S.A = (const char*)(F.ws + WS_OC); S.B = (const char*)(F.ws + WS_WB + l * SZ_WB);
            pg8::EpiBranch E{WSP(bf16_t, WS_GT), WSP(float, WS_SSQ), WSP(bf16_t, WS_PRJ)};
            pg8::gemm_phase<pg8::EpiBranch, pg8::SchedBranch, true>(F.lds, F.tid, 512, OCW, 512, S, E);
        }
        SEAM(pb + 4);
        if (PHM(5) && IN(pb + 5)) { const Frame F = launder(F0);
            pg8::SchedGrid S; S.nMa = mtiles; S.nNa = 4; S.nMb = 0; S.nNb = 1; S.total = S.nMa * S.nNa; S.G = F.G; S.c = F.vcu;
            S.A = (const char*)(F.ws + WS_PRJ); S.B = (const char*)(F.ws + WS_WO + l * SZ_WO); S.lda = DM; S.ldb = DM; S.a_div = 1; S.a_cols = 0; S.pe = nullptr; S.estride = 0; S.rep = REPB(5);
            pg8::EpiResid E{WSP(float, WS_XS), WSP(float, WS_MVEC) + (size_t)l * 5 * 6144 + 2048, nullptr, WSP(bf16_t, WS_END)};
            pg8::gemm_phase(F.lds, F.tid, DM, DM, DM, S, E);
        }
        SEAM(pb + 5);
        if (PHM(6) && IN(pb + 6)) { const Frame F = launder(F0); phase_ln1(F, l, mrows); }
        SEAM(pb + 6);
        if (moe) { if (PHM(7) && IN(pb + 7)) { const Frame F = launder(F0); phase_gather(F, l, mrows); } SEAM(pb + 7); }
        if (PHM(8) && IN(pb + 8)) { const Frame F = launder(F0);
            pg8::SchedGrid S; S.rep = REPB(8); S.nMb = 0; S.nNb = 1; S.G = F.G; S.c = F.vcu; S.lda = DM; S.ldb = DM; S.a_div = 1; S.a_cols = 0; S.pe = nullptr; S.estride = 0; int ldh;
            if (!moe) { S.nMa = mtiles; S.nNa = DFF / 128; S.A = (const char*)(F.ws + WS_HB); S.B = (const char*)(F.ws + WS_WUP + fi * SZ_WUP); ldh = DFF; }
            else { const int npad = moe_pad_ends_lds(F, fi); S.pe = (const LAS int*)(F.lds + MISC_OFF + 64); S.nMa = npad / 256; S.nNa = DFFE / 128;
                   S.A = (const char*)(F.ws + WS_XPAD); S.B = (const char*)(F.ws + WS_MUP + fi * SZ_MUP); S.estride = (size_t)2 * DFFE * DM * 2; ldh = DFFE; }
            S.total = S.nMa * S.nNa;
            pg8::EpiSwiGLU E{WSP(bf16_t, WS_HID), ldh};
            pg8::gemm_phase(F.lds, F.tid, DM, DM, DM, S, E);
        }
        SEAM(pb + 8);
        if (PHM(9) && IN(pb + 9)) { const Frame F = launder(F0);
            pg8::SchedGrid S; S.rep = REPB(9); S.nMb = 0; S.nNb = 1; S.nNa = 4; S.G = F.G; S.c = F.vcu; S.a_div = 1; S.a_cols = 0; S.pe = nullptr; S.estride = 0; S.A = (const char*)(F.ws + WS_HID);
            pg8::EpiResid E{WSP(float, WS_XS), WSP(float, WS_MVEC) + (size_t)l * 5 * 6144 + 5120, nullptr, WSP(bf16_t, WS_END)};
            int kk;
            if (!moe) { S.nMa = mtiles; S.B = (const char*)(F.ws + WS_WDN + fi * SZ_WDN); kk = DFF; }
            else { const int npad = moe_pad_ends_lds(F, fi); S.pe = (const LAS int*)(F.lds + MISC_OFF + 64); S.nMa = npad / 256; S.B = (const char*)(F.ws + WS_MDN + fi * SZ_MDN); S.estride = (size_t)DM * DFFE * 2; kk = DFFE; E.plainO = WSP(bf16_t, WS_YPAD); }
            S.lda = kk; S.ldb = kk; S.total = S.nMa * S.nNa;
            pg8::gemm_phase(F.lds, F.tid, kk, kk, kk, S, E);
        }
        SEAM(pb + 9);
        if (PHM(10) && IN(pb + 10)) { const Frame F = launder(F0); phase_ln2(F, l, mrows); }
        if (l + 1 < DEPTH) SEAM(pb + 10);
    }
#undef IN
#undef SEAM
}

extern "C" void kernel_launch(void* const* d_in, const int* in_sizes, int n_in, void* d_out, int out_size, void* d_ws, size_t ws_size, hipStream_t stream) {
    static int grid = 0;
    if (grid == 0) {
        if (n_in != 31 || in_sizes[0] != NLAT * DM || out_size != NLAT * DM || ws_size < WS_END) {
            fprintf(stderr, "kernel_launch: unexpected shapes: n_in %d in0 %d out %d ws %zu (need %zu); nothing launched\n", n_in, n_in > 0 ? in_sizes[0] : -1, out_size, ws_size, (size_t)WS_END); grid = -1; return; }
        int dev = 0, cus = 0, per_cu = 0;
        if (hipGetDevice(&dev) != hipSuccess || hipDeviceGetAttribute(&cus, hipDeviceAttributeMultiprocessorCount, dev) != hipSuccess) { fprintf(stderr, "kernel_launch: device query failed\n"); grid = -1; return; }
        if (hipFuncSetAttribute((const void*)fwd_kernel, hipFuncAttributeMaxDynamicSharedMemorySize, LDS_BYTES) != hipSuccess) { fprintf(stderr, "kernel_launch: hipFuncSetAttribute failed\n"); grid = -1; return; }
        if (hipOccupancyMaxActiveBlocksPerMultiprocessor(&per_cu, (const void*)fwd_kernel, NTHR, LDS_BYTES) != hipSuccess || per_cu < 1)
            fprintf(stderr, "kernel_launch: note: occupancy query reports %d workgroups per CU\n", per_cu);
        (void)hipGetLastError();
        grid = cus;
    }
    if (grid < 0) return;
    if (hipMemsetAsync((char*)d_ws + WS_CTL, 0, CTL_ZERO_BYTES, stream) != hipSuccess) { fprintf(stderr, "kernel_launch: memset failed\n"); return; }
    Args a{};
    for (int i = 0; i < 31; ++i) a.in[i] = (const float*)d_in[i];
    a.out = (float*)d_out; a.ws = (unsigned char*)d_ws;
#if MK_PER_PHASE
    for (int p = 0; p < N_PHASES; ++p) { a.ph_lo = p; a.ph_hi = p + 1; hipLaunchKernelGGL(fwd_kernel, dim3(grid), dim3(NTHR), LDS_BYTES, stream, a); }
#else
    a.ph_lo = 0; a.ph_hi = N_PHASES;
    hipLaunchKernelGGL(fwd_kernel, dim3(grid), dim3(NTHR), LDS_BYTES, stream, a);
#endif
    const hipError_t le = hipPeekAtLastError();
    if (le != hipSuccess) fprintf(stderr, "kernel_launch: launch failed: %s\n", hipGetErrorName(le));
}
```

```cpp
#include <hip/hip_runtime.h>
#include <cstdio>
#include <cstdint>
#include <hip/hip_bf16.h>
#include <cmath>

#define DI __device__ __forceinline__
#define LAS __attribute__((address_space(3)))
#define GAS __attribute__((address_space(1)))
typedef unsigned short bf16_t;
typedef short bf16x8 __attribute__((ext_vector_type(8)));
typedef short s16x4 __attribute__((ext_vector_type(4)));
typedef float f32x2 __attribute__((ext_vector_type(2)));
typedef float f32x4 __attribute__((ext_vector_type(4)));
typedef float f32x16 __attribute__((ext_vector_type(16)));
typedef unsigned u32x2 __attribute__((ext_vector_type(2)));
typedef unsigned u32x4 __attribute__((ext_vector_type(4)));
typedef __bf16 bf16x2_t __attribute__((ext_vector_type(2)));
typedef GAS unsigned gu32;

#ifndef MK_PER_PHASE
#define MK_PER_PHASE 0
#endif
#ifndef PHMASK
#define PHMASK 0xFFFF
#endif
#define PHM(k) ((PHMASK >> (k)) & 1)
#ifndef REP_MASK
#define REP_MASK 0
#endif
#define REPB(k) ((REP_MASK >> (k)) & 1)
#ifndef ABL
#define ABL 0
#endif

constexpr int DM = 1024, NB = 4, SEQ = 8192, CTXL = 256, NLAT = NB * SEQ, NCTX = NB * CTXL, MTOT = NLAT + NCTX;
constexpr int DEPTH = 4, DIN = 4624, PRJW = 4608, GTW = 4096, NCOMB = PRJW + GTW, OCW = 2048;
constexpr int DFF = 2816, DFFE = 3584, NEXP = 8, MOE_ROWS_MAX = 69632;
constexpr int NCH = 66;
constexpr float ALPHA = 1.6817928305074292f;
constexpr float LOG2E = 1.4426950408889634f;
constexpr float C2 = 0.125f * LOG2E;
constexpr float LN_EPS = 1e-5f, RMS_EPS = 1e-6f;
constexpr int C_NAQ = 0, C_NAK = 512, C_NAV = 1024, C_SWQ = 1536, C_SWK = 2048, C_SWV = 2176, C_GAQ = 2304, C_GAK = 2816, C_GAV = 2944, C_Z = 3072, C_XBC = 3584;

constexpr size_t KiB = 1024, MiB = 1u << 20;
constexpr size_t WS_CTL = 0, CTL_ZERO_BYTES = 1 * MiB;
constexpr size_t WS_MVEC = 1 * MiB;
constexpr size_t WS_ROPE = WS_MVEC + 512 * KiB;
constexpr size_t WS_DT = 4 * MiB;
constexpr size_t WS_SSQ = WS_DT + (size_t)MTOT * 16 * 4;
constexpr size_t WS_SLOT = WS_SSQ + (size_t)MTOT * 8 * 4;
constexpr size_t WS_CDEC = WS_SLOT + (size_t)MTOT * 8 * 4;
constexpr size_t WS_W = 10 * MiB;
constexpr size_t SZ_WCOMB = (size_t)NCOMB * DM * 2, SZ_WB = (size_t)4096 * 512 * 2, SZ_WO = (size_t)1024 * 4096 * 2;
constexpr size_t SZ_WUP = (size_t)2 * DFF * DM * 2, SZ_WDN = (size_t)DM * DFF * 2, SZ_MUP = (size_t)NEXP * 2 * DFFE * DM * 2, SZ_MDN = (size_t)NEXP * DM * DFFE * 2;
constexpr size_t WS_WCOMB = WS_W, WS_WB = WS_WCOMB + 4 * SZ_WCOMB, WS_WO = WS_WB + 4 * SZ_WB, WS_WUP = WS_WO + 4 * SZ_WO, WS_WDN = WS_WUP + 2 * SZ_WUP,
                 WS_MUP = WS_WDN + 2 * SZ_WDN, WS_MDN = WS_MUP + 2 * SZ_MUP, WS_WEND = WS_MDN + 2 * SZ_MDN;
constexpr size_t WS_XS = (WS_WEND + 255) & ~(size_t)255;
constexpr size_t WS_HB = WS_XS + (size_t)MTOT * DM * 4;
constexpr size_t WS_U = WS_HB + (size_t)MTOT * DM * 2;
constexpr size_t WS_PRJ = WS_U;
constexpr size_t WS_GT = WS_PRJ + (size_t)MTOT * PRJW * 2;
constexpr size_t WS_OC = WS_GT + (size_t)MTOT * GTW * 2;
constexpr size_t WS_ST = WS_OC + (size_t)MTOT * OCW * 2;
constexpr size_t WS_UEND = WS_ST + (size_t)NB * NCH * 16 * 8192 * 4;
constexpr size_t WS_HID = WS_U;
constexpr size_t WS_XPAD = WS_HID + (size_t)MOE_ROWS_MAX * DFFE * 2;
constexpr size_t WS_YPAD = WS_XPAD + (size_t)MOE_ROWS_MAX * DM * 2;
static_assert(WS_YPAD + (size_t)MOE_ROWS_MAX * DM * 2 <= WS_UEND, "FFN overlay fits the union region");
constexpr size_t WS_END = WS_UEND;
constexpr int CW_BAR = 4096, CW_MOECNT = 16384;

constexpr int RING_BYTES = 131072, MISC_OFF = RING_BYTES + 320, LDS_BYTES = 147456;
constexpr int NWAVES = 8, NTHR = 512;

DI unsigned pk2(float lo, float hi) { f32x2 v = {lo, hi}; bf16x2_t b = __builtin_convertvector(v, bf16x2_t); return __builtin_bit_cast(unsigned, b); }
DI float bflo(unsigned u) { return __uint_as_float(u << 16); }
DI float bfhi(unsigned u) { return __uint_as_float(u & 0xffff0000u); }
DI f32x4 ld4bf(const bf16_t* p) { const u32x2 u = *(const u32x2*)p; return (f32x4){bflo(u.x), bfhi(u.x), bflo(u.y), bfhi(u.y)}; }
DI void st4bf(bf16_t* p, const f32x4 v) { u32x2 w; w.x = pk2(v[0], v[1]); w.y = pk2(v[2], v[3]); *(u32x2*)p = w; }
DI float sigm(float x) { return __builtin_amdgcn_rcpf(1.f + __expf(-x)); }
DI float silu(float x) { return x * sigm(x); }
DI float wave_sum(float v) {
#pragma unroll
    for (int o = 1; o < 64; o <<= 1) v += __shfl_xor(v, o);
    return v;
}
DI int clampi(int v, int lo, int hi) { return v < lo ? lo : (v > hi ? hi : v); }
#define MFMA32(a, b, c) __builtin_amdgcn_mfma_f32_32x32x16_bf16((a), (b), (c), 0, 0, 0)
DI int crow(int reg, int h) { return (reg & 3) + 8 * (reg >> 2) + 4 * h; }
typedef short v4i16_t __attribute__((ext_vector_type(4)));
DI s16x4 tr_read(const LAS unsigned char* p) { return __builtin_bit_cast(s16x4, __builtin_amdgcn_ds_read_tr16_b64_v4i16((LAS v4i16_t*)p)); }
DI bf16x8 cat8(s16x4 lo, s16x4 hi) { return __builtin_shufflevector(lo, hi, 0, 1, 2, 3, 4, 5, 6, 7); }
template <int S> DI bf16x8 pack8(const f32x16& x) {
    u32x4 w; w.x = pk2(x[8 * S], x[8 * S + 1]); w.y = pk2(x[8 * S + 2], x[8 * S + 3]); w.z = pk2(x[8 * S + 4], x[8 * S + 5]); w.w = pk2(x[8 * S + 6], x[8 * S + 7]);
    return __builtin_bit_cast(bf16x8, w);
}

#define XB_TMO      128
#define XB_XCNT(j)  (256  + 64 * (j))
#define XB_XSUB(j)  (1280 + 64 * (j))
#define XB_XGEN(j)  (2304 + 64 * (j))
#define XB_TOP      3328
#define XB_TOPGEN   3392
#define XCD_BAR_WORDS 3456
#define XB_SPIN_CAP (1u << 18)
DI unsigned xb_ld(unsigned* p)              { return __hip_atomic_load(p, __ATOMIC_RELAXED, __HIP_MEMORY_SCOPE_AGENT); }
DI unsigned xb_add(unsigned* p, unsigned v) { return __hip_atomic_fetch_add(p, v, __ATOMIC_RELAXED, __HIP_MEMORY_SCOPE_AGENT); }
DI unsigned xb_xcc_id() { return (unsigned)__builtin_amdgcn_s_getreg((3 << 11) | 20) & 0xFu; }
#define XB_SPIN(cond, bar) do { unsigned _sp = 0; while (cond) { __builtin_amdgcn_s_sleep(1); \
    if ((++_sp & 255u) == 0u) { if (xb_ld(&(bar)[XB_TMO])) break; if (_sp > XB_SPIN_CAP) { atomicAdd(&(bar)[XB_TMO], 1u); break; } } } } while (0)
struct XcdBarrier { unsigned* bar; unsigned x; volatile LAS unsigned* st; };
DI XcdBarrier xcd_barrier_post(unsigned* bar, volatile LAS unsigned* st) {
    XcdBarrier b; b.bar = bar; b.x = xb_xcc_id(); b.st = st;
    if (threadIdx.x == 0) (void)xb_add(&bar[XB_XCNT(b.x)], 1u);
    return b;
}
DI void xcd_barrier_complete(unsigned* bar, unsigned x, unsigned& nloc, unsigned& nx) {
    const unsigned G = gridDim.x * gridDim.y * gridDim.z;
    unsigned sum, cnt, mine, sp = 0u;
    for (;;) {
        sum = 0u; cnt = 0u; mine = 0u;
#pragma unroll
        for (unsigned j = 0; j < 16; ++j) { const unsigned c = xb_ld(&bar[XB_XCNT(j)]); sum += c; cnt += (c > 0u) ? 1u : 0u; mine = (j == x) ? c : mine; }
        if (sum == G) break;
        __builtin_amdgcn_s_sleep(1);
        if ((++sp & 255u) == 0u) { if (xb_ld(&bar[XB_TMO])) break; if (sp > XB_SPIN_CAP) { atomicAdd(&bar[XB_TMO], 1u); break; } }
    }
    nloc = mine > 0u ? mine : 1u; nx = cnt > 0u ? cnt : 1u;
}
DI void xcd_barrier(const XcdBarrier& b) {
    asm volatile("s_waitcnt vmcnt(0)" ::: "memory");
    __syncthreads();
    if (threadIdx.x == 0) {
        unsigned* bar = b.bar;
        __builtin_amdgcn_s_waitcnt(0);
        unsigned nloc = b.st[0], nx = b.st[1];
        if (nloc == 0u) { xcd_barrier_complete(bar, b.x, nloc, nx); b.st[0] = nloc; b.st[1] = nx; }
        const unsigned old = xb_add(&bar[XB_XSUB(b.x)], 1u);
        const unsigned gen = old / nloc;
        if (old + 1u == (gen + 1u) * nloc) {
            __builtin_amdgcn_fence(__ATOMIC_RELEASE, "agent");
            asm volatile("s_waitcnt vmcnt(0)" ::: "memory");
            const unsigned og = xb_add(&bar[XB_TOP], 1u);
            const unsigned tg = og / nx;
            if (og + 1u == (tg + 1u) * nx) xb_add(&bar[XB_TOPGEN], 1u);
            else XB_SPIN(xb_ld(&bar[XB_TOPGEN]) == tg, bar);
            __builtin_amdgcn_fence(__ATOMIC_ACQUIRE, "agent");
            xb_add(&bar[XB_XGEN(b.x)], 1u);
            asm volatile("s_waitcnt vmcnt(0)" ::: "memory");
        } else {
            XB_SPIN(xb_ld(&bar[XB_XGEN(b.x)]) == gen, bar);
            __builtin_amdgcn_fence(__ATOMIC_ACQUIRE, "agent");
            asm volatile("s_waitcnt vmcnt(0)" ::: "memory");
        }
    }
    __syncthreads();
}

namespace pg8 {
constexpr int BM = 256, BK = 64, HALF = 128, HTB = HALF * BK * 2, STAGE_BYTES = 8 * HTB;
__host__ __device__ __forceinline__ int lds_byte(int r, int c) { const int st = (r >> 4) * 2 + (c >> 5), rr = r & 15, cc = c & 31, ob = rr * 64 + cc * 2; return st * 1024 + (ob ^ (((ob >> 9) & 1) << 5)); }
__host__ __device__ __forceinline__ void stage_rc(int b, int& R, int& C) { const int st = b / 1024, sb = b % 1024, swz = sb ^ (((sb >> 9) & 1) << 5); R = (st >> 1) * 16 + swz / 64; C = (st & 1) * 32 + (swz % 64) / 2; }
__host__ __device__ __forceinline__ int perm32(int rho) { const int n = rho >> 4, i = rho & 15; return 8 * (i >> 2) + 4 * n + (i & 3); }
struct Unit { int pm, pn, dup; const char* A; const char* B; };

template <class Epi, class Sched, bool HM = false>
DI void gemm_phase(LAS unsigned char* lds, const int tid, const int K, const int lda, const int ldb, const Sched& S, const Epi& E) {
    const int wid = __builtin_amdgcn_readfirstlane(tid >> 6), lane = tid & 63, wr = wid >> 2, wc = wid & 3, fr = lane & 15, fq = lane >> 4;
    const int nt = K / BK;
    unsigned voffA[2], voffB[2];
#pragma unroll
    for (int i = 0; i < 2; ++i) { int R, C; stage_rc(tid * 16 + i * 8192, R, C); const int Rb = (R & ~31) + perm32(R & 31);
        voffA[i] = (unsigned)(R * lda + C) * 2u; voffB[i] = (unsigned)(Rb * ldb + C) * 2u; }
    const size_t kstep = (size_t)(BK * 2);
    const size_t hstepA = (size_t)HALF * lda * 2, hstepB = (size_t)HALF * ldb * 2;
    const unsigned ldsw = (unsigned)wid * 1024u;
    const int aoff = lds_byte(wr * 64 + fr, fq * 8), boff = lds_byte(wc * 32 + fr, fq * 8);
#define PG8_SA(b, h) (((b) * 2 + (h)) * HTB)
#define PG8_SB(b, h) ((4 + (b) * 2 + (h)) * HTB)
#define PG8_STAGE(bufoff, gbase, voff) do { _Pragma("unroll") for (int _i = 0; _i < 2; ++_i) \
        __builtin_amdgcn_global_load_lds((const unsigned*)((const char*)(gbase) + (voff)[_i]), (LAS unsigned*)(lds + (bufoff) + ldsw + _i * 8192), 16, 0, 0); } while (0)
#define PG8_LDA(dst, b, h) do { _Pragma("unroll") for (int m = 0; m < 4; ++m) _Pragma("unroll") for (int k = 0; k < 2; ++k) dst[m][k] = *(const LAS bf16x8*)(lds + PG8_SA(b, h) + aoff + m * 2048 + k * 1024); } while (0)
#define PG8_LDB(dst, b, h) do { _Pragma("unroll") for (int n = 0; n < 2; ++n) _Pragma("unroll") for (int k = 0; k < 2; ++k) dst[n][k] = *(const LAS bf16x8*)(lds + PG8_SB(b, h) + boff + n * 2048 + k * 1024); } while (0)
#define PG8_MMA(ai, bj, At, Bt) do { __builtin_amdgcn_s_setprio(1); _Pragma("unroll") for (int m = 0; m < 4; ++m) _Pragma("unroll") for (int n = 0; n < 2; ++n) _Pragma("unroll") for (int k = 0; k < 2; ++k) \
        acc[ai][bj][m][n] = __builtin_amdgcn_mfma_f32_16x16x32_bf16(Bt[n][k], At[m][k], acc[ai][bj][m][n], 0, 0, 0); __builtin_amdgcn_s_setprio(0); } while (0)
#define PG8_WAIT_V(n) asm volatile("s_waitcnt vmcnt(" #n ")" ::: "memory")
#define PG8_WAIT_L(n) asm volatile("s_waitcnt lgkmcnt(" #n ")" ::: "memory")
#define PG8_BAR __builtin_amdgcn_s_barrier()
#define PG8_SCHED __builtin_amdgcn_sched_barrier(0)
    Unit cur, nxt; int ui = 0;
    if (!S.next(0, cur)) return;
    f32x4 acc[2][2][4][2];
#pragma unroll
    for (int a = 0; a < 2; ++a)
#pragma unroll
        for (int b = 0; b < 2; ++b)
#pragma unroll
            for (int m = 0; m < 4; ++m)
#pragma unroll
                for (int n = 0; n < 2; ++n) acc[a][b][m][n] = (f32x4){0.f, 0.f, 0.f, 0.f};
    bf16x8 At[4][2], B0[2][2], B1[2][2];
    const char* cA = cur.A; const char* cB = cur.B;
    PG8_STAGE(PG8_SB(0, 0), cB, voffB); PG8_STAGE(PG8_SB(0, 1), cB + hstepB, voffB); PG8_STAGE(PG8_SA(0, 0), cA, voffA); PG8_STAGE(PG8_SA(0, 1), cA + hstepA, voffA);
    if (wr == 1) PG8_BAR;
    PG8_WAIT_V(2); PG8_BAR;
    PG8_STAGE(PG8_SB(1, 0), cB + kstep, voffB); PG8_STAGE(PG8_SA(1, 0), cA + kstep, voffA); PG8_STAGE(PG8_SB(1, 1), cB + hstepB + kstep, voffB);
    PG8_WAIT_V(6); PG8_BAR;
    for (;;) {
        const bool has_next = S.next(ui + 1, nxt);
        const char* nA = has_next ? nxt.A : cA; const char* nB = has_next ? nxt.B : cB;
        for (int t = 0; t < nt; t += 2) {
            const bool last = (t == nt - 2);
            const char* a1 = cA + (size_t)(t + 1) * kstep;
            const char* a2 = last ? nA : cA + (size_t)(t + 2) * kstep; const char* b2 = last ? nB : cB + (size_t)(t + 2) * kstep;
            const char* a3 = a2 + kstep; const char* b3 = b2 + kstep;
            PG8_LDB(B0, 0, 0); PG8_LDB(B1, 0, 1); PG8_SCHED; PG8_LDA(At, 0, 0); PG8_STAGE(PG8_SA(1, 1), a1 + hstepA, voffA);
            PG8_WAIT_V(8); PG8_WAIT_L(0); PG8_BAR; PG8_MMA(0, 0, At, B0); PG8_MMA(0, 1, At, B1); PG8_BAR; PG8_SCHED;
            PG8_LDA(At, 0, 1); PG8_STAGE(PG8_SB(0, 0), b2, voffB); PG8_STAGE(PG8_SB(0, 1), b2 + hstepB, voffB); PG8_STAGE(PG8_SA(0, 0), a2, voffA);
            PG8_WAIT_V(8); PG8_WAIT_L(0); PG8_BAR; if constexpr (!HM) { PG8_MMA(1, 0, At, B0); PG8_MMA(1, 1, At, B1); } PG8_BAR; PG8_SCHED;
            PG8_LDB(B0, 1, 0); PG8_LDB(B1, 1, 1); PG8_SCHED; PG8_LDA(At, 1, 0); PG8_STAGE(PG8_SA(0, 1), a2 + hstepA, voffA);
            PG8_WAIT_V(8); PG8_WAIT_L(0); PG8_BAR; PG8_MMA(0, 0, At, B0); PG8_MMA(0, 1, At, B1); PG8_BAR; PG8_SCHED;
            PG8_LDA(At, 1, 1); PG8_STAGE(PG8_SB(1, 0), b3, voffB); PG8_STAGE(PG8_SB(1, 1), b3 + hstepB, voffB); PG8_STAGE(PG8_SA(1, 0), a3, voffA);
            PG8_WAIT_V(8); PG8_WAIT_L(0); PG8_BAR; if constexpr (!HM) { PG8_MMA(1, 0, At, B0); PG8_MMA(1, 1, At, B1); } PG8_BAR; PG8_SCHED;
        }
        if (wr == 0) PG8_BAR;
        E(acc, cur, wr, wc, fr, fq);
        if (!has_next) break;
#pragma unroll
        for (int a = 0; a < (HM ? 1 : 2); ++a)
#pragma unroll
            for (int b = 0; b < 2; ++b)
#pragma unroll
                for (int m = 0; m < 4; ++m)
#pragma unroll
                    for (int n = 0; n < 2; ++n) acc[a][b][m][n] = (f32x4){0.f, 0.f, 0.f, 0.f};
        cur = nxt; cA = nA; cB = nB; ++ui;
        if (wr == 1) PG8_BAR;
    }
    PG8_WAIT_V(0);
    PG8_BAR;
#undef PG8_SA
#undef PG8_SB
#undef PG8_STAGE
#undef PG8_LDA
#undef PG8_LDB
#undef PG8_MMA
#undef PG8_WAIT_V
#undef PG8_WAIT_L
#undef PG8_BAR
#undef PG8_SCHED
}

struct SchedGrid {
    int nMa, nNa, nMb, nNb, total, G, c; const char* A; const char* B; int lda, ldb, a_div, a_cols; const LAS int* pe; size_t estride; int rep;
    DI bool next(int i, Unit& u) const {
        const long L = (long)(i >> rep) * G + c; if (L >= total) return false;
        u.dup = i & rep;
        const int La = nMa * nNa; int pm, pn;
        if (L < La) { pm = (int)L / nNa; pn = (int)L % nNa; } else { const int r = (int)L - La; pm = nMa + r / nNb; pn = r % nNb; }
        size_t eoff = 0;
        if (pe) { int e = 0;
#pragma unroll
            for (int j = 0; j < 7; ++j) e += (pe[j] <= pm * 256) ? 1 : 0;
            eoff = (size_t)__builtin_amdgcn_readfirstlane(e) * estride; }
        u.pm = pm; u.pn = pn; u.A = A + ((size_t)pm * 256 * lda + (size_t)(pn / a_div) * a_cols) * 2; u.B = B + eoff + (size_t)pn * 256 * ldb * 2; return true;
    }
};

struct SchedBranch {
    int T, G, c; const char* A; const char* B; int rep;
    DI bool next(int n, Unit& u) const {
        const int tile = c + (n >> (2 + rep)) * G; if (tile >= T) return false;
        const int i = n & 3, pm = tile >> 2, pc = tile & 3;
        u.dup = 0; u.pm = pm; u.pn = i * 4 + pc; u.A = A + ((size_t)pm * 128 * OCW + (size_t)i * 512) * 2; u.B = B + (size_t)(i * 1024 + pc * 256) * 512 * 2; return true;
    }
};
struct EpiInGate {
    bf16_t* PRJ; bf16_t* GT; const float* bg;
    DI void operator()(f32x4 (&acc)[2][2][4][2], const Unit& u, int wr, int wc, int fr, int fq) const {
        const int row0 = u.pm * BM + wr * 64 + fr; const bool sg = u.pn >= 18;
        bf16_t* base = sg ? GT : PRJ; const int ldc = sg ? GTW : PRJW; const int col0 = (sg ? (u.pn - 18) : u.pn) * BM + wc * 32 + 8 * fq;
        f32x4 bv[2][2];
#pragma unroll
        for (int bj = 0; bj < 2; ++bj)
#pragma unroll
            for (int n = 0; n < 2; ++n) bv[bj][n] = sg ? *(const f32x4*)(bg + col0 + bj * HALF + 4 * n) : (f32x4){0.f, 0.f, 0.f, 0.f};
#pragma unroll
        for (int ai = 0; ai < 2; ++ai)
#pragma unroll
            for (int m = 0; m < 4; ++m) { bf16_t* rowp = base + (size_t)(row0 + ai * HALF + m * 16) * ldc + col0;
#pragma unroll
                for (int bj = 0; bj < 2; ++bj) { f32x4 v0 = acc[ai][bj][m][0] + bv[bj][0], v1 = acc[ai][bj][m][1] + bv[bj][1];
                    if (sg) { v0 = (f32x4){sigm(v0[0]), sigm(v0[1]), sigm(v0[2]), sigm(v0[3])}; v1 = (f32x4){sigm(v1[0]), sigm(v1[1]), sigm(v1[2]), sigm(v1[3])}; }
                    u32x4 w; w.x = pk2(v0[0], v0[1]); w.y = pk2(v0[2], v0[3]); w.z = pk2(v1[0], v1[1]); w.w = pk2(v1[2], v1[3]);
                    *(u32x4*)(rowp + bj * HALF) = w; } }
    }
};
struct EpiBranch {
    const bf16_t* GT; const float* SSQ; bf16_t* MRG;
    DI void operator()(f32x4 (&acc)[2][2][4][2], const Unit& u, int wr, int wc, int fr, int fq) const {
        const int i = u.pn >> 2, pc = u.pn & 3;
        const int row0 = u.pm * HALF + wr * 64 + fr; const int gcol0 = u.pn * BM + wc * 32 + 8 * fq, col0 = pc * BM + wc * 32 + 8 * fq;
#pragma unroll
        for (int mp = 0; mp < 4; ++mp) {
            u32x4 g[1][2]; float rs[1];
#pragma unroll
            for (int mm = 0; mm < 1; ++mm) { const int row = row0 + (mp + mm) * 16; const bf16_t* gp = GT + (size_t)row * GTW + gcol0;
                g[mm][0] = *(const u32x4*)gp; g[mm][1] = *(const u32x4*)(gp + HALF); rs[mm] = 1.f;
                if (i == 3) { const f32x4 s0 = *(const f32x4*)(SSQ + (size_t)row * 8), s1 = *(const f32x4*)(SSQ + (size_t)row * 8 + 4);
                    rs[mm] = __builtin_amdgcn_rsqf(((s0[0] + s0[1]) + (s0[2] + s0[3]) + (s1[0] + s1[1]) + (s1[2] + s1[3])) * (1.f / 512.f) + RMS_EPS); } }
#pragma unroll
            for (int mm = 0; mm < 1; ++mm) { const int m = mp + mm;
#pragma unroll
                for (int bj = 0; bj < 2; ++bj) { const u32x4 gg = g[mm][bj]; const f32x4 a0 = acc[0][bj][m][0] * rs[mm], a1 = acc[0][bj][m][1] * rs[mm];
                    acc[1][bj][m][0] += (f32x4){bflo(gg.x) * a0[0], bfhi(gg.x) * a0[1], bflo(gg.y) * a0[2], bfhi(gg.y) * a0[3]};
                    acc[1][bj][m][1] += (f32x4){bflo(gg.z) * a1[0], bfhi(gg.z) * a1[1], bflo(gg.w) * a1[2], bfhi(gg.w) * a1[3]}; } }
        }
        if (i == 3) {
#pragma unroll
            for (int m = 0; m < 4; ++m)
#pragma unroll
                for (int bj = 0; bj < 2; ++bj) { const f32x4 t0 = acc[1][bj][m][0], t1 = acc[1][bj][m][1];
                    u32x4 w; w.x = pk2(t0[0], t0[1]); w.y = pk2(t0[2], t0[3]); w.z = pk2(t1[0], t1[1]); w.w = pk2(t1[2], t1[3]);
                    *(u32x4*)(MRG + (size_t)(row0 + m * 16) * DM + col0 + bj * HALF) = w;
                    acc[1][bj][m][0] = (f32x4){0.f, 0.f, 0.f, 0.f}; acc[1][bj][m][1] = (f32x4){0.f, 0.f, 0.f, 0.f}; }
        }
    }
};
struct EpiResid {
    bf16_t* XS; const float* mv; bf16_t* plainO; bf16_t* dummy;
    DI void operator()(f32x4 (&acc)[2][2][4][2], const Unit& u, int wr, int wc, int fr, int fq) const {
        const int row0 = u.pm * BM + wr * 64 + fr; const int col0 = u.pn * BM + wc * 32 + 8 * fq;
        if (plainO || u.dup) { bf16_t* const po = plainO ? plainO : dummy;
#pragma unroll
            for (int ai = 0; ai < 2; ++ai)
#pragma unroll
                for (int m = 0; m < 4; ++m) { bf16_t* rowp = po + (size_t)(row0 + ai * HALF + m * 16) * DM + col0;
#pragma unroll
                    for (int bj = 0; bj < 2; ++bj) { const f32x4 v0 = acc[ai][bj][m][0], v1 = acc[ai][bj][m][1];
                        u32x4 w; w.x = pk2(v0[0], v0[1]); w.y = pk2(v0[2], v0[3]); w.z = pk2(v1[0], v1[1]); w.w = pk2(v1[2], v1[3]);
                        *(u32x4*)(rowp + bj * HALF) = w; } }
            return;
        }
        const int v = u.pm < 128 ? (u.pm >> 5) : 4;
        const float* g = mv + (size_t)v * 6144 + col0;
        f32x4 gv[2][2];
#pragma unroll
        for (int bj = 0; bj < 2; ++bj)
#pragma unroll
            for (int n = 0; n < 2; ++n) gv[bj][n] = *(const f32x4*)(g + bj * HALF + 4 * n);
#pragma unroll
        for (int ai = 0; ai < 2; ++ai)
#pragma unroll
            for (int mp = 0; mp < 2; ++mp) {
                u32x4 x[2][2];
#pragma unroll
                for (int mm = 0; mm < 2; ++mm) { const bf16_t* rowp = XS + (size_t)(row0 + ai * HALF + (2 * mp + mm) * 16) * DM + col0;
#pragma unroll
                    for (int bj = 0; bj < 2; ++bj) x[mm][bj] = *(const u32x4*)(rowp + bj * HALF); }
#pragma unroll
                for (int mm = 0; mm < 2; ++mm) { const int m = 2 * mp + mm; bf16_t* rowp = XS + (size_t)(row0 + ai * HALF + m * 16) * DM + col0;
#pragma unroll
                    for (int bj = 0; bj < 2; ++bj) { const u32x4 xx = x[mm][bj];
                        const f32x4 y0 = (f32x4){bflo(xx.x), bfhi(xx.x), bflo(xx.y), bfhi(xx.y)} * ALPHA + gv[bj][0] * acc[ai][bj][m][0];
                        const f32x4 y1 = (f32x4){bflo(xx.z), bfhi(xx.z), bflo(xx.w), bfhi(xx.w)} * ALPHA + gv[bj][1] * acc[ai][bj][m][1];
                        u32x4 w; w.x = pk2(y0[0], y0[1]); w.y = pk2(y0[2], y0[3]); w.z = pk2(y1[0], y1[1]); w.w = pk2(y1[2], y1[3]); *(u32x4*)(rowp + bj * HALF) = w; } }
            }
    }
};
struct EpiSwiGLU {
    bf16_t* HID; int ldc;
    DI void operator()(f32x4 (&acc)[2][2][4][2], const Unit& u, int wr, int wc, int fr, int fq) const {
        const int row0 = u.pm * BM + wr * 64 + fr; const int col0 = u.pn * HALF + wc * 32 + 8 * fq;
#pragma unroll
        for (int ai = 0; ai < 2; ++ai)
#pragma unroll
            for (int m = 0; m < 4; ++m) { bf16_t* rowp = HID + (size_t)(row0 + ai * HALF + m * 16) * ldc + col0;
                const f32x4 g0 = acc[ai][0][m][0], g1 = acc[ai][0][m][1], u0 = acc[ai][1][m][0], u1 = acc[ai][1][m][1];
                u32x4 w; w.x = pk2(silu(g0[0]) * u0[0], silu(g0[1]) * u0[1]); w.y = pk2(silu(g0[2]) * u0[2], silu(g0[3]) * u0[3]);
                w.z = pk2(silu(g1[0]) * u1[0], silu(g1[1]) * u1[1]); w.w = pk2(silu(g1[2]) * u1[2], silu(g1[3]) * u1[3]);
                *(u32x4*)rowp = w; }
    }
};
}

struct Args { const float* in[31]; float* out; unsigned char* ws; int ph_lo, ph_hi; };
enum { I_X = 0, I_C, I_CTX, I_CCTX, I_WMOD, I_BMOD, I_WIN, I_WGATE, I_BGATE, I_RPB, I_SINK, I_QGQ, I_QGK, I_CONVW, I_CONVB, I_DTB, I_ALOG, I_DSKIP, I_NORMG,
       I_WBR, I_WOUT, I_LN1G, I_LN1B, I_LN2G, I_LN2B, I_FUP, I_FDN, I_MRW, I_MRB, I_MUP, I_MDN };
struct Frame {
    LAS unsigned char* lds; gu32* ctl; int tid, lane, wave, vcu, G;
    const float* const* in; float* out; unsigned char* ws;
};
#define WSP(T, off) ((T*)(F.ws + (off)))
DI Frame launder(const Frame& F0) {
    Frame F = F0;
    asm volatile("" : "+v"(F.tid), "+v"(F.lane));
    asm volatile("" : "+s"(F.wave), "+s"(F.vcu), "+s"(F.ws), "+s"(F.lds));
    F.ws = (unsigned char*)(GAS unsigned char*)F.ws;
    return F;
}

DI void transpose_item(const float* W, int ld, bf16_t* dst, int ldk, int koff, int map_h, int rowoff, int cscale, const float* kscale, LAS float* scr, int kb, int nb, int lane) {
    const int k0 = 64 * kb, n0 = 32 * nb;
    float tmp[32];
#pragma unroll
    for (int i = 0; i < 32; ++i) tmp[i] = W[(size_t)(k0 + 2 * i + (lane >> 5)) * ld + n0 + (lane & 31)];
#pragma unroll
    for (int i = 0; i < 32; ++i) scr[(2 * i + (lane >> 5)) * 33 + (lane & 31)] = tmp[i];
    asm volatile("s_waitcnt lgkmcnt(0)" ::: "memory");
    const int c = lane & 7;
    float ks[8];
#pragma unroll
    for (int e = 0; e < 8; ++e) ks[e] = kscale ? kscale[k0 + 8 * c + e] : 1.f;
#pragma unroll
    for (int j = 0; j < 4; ++j) { const int nl = (lane >> 3) + 8 * j, n = n0 + nl; const LAS float* s = scr + (8 * c) * 33 + nl;
        float cs = 1.f; if (cscale && (n < 512 || (n >= 1536 && n < 2048))) cs = C2;
        int drow;
        if (map_h == 0) drow = rowoff + n;
        else if (n < map_h) drow = rowoff + 256 * (n >> 7) + (n & 127);
        else { const int n2 = n - map_h; drow = rowoff + 256 * (n2 >> 7) + 128 + (n2 & 127); }
        u32x4 o; o.x = pk2(s[0 * 33] * ks[0] * cs, s[1 * 33] * ks[1] * cs); o.y = pk2(s[2 * 33] * ks[2] * cs, s[3 * 33] * ks[3] * cs);
        o.z = pk2(s[4 * 33] * ks[4] * cs, s[5 * 33] * ks[5] * cs); o.w = pk2(s[6 * 33] * ks[6] * cs, s[7 * 33] * ks[7] * cs);
        *(u32x4*)(dst + (size_t)drow * ldk + koff + k0 + 8 * c) = o; }
    asm volatile("s_waitcnt lgkmcnt(0)" ::: "memory");
}
struct CvtJob { const float* W; int K, N, ld; bf16_t* dst; int ldk, koff, map_h, rowoff, cscale; const float* kscale; };
DI void get_job(const Frame& F, int j, CvtJob& J) {
    J.koff = 0; J.map_h = 0; J.rowoff = 0; J.cscale = 0; J.kscale = nullptr;
    if (j < 52) {
        const int l = j / 13, r = j % 13;
        if (r == 0) { J.W = F.in[I_WIN] + (size_t)l * DM * DIN; J.K = DM; J.N = PRJW; J.ld = DIN; J.dst = WSP(bf16_t, WS_WCOMB + l * SZ_WCOMB); J.ldk = DM; J.cscale = 1; }
        else if (r < 5) { const int i = r - 1; J.W = F.in[I_WGATE] + ((size_t)l * 4 + i) * DM * DM; J.K = DM; J.N = DM; J.ld = DM; J.dst = WSP(bf16_t, WS_WCOMB + l * SZ_WCOMB); J.ldk = DM; J.rowoff = PRJW + 1024 * i; }
        else if (r < 9) { const int i = r - 5; J.W = F.in[I_WBR] + ((size_t)l * 4 + i) * 512 * DM; J.K = 512; J.N = DM; J.ld = DM; J.dst = WSP(bf16_t, WS_WB + l * SZ_WB); J.ldk = 512; J.rowoff = 1024 * i;
            if (i == 3) J.kscale = F.in[I_NORMG] + l * 512; }
        else { J.W = F.in[I_WOUT] + (size_t)l * DM * DM; J.K = (r == 9) ? DM : 0; J.N = DM; J.ld = DM; J.dst = WSP(bf16_t, WS_WO + l * SZ_WO); J.ldk = DM; }
    } else if (j < 56) {
        const int i = (j - 52) >> 1;
        if (((j - 52) & 1) == 0) { J.W = F.in[I_FUP] + (size_t)i * DM * 2 * DFF; J.K = DM; J.N = 2 * DFF; J.ld = 2 * DFF; J.dst = WSP(bf16_t, WS_WUP + i * SZ_WUP); J.ldk = DM; J.map_h = DFF; }
        else { J.W = F.in[I_FDN] + (size_t)i * DFF * DM; J.K = DFF; J.N = DM; J.ld = DM; J.dst = WSP(bf16_t, WS_WDN + i * SZ_WDN); J.ldk = DFF; }
    } else {
        const int q = j - 56, ie = q >> 1, i = ie >> 3, e = ie & 7;
        if ((q & 1) == 0) { J.W = F.in[I_MUP] + ((size_t)i * NEXP + e) * DM * 2 * DFFE; J.K = DM; J.N = 2 * DFFE; J.ld = 2 * DFFE; J.dst = WSP(bf16_t, WS_MUP + i * SZ_MUP); J.ldk = DM; J.map_h = DFFE; J.rowoff = e * 2 * DFFE; }
        else { J.W = F.in[I_MDN] + ((size_t)i * NEXP + e) * DFFE * DM; J.K = DFFE; J.N = DM; J.ld = DM; J.dst = WSP(bf16_t, WS_MDN + i * SZ_MDN); J.ldk = DFFE; J.rowoff = e * DM; }
    }
}
constexpr int NJOBS = 52 + 4 + 32;

DI void phase_prologue_a(const Frame& F) {
    const int NGW = F.G * NWAVES, gw = F.vcu * NWAVES + F.wave;
    {
        LAS float* sv = (LAS float*)(F.lds + 73728);
        LAS float* red = (LAS float*)(F.lds + 73728 + 20480);
        for (int i = F.tid; i < 5 * 1024; i += NTHR) { const int v = i >> 10, k = i & 1023; const float c = v < 4 ? F.in[I_C][v * DM + k] : F.in[I_CCTX][k]; sv[i] = silu(c); }
        __syncthreads();
        float* MV = WSP(float, WS_MVEC);
        for (int item = F.vcu; item < 4 * 96; item += F.G) {
            const int l = item / 96, n0 = (item % 96) * 64, c = F.tid & 63, ks = F.tid >> 6;
            const float* w = F.in[I_WMOD] + (size_t)l * DM * 6144 + n0 + c;
            float a0 = 0.f, a1 = 0.f, a2 = 0.f, a3 = 0.f, a4 = 0.f;
#pragma unroll 8
            for (int k = ks * 128; k < ks * 128 + 128; ++k) { const float wv = w[(size_t)k * 6144]; a0 += sv[k] * wv; a1 += sv[1024 + k] * wv; a2 += sv[2048 + k] * wv; a3 += sv[3072 + k] * wv; a4 += sv[4096 + k] * wv; }
            red[(ks * 5 + 0) * 64 + c] = a0; red[(ks * 5 + 1) * 64 + c] = a1; red[(ks * 5 + 2) * 64 + c] = a2; red[(ks * 5 + 3) * 64 + c] = a3; red[(ks * 5 + 4) * 64 + c] = a4;
            __syncthreads();
            if (F.tid < 320) { const int v = F.tid >> 6, cc = F.tid & 63; float s = F.in[I_BMOD][l * 6144 + n0 + cc];
#pragma unroll
                for (int q = 0; q < 8; ++q) s += red[(q * 5 + v) * 64 + cc];
                MV[((size_t)l * 5 + v) * 6144 + n0 + cc] = s; }
            __syncthreads();
        }
    }
    {
        float* rc = WSP(float, WS_ROPE); float* rs = rc + SEQ * 32;
        for (int i = F.vcu * NTHR + F.tid; i < SEQ * 32; i += F.G * NTHR) {
            const int t = i >> 5, p = i & 31; const float pos = (p < 16) ? (float)(t >> 6) : (float)(t & 63);
            const float invf = exp2f(-(float)(p & 15) * (13.287712379549449f / 16.f));
            const float ang = pos * invf; const float rev = ang * 0.15915494309189535f; const float fr = rev - rintf(rev);
            rc[i] = __builtin_amdgcn_cosf(fr); rs[i] = __builtin_amdgcn_sinf(fr);
        }
    }
    {
        LAS float* scr = (LAS float*)(F.lds + F.wave * 8448);
        int base = 0;
        for (int j = 0; j < NJOBS; ++j) {
            CvtJob J; get_job(F, j, J);
            const int nblk = J.N / 32, nit = (J.K / 64) * nblk;
            int vid = (gw - base) % NGW; if (vid < 0) vid += NGW;
            for (int it = vid; it < nit; it += NGW) transpose_item(J.W, J.ld, J.dst, J.ldk, J.koff, J.map_h, J.rowoff, J.cscale, J.kscale, scr, it / nblk, it % nblk, F.lane);
            base = (base + nit) % NGW;
        }
    }
}

DI void load_wdt(const Frame& F, int l) {
    LAS float* wd = (LAS float*)F.lds; const float* w = F.in[I_WIN] + (size_t)l * DM * DIN + PRJW;
    for (int i = F.tid; i < DM * 16; i += NTHR) { const int k = i >> 4; wd[(((k & 3) << 8) + (k >> 2)) * 20 + (i & 15)] = w[(size_t)k * DIN + (i & 15)]; }
}
DI void emit_h_dt(const Frame& F, const f32x4 (&xn)[4], const float* mv, int m, const float* dtb) {
    bf16_t* hb = WSP(bf16_t, WS_HB) + (size_t)m * DM; float* DT = WSP(float, WS_DT);
    const LAS float* wd = (const LAS float*)F.lds;
    float acc[16];
#pragma unroll
    for (int c = 0; c < 16; ++c) acc[c] = 0.f;
#pragma unroll
    for (int j = 0; j < 4; ++j) {
        const int k = 4 * F.lane + 256 * j;
        const f32x4 sh = *(const f32x4*)(mv + k), sc = *(const f32x4*)(mv + 1024 + k);
        const f32x4 h = xn[j] * (sc + 1.f) + sh;
        u32x2 w; w.x = pk2(h[0], h[1]); w.y = pk2(h[2], h[3]); *(u32x2*)(hb + k) = w;
#pragma unroll
        for (int e = 0; e < 4; ++e) {
            const LAS f32x4* wr = (const LAS f32x4*)(wd + ((e << 8) + (k >> 2)) * 20);
#pragma unroll
            for (int q = 0; q < 4; ++q) { const f32x4 wv = wr[q]; acc[4 * q] += h[e] * wv[0]; acc[4 * q + 1] += h[e] * wv[1]; acc[4 * q + 2] += h[e] * wv[2]; acc[4 * q + 3] += h[e] * wv[3]; }
            asm volatile("" ::: "memory");
        }
    }
    const bool b0 = F.lane & 1, b1 = F.lane & 2, b2 = F.lane & 4, b3 = F.lane & 8;
    float t8[8], t4[4], t2[2], t1;
#pragma unroll
    for (int i = 0; i < 8; ++i) { const float keep = b0 ? acc[2 * i + 1] : acc[2 * i], give = b0 ? acc[2 * i] : acc[2 * i + 1]; t8[i] = keep + __shfl_xor(give, 1); }
#pragma unroll
    for (int i = 0; i < 4; ++i) { const float keep = b1 ? t8[2 * i + 1] : t8[2 * i], give = b1 ? t8[2 * i] : t8[2 * i + 1]; t4[i] = keep + __shfl_xor(give, 2); }
#pragma unroll
    for (int i = 0; i < 2; ++i) { const float keep = b2 ? t4[2 * i + 1] : t4[2 * i], give = b2 ? t4[2 * i] : t4[2 * i + 1]; t2[i] = keep + __shfl_xor(give, 4); }
    { const float keep = b3 ? t2[1] : t2[0], give = b3 ? t2[0] : t2[1]; t1 = keep + __shfl_xor(give, 8); }
    t1 += __shfl_xor(t1, 16); t1 += __shfl_xor(t1, 32);
    if (F.lane < 16) { const float x = t1 + dtb[F.lane]; const float t = __expf(x); const float sp = t < 0.01f ? t * (1.f + t * (-0.5f + t * (1.f / 3.f))) : __logf(1.f + t); DT[(size_t)m * 16 + F.lane] = x > 15.f ? x : sp; }
}
DI void ln_rows(f32x4 (&v)[4], const float* g, const float* b, int lane) {
    float s = 0.f;
#pragma unroll
    for (int j = 0; j < 4; ++j) s += (v[j][0] + v[j][1]) + (v[j][2] + v[j][3]);
    const float mean = wave_sum(s) * (1.f / DM); float s2 = 0.f;
#pragma unroll
    for (int j = 0; j < 4; ++j) { v[j] = v[j] - mean; s2 += (v[j][0] * v[j][0] + v[j][1] * v[j][1]) + (v[j][2] * v[j][2] + v[j][3] * v[j][3]); }
    const float rstd = 1.f / sqrtf(wave_sum(s2) * (1.f / DM) + LN_EPS);
#pragma unroll
    for (int j = 0; j < 4; ++j) { const int k = 4 * lane + 256 * j; v[j] = v[j] * rstd * *(const f32x4*)(g + k) + *(const f32x4*)(b + k); }
}
DI void phase_prologue_b(const Frame& F) {
    load_wdt(F, 0); __syncthreads();
    const int NGW = F.G * NWAVES, gw = F.vcu * NWAVES + F.wave;
    bf16_t* XS = WSP(bf16_t, WS_XS); const float* MV = WSP(float, WS_MVEC);
    const float* dtb = F.in[I_DTB];
    for (int m = gw; m < MTOT; m += NGW) {
        const float* src = m < NLAT ? F.in[I_X] + (size_t)m * DM : F.in[I_CTX] + (size_t)(m - NLAT) * DM; const int v = m < NLAT ? (m >> 13) : 4;
        f32x4 x[4];
#pragma unroll
        for (int j = 0; j < 4; ++j) { x[j] = *(const f32x4*)(src + 4 * F.lane + 256 * j); st4bf(XS + (size_t)m * DM + 4 * F.lane + 256 * j, x[j]); }
        emit_h_dt(F, x, MV + (size_t)v * 6144, m, dtb);
    }
}
DI void phase_ln1(const Frame& F, int l, int mrows) {
    const bool moe = l & 1; const int mi = l >> 1;
    LAS float* wrt = (LAS float*)F.lds;
    if (moe) { const float* w = F.in[I_MRW] + (size_t)mi * DM * 8; for (int i = F.tid; i < DM * 8; i += NTHR) { const int k = i >> 3; wrt[(((k & 3) << 8) + (k >> 2)) * 12 + (i & 7)] = w[i]; } __syncthreads(); }
    const int NGW = F.G * NWAVES, gw = F.vcu * NWAVES + F.wave;
    bf16_t* XS = WSP(bf16_t, WS_XS); const float* MV = WSP(float, WS_MVEC) + (size_t)l * 5 * 6144; bf16_t* HB = WSP(bf16_t, WS_HB);
    const float* g = F.in[I_LN1G] + l * DM; const float* b = F.in[I_LN1B] + l * DM;
    unsigned* SL = WSP(unsigned, WS_SLOT); unsigned* gcnt = (unsigned*)F.ctl + CW_MOECNT + mi * 1024;
    int cnt = 0, nst = 0; int me0 = 0, me1 = 0, mr0 = 0, mr1 = 0, mm = 0; float mg0 = 0.f, mg1 = 0.f;
    f32x4 xnx[4];
    if (gw < mrows) {
#pragma unroll
        for (int j = 0; j < 4; ++j) xnx[j] = ld4bf(XS + (size_t)gw * DM + 4 * F.lane + 256 * j);
    }
    for (int m = gw; m < mrows; m += NGW) {
        const int v = m < NLAT ? (m >> 13) : 4;
        f32x4 x[4];
#pragma unroll
        for (int j = 0; j < 4; ++j) x[j] = xnx[j];
        if (m + NGW < mrows) {
#pragma unroll
            for (int j = 0; j < 4; ++j) xnx[j] = ld4bf(XS + (size_t)(m + NGW) * DM + 4 * F.lane + 256 * j);
        }
        ln_rows(x, g, b, F.lane);
        float acc[8];
#pragma unroll
        for (int c = 0; c < 8; ++c) acc[c] = 0.f;
        const float* mv = MV + (size_t)v * 6144;
#pragma unroll
        for (int j = 0; j < 4; ++j) {
            const int k = 4 * F.lane + 256 * j;
            st4bf(XS + (size_t)m * DM + k, x[j]);
            const f32x4 sh = *(const f32x4*)(mv + 3072 + k), sc = *(const f32x4*)(mv + 4096 + k);
            const f32x4 h = x[j] * (sc + 1.f) + sh;
            u32x2 w; w.x = pk2(h[0], h[1]); w.y = pk2(h[2], h[3]); *(u32x2*)(HB + (size_t)m * DM + k) = w;
            if (moe) {
#pragma unroll
                for (int e = 0; e < 4; ++e) { const LAS f32x4* wr = (const LAS f32x4*)(wrt + ((e << 8) + (k >> 2)) * 12);
#pragma unroll
                    for (int q = 0; q < 2; ++q) { const f32x4 wv = wr[q]; acc[4 * q] += h[e] * wv[0]; acc[4 * q + 1] += h[e] * wv[1]; acc[4 * q + 2] += h[e] * wv[2]; acc[4 * q + 3] += h[e] * wv[3]; } }
            }
        }
        if (moe) {
            const bool b0 = F.lane & 1, b1 = F.lane & 2, b2 = F.lane & 4;
            float t4[4], t2[2], t1;
#pragma unroll
            for (int i = 0; i < 4; ++i) { const float keep = b0 ? acc[2 * i + 1] : acc[2 * i], give = b0 ? acc[2 * i] : acc[2 * i + 1]; t4[i] = keep + __shfl_xor(give, 1); }
#pragma unroll
            for (int i = 0; i < 2; ++i) { const float keep = b1 ? t4[2 * i + 1] : t4[2 * i], give = b1 ? t4[2 * i] : t4[2 * i + 1]; t2[i] = keep + __shfl_xor(give, 2); }
            { const float keep = b2 ? t2[1] : t2[0], give = b2 ? t2[0] : t2[1]; t1 = keep + __shfl_xor(give, 4); }
            t1 += __shfl_xor(t1, 8); t1 += __shfl_xor(t1, 16); t1 += __shfl_xor(t1, 32);
            t1 += F.in[I_MRB][mi * 8 + (F.lane & 7)];
            float lg[8];
#pragma unroll
            for (int e = 0; e < 8; ++e) lg[e] = __shfl(t1, e);
            int e0 = 0; float l0 = lg[0];
#pragma unroll
            for (int e = 1; e < 8; ++e) if (lg[e] > l0) { l0 = lg[e]; e0 = e; }
            int e1 = -1; float l1 = -3.0e38f;
#pragma unroll
            for (int e = 0; e < 8; ++e) if (e != e0 && lg[e] > l1) { l1 = lg[e]; e1 = e; }
            const float g1 = 1.f / (1.f + __expf(l0 - l1)), g0 = 1.f - g1;
            const int r0 = __shfl(cnt, e0); if (F.lane == e0) cnt++;
            const int r1 = __shfl(cnt, e1); if (F.lane == e1) cnt++;
            if (F.lane == nst) { me0 = e0; me1 = e1; mr0 = r0; mr1 = r1; mg0 = g0; mg1 = g1; mm = m; }
            ++nst;
        }
        if (moe && (nst == 64 || m + NGW >= mrows)) {
            unsigned base = 0u; if (F.lane < 8) base = __hip_atomic_fetch_add(gcnt + F.lane * 64, (unsigned)cnt, __ATOMIC_RELAXED, __HIP_MEMORY_SCOPE_AGENT);
            const unsigned p0 = __shfl(base, me0) + mr0, p1 = __shfl(base, me1) + mr1;
            if (F.lane < nst) { u32x4 a; a.x = me0; a.y = me1; a.z = p0; a.w = p1; *(u32x4*)(SL + (size_t)mm * 8) = a; u32x2 c; c.x = __float_as_uint(mg0); c.y = __float_as_uint(mg1); *(u32x2*)(SL + (size_t)mm * 8 + 4) = c; }
            cnt = 0; nst = 0;
        }
    }
}
DI void moe_pad_ends(const Frame& F, int mi, int (&pe)[8]) {
    unsigned* gcnt = (unsigned*)F.ctl + CW_MOECNT + mi * 1024; int run = 0;
#pragma unroll
    for (int e = 0; e < 8; ++e) { const int c = (int)__builtin_amdgcn_readfirstlane(__hip_atomic_load(gcnt + e * 64, __ATOMIC_RELAXED, __HIP_MEMORY_SCOPE_AGENT)); run += (c + 255) & ~255; pe[e] = run; }
}
DI int moe_pad_ends_lds(const Frame& F, int mi) {
    int pe[8]; moe_pad_ends(F, mi, pe);
    LAS int* d = (LAS int*)(F.lds + MISC_OFF + 64);
    __syncthreads();
    if (F.tid == 0) {
#pragma unroll
        for (int e = 0; e < 8; ++e) d[e] = pe[e];
    }
    __syncthreads();
    return pe[7];
}
DI void phase_gather(const Frame& F, int l, int mrows) {
    int pe[8]; moe_pad_ends(F, l >> 1, pe);
    const int NGW = F.G * NWAVES, gw = F.vcu * NWAVES + F.wave;
    unsigned* SL = WSP(unsigned, WS_SLOT); const bf16_t* HB = WSP(bf16_t, WS_HB); bf16_t* XP = WSP(bf16_t, WS_XPAD);
    for (int m = gw; m < mrows; m += NGW) {
        const u32x4 a = *(const u32x4*)(SL + (size_t)m * 8);
        int ps0 = 0, ps1 = 0;
#pragma unroll
        for (int e = 1; e < 8; ++e) { if ((int)a.x == e) ps0 = pe[e - 1]; if ((int)a.y == e) ps1 = pe[e - 1]; }
        const int d0 = ps0 + (int)a.z, d1 = ps1 + (int)a.w;
        const u32x4* src = (const u32x4*)(HB + (size_t)m * DM);
        const u32x4 v0 = src[F.lane], v1 = src[64 + F.lane];
        u32x4* q0 = (u32x4*)(XP + (size_t)d0 * DM); u32x4* q1 = (u32x4*)(XP + (size_t)d1 * DM);
        q0[F.lane] = v0; q0[64 + F.lane] = v1; q1[F.lane] = v0; q1[64 + F.lane] = v1;
        if (F.lane == 0) { u32x2 d; d.x = d0; d.y = d1; *(u32x2*)(SL + (size_t)m * 8 + 2) = d; }
    }
}
DI void phase_ln2(const Frame& F, int l, int mrows) {
    const bool moe = l & 1, lastl = (l == DEPTH - 1);
    if (!lastl) { load_wdt(F, l + 1); __syncthreads(); }
    const int NGW = F.G * NWAVES, gw = F.vcu * NWAVES + F.wave;
    bf16_t* XS = WSP(bf16_t, WS_XS); const float* MVl = WSP(float, WS_MVEC) + (size_t)l * 5 * 6144; const float* MVn = WSP(float, WS_MVEC) + (size_t)(l + 1) * 5 * 6144;
    const float* g = F.in[I_LN2G] + l * DM; const float* b = F.in[I_LN2B] + l * DM;
    const unsigned* SL = WSP(unsigned, WS_SLOT); const bf16_t* YP = WSP(bf16_t, WS_YPAD);
    const float* dtb = F.in[I_DTB] + (lastl ? 0 : (l + 1) * 16);
    f32x4 xnx[4]; u32x4 anx = (u32x4){0u, 0u, 0u, 0u}; u32x2 gnx = (u32x2){0u, 0u};
    if (gw < mrows) {
#pragma unroll
        for (int j = 0; j < 4; ++j) xnx[j] = ld4bf(XS + (size_t)gw * DM + 4 * F.lane + 256 * j);
        if (moe) { anx = *(const u32x4*)(SL + (size_t)gw * 8); gnx = *(const u32x2*)(SL + (size_t)gw * 8 + 4); }
    }
    for (int m = gw; m < mrows; m += NGW) {
        const int v = m < NLAT ? (m >> 13) : 4;
        f32x4 x[4];
#pragma unroll
        for (int j = 0; j < 4; ++j) x[j] = xnx[j];
        const u32x4 a = anx; const u32x2 gg = gnx;
        if (m + NGW < mrows) {
#pragma unroll
            for (int j = 0; j < 4; ++j) xnx[j] = ld4bf(XS + (size_t)(m + NGW) * DM + 4 * F.lane + 256 * j);
            if (moe) { anx = *(const u32x4*)(SL + (size_t)(m + NGW) * 8); gnx = *(const u32x2*)(SL + (size_t)(m + NGW) * 8 + 4); }
        }
        if (moe) {
            const float g0 = __uint_as_float(gg.x), g1 = __uint_as_float(gg.y);
            const bf16_t* y0 = YP + (size_t)a.z * DM; const bf16_t* y1 = YP + (size_t)a.w * DM;
#pragma unroll
            for (int j = 0; j < 4; ++j) { const int k = 4 * F.lane + 256 * j; const u32x2 u0 = *(const u32x2*)(y0 + k), u1 = *(const u32x2*)(y1 + k);
                const f32x4 gt = *(const f32x4*)(MVl + (size_t)v * 6144 + 5120 + k);
                f32x4 f; f[0] = g0 * bflo(u0.x) + g1 * bflo(u1.x); f[1] = g0 * bfhi(u0.x) + g1 * bfhi(u1.x); f[2] = g0 * bflo(u0.y) + g1 * bflo(u1.y); f[3] = g0 * bfhi(u0.y) + g1 * bfhi(u1.y);
                if (ABL & 16) f = (f32x4){0.f, 0.f, 0.f, 0.f};
                x[j] = x[j] * ALPHA + gt * f; }
        }
        ln_rows(x, g, b, F.lane);
        if (lastl) {
#pragma unroll
            for (int j = 0; j < 4; ++j) *(f32x4*)(F.out + (size_t)m * DM + 4 * F.lane + 256 * j) = x[j];
        } else {
#pragma unroll
            for (int j = 0; j < 4; ++j) st4bf(XS + (size_t)m * DM + 4 * F.lane + 256 * j, x[j]);
            emit_h_dt(F, x, MVn + (size_t)v * 6144, m, dtb);
        }
    }
}

DI void phase_qkprep_rows(const Frame& F, int l) {
    const int NGW = F.G * NWAVES, gw = F.vcu * NWAVES + F.wave;
    bf16_t* PRJ = WSP(bf16_t, WS_PRJ); const float* rc = WSP(float, WS_ROPE); const float* rs = rc + SEQ * 32;
    const float* gq = F.in[I_QGQ] + l * 64; const float* gk = F.in[I_QGK] + l * 64;
    const int hs = F.lane >> 4, i2 = 2 * (F.lane & 15);
    for (int m = gw; m < MTOT; m += NGW) {
        const bool lat = m < NLAT; const int t = m & (SEQ - 1);
        float c0 = 1.f, c1 = 1.f, s0 = 0.f, s1 = 0.f;
        if (lat) { const f32x2 cc = *(const f32x2*)(rc + t * 32 + i2), ss = *(const f32x2*)(rs + t * 32 + i2); c0 = cc[0]; c1 = cc[1]; s0 = ss[0]; s1 = ss[1]; }
#pragma unroll
        for (int it = 0; it < 5; ++it) {
            const int hd = it * 4 + hs;
            const int col = hd < 8 ? C_SWQ + 64 * hd : hd < 10 ? C_SWK + 64 * (hd - 8) : hd < 18 ? C_GAQ + 64 * (hd - 10) : C_GAK + 64 * (hd - 18);
            bf16_t* p = PRJ + (size_t)m * PRJW + col + i2;
            const unsigned u1 = *(const unsigned*)p, u2 = *(const unsigned*)(p + 32);
            float a0 = bflo(u1), a1 = bfhi(u1), b0 = bflo(u2), b1 = bfhi(u2);
            if (hd >= 10) {
                float ss = a0 * a0 + a1 * a1 + b0 * b0 + b1 * b1;
                ss += __shfl_xor(ss, 1); ss += __shfl_xor(ss, 2); ss += __shfl_xor(ss, 4); ss += __shfl_xor(ss, 8);
                const float rn = 1.f / sqrtf(ss * (1.f / 64.f) + RMS_EPS); const float* gg = hd < 18 ? gq : gk; const float post = hd < 18 ? C2 : 1.f;
                a0 *= rn * gg[i2] * post; a1 *= rn * gg[i2 + 1] * post; b0 *= rn * gg[32 + i2] * post; b1 *= rn * gg[32 + i2 + 1] * post;
            }
            const float o0 = a0 * c0 - b0 * s0, o1 = a1 * c1 - b1 * s1, q0 = b0 * c0 + a0 * s0, q1 = b1 * c1 + a1 * s1;
            *(unsigned*)p = pk2(o0, o1); *(unsigned*)(p + 32) = pk2(q0, q1);
        }
    }
}

constexpr int AT_KVB = 16384, AT_VOFF = 8192, AT_BIAS = 2 * AT_KVB;
DI void attn_unit(const Frame& Fin, int l, int mode, bool ctxq, int b, int hq, int qblk) {
    const Frame F = launder(Fin);
    const int lane = F.lane, wid = F.wave, tid = F.tid, r = lane & 31, h = lane >> 5;
    const bf16_t* PRJ = WSP(bf16_t, WS_PRJ); bf16_t* OC = WSP(bf16_t, WS_OC);
    int qcol, kcol, vcol, ocol, kvh;
    if (mode == 0) { qcol = C_NAQ; kcol = C_NAK; vcol = C_NAV; ocol = 0; kvh = hq; }
    else if (mode == 1) { qcol = C_SWQ; kcol = C_SWK; vcol = C_SWV; ocol = 512; kvh = hq >> 2; }
    else { qcol = C_GAQ; kcol = C_GAK; vcol = C_GAV; ocol = 1024; kvh = hq >> 2; }
    const int qrow = ctxq ? (NLAT + b * CTXL + 32 * wid + r) : (b * SEQ + 256 * qblk + 32 * wid + r);
    bf16x8 qf[4];
    { const bf16_t* qp = PRJ + (size_t)qrow * PRJW + qcol + hq * 64 + 8 * h;
#pragma unroll
      for (int d0 = 0; d0 < 4; ++d0) qf[d0] = *(const bf16x8*)(qp + 16 * d0); }
    int tl_lo = 0, tl_hi = 0;
    if (!ctxq) {
        if (mode == 0) { tl_lo = clampi(4 * qblk - 4, 0, 120); tl_hi = clampi(4 * qblk - 1, 0, 120) + 8; }
        else if (mode == 1) { tl_lo = 4 * qblk - 2 < 0 ? 0 : 4 * qblk - 2; tl_hi = 4 * qblk + 6 > 128 ? 128 : 4 * qblk + 6; }
        else { tl_lo = 0; tl_hi = 128; }
    }
    const int ntile = 4 + (tl_hi - tl_lo);
    LAS float* biasT = (LAS float*)(F.lds + AT_BIAS);
    __syncthreads();
    if (mode == 0 && !ctxq) { const float* rp = F.in[I_RPB] + ((size_t)l * 8 + hq) * 465; for (int i = tid; i < 465; i += NTHR) biasT[i] = rp[i] * LOG2E; }
    const int lr = tid >> 3, ch = tid & 7;
    const size_t ctxbase = (size_t)(NLAT + b * CTXL), latbase = (size_t)b * SEQ;
    u32x4 kreg, vreg;
#define AT_LOAD(it) do { const size_t rb_ = ((it) < 4 ? ctxbase + 64 * (it) : latbase + 64 * (tl_lo + (it) - 4)) + lr; const bf16_t* rp_ = PRJ + rb_ * PRJW + kvh * 64 + ch * 8; \
        kreg = *(const u32x4*)(rp_ + kcol); vreg = *(const u32x4*)(rp_ + vcol); } while (0)
#define AT_STORE(buf) do { LAS unsigned char* d_ = F.lds + (buf) * AT_KVB; *(LAS u32x4*)(d_ + ch * 1024 + lr * 16) = kreg; *(LAS u32x4*)(d_ + AT_VOFF + (ch >> 2) * 4096 + lr * 64 + (ch & 3) * 16) = vreg; } while (0)
    AT_LOAD(0); AT_STORE(0);
    __syncthreads();
    float mrun = -1e30f, lrun = 0.f;
    if (mode == 1) { mrun = F.in[I_SINK][l * 8 + hq] * LOG2E; lrun = (h == 0) ? 1.f : 0.f; }
    f32x16 o0, o1;
#pragma unroll
    for (int i = 0; i < 16; ++i) { o0[i] = 0.f; o1[i] = 0.f; }
    const int q4 = (lane & 15) >> 2, p4 = lane & 3, blk = (lane >> 4) & 1;
    const int tq = 256 * qblk + 32 * wid + r;
    const int gr = 4 * qblk + (wid >> 1), qc = 32 * (wid & 1) + r, cs = clampi(qc - 8, 0, 48), rsw = clampi(gr - 4, 0, 120);
    for (int it = 0; it < ntile; ++it) {
        const int buf = it & 1;
        if (it + 1 < ntile) AT_LOAD(it + 1);
        const int g = tl_lo + it - 4;
        bool rel = true;
        if (it >= 4) { if (mode == 0) rel = (g >= rsw && g < rsw + 8); else if (mode == 1) rel = (64 * g + 63 >= 256 * qblk + 32 * wid - 128) && (64 * g <= 256 * qblk + 32 * wid + 31 + 128); }
        if (rel) {
            const LAS unsigned char* Kb = F.lds + buf * AT_KVB; const LAS unsigned char* Vb = Kb + AT_VOFF;
            f32x16 p0, p1;
#pragma unroll
            for (int i = 0; i < 16; ++i) { p0[i] = 0.f; p1[i] = 0.f; }
#pragma unroll
            for (int d0 = 0; d0 < 4; ++d0) {
                const bf16x8 k0 = *(const LAS bf16x8*)(Kb + (2 * d0 + h) * 1024 + r * 16);
                const bf16x8 k1 = *(const LAS bf16x8*)(Kb + (2 * d0 + h) * 1024 + 512 + r * 16);
                p0 = MFMA32(k0, qf[d0], p0); p1 = MFMA32(k1, qf[d0], p1);
            }
            if (it >= 4 && mode == 0) {
                int csl = cs; asm volatile("" : "+v"(csl));
                const LAS float* bt = biasT + (g - gr + 7) * 31 + 15 - qc;
#pragma unroll
                for (int i = 0; i < 16; ++i) { const int k0 = crow(i, h), k1 = k0 + 32;
                    p0[i] = (k0 >= csl && k0 < csl + 16) ? p0[i] + bt[k0] : -INFINITY; p1[i] = (k1 >= csl && k1 < csl + 16) ? p1[i] + bt[k1] : -INFINITY; }
            } else if (it >= 4 && mode == 1) {
                const int d0 = 64 * g - tq;
#pragma unroll
                for (int i = 0; i < 16; ++i) { const int dd = d0 + crow(i, h);
                    if (dd > 128 || dd < -128) p0[i] = -INFINITY; if (dd + 32 > 128 || dd + 32 < -128) p1[i] = -INFINITY; }
            }
            float mx = p0[0];
#pragma unroll
            for (int i = 1; i < 16; ++i) mx = fmaxf(mx, p0[i]);
#pragma unroll
            for (int i = 0; i < 16; ++i) mx = fmaxf(mx, p1[i]);
            mx = fmaxf(mx, __shfl_xor(mx, 32));
            const float mnew = fmaxf(mrun, mx), alpha = __builtin_amdgcn_exp2f(mrun - mnew); mrun = mnew;
            float ls = 0.f;
#pragma unroll
            for (int i = 0; i < 16; ++i) { p0[i] = __builtin_amdgcn_exp2f(p0[i] - mnew); p1[i] = __builtin_amdgcn_exp2f(p1[i] - mnew); ls += p0[i] + p1[i]; }
            lrun = lrun * alpha + ls;
            if (__any(alpha != 1.f)) {
#pragma unroll
                for (int i = 0; i < 16; ++i) { o0[i] *= alpha; o1[i] *= alpha; }
            }
            bf16x8 pa[4]; pa[0] = pack8<0>(p0); pa[1] = pack8<1>(p0); pa[2] = pack8<0>(p1); pa[3] = pack8<1>(p1);
            const LAS unsigned char* va = Vb + (4 * h + q4) * 64 + blk * 32 + p4 * 8;
#pragma unroll
            for (int ks = 0; ks < 4; ++ks) {
                const bf16x8 v0 = cat8(tr_read(va + ks * 1024), tr_read(va + ks * 1024 + 512));
                const bf16x8 v1 = cat8(tr_read(va + ks * 1024 + 4096), tr_read(va + ks * 1024 + 4096 + 512));
                o0 = MFMA32(v0, pa[ks], o0); o1 = MFMA32(v1, pa[ks], o1);
            }
        }
        if (it + 1 < ntile) AT_STORE(buf ^ 1);
        __syncthreads();
    }
#undef AT_LOAD
#undef AT_STORE
    const float lt = lrun + __shfl_xor(lrun, 32), inv = 1.f / lt;
    bf16_t* op = OC + (size_t)qrow * OCW + ocol + hq * 64 + 4 * h;
#pragma unroll
    for (int g4 = 0; g4 < 4; ++g4) {
        u32x2 w; w.x = pk2(o0[4 * g4] * inv, o0[4 * g4 + 1] * inv); w.y = pk2(o0[4 * g4 + 2] * inv, o0[4 * g4 + 3] * inv); *(u32x2*)(op + 8 * g4) = w;
        u32x2 w2; w2.x = pk2(o1[4 * g4] * inv, o1[4 * g4 + 1] * inv); w2.y = pk2(o1[4 * g4 + 2] * inv, o1[4 * g4 + 3] * inv); *(u32x2*)(op + 32 + 8 * g4) = w2;
    }
}

namespace ga_body {
using bf16=__hip_bfloat16;
using bf16x8=__attribute__((ext_vector_type(8)))short;
using s16x4=__attribute__((ext_vector_type(4)))short;
using f32x16=__attribute__((ext_vector_type(16)))float;
using u32x4=__attribute__((ext_vector_type(4)))unsigned;
constexpr int SEQ=8192,D=64,PQ=4608,PO=2048,NCTXT=4;
constexpr int NW=8,QBLK=32,QB=QBLK*NW,KVBLK=64,NQB=SEQ/QB;
__device__ __forceinline__ int crow(int r,int hi){return (r&3)+8*(r>>2)+4*hi;}
#define SBAR() __builtin_amdgcn_sched_barrier(0)
__device__ __forceinline__ void cmask(f32x16&p0,f32x16&p1,int jb,int qrel,int hi){
  const float NEG=-INFINITY; int kb=64*jb+4*hi;
  #pragma unroll
  for(int r=0;r<16;++r){int kv=kb+(r&3)+8*(r>>2); if(kv>qrel)p0[r]=NEG; if(kv+32>qrel)p1[r]=NEG;}
}

constexpr int NSLOT=3, SLOTB=8192;
constexpr int LDS_K=0, LDS_V=NSLOT*SLOTB, LDS_WS=2*NSLOT*SLOTB, LDS_OST=LDS_WS+NW*64*4, LDS_BYTES=LDS_OST+NW*4096;
constexpr float C2=0.125f*1.4426950408889634f;
__device__ __forceinline__ void glds16(const void*gsrc,unsigned lds_dst){unsigned keep;
  asm volatile("s_mov_b32 %0, m0\n\ts_mov_b32 m0, %2\n\ts_nop 0\n\tglobal_load_lds_dwordx4 %1, off\n\ts_mov_b32 m0, %0":"=&s"(keep):"v"(gsrc),"s"(lds_dst):"memory");}
__device__ __forceinline__ float max3f(float a,float b,float c){float r;asm("v_max3_f32 %0, %1, %2, %3":"=v"(r):"v"(a),"v"(b),"v"(c));return r;}
__device__ __forceinline__ float max2f(float a,float b){float r;asm("v_max_f32_e32 %0, %1, %2":"=v"(r):"v"(a),"v"(b));return r;}
__device__ __forceinline__ float fadd_s(float a,float b){float r;asm("v_add_f32_e32 %0, %1, %2":"=v"(r):"v"(a),"v"(b));return r;}
__device__ __forceinline__ float fsub_s(float a,float b){float r;asm("v_sub_f32_e32 %0, %1, %2":"=v"(r):"v"(a),"v"(b));return r;}
typedef float f32x2_t __attribute__((ext_vector_type(2))); typedef __bf16 bf16x2_t __attribute__((ext_vector_type(2)));
__device__ __forceinline__ unsigned cvtpk_s(float lo,float hi){f32x2_t v={lo,hi};bf16x2_t b=__builtin_convertvector(v,bf16x2_t);return __builtin_bit_cast(unsigned,b);}
#define WAIT_BAR(N) asm volatile("s_waitcnt vmcnt(" #N ") lgkmcnt(0)\n\ts_barrier":::"memory")

__device__ __forceinline__ void qkt(f32x16&p0,f32x16&p1,const char*Kslot,const bf16x8*qr,const f32x16&negm,int r32,int hi){
  const char*kb=Kslot+hi*1024+r32*16;
  #pragma unroll
  for(int d0=0;d0<4;++d0){
    const bf16x8 b0=*reinterpret_cast<const bf16x8*>(kb+d0*2048);
    const bf16x8 b1=*reinterpret_cast<const bf16x8*>(kb+d0*2048+512);
    if(d0==0){p0=__builtin_amdgcn_mfma_f32_32x32x16_bf16(b0,qr[0],negm,0,0,0);p1=__builtin_amdgcn_mfma_f32_32x32x16_bf16(b1,qr[0],negm,0,0,0);}
    else{p0=__builtin_amdgcn_mfma_f32_32x32x16_bf16(b0,qr[d0],p0,0,0,0);p1=__builtin_amdgcn_mfma_f32_32x32x16_bf16(b1,qr[d0],p1,0,0,0);}}
}
typedef __attribute__((address_space(3))) const char* lds_cptr;
typedef short v4i16_t __attribute__((ext_vector_type(4)));
__device__ __forceinline__ void kload8(bf16x8*kf,lds_cptr kp){
  kf[0]=*(const __attribute__((address_space(3))) bf16x8*)(kp);      kf[1]=*(const __attribute__((address_space(3))) bf16x8*)(kp+512);
  kf[2]=*(const __attribute__((address_space(3))) bf16x8*)(kp+2048); kf[3]=*(const __attribute__((address_space(3))) bf16x8*)(kp+2560);
  kf[4]=*(const __attribute__((address_space(3))) bf16x8*)(kp+4096); kf[5]=*(const __attribute__((address_space(3))) bf16x8*)(kp+4608);
  kf[6]=*(const __attribute__((address_space(3))) bf16x8*)(kp+6144); kf[7]=*(const __attribute__((address_space(3))) bf16x8*)(kp+6656);
}
__device__ __forceinline__ void kload2(bf16x8*kf,lds_cptr kp,int j){ kf[2*j]=*(const __attribute__((address_space(3))) bf16x8*)(kp+j*2048); kf[2*j+1]=*(const __attribute__((address_space(3))) bf16x8*)(kp+j*2048+512); }
__device__ __forceinline__ s16x4 vtr(lds_cptr p){ return __builtin_bit_cast(s16x4,__builtin_amdgcn_ds_read_tr16_b64_v4i16((__attribute__((address_space(3))) v4i16_t*)p)); }
__device__ __forceinline__ float rowmax(const f32x16&p0,const f32x16&p1){
  float a=max3f(p0[0],p0[1],p1[0]),b=max3f(p0[2],p0[3],p1[1]);a=max3f(a,p1[2],p1[3]);
  #pragma unroll
  for(int r=4;r<16;r+=4){a=max3f(a,p0[r],p0[r+1]);b=max3f(b,p0[r+2],p0[r+3]);a=max3f(a,p1[r],p1[r+1]);b=max3f(b,p1[r+2],p1[r+3]);}
  const float m=max2f(a,b);
  auto rr=__builtin_amdgcn_permlane32_swap(__float_as_uint(m),__float_as_uint(m),false,false);
  return max2f(__uint_as_float(rr[0]),__uint_as_float(rr[1]));
}
__device__ __forceinline__ void pv(f32x16*o,int vb,bf16x8 pa0,bf16x8 pa1,bf16x8 pa2,bf16x8 pa3){
  #pragma unroll
  for(int d0=0;d0<2;++d0){s16x4 lo[4],hi[4];
    #pragma unroll
    for(int ks=0;ks<4;++ks){
      asm volatile("ds_read_b64_tr_b16 %0,%1 offset:%c2":"=&v"(lo[ks]):"v"(vb),"i"(d0*4096+ks*1024):"memory");
      asm volatile("ds_read_b64_tr_b16 %0,%1 offset:%c2":"=&v"(hi[ks]):"v"(vb),"i"(d0*4096+ks*1024+512):"memory");}
    asm volatile("s_waitcnt lgkmcnt(0)":::"memory");SBAR();
    #define PK(k) (bf16x8){lo[k][0],lo[k][1],lo[k][2],lo[k][3],hi[k][0],hi[k][1],hi[k][2],hi[k][3]}
    o[d0]=__builtin_amdgcn_mfma_f32_32x32x16_bf16(pa0,PK(0),o[d0],0,0,0);
    o[d0]=__builtin_amdgcn_mfma_f32_32x32x16_bf16(pa1,PK(1),o[d0],0,0,0);
    o[d0]=__builtin_amdgcn_mfma_f32_32x32x16_bf16(pa2,PK(2),o[d0],0,0,0);
    o[d0]=__builtin_amdgcn_mfma_f32_32x32x16_bf16(pa3,PK(3),o[d0],0,0,0);
    #undef PK
  }
}

#ifndef ATTN_STORE16
#define ATTN_STORE16(p,v) (*(u32x4*)(p)=(v))
#endif
template<int MODE> __device__ __forceinline__ void amask(f32x16&p0,f32x16&p1,int t,int g0,int qb,int wid,int r32,int hi,const __attribute__((address_space(3))) float*biasT){
  if(MODE==0||t<NCTXT)return;
  const float NEG=-INFINITY; const int g=g0+t-NCTXT;
  if(MODE==1){ int d0=64*g-(256*qb+32*wid+r32)+4*hi; asm volatile("":"+v"(d0));
    #pragma unroll
    for(int r=0;r<16;++r){const int dd=d0+(r&3)+8*(r>>2); if(dd>128||dd<-128)p0[r]=NEG; if(dd+32>128||dd+32<-128)p1[r]=NEG;}
  } else {
    const int gr=4*qb+(wid>>1); int rs=gr-4; rs=rs<0?0:(rs>120?120:rs); const bool rel=(g>=rs&&g<rs+8);
    const int qc=32*(wid&1)+r32; int cs=qc-8; cs=cs<0?0:(cs>48?48:cs); asm volatile("":"+v"(cs));
    const int dr=rel?(g-gr+7):0; const __attribute__((address_space(3))) float*bt=biasT+dr*31+15-qc+4*hi; const int k0=4*hi-cs;
    #pragma unroll
    for(int r=0;r<16;++r){const int ko=(r&3)+8*(r>>2); const unsigned u0=(unsigned)(k0+ko),u1=(unsigned)(k0+ko+32);
      p0[r]=(rel&&u0<16u)?p0[r]+bt[ko]:NEG; p1[r]=(rel&&u1<16u)?p1[r]+bt[ko+32]:NEG;
      if((r&3)==3)asm volatile("":"+v"(p0),"+v"(p1)::"memory");}
  }
}
template<int THRL,int MODE> __device__ __forceinline__ void attn_unit(int qb,const bf16*Qp,const bf16*__restrict__ Kl,const bf16*__restrict__ Vl,const bf16*__restrict__ Kc,const bf16*__restrict__ Vc,bf16*Op,char*shm,const int tid,const int NT,const int g0,const float sinkl2,const float*rpbh){
  const int lane=tid&63,r32=lane&31,hi=lane>>5; const int wid=__builtin_amdgcn_readfirstlane(tid>>6);
  const int q0=qb*QB;
  const bf16*Qw=Qp+(long)(q0+wid*QBLK)*PQ;
  const unsigned lds0=(unsigned)(uintptr_t)shm;
  float*wsf=(float*)(shm+LDS_WS)+wid*64;
  const long koff=(long)lane*PQ+wid*8;
  const long voff=(long)(16*(wid&3)+(lane>>2))*PQ+(wid>>2)*32+(lane&3)*8;
  const unsigned kdst=lds0+LDS_K+wid*1024, vdst=lds0+LDS_V+wid*1024;
  #define TILE_SRC(t,C,L) (((t)<NCTXT?(C)+(long)(t)*KVBLK*PQ:(L)+(long)((t)-NCTXT)*KVBLK*PQ))
  #define DMA_K(t,slot) glds16(TILE_SRC(t,Kc,Kl)+koff,(unsigned)__builtin_amdgcn_readfirstlane(kdst+(slot)))
  #define DMA_V(t,slot) glds16(TILE_SRC(t,Vc,Vl)+voff,(unsigned)__builtin_amdgcn_readfirstlane(vdst+(slot)))
  const int vb0=(int)(lds0+LDS_V)+((lane>>4)&1)*32+(lane&3)*8+(4*hi+((lane&15)>>2))*64;
  const char*Kbase=shm+LDS_K; bf16x8 kf[8];
  const lds_cptr shm3=(lds_cptr)shm; const lds_cptr kp0=shm3+LDS_K+hi*1024+r32*16; const lds_cptr vp0=shm3+LDS_V+((lane>>4)&1)*32+(lane&3)*8+(4*hi+((lane&15)>>2))*64;
  const __attribute__((address_space(3))) float*biasT=(const __attribute__((address_space(3))) float*)((lds_cptr)shm+LDS_BYTES);
  if(MODE==2){ __attribute__((address_space(3))) float*bw=(__attribute__((address_space(3))) float*)((lds_cptr)shm+LDS_BYTES); for(int i=tid;i<465;i+=512)bw[i]=rpbh[i]*1.4426950408889634f; }
  DMA_K(0,0);DMA_V(0,0);DMA_K(1,SLOTB);
  bf16x8 qr[4];
  #pragma unroll
  for(int d0=0;d0<4;++d0)qr[d0]=*reinterpret_cast<const bf16x8*>(&Qw[(long)r32*PQ+d0*16+hi*8]);
  float mhat=0.f,l_reg=0.f;f32x16 o[2],negm; { float zz=0.f; asm volatile("":"+v"(zz)); _Pragma("unroll") for(int r=0;r<16;++r){o[0][r]=zz;o[1][r]=zz;negm[r]=zz;} } asm volatile("":"+v"(negm));
  #define CMASK(P0,P1,t) amask<MODE>(P0,P1,t,g0,qb,wid,r32,hi,biasT)
  bool resc=false;
  #define START(P0,P1) do{ const float rm=rowmax(P0,P1); resc=false; \
    { const float dl=rm; mhat=fadd_s(mhat,dl); \
      _Pragma("unroll") for(int r=0;r<16;++r){P0[r]=fsub_s(P0[r],dl);P1[r]=fsub_s(P1[r],dl);} \
      _Pragma("unroll") for(int r=0;r<16;++r)negm[r]=-mhat; asm volatile("":"+v"(negm)); } \
    _Pragma("unroll") for(int r=0;r<16;++r)P0[r]=__builtin_amdgcn_exp2f(P0[r]); }while(0)
  #define RESC() do{ if(resc){ asm volatile("s_waitcnt lgkmcnt(0)":::"memory"); \
      _Pragma("unroll") for(int d_=0;d_<2;++d_) _Pragma("unroll") for(int r=0;r<16;++r)o[d_][r]*=wsf[crow(r,hi)]; } }while(0)
  f32x16 pA0,pA1,pB0,pB1;
  int sl_prev=0,sl_cur=0,sl_next=SLOTB;
  #define ROT() do{sl_prev=sl_cur;sl_cur=sl_next;sl_next=(sl_next==(NSLOT-1)*SLOTB)?0:sl_next+SLOTB;}while(0)
  DMA_K(2,2*SLOTB);
  WAIT_BAR(3);
  qkt(pA0,pA1,Kbase,qr,negm,r32,hi);asm volatile("s_nop 15\n\ts_nop 7":"+v"(pA0),"+v"(pA1));CMASK(pA0,pA1,0);
  START(pA0,pA1);
  _Pragma("unroll") for(int r=0;r<16;++r)pA1[r]=__builtin_amdgcn_exp2f(pA1[r]);
  WAIT_BAR(0);
  DMA_K(3,0);DMA_V(1,SLOTB);
  ROT();
  kload8(kf,kp0+sl_cur);
  WAIT_BAR(2);
  s16x4 vlo[8],vhi[8]; u32x4 pw0,pw1,pw2,pw3;
  #define PKW(P,B) cvtpk_s(P[B],P[B+1])
  #define PAF(k) __builtin_bit_cast(bf16x8,pw##k)
  #define VFR(i) (bf16x8){vlo[i][0],vlo[i][1],vlo[i][2],vlo[i][3],vhi[i][0],vhi[i][1],vhi[i][2],vhi[i][3]}
  #define PIN(x) asm volatile("":"+v"(x))
  #define MX3(a,b,c) __builtin_fmaxf(__builtin_fmaxf((a),(b)),(c))
  #define GAPA(MF,A0,A1,A2,A3,W0,W1,PW) do{ MF; sacc+=A0; sacc+=A1; sacc+=A2; sacc+=A3; PIN(sacc); W0; W1; PIN(PW); SBAR(); }while(0)
  #define EX(v) __builtin_amdgcn_exp2f(v)
  #define GAPB(MF,X,B) do{ MF; X[B]=EX(X[B]); X[B+1]=EX(X[B+1]); X[B+2]=EX(X[B+2]); X[B+3]=EX(X[B+3]); PIN(X); SBAR(); }while(0)
  #define VRD(i) do{ vlo[i]=vtr(vp_+(((i)>>2)*4096+((i)&3)*1024)); vhi[i]=vtr(vp_+(((i)>>2)*4096+((i)&3)*1024+512)); }while(0)
  #define KRD(G,j) do{ if(G){ kload2(kf,kp0+sl_next,j); SBAR(); } }while(0)
  #define STEP(C0,C1,P0,P1,t,GK,GV,GL) do{ SBAR(); \
    const lds_cptr vp_=vp0+sl_prev; \
    VRD(0); SBAR(); float sacc=(P0[0]+P0[1]); \
    GAPA(C0=__builtin_amdgcn_mfma_f32_32x32x16_bf16(kf[0],qr[0],negm,0,0,0), P0[2],P0[3],P0[4],P0[5],     pw0[0]=PKW(P0,0), pw0[1]=PKW(P0,2), pw0); \
    VRD(4); SBAR(); GAPA(C1=__builtin_amdgcn_mfma_f32_32x32x16_bf16(kf[1],qr[0],negm,0,0,0), P0[6],P0[7],P0[8],P0[9],     pw0[2]=PKW(P0,4), pw0[3]=PKW(P0,6), pw0); \
    VRD(1); SBAR(); GAPA(C0=__builtin_amdgcn_mfma_f32_32x32x16_bf16(kf[2],qr[1],C0,0,0,0),   P0[10],P0[11],P0[12],P0[13], pw1[0]=PKW(P0,8), pw1[1]=PKW(P0,10), pw1); \
    VRD(5); SBAR(); GAPA(C1=__builtin_amdgcn_mfma_f32_32x32x16_bf16(kf[3],qr[1],C1,0,0,0),   P0[14],P0[15],P1[0],P1[1],   pw1[2]=PKW(P0,12),pw1[3]=PKW(P0,14), pw1); \
    VRD(2); SBAR(); GAPA(C0=__builtin_amdgcn_mfma_f32_32x32x16_bf16(kf[4],qr[2],C0,0,0,0),   P1[2],P1[3],P1[4],P1[5],     pw2[0]=PKW(P1,0), pw2[1]=PKW(P1,2), pw2); \
    VRD(6); SBAR(); GAPA(C1=__builtin_amdgcn_mfma_f32_32x32x16_bf16(kf[5],qr[2],C1,0,0,0),   P1[6],P1[7],P1[8],P1[9],     pw2[2]=PKW(P1,4), pw2[3]=PKW(P1,6), pw2); \
    VRD(3); SBAR(); GAPA(C0=__builtin_amdgcn_mfma_f32_32x32x16_bf16(kf[6],qr[3],C0,0,0,0),   P1[10],P1[11],P1[12],P1[13], pw3[0]=PKW(P1,8), pw3[1]=PKW(P1,10), pw3); \
    VRD(7); SBAR(); GAPA(C1=__builtin_amdgcn_mfma_f32_32x32x16_bf16(kf[7],qr[3],C1,0,0,0),   P1[14],P1[15],0.f,0.f,       pw3[2]=PKW(P1,12),pw3[3]=PKW(P1,14), pw3); \
    l_reg+=sacc; \
    if(GK){DMA_K((t)+3,sl_cur);} if(GV){DMA_V((t)+1,sl_next);} \
    CMASK(C0,C1,t); \
    { float a=MX3(C0[0],C0[1],C1[0]),b=MX3(C0[2],C0[3],C1[1]); a=MX3(a,C1[2],C1[3]); \
      _Pragma("unroll") for(int r=4;r<16;r+=4){a=MX3(a,C0[r],C0[r+1]);b=MX3(b,C0[r+2],C0[r+3]);a=MX3(a,C1[r],C1[r+1]);b=MX3(b,C1[r+2],C1[r+3]);} \
      float rm=__builtin_fmaxf(a,b); { auto rr=__builtin_amdgcn_permlane32_swap(__float_as_uint(rm),__float_as_uint(rm),false,false); rm=__builtin_fmaxf(__uint_as_float(rr[0]),__uint_as_float(rr[1])); } \
      resc=false; \
      if(__builtin_expect(__any(rm>(float)THRL),0)){ const float dl=__builtin_fmaxf(rm,0.f); mhat+=dl; \
        _Pragma("unroll") for(int r=0;r<16;++r){C0[r]-=dl;C1[r]-=dl;} \
        _Pragma("unroll") for(int r=0;r<16;++r)negm[r]=-mhat; asm volatile("":"+v"(negm)); \
        const float f=__builtin_amdgcn_exp2f(-dl); l_reg*=f; if(hi==0)wsf[r32]=f; resc=true; } } \
    SBAR(); \
    GAPB(o[0]=__builtin_amdgcn_mfma_f32_32x32x16_bf16(PAF(0),VFR(0),o[0],0,0,0), C0,0); \
    GAPB(o[1]=__builtin_amdgcn_mfma_f32_32x32x16_bf16(PAF(0),VFR(4),o[1],0,0,0), C0,4); \
    KRD(GL,0); GAPB(o[0]=__builtin_amdgcn_mfma_f32_32x32x16_bf16(PAF(1),VFR(1),o[0],0,0,0), C0,8); \
    KRD(GL,1); GAPB(o[1]=__builtin_amdgcn_mfma_f32_32x32x16_bf16(PAF(1),VFR(5),o[1],0,0,0), C0,12); \
    KRD(GL,2); GAPB(o[0]=__builtin_amdgcn_mfma_f32_32x32x16_bf16(PAF(2),VFR(2),o[0],0,0,0), C1,0); \
    KRD(GL,3); GAPB(o[1]=__builtin_amdgcn_mfma_f32_32x32x16_bf16(PAF(2),VFR(6),o[1],0,0,0), C1,4); \
    GAPB(o[0]=__builtin_amdgcn_mfma_f32_32x32x16_bf16(PAF(3),VFR(3),o[0],0,0,0), C1,8); \
    GAPB(o[1]=__builtin_amdgcn_mfma_f32_32x32x16_bf16(PAF(3),VFR(7),o[1],0,0,0), C1,12); \
    }while(0)
  int t=1;
  for(;t+5<NT;t+=2){
    STEP(pB0,pB1,pA0,pA1,t,true,true,true);     WAIT_BAR(2); RESC(); ROT();
    STEP(pA0,pA1,pB0,pB1,t+1,true,true,true);   WAIT_BAR(2); RESC(); ROT();
  }
  #define ENDW(tt) do{ if((tt)+3<NT){WAIT_BAR(2);} else if((tt)+2<NT){WAIT_BAR(1);} else {WAIT_BAR(0);} }while(0)
  for(;t+1<NT;t+=2){
    STEP(pB0,pB1,pA0,pA1,t,(t+3<NT),(t+1<NT),(t+1<NT));       ENDW(t);   RESC(); ROT();
    STEP(pA0,pA1,pB0,pB1,t+1,(t+4<NT),(t+2<NT),(t+2<NT));     ENDW(t+1); RESC(); ROT();
  }
  STEP(pB0,pB1,pA0,pA1,NT-1,false,false,false); RESC();
  { float sacc=pB0[0]+pB0[1]; _Pragma("unroll") for(int r=2;r<16;++r)sacc+=pB0[r]; _Pragma("unroll") for(int r=0;r<16;++r)sacc+=pB1[r]; l_reg+=sacc;
    pw0=(u32x4){PKW(pB0,0),PKW(pB0,2),PKW(pB0,4),PKW(pB0,6)};pw1=(u32x4){PKW(pB0,8),PKW(pB0,10),PKW(pB0,12),PKW(pB0,14)};pw2=(u32x4){PKW(pB1,0),PKW(pB1,2),PKW(pB1,4),PKW(pB1,6)};pw3=(u32x4){PKW(pB1,8),PKW(pB1,10),PKW(pB1,12),PKW(pB1,14)};
    SBAR(); pv(o,vb0+sl_cur,PAF(0),PAF(1),PAF(2),PAF(3)); }
  #undef PKW
  #undef PAF
  #undef VFR
  #undef PIN
  #undef MX3
  #undef GAPA
  #undef GAPB
  #undef EX
  #undef VRD
  #undef KRD
  #undef STEP
  #undef ENDW
  if(MODE==1&&hi==0)l_reg+=__builtin_amdgcn_exp2f(sinkl2-mhat);
  {auto rr=__builtin_amdgcn_permlane32_swap(__float_as_uint(l_reg),__float_as_uint(l_reg),false,false);l_reg=__uint_as_float(rr[0])+__uint_as_float(rr[1]);}
  if(hi==0)wsf[32+r32]=l_reg;asm volatile("s_waitcnt lgkmcnt(0)":::"memory");
  float rli[16];
  #pragma unroll
  for(int r=0;r<16;++r)rli[r]=__builtin_amdgcn_rcpf(wsf[32+crow(r,hi)]);
  bf16*Ow=Op+(long)(q0+wid*QBLK)*PO;
  { bf16*stg=(bf16*)(shm+LDS_OST)+wid*2048;
    #pragma unroll
    for(int r=0;r<16;++r){const int orow=crow(r,hi);
      #pragma unroll
      for(int d0=0;d0<2;++d0)stg[orow*64+d0*32+r32]=__float2bfloat16(o[d0][r]*rli[r]);}
    asm volatile("s_waitcnt lgkmcnt(0)":::"memory");
    #pragma unroll
    for(int i=0;i<4;++i){const int row=i*8+(lane>>3),ch=lane&7; const u32x4 v=*(const u32x4*)(stg+row*64+ch*8); ATTN_STORE16(Ow+(long)row*PO+ch*8,v);} }
  asm volatile("s_waitcnt lgkmcnt(0)\n\ts_barrier":::"memory");
  #undef DMA_K
  #undef TILE_SRC
  #undef DMA_V
  #undef CMASK
  #undef START
  #undef RESC
  #undef ROT
}
#undef SBAR
#undef WAIT_BAR
}

constexpr int SD_CUM = 0, SD_DTV = 1024, SD_XC = 2048, SD_XCS = 144, SD_BC = SD_XC + 128 * SD_XCS, SD_BCS = 272, SD_CC = SD_BC + 128 * SD_BCS, SD_HS = SD_CC + 128 * SD_BCS,
              SD_SSQ = SD_HS + 2 * 64 * SD_BCS, SD_XW = SD_CC;
static_assert(SD_SSQ + 1024 <= RING_BYTES && SD_XW + 2 * 128 * SD_XCS <= RING_BYTES, "SSD LDS map");
DI int chunk_row(int b, int cidx) { return cidx < 2 ? NLAT + b * CTXL + 128 * cidx : b * SEQ + 128 * (cidx - 2); }
DI void ssd_cum(const Frame& F, int l, int b, int cidx, int hd, int wv0) {
    if (F.wave >= wv0 && F.wave < wv0 + 2) {
        const int dir = F.wave - wv0; const float* DT = WSP(float, WS_DT) + (size_t)chunk_row(b, cidx) * 16 + dir * 8 + hd;
        const float a = -__expf(F.in[I_ALOG][l * 16 + dir * 8 + hd]);
        const float d0 = DT[(size_t)(2 * F.lane) * 16], d1 = DT[(size_t)(2 * F.lane + 1) * 16];
        const float a0 = d0 * a, a1 = d1 * a, s = a0 + a1; float v = s;
        LAS float* cum = (LAS float*)(F.lds + SD_CUM) + dir * 128; LAS float* dtv = (LAS float*)(F.lds + SD_DTV) + dir * 128;
        if (dir == 0) {
#pragma unroll
            for (int o = 1; o < 64; o <<= 1) { const float t = __shfl_up(v, o); if (F.lane >= o) v += t; }
            cum[2 * F.lane] = v - s + a0; cum[2 * F.lane + 1] = v;
        } else {
#pragma unroll
            for (int o = 1; o < 64; o <<= 1) { const float t = __shfl_down(v, o); if (F.lane + o < 64) v += t; }
            cum[2 * F.lane + 1] = v - s + a1; cum[2 * F.lane] = v;
        }
        dtv[2 * F.lane] = d0; dtv[2 * F.lane + 1] = d1;
    }
}
DI void conv_items(const Frame& F, int l, int hd, int nitems, int rowbase, int seqlo, int seqhi) {
    const bf16_t* PRJ = WSP(bf16_t, WS_PRJ); const float* cw = F.in[I_CONVW] + (size_t)l * 5 * 1024; const float* cb = F.in[I_CONVB] + l * 1024;
    for (int item = F.tid; item < nitems; item += NTHR) {
        int chunk, seg, c0, dstride, dcol; LAS unsigned char* dst;
        if (item < 128) { chunk = item & 7; seg = item >> 3; c0 = 64 * hd + chunk * 8; dst = F.lds + SD_XC; dstride = SD_XCS; dcol = chunk * 16; }
        else if (item < 384) { const int q = item - 128; chunk = q & 15; seg = q >> 4; c0 = 512 + 128 * (hd >> 2) + chunk * 8; dst = F.lds + SD_BC; dstride = SD_BCS; dcol = chunk * 16; }
        else { const int q = item - 384; chunk = q & 15; seg = q >> 4; c0 = 768 + 128 * (hd >> 2) + chunk * 8; dst = F.lds + SD_CC; dstride = SD_BCS; dcol = chunk * 16; }
        const int t0 = seg * 8;
        float w[5][8], bb[8];
#pragma unroll
        for (int k = 0; k < 5; ++k) { const f32x4 wa = *(const f32x4*)(cw + k * 1024 + c0), wb = *(const f32x4*)(cw + k * 1024 + c0 + 4);
            w[k][0] = wa[0]; w[k][1] = wa[1]; w[k][2] = wa[2]; w[k][3] = wa[3]; w[k][4] = wb[0]; w[k][5] = wb[1]; w[k][6] = wb[2]; w[k][7] = wb[3]; }
        { const f32x4 ba = *(const f32x4*)(cb + c0), b2 = *(const f32x4*)(cb + c0 + 4); bb[0] = ba[0]; bb[1] = ba[1]; bb[2] = ba[2]; bb[3] = ba[3]; bb[4] = b2[0]; bb[5] = b2[1]; bb[6] = b2[2]; bb[7] = b2[3]; }
        u32x4 rows[12];
#pragma unroll
        for (int i = 0; i < 12; ++i) { const int row = rowbase + t0 - 2 + i;
            rows[i] = (row >= seqlo && row < seqhi) ? *(const u32x4*)(PRJ + (size_t)row * PRJW + C_XBC + c0) : (u32x4){0u, 0u, 0u, 0u}; }
#pragma unroll
        for (int j = 0; j < 8; ++j) {
            float y[8];
#pragma unroll
            for (int e = 0; e < 8; ++e) y[e] = bb[e];
#pragma unroll
            for (int k = 0; k < 5; ++k) { const u32x4 rr = rows[j + k];
                y[0] += w[k][0] * bflo(rr.x); y[1] += w[k][1] * bfhi(rr.x); y[2] += w[k][2] * bflo(rr.y); y[3] += w[k][3] * bfhi(rr.y);
                y[4] += w[k][4] * bflo(rr.z); y[5] += w[k][5] * bfhi(rr.z); y[6] += w[k][6] * bflo(rr.w); y[7] += w[k][7] * bfhi(rr.w); }
            u32x4 o; o.x = pk2(silu(y[0]), silu(y[1])); o.y = pk2(silu(y[2]), silu(y[3])); o.z = pk2(silu(y[4]), silu(y[5])); o.w = pk2(silu(y[6]), silu(y[7]));
            *(LAS u32x4*)(dst + (t0 + j) * dstride + dcol) = o;
        }
    }
}
DI void ssd_s1_unit(const Frame& Fin, int l, int b, int cidx, int hd) {
    const Frame F = launder(Fin);
    const int lane = F.lane, wid = F.wave, r = lane & 31, h = lane >> 5;
    const int rowbase = chunk_row(b, cidx), seqlo = cidx < 2 ? NLAT + b * CTXL : b * SEQ, seqhi = cidx < 2 ? seqlo + CTXL : seqlo + SEQ;
    __syncthreads();
    ssd_cum(F, l, b, cidx, hd, 6);
    conv_items(F, l, hd, 384, rowbase, seqlo, seqhi);
    __syncthreads();
    const LAS float* cum = (const LAS float*)(F.lds + SD_CUM); const LAS float* dtv = (const LAS float*)(F.lds + SD_DTV);
    for (int i = F.tid; i < 2 * 128 * 8; i += NTHR) {
        const int dir = i >> 10, t = (i >> 3) & 127, c8 = i & 7;
        const float ce = dir == 0 ? cum[127] : cum[128]; const float wgt = dtv[dir * 128 + t] * __expf(ce - cum[dir * 128 + t]);
        const u32x4 x = *(const LAS u32x4*)(F.lds + SD_XC + t * SD_XCS + c8 * 16);
        u32x4 o; o.x = pk2(bflo(x.x) * wgt, bfhi(x.x) * wgt); o.y = pk2(bflo(x.y) * wgt, bfhi(x.y) * wgt); o.z = pk2(bflo(x.z) * wgt, bfhi(x.z) * wgt); o.w = pk2(bflo(x.w) * wgt, bfhi(x.w) * wgt);
        *(LAS u32x4*)(F.lds + SD_XW + (dir * 128 + t) * SD_XCS + c8 * 16) = o;
    }
    __syncthreads();
    const int dir = wid >> 2, nb = wid & 3, q4 = (lane & 15) >> 2, p4 = lane & 3, blk = (lane >> 4) & 1;
    f32x16 s0, s1;
#pragma unroll
    for (int i = 0; i < 16; ++i) { s0[i] = 0.f; s1[i] = 0.f; }
    const LAS unsigned char* xa = F.lds + SD_XW + (dir * 128 + 8 * h + q4) * SD_XCS + (16 * blk + 4 * p4) * 2;
    const LAS unsigned char* ba = F.lds + SD_BC + (8 * h + q4) * SD_BCS + (32 * nb + 16 * blk + 4 * p4) * 2;
#pragma unroll
    for (int ks = 0; ks < 8; ++ks) {
        const bf16x8 bfr = cat8(tr_read(ba + (16 * ks) * SD_BCS), tr_read(ba + (16 * ks + 4) * SD_BCS));
        const bf16x8 x0 = cat8(tr_read(xa + (16 * ks) * SD_XCS), tr_read(xa + (16 * ks + 4) * SD_XCS));
        const bf16x8 x1 = cat8(tr_read(xa + (16 * ks) * SD_XCS + 64), tr_read(xa + (16 * ks + 4) * SD_XCS + 64));
        s0 = MFMA32(bfr, x0, s0); s1 = MFMA32(bfr, x1, s1);
    }
    bf16_t* ST = WSP(bf16_t, WS_ST) + ((((size_t)b * NCH + cidx) * 8 + hd) * 2 + dir) * 8192 + 32 * nb + 4 * h;
#pragma unroll
    for (int g4 = 0; g4 < 4; ++g4) { st4bf(ST + (size_t)r * 128 + 8 * g4, (f32x4){s0[4 * g4], s0[4 * g4 + 1], s0[4 * g4 + 2], s0[4 * g4 + 3]});
        st4bf(ST + (size_t)(32 + r) * 128 + 8 * g4, (f32x4){s1[4 * g4], s1[4 * g4 + 1], s1[4 * g4 + 2], s1[4 * g4 + 3]}); }
    if (F.tid < 2) WSP(float, WS_CDEC)[(((size_t)b * NCH + cidx) * 8 + hd) * 2 + F.tid] = __expf(F.tid == 0 ? cum[127] : cum[128]);
}
DI void phase_scan(const Frame& F) {
    bf16_t* ST = WSP(bf16_t, WS_ST); const float* CD = WSP(float, WS_CDEC);
    for (int gid = F.vcu * NTHR + F.tid; gid < 64 * 1024; gid += F.G * NTHR) {
        const int chain = gid >> 10, e8 = gid & 1023, b = chain >> 4, hd = (chain >> 1) & 7, dir = chain & 1;
        float hs[8];
#pragma unroll
        for (int e = 0; e < 8; ++e) hs[e] = 0.f;
        for (int k0 = 0; k0 < NCH; k0 += 11) {
            u32x4 st[11]; float dec[11];
#pragma unroll
            for (int j = 0; j < 11; ++j) { const int k = k0 + j, cidx = dir == 0 ? k : (k < 2 ? 1 - k : 67 - k); const size_t idx = (((size_t)b * NCH + cidx) * 8 + hd) * 2 + dir;
                st[j] = *((const u32x4*)(ST + idx * 8192) + e8); dec[j] = CD[idx]; }
#pragma unroll
            for (int j = 0; j < 11; ++j) { const int k = k0 + j, cidx = dir == 0 ? k : (k < 2 ? 1 - k : 67 - k); const size_t idx = (((size_t)b * NCH + cidx) * 8 + hd) * 2 + dir;
                u32x4 o; o.x = pk2(hs[0], hs[1]); o.y = pk2(hs[2], hs[3]); o.z = pk2(hs[4], hs[5]); o.w = pk2(hs[6], hs[7]); *((u32x4*)(ST + idx * 8192) + e8) = o;
                const u32x4 u = st[j]; const float d = dec[j];
                hs[0] = hs[0] * d + bflo(u.x); hs[1] = hs[1] * d + bfhi(u.x); hs[2] = hs[2] * d + bflo(u.y); hs[3] = hs[3] * d + bfhi(u.y);
                hs[4] = hs[4] * d + bflo(u.z); hs[5] = hs[5] * d + bfhi(u.z); hs[6] = hs[6] * d + bflo(u.w); hs[7] = hs[7] * d + bfhi(u.w); }
        }
    }
}
DI void ssd_s3_unit(const Frame& Fin, int l, int b, int cidx, int hd) {
    const Frame F = launder(Fin);
    const int lane = F.lane, wid = F.wave, r = lane & 31, h = lane >> 5;
    const int rowbase = chunk_row(b, cidx), seqlo = cidx < 2 ? NLAT + b * CTXL : b * SEQ, seqhi = cidx < 2 ? seqlo + CTXL : seqlo + SEQ;
    __syncthreads();
    ssd_cum(F, l, b, cidx, hd, 6);
    conv_items(F, l, hd, 640, rowbase, seqlo, seqhi);
    {
        const bf16_t* ST = WSP(bf16_t, WS_ST) + (((size_t)b * NCH + cidx) * 8 + hd) * 2 * 8192;
        for (int i = F.tid; i < 2 * 64 * 16; i += NTHR) { const int dp = i >> 4, c8 = i & 15; *(LAS u32x4*)(F.lds + SD_HS + dp * SD_BCS + c8 * 16) = *(const u32x4*)(ST + (size_t)dp * 128 + c8 * 8); }
    }
    __syncthreads();
    const LAS float* cum = (const LAS float*)(F.lds + SD_CUM); const LAS float* dtv = (const LAS float*)(F.lds + SD_DTV);
    const int lb = wid & 3, ph = wid >> 2, q4 = (lane & 15) >> 2, p4 = lane & 3, blk = (lane >> 4) & 1;
    const int lidx = 32 * lb + r;
    bf16x8 cf[8];
#pragma unroll
    for (int ks = 0; ks < 8; ++ks) cf[ks] = *(const LAS bf16x8*)(F.lds + SD_CC + lidx * SD_BCS + (16 * ks + 8 * h) * 2);
    f32x16 gt[4];
#pragma unroll
    for (int sb = 0; sb < 4; ++sb) {
#pragma unroll
        for (int i = 0; i < 16; ++i) gt[sb][i] = 0.f;
#pragma unroll
        for (int ks = 0; ks < 8; ++ks) { const bf16x8 bfr = *(const LAS bf16x8*)(F.lds + SD_BC + (32 * sb + r) * SD_BCS + (16 * ks + 8 * h) * 2); gt[sb] = MFMA32(bfr, cf[ks], gt[sb]); }
    }
    f32x16 ytot;
#pragma unroll
    for (int i = 0; i < 16; ++i) ytot[i] = 0.f;
    const LAS unsigned char* xa = F.lds + SD_XC + (4 * h + q4) * SD_XCS + (32 * ph + 16 * blk + 4 * p4) * 2;
#pragma unroll
    for (int dir = 0; dir < 2; ++dir) {
        const float cl = cum[dir * 128 + lidx];
        f32x16 acc;
#pragma unroll
        for (int i = 0; i < 16; ++i) acc[i] = 0.f;
#pragma unroll
        for (int sb = 0; sb < 4; ++sb) {
            const bool relv = dir == 0 ? (sb <= lb) : (sb >= lb);
            if (relv) {
                f32x16 mt; int rl = r; asm volatile("" : "+v"(rl));
#pragma unroll
                for (int i = 0; i < 16; ++i) { const int sl = crow(i, h), s = 32 * sb + sl;
                    const bool ok = (sb != lb) || (dir == 0 ? (sl <= rl) : (sl >= rl));
                    const float e = __expf(cl - cum[dir * 128 + s]) * dtv[dir * 128 + s];
                    mt[i] = ok ? gt[sb][i] * e : 0.f; }
                const bf16x8 pa0 = pack8<0>(mt), pa1 = pack8<1>(mt);
                const bf16x8 x0 = cat8(tr_read(xa + (32 * sb) * SD_XCS), tr_read(xa + (32 * sb + 8) * SD_XCS));
                const bf16x8 x1 = cat8(tr_read(xa + (32 * sb + 16) * SD_XCS), tr_read(xa + (32 * sb + 24) * SD_XCS));
                acc = MFMA32(x0, pa0, acc); acc = MFMA32(x1, pa1, acc);
            }
        }
        f32x16 yo;
#pragma unroll
        for (int i = 0; i < 16; ++i) yo[i] = 0.f;
#pragma unroll
        for (int ks = 0; ks < 8; ++ks) { const bf16x8 hf = *(const LAS bf16x8*)(F.lds + SD_HS + (dir * 64 + 32 * ph + r) * SD_BCS + (16 * ks + 8 * h) * 2); yo = MFMA32(hf, cf[ks], yo); }
        const float el = __expf(cl);
#pragma unroll
        for (int i = 0; i < 16; ++i) ytot[i] += acc[i] + el * yo[i];
    }
    const float dsk = F.in[I_DSKIP][l * 8 + hd];
    const int row = rowbase + lidx;
    const bf16_t* zp = WSP(bf16_t, WS_PRJ) + (size_t)row * PRJW + C_Z + 64 * hd + 32 * ph + 4 * h;
    bf16_t* op = WSP(bf16_t, WS_OC) + (size_t)row * OCW + 1536 + 64 * hd + 32 * ph + 4 * h;
    float ss = 0.f;
#pragma unroll
    for (int g4 = 0; g4 < 4; ++g4) {
        const u32x2 zz = *(const u32x2*)(zp + 8 * g4);
        const u32x2 xx = *(const LAS u32x2*)(F.lds + SD_XC + lidx * SD_XCS + (32 * ph + 8 * g4 + 4 * h) * 2);
        const float v0 = (ytot[4 * g4] + dsk * bflo(xx.x)) * silu(bflo(zz.x)), v1 = (ytot[4 * g4 + 1] + dsk * bfhi(xx.x)) * silu(bfhi(zz.x));
        const float v2 = (ytot[4 * g4 + 2] + dsk * bflo(xx.y)) * silu(bflo(zz.y)), v3 = (ytot[4 * g4 + 3] + dsk * bfhi(xx.y)) * silu(bfhi(zz.y));
        ss += (v0 * v0 + v1 * v1) + (v2 * v2 + v3 * v3);
        u32x2 w; w.x = pk2(v0, v1); w.y = pk2(v2, v3); *(u32x2*)(op + 8 * g4) = w;
    }
    ss += __shfl_xor(ss, 32);
    LAS float* sq = (LAS float*)(F.lds + SD_SSQ);
    if (h == 0) sq[ph * 128 + lidx] = ss;
    __syncthreads();
    if (F.tid < 128) WSP(float, WS_SSQ)[(size_t)(rowbase + F.tid) * 8 + hd] = sq[F.tid] + sq[128 + F.tid];
}

constexpr int PH_PER_LAYER = 11, N_PHASES = 2 + PH_PER_LAYER * DEPTH;
__global__ void __launch_bounds__(NTHR, 2) fwd_kernel(Args args) {
    extern __shared__ __attribute__((aligned(16))) unsigned char smem[];
    Frame F0;
    F0.lds = (LAS unsigned char*)smem;
    F0.tid = threadIdx.x; F0.lane = F0.tid & 63; F0.wave = __builtin_amdgcn_readfirstlane(F0.tid >> 6);
    F0.G = gridDim.x; { const int bx = blockIdx.x; F0.vcu = (F0.G % 8 == 0) ? (bx % 8) * (F0.G / 8) + bx / 8 : bx; }
    F0.in = args.in; F0.out = args.out; F0.ws = args.ws; F0.ctl = (gu32*)(args.ws + WS_CTL);
    volatile LAS unsigned* MISC = (volatile LAS unsigned*)(F0.lds + MISC_OFF);
    for (int u = F0.tid; u < (LDS_BYTES - RING_BYTES) / 4; u += NTHR) ((LAS unsigned*)(F0.lds + RING_BYTES))[u] = 0u;
    __syncthreads();
    XcdBarrier bar; bar.bar = (unsigned*)(F0.ctl + CW_BAR); bar.x = 0; bar.st = nullptr;
    if (!MK_PER_PHASE) bar = xcd_barrier_post((unsigned*)(F0.ctl + CW_BAR), MISC + 8);
    const int lo = args.ph_lo, hi = args.ph_hi;
#define IN(k) (lo <= (k) && (k) < hi)
#define SEAM(k) do { if (IN(k) && IN((k) + 1)) { if (MK_PER_PHASE) { if (F0.tid == 0) __hip_atomic_store(F0.ctl + 0, 0xBADBA0u, __ATOMIC_RELAXED, __HIP_MEMORY_SCOPE_AGENT); } else xcd_barrier(bar); } } while (0)

    if (PHM(11) && IN(0)) { const Frame F = launder(F0); _Pragma("nounroll") for (int rep = 0; rep < 1 + REPB(11); ++rep) { phase_prologue_a(F); __syncthreads(); } } SEAM(0);
    if (PHM(12) && IN(1)) { const Frame F = launder(F0); _Pragma("nounroll") for (int rep = 0; rep < 1 + REPB(12); ++rep) { phase_prologue_b(F); __syncthreads(); } } SEAM(1);

    for (int l = 0; l < DEPTH; ++l) {
        const int pb = 2 + PH_PER_LAYER * l;
        const bool with_ctx = l < DEPTH - 1, moe = l & 1; const int fi = l >> 1;
        const int mrows = with_ctx ? MTOT : NLAT, mtiles = with_ctx ? 132 : 128;
        if (PHM(0) && IN(pb + 0)) { const Frame F = launder(F0);
            pg8::SchedGrid S; S.nMa = mtiles; S.nNa = 34; S.nMb = with_ctx ? 0 : 4; S.nNb = 18; S.total = S.nMa * S.nNa + S.nMb * S.nNb; S.G = F.G; S.c = F.vcu;
            S.A = (const char*)(F.ws + WS_HB); S.B = (const char*)(F.ws + WS_WCOMB + l * SZ_WCOMB); S.lda = DM; S.ldb = DM; S.a_div = 1; S.a_cols = 0; S.pe = nullptr; S.estride = 0; S.rep = REPB(0);
            pg8::EpiInGate E{WSP(bf16_t, WS_PRJ), WSP(bf16_t, WS_GT), F.in[I_BGATE] + (size_t)l * 4096};
            pg8::gemm_phase(F.lds, F.tid, DM, DM, DM, S, E);
        }
        SEAM(pb + 0);
        if (PHM(1) && IN(pb + 1)) { const Frame F = launder(F0);
            phase_qkprep_rows(F, l);
            for (int u = F.vcu; u < NB * NCH * 8; u += F.G) { const int hd = u & 7, cidx = (u >> 3) % NCH, b = (u >> 3) / NCH; ssd_s1_unit(F, l, b, cidx, hd); }
        }
        SEAM(pb + 1);
        if (PHM(2) && IN(pb + 2)) { const Frame F = launder(F0); phase_scan(F); }
        SEAM(pb + 2);
        if (PHM(3) && IN(pb + 3)) { const Frame F = launder(F0);
            const int nchs = with_ctx ? NCH : NCH - 2, n_s3 = NB * nchs * 8, n_cx = with_ctx ? 96 : 0, total = 3072 + n_s3 + n_cx;
            _Pragma("nounroll") for (int rep = 0; rep < 1 + REPB(3); ++rep) {
            {
                for (int uu = F.vcu; uu < (1024 << REPB(13)); uu += F.G) { const int u = uu & 1023;
                    const int v = u & 1023, qblk = v & 31, b = v >> 8, hg = (v >> 5) & 3, kvh = (v >> 7) & 1, hq = kvh * 4 + hg;
                    const ga_body::bf16* P = (const ga_body::bf16*)(F.ws + WS_PRJ); const size_t lat0 = (size_t)(b * SEQ) * PRJW, ctx0 = (size_t)(NLAT + b * CTXL) * PRJW;
                    ga_body::bf16* O = (ga_body::bf16*)(F.ws + WS_OC) + (size_t)(b * SEQ) * OCW;
                    ga_body::attn_unit<8, 0>(qblk, P + lat0 + C_GAQ + hq * 64, P + lat0 + C_GAK + kvh * 64, P + lat0 + C_GAV + kvh * 64, P + ctx0 + C_GAK + kvh * 64, P + ctx0 + C_GAV + kvh * 64,
                                             O + 1024 + hq * 64, (char*)F.lds, F.tid, 132, 0, 0.f, nullptr);
                }
            }
            {
                const Frame F = launder(F0);
                for (int u = F.vcu; u < 1024; u += F.G) {
                    const int v = u & 1023, qblk = v & 31, b = v >> 8, hq = (v >> 5) & 7;
                    const ga_body::bf16* P = (const ga_body::bf16*)(F.ws + WS_PRJ); const size_t lat0 = (size_t)(b * SEQ) * PRJW, ctx0 = (size_t)(NLAT + b * CTXL) * PRJW;
                    ga_body::bf16* O = (ga_body::bf16*)(F.ws + WS_OC) + (size_t)(b * SEQ) * OCW;
                    int tlo = clampi(4 * qblk - 4, 0, 120), thi = clampi(4 * qblk - 1, 0, 120) + 8; if ((thi - tlo) & 1) { if (thi < 128) ++thi; else --tlo; }
                    const size_t lo = lat0 + (size_t)tlo * 64 * PRJW;
                    ga_body::attn_unit<8, 2>(qblk, P + lat0 + C_NAQ + hq * 64, P + lo + C_NAK + hq * 64, P + lo + C_NAV + hq * 64, P + ctx0 + C_NAK + hq * 64, P + ctx0 + C_NAV + hq * 64,
                                             O + hq * 64, (char*)F.lds, F.tid, 4 + thi - tlo, tlo, 0.f, F.in[I_RPB] + ((size_t)l * 8 + hq) * 465);
                }
            }
            {
                const Frame F = launder(F0);
                for (int u = F.vcu; u < 1024; u += F.G) {
                    const int v = u & 1023, qblk = v & 31, b = v >> 8, hg = (v >> 5) & 3, kvh = (v >> 7) & 1, hq = kvh * 4 + hg;
                    const ga_body::bf16* P = (const ga_body::bf16*)(F.ws + WS_PRJ); const size_t lat0 = (size_t)(b * SEQ) * PRJW, ctx0 = (size_t)(NLAT + b * CTXL) * PRJW;
                    ga_body::bf16* O = (ga_body::bf16*)(F.ws + WS_OC) + (size_t)(b * SEQ) * OCW;
                    const int tlo = 4 * qblk - 2 < 0 ? 0 : 4 * qblk - 2, thi = 4 * qblk + 6 > 128 ? 128 : 4 * qblk + 6; const size_t lo = lat0 + (size_t)tlo * 64 * PRJW;
                    ga_body::attn_unit<8, 1>(qblk, P + lat0 + C_SWQ + hq * 64, P + lo + C_SWK + kvh * 64, P + lo + C_SWV + kvh * 64, P + ctx0 + C_SWK + kvh * 64, P + ctx0 + C_SWV + kvh * 64,
                                             O + 512 + hq * 64, (char*)F.lds, F.tid, 4 + thi - tlo, tlo, F.in[I_SINK][l * 8 + hq] * LOG2E, nullptr);
                }
            }
            const Frame Fb = launder(F0);
            for (int u = 3072 + Fb.vcu; u < total; u += Fb.G) { const Frame& F = Fb;
                if (u < 3072 + n_s3) { const int v = u - 3072, hd = v & 7, cc = (v >> 3) % nchs, b = (v >> 3) / nchs; ssd_s3_unit(F, l, b, with_ctx ? cc : cc + 2, hd); }
                else { const int v = u - 3072 - n_s3, mode = v >> 5, b = (v >> 3) & 3, hq = v & 7; attn_unit(F, l, mode, true, b, hq, 0); }
            }
            }
        }
        SEAM(pb + 3);
        if (PHM(4) && IN(pb + 4)) { const Frame F = launder(F0);
            pg8::SchedBranch S; S.rep = REPB(4); S.T = mtiles * 8; S.G = F.G; S.c = F.vcu; S.A = (const char*)(F.ws + WS_OC); S.B = (const char*)(F.ws + WS_WB + l * SZ_WB);
            pg8::EpiBranch E{WSP(bf16_t, WS_GT), WSP(float, WS_SSQ), WSP(bf16_t, WS_PRJ)};
            pg8::gemm_phase<pg8::EpiBranch, pg8::SchedBranch, true>(F.lds, F.tid, 512, OCW, 512, S, E);
        }
        SEAM(pb + 4);
        if (PHM(5) && IN(pb + 5)) { const Frame F = launder(F0);
            pg8::SchedGrid S; S.nMa = mtiles; S.nNa = 4; S.nMb = 0; S.nNb = 1; S.total = S.nMa * S.nNa; S.G = F.G; S.c = F.vcu;
            S.A = (const char*)(F.ws + WS_PRJ); S.B = (const char*)(F.ws + WS_WO + l * SZ_WO); S.lda = DM; S.ldb = DM; S.a_div = 1; S.a_cols = 0; S.pe = nullptr; S.estride = 0; S.rep = REPB(5);
            pg8::EpiResid E{WSP(bf16_t, WS_XS), WSP(float, WS_MVEC) + (size_t)l * 5 * 6144 + 2048, nullptr, WSP(bf16_t, WS_END)};
            pg8::gemm_phase(F.lds, F.tid, DM, DM, DM, S, E);
        }
        SEAM(pb + 5);
        if (PHM(6) && IN(pb + 6)) { const Frame F = launder(F0); phase_ln1(F, l, mrows); }
        SEAM(pb + 6);
        if (moe) { if (PHM(7) && IN(pb + 7)) { const Frame F = launder(F0); phase_gather(F, l, mrows); } SEAM(pb + 7); }
        if (PHM(8) && IN(pb + 8)) { const Frame F = launder(F0);
            pg8::SchedGrid S; S.rep = REPB(8); S.nMb = 0; S.nNb = 1; S.G = F.G; S.c = F.vcu; S.lda = DM; S.ldb = DM; S.a_div = 1; S.a_cols = 0; S.pe = nullptr; S.estride = 0; int ldh;
            if (!moe) { S.nMa = mtiles; S.nNa = DFF / 128; S.A = (const char*)(F.ws + WS_HB); S.B = (const char*)(F.ws + WS_WUP + fi * SZ_WUP); ldh = DFF; }
            else { const int npad = moe_pad_ends_lds(F, fi); S.pe = (const LAS int*)(F.lds + MISC_OFF + 64); S.nMa = npad / 256; S.nNa = DFFE / 128;
                   S.A = (const char*)(F.ws + WS_XPAD); S.B = (const char*)(F.ws + WS_MUP + fi * SZ_MUP); S.estride = (size_t)2 * DFFE * DM * 2; ldh = DFFE; }
            S.total = S.nMa * S.nNa;
            pg8::EpiSwiGLU E{WSP(bf16_t, WS_HID), ldh};
            pg8::gemm_phase(F.lds, F.tid, DM, DM, DM, S, E);
        }
        SEAM(pb + 8);
        if (PHM(9) && IN(pb + 9)) { const Frame F = launder(F0);
            pg8::SchedGrid S; S.rep = REPB(9); S.nMb = 0; S.nNb = 1; S.nNa = 4; S.G = F.G; S.c = F.vcu; S.a_div = 1; S.a_cols = 0; S.pe = nullptr; S.estride = 0; S.A = (const char*)(F.ws + WS_HID);
            pg8::EpiResid E{WSP(bf16_t, WS_XS), WSP(float, WS_MVEC) + (size_t)l * 5 * 6144 + 5120, nullptr, WSP(bf16_t, WS_END)};
            int kk;
            if (!moe) { S.nMa = mtiles; S.B = (const char*)(F.ws + WS_WDN + fi * SZ_WDN); kk = DFF; }
            else { const int npad = moe_pad_ends_lds(F, fi); S.pe = (const LAS int*)(F.lds + MISC_OFF + 64); S.nMa = npad / 256; S.B = (const char*)(F.ws + WS_MDN + fi * SZ_MDN); S.estride = (size_t)DM * DFFE * 2; kk = DFFE; E.plainO = WSP(bf16_t, WS_YPAD); }
            S.lda = kk; S.ldb = kk; S.total = S.nMa * S.nNa;
            pg8::gemm_phase(F.lds, F.tid, kk, kk, kk, S, E);
        }
        SEAM(pb + 9);
        if (PHM(10) && IN(pb + 10)) { const Frame F = launder(F0); phase_ln2(F, l, mrows); }
        if (l + 1 < DEPTH) SEAM(pb + 10);
    }
#undef IN
#undef SEAM
}

extern "C" void kernel_launch(void* const* d_in, const int* in_sizes, int n_in, void* d_out, int out_size, void* d_ws, size_t ws_size, hipStream_t stream) {
    static int grid = 0;
    if (grid == 0) {
        if (n_in != 31 || in_sizes[0] != NLAT * DM || out_size != NLAT * DM || ws_size < WS_END) {
            fprintf(stderr, "kernel_launch: unexpected shapes: n_in %d in0 %d out %d ws %zu (need %zu); nothing launched\n", n_in, n_in > 0 ? in_sizes[0] : -1, out_size, ws_size, (size_t)WS_END); grid = -1; return; }
        int dev = 0, cus = 0, per_cu = 0;
        if (hipGetDevice(&dev) != hipSuccess || hipDeviceGetAttribute(&cus, hipDeviceAttributeMultiprocessorCount, dev) != hipSuccess) { fprintf(stderr, "kernel_launch: device query failed\n"); grid = -1; return; }
        if (hipFuncSetAttribute((const void*)fwd_kernel, hipFuncAttributeMaxDynamicSharedMemorySize, LDS_BYTES) != hipSuccess) { fprintf(stderr, "kernel_launch: hipFuncSetAttribute failed\n"); grid = -1; return; }
        if (hipOccupancyMaxActiveBlocksPerMultiprocessor(&per_cu, (const void*)fwd_kernel, NTHR, LDS_BYTES) != hipSuccess || per_cu < 1)
            fprintf(stderr, "kernel_launch: note: occupancy query reports %d workgroups per CU\n", per_cu);
        (void)hipGetLastError();
        grid = cus;
    }
    if (grid < 0) return;
    if (hipMemsetAsync((char*)d_ws + WS_CTL, 0, CTL_ZERO_BYTES, stream) != hipSuccess) { fprintf(stderr, "kernel_launch: memset failed\n"); return; }
    Args a{};
    for (int i = 0; i < 31; ++i) a.in[i] = (const float*)d_in[i];
    a.out = (float*)d_out; a.ws = (unsigned char*)d_ws;
#if MK_PER_PHASE
    for (int p = 0; p < N_PHASES; ++p) { a.ph_lo = p; a.ph_hi = p + 1; hipLaunchKernelGGL(fwd_kernel, dim3(grid), dim3(NTHR), LDS_BYTES, stream, a); }
#else
    a.ph_lo = 0; a.ph_hi = N_PHASES;
    hipLaunchKernelGGL(fwd_kernel, dim3(grid), dim3(NTHR), LDS_BYTES, stream, a);
#endif
    const hipError_t le = hipPeekAtLastError();
    if (le != hipSuccess) fprintf(stderr, "kernel_launch: launch failed: %s\n", hipGetErrorName(le));
}
```

```cpp
#include <hip/hip_runtime.h>
#include <cstdio>
#include <cstdint>
#include <hip/hip_bf16.h>
#include <cmath>

#define DI __device__ __forceinline__
#define LAS __attribute__((address_space(3)))
#define GAS __attribute__((address_space(1)))
typedef unsigned short bf16_t;
typedef short bf16x8 __attribute__((ext_vector_type(8)));
typedef short s16x4 __attribute__((ext_vector_type(4)));
typedef float f32x2 __attribute__((ext_vector_type(2)));
typedef float f32x4 __attribute__((ext_vector_type(4)));
typedef float f32x16 __attribute__((ext_vector_type(16)));
typedef unsigned u32x2 __attribute__((ext_vector_type(2)));
typedef unsigned u32x4 __attribute__((ext_vector_type(4)));
typedef __bf16 bf16x2_t __attribute__((ext_vector_type(2)));
typedef GAS unsigned gu32;

#ifndef MK_PER_PHASE
#define MK_PER_PHASE 0
#endif
#ifndef PHMASK
#define PHMASK 0xFFFF
#endif
#define PHM(k) ((PHMASK >> (k)) & 1)
#ifndef REP_MASK
#define REP_MASK 0
#endif
#define REPB(k) ((REP_MASK >> (k)) & 1)
#ifndef ABL
#define ABL 0
#endif

constexpr int DM = 1024, NB = 4, SEQ = 8192, CTXL = 256, NLAT = NB * SEQ, NCTX = NB * CTXL, MTOT = NLAT + NCTX;
constexpr int DEPTH = 4, DIN = 4624, PRJW = 4608, GTW = 4096, NCOMB = PRJW + GTW, OCW = 2048;
constexpr int DFF = 2816, DFFE = 3584, NEXP = 8, MOE_ROWS_MAX = 69632;
constexpr int NCH = 66;
constexpr float ALPHA = 1.6817928305074292f;
constexpr float LOG2E = 1.4426950408889634f;
constexpr float C2 = 0.125f * LOG2E;
constexpr float LN_EPS = 1e-5f, RMS_EPS = 1e-6f;
constexpr int C_NAQ = 0, C_NAK = 512, C_NAV = 1024, C_SWQ = 1536, C_SWK = 2048, C_SWV = 2176, C_GAQ = 2304, C_GAK = 2816, C_GAV = 2944, C_Z = 3072, C_XBC = 3584;

constexpr size_t KiB = 1024, MiB = 1u << 20;
constexpr size_t WS_CTL = 0, CTL_ZERO_BYTES = 1 * MiB;
constexpr size_t WS_MVEC = 1 * MiB;
constexpr size_t WS_ROPE = WS_MVEC + 512 * KiB;
constexpr size_t WS_DT = 4 * MiB;
constexpr size_t WS_SSQ = WS_DT + (size_t)MTOT * 16 * 4;
constexpr size_t WS_SLOT = WS_SSQ + (size_t)MTOT * 8 * 4;
constexpr size_t WS_CDEC = WS_SLOT + (size_t)MTOT * 8 * 4;
constexpr size_t WS_W = 10 * MiB;
constexpr size_t SZ_WCOMB = (size_t)NCOMB * DM * 2, SZ_WB = (size_t)4096 * 512 * 2, SZ_WO = (size_t)1024 * 4096 * 2;
constexpr size_t SZ_WUP = (size_t)2 * DFF * DM * 2, SZ_WDN = (size_t)DM * DFF * 2, SZ_MUP = (size_t)NEXP * 2 * DFFE * DM * 2, SZ_MDN = (size_t)NEXP * DM * DFFE * 2;
constexpr size_t WS_WCOMB = WS_W, WS_WB = WS_WCOMB + 4 * SZ_WCOMB, WS_WO = WS_WB + 4 * SZ_WB, WS_WUP = WS_WO + 4 * SZ_WO, WS_WDN = WS_WUP + 2 * SZ_WUP,
                 WS_MUP = WS_WDN + 2 * SZ_WDN, WS_MDN = WS_MUP + 2 * SZ_MUP, WS_WEND = WS_MDN + 2 * SZ_MDN;
constexpr size_t WS_XS = (WS_WEND + 255) & ~(size_t)255;
constexpr size_t WS_HB = WS_XS + (size_t)MTOT * DM * 4;
constexpr size_t WS_U = WS_HB + (size_t)MTOT * DM * 2;
constexpr size_t WS_PRJ = WS_U;
constexpr size_t WS_GT = WS_PRJ + (size_t)MTOT * PRJW * 2;
constexpr size_t WS_OC = WS_GT + (size_t)MTOT * GTW * 2;
constexpr size_t WS_ST = WS_OC + (size_t)MTOT * OCW * 2;
constexpr size_t WS_UEND = WS_ST + (size_t)NB * NCH * 16 * 8192 * 4;
constexpr size_t WS_HID = WS_U;
constexpr size_t WS_XPAD = WS_HID + (size_t)MOE_ROWS_MAX * DFFE * 2;
constexpr size_t WS_YPAD = WS_XPAD + (size_t)MOE_ROWS_MAX * DM * 2;
static_assert(WS_YPAD + (size_t)MOE_ROWS_MAX * DM * 2 <= WS_UEND, "FFN overlay fits the union region");
constexpr size_t WS_END = WS_UEND;
constexpr int CW_BAR = 4096, CW_MOECNT = 16384;

constexpr int RING_BYTES = 131072, MISC_OFF = RING_BYTES + 320, LDS_BYTES = 147456;
constexpr int NWAVES = 8, NTHR = 512;

DI unsigned pk2(float lo, float hi) { f32x2 v = {lo, hi}; bf16x2_t b = __builtin_convertvector(v, bf16x2_t); return __builtin_bit_cast(unsigned, b); }
DI float bflo(unsigned u) { return __uint_as_float(u << 16); }
DI float bfhi(unsigned u) { return __uint_as_float(u & 0xffff0000u); }
DI f32x4 ld4bf(const bf16_t* p) { const u32x2 u = *(const u32x2*)p; return (f32x4){bflo(u.x), bfhi(u.x), bflo(u.y), bfhi(u.y)}; }
DI void st4bf(bf16_t* p, const f32x4 v) { u32x2 w; w.x = pk2(v[0], v[1]); w.y = pk2(v[2], v[3]); *(u32x2*)p = w; }
DI float sigm(float x) { return __builtin_amdgcn_rcpf(1.f + __expf(-x)); }
DI float silu(float x) { return x * sigm(x); }
DI float wave_sum(float v) {
#pragma unroll
    for (int o = 1; o < 64; o <<= 1) v += __shfl_xor(v, o);
    return v;
}
DI int clampi(int v, int lo, int hi) { return v < lo ? lo : (v > hi ? hi : v); }
#define MFMA32(a, b, c) __builtin_amdgcn_mfma_f32_32x32x16_bf16((a), (b), (c), 0, 0, 0)
DI int crow(int reg, int h) { return (reg & 3) + 8 * (reg >> 2) + 4 * h; }
typedef short v4i16_t __attribute__((ext_vector_type(4)));
DI s16x4 tr_read(const LAS unsigned char* p) { return __builtin_bit_cast(s16x4, __builtin_amdgcn_ds_read_tr16_b64_v4i16((LAS v4i16_t*)p)); }
DI bf16x8 cat8(s16x4 lo, s16x4 hi) { return __builtin_shufflevector(lo, hi, 0, 1, 2, 3, 4, 5, 6, 7); }
template <int S> DI bf16x8 pack8(const f32x16& x) {
    u32x4 w; w.x = pk2(x[8 * S], x[8 * S + 1]); w.y = pk2(x[8 * S + 2], x[8 * S + 3]); w.z = pk2(x[8 * S + 4], x[8 * S + 5]); w.w = pk2(x[8 * S + 6], x[8 * S + 7]);
    return __builtin_bit_cast(bf16x8, w);
}

#define XB_TMO      128
#define XB_XCNT(j)  (256  + 64 * (j))
#define XB_XSUB(j)  (1280 + 64 * (j))
#define XB_XGEN(j)  (2304 + 64 * (j))
#define XB_TOP      3328
#define XB_TOPGEN   3392
#define XCD_BAR_WORDS 3456
#define XB_SPIN_CAP (1u << 18)
DI unsigned xb_ld(unsigned* p)              { return __hip_atomic_load(p, __ATOMIC_RELAXED, __HIP_MEMORY_SCOPE_AGENT); }
DI unsigned xb_add(unsigned* p, unsigned v) { return __hip_atomic_fetch_add(p, v, __ATOMIC_RELAXED, __HIP_MEMORY_SCOPE_AGENT); }
DI unsigned xb_xcc_id() { return (unsigned)__builtin_amdgcn_s_getreg((3 << 11) | 20) & 0xFu; }
#define XB_SPIN(cond, bar) do { unsigned _sp = 0; while (cond) { __builtin_amdgcn_s_sleep(1); \
    if ((++_sp & 255u) == 0u) { if (xb_ld(&(bar)[XB_TMO])) break; if (_sp > XB_SPIN_CAP) { atomicAdd(&(bar)[XB_TMO], 1u); break; } } } } while (0)
struct XcdBarrier { unsigned* bar; unsigned x; volatile LAS unsigned* st; };
DI XcdBarrier xcd_barrier_post(unsigned* bar, volatile LAS unsigned* st) {
    XcdBarrier b; b.bar = bar; b.x = xb_xcc_id(); b.st = st;
    if (threadIdx.x == 0) (void)xb_add(&bar[XB_XCNT(b.x)], 1u);
    return b;
}
DI void xcd_barrier_complete(unsigned* bar, unsigned x, unsigned& nloc, unsigned& nx) {
    const unsigned G = gridDim.x * gridDim.y * gridDim.z;
    unsigned sum, cnt, mine, sp = 0u;
    for (;;) {
        sum = 0u; cnt = 0u; mine = 0u;
#pragma unroll
        for (unsigned j = 0; j < 16; ++j) { const unsigned c = xb_ld(&bar[XB_XCNT(j)]); sum += c; cnt += (c > 0u) ? 1u : 0u; mine = (j == x) ? c : mine; }
        if (sum == G) break;
        __builtin_amdgcn_s_sleep(1);
        if ((++sp & 255u) == 0u) { if (xb_ld(&bar[XB_TMO])) break; if (sp > XB_SPIN_CAP) { atomicAdd(&bar[XB_TMO], 1u); break; } }
    }
    nloc = mine > 0u ? mine : 1u; nx = cnt > 0u ? cnt : 1u;
}
DI void xcd_barrier(const XcdBarrier& b) {
    asm volatile("s_waitcnt vmcnt(0)" ::: "memory");
    __syncthreads();
    if (threadIdx.x == 0) {
        unsigned* bar = b.bar;
        __builtin_amdgcn_s_waitcnt(0);
        unsigned nloc = b.st[0], nx = b.st[1];
        if (nloc == 0u) { xcd_barrier_complete(bar, b.x, nloc, nx); b.st[0] = nloc; b.st[1] = nx; }
        const unsigned old = xb_add(&bar[XB_XSUB(b.x)], 1u);
        const unsigned gen = old / nloc;
        if (old + 1u == (gen + 1u) * nloc) {
            __builtin_amdgcn_fence(__ATOMIC_RELEASE, "agent");
            asm volatile("s_waitcnt vmcnt(0)" ::: "memory");
            const unsigned og = xb_add(&bar[XB_TOP], 1u);
            const unsigned tg = og / nx;
            if (og + 1u == (tg + 1u) * nx) xb_add(&bar[XB_TOPGEN], 1u);
            else XB_SPIN(xb_ld(&bar[XB_TOPGEN]) == tg, bar);
            __builtin_amdgcn_fence(__ATOMIC_ACQUIRE, "agent");
            xb_add(&bar[XB_XGEN(b.x)], 1u);
            asm volatile("s_waitcnt vmcnt(0)" ::: "memory");
        } else {
            XB_SPIN(xb_ld(&bar[XB_XGEN(b.x)]) == gen, bar);
            __builtin_amdgcn_fence(__ATOMIC_ACQUIRE, "agent");
            asm volatile("s_waitcnt vmcnt(0)" ::: "memory");
        }
    }
    __syncthreads();
}

namespace pg8 {
constexpr int BM = 256, BK = 64, HALF = 128, HTB = HALF * BK * 2, STAGE_BYTES = 8 * HTB;
__host__ __device__ __forceinline__ int lds_byte(int r, int c) { const int st = (r >> 4) * 2 + (c >> 5), rr = r & 15, cc = c & 31, ob = rr * 64 + cc * 2; return st * 1024 + (ob ^ (((ob >> 9) & 1) << 5)); }
__host__ __device__ __forceinline__ void stage_rc(int b, int& R, int& C) { const int st = b / 1024, sb = b % 1024, swz = sb ^ (((sb >> 9) & 1) << 5); R = (st >> 1) * 16 + swz / 64; C = (st & 1) * 32 + (swz % 64) / 2; }
__host__ __device__ __forceinline__ int perm32(int rho) { const int n = rho >> 4, i = rho & 15; return 8 * (i >> 2) + 4 * n + (i & 3); }
struct Unit { int pm, pn, dup; const char* A; const char* B; };

template <class Epi, class Sched, bool HM = false>
DI void gemm_phase(LAS unsigned char* lds, const int tid, const int K, const int lda, const int ldb, const Sched& S, const Epi& E) {
    const int wid = __builtin_amdgcn_readfirstlane(tid >> 6), lane = tid & 63, wr = wid >> 2, wc = wid & 3, fr = lane & 15, fq = lane >> 4;
    const int nt = K / BK;
    unsigned voffA[2], voffB[2];
#pragma unroll
    for (int i = 0; i < 2; ++i) { int R, C; stage_rc(tid * 16 + i * 8192, R, C); const int Rb = (R & ~31) + perm32(R & 31);
        voffA[i] = (unsigned)(R * lda + C) * 2u; voffB[i] = (unsigned)(Rb * ldb + C) * 2u; }
    const size_t kstep = (size_t)(BK * 2);
    const size_t hstepA = (size_t)HALF * lda * 2, hstepB = (size_t)HALF * ldb * 2;
    const unsigned ldsw = (unsigned)wid * 1024u;
    const int aoff = lds_byte(wr * 64 + fr, fq * 8), boff = lds_byte(wc * 32 + fr, fq * 8);
#define PG8_SA(b, h) (((b) * 2 + (h)) * HTB)
#define PG8_SB(b, h) ((4 + (b) * 2 + (h)) * HTB)
#define PG8_STAGE(bufoff, gbase, voff) do { _Pragma("unroll") for (int _i = 0; _i < 2; ++_i) \
        __builtin_amdgcn_global_load_lds((const unsigned*)((const char*)(gbase) + (voff)[_i]), (LAS unsigned*)(lds + (bufoff) + ldsw + _i * 8192), 16, 0, 0); } while (0)
#define PG8_LDA(dst, b, h) do { _Pragma("unroll") for (int m = 0; m < 4; ++m) _Pragma("unroll") for (int k = 0; k < 2; ++k) dst[m][k] = *(const LAS bf16x8*)(lds + PG8_SA(b, h) + aoff + m * 2048 + k * 1024); } while (0)
#define PG8_LDB(dst, b, h) do { _Pragma("unroll") for (int n = 0; n < 2; ++n) _Pragma("unroll") for (int k = 0; k < 2; ++k) dst[n][k] = *(const LAS bf16x8*)(lds + PG8_SB(b, h) + boff + n * 2048 + k * 1024); } while (0)
#define PG8_MMA(ai, bj, At, Bt) do { __builtin_amdgcn_s_setprio(1); _Pragma("unroll") for (int m = 0; m < 4; ++m) _Pragma("unroll") for (int n = 0; n < 2; ++n) _Pragma("unroll") for (int k = 0; k < 2; ++k) \
        acc[ai][bj][m][n] = __builtin_amdgcn_mfma_f32_16x16x32_bf16(Bt[n][k], At[m][k], acc[ai][bj][m][n], 0, 0, 0); __builtin_amdgcn_s_setprio(0); } while (0)
#define PG8_WAIT_V(n) asm volatile("s_waitcnt vmcnt(" #n ")" ::: "memory")
#define PG8_WAIT_L(n) asm volatile("s_waitcnt lgkmcnt(" #n ")" ::: "memory")
#define PG8_BAR __builtin_amdgcn_s_barrier()
#define PG8_SCHED __builtin_amdgcn_sched_barrier(0)
    Unit cur, nxt; int ui = 0;
    if (!S.next(0, cur)) return;
    f32x4 acc[2][2][4][2];
#pragma unroll
    for (int a = 0; a < 2; ++a)
#pragma unroll
        for (int b = 0; b < 2; ++b)
#pragma unroll
            for (int m = 0; m < 4; ++m)
#pragma unroll
                for (int n = 0; n < 2; ++n) acc[a][b][m][n] = (f32x4){0.f, 0.f, 0.f, 0.f};
    bf16x8 At[4][2], B0[2][2], B1[2][2];
    const char* cA = cur.A; const char* cB = cur.B;
    PG8_STAGE(PG8_SB(0, 0), cB, voffB); PG8_STAGE(PG8_SB(0, 1), cB + hstepB, voffB); PG8_STAGE(PG8_SA(0, 0), cA, voffA); PG8_STAGE(PG8_SA(0, 1), cA + hstepA, voffA);
    if (wr == 1) PG8_BAR;
    PG8_WAIT_V(2); PG8_BAR;
    PG8_STAGE(PG8_SB(1, 0), cB + kstep, voffB); PG8_STAGE(PG8_SA(1, 0), cA + kstep, voffA); PG8_STAGE(PG8_SB(1, 1), cB + hstepB + kstep, voffB);
    PG8_WAIT_V(6); PG8_BAR;
    for (;;) {
        const bool has_next = S.next(ui + 1, nxt);
        const char* nA = has_next ? nxt.A : cA; const char* nB = has_next ? nxt.B : cB;
        for (int t = 0; t < nt; t += 2) {
            const bool last = (t == nt - 2);
            const char* a1 = cA + (size_t)(t + 1) * kstep;
            const char* a2 = last ? nA : cA + (size_t)(t + 2) * kstep; const char* b2 = last ? nB : cB + (size_t)(t + 2) * kstep;
            const char* a3 = a2 + kstep; const char* b3 = b2 + kstep;
            PG8_LDB(B0, 0, 0); PG8_LDB(B1, 0, 1); PG8_SCHED; PG8_LDA(At, 0, 0); PG8_STAGE(PG8_SA(1, 1), a1 + hstepA, voffA);
            PG8_WAIT_V(8); PG8_WAIT_L(0); PG8_BAR; PG8_MMA(0, 0, At, B0); PG8_MMA(0, 1, At, B1); PG8_BAR; PG8_SCHED;
            PG8_LDA(At, 0, 1); PG8_STAGE(PG8_SB(0, 0), b2, voffB); PG8_STAGE(PG8_SB(0, 1), b2 + hstepB, voffB); PG8_STAGE(PG8_SA(0, 0), a2, voffA);
            PG8_WAIT_V(8); PG8_WAIT_L(0); PG8_BAR; if constexpr (!HM) { PG8_MMA(1, 0, At, B0); PG8_MMA(1, 1, At, B1); } PG8_BAR; PG8_SCHED;
            PG8_LDB(B0, 1, 0); PG8_LDB(B1, 1, 1); PG8_SCHED; PG8_LDA(At, 1, 0); PG8_STAGE(PG8_SA(0, 1), a2 + hstepA, voffA);
            PG8_WAIT_V(8); PG8_WAIT_L(0); PG8_BAR; PG8_MMA(0, 0, At, B0); PG8_MMA(0, 1, At, B1); PG8_BAR; PG8_SCHED;
            PG8_LDA(At, 1, 1); PG8_STAGE(PG8_SB(1, 0), b3, voffB); PG8_STAGE(PG8_SB(1, 1), b3 + hstepB, voffB); PG8_STAGE(PG8_SA(1, 0), a3, voffA);
            PG8_WAIT_V(8); PG8_WAIT_L(0); PG8_BAR; if constexpr (!HM) { PG8_MMA(1, 0, At, B0); PG8_MMA(1, 1, At, B1); } PG8_BAR; PG8_SCHED;
        }
        if (wr == 0) PG8_BAR;
        E(acc, cur, wr, wc, fr, fq);
        if (!has_next) break;
#pragma unroll
        for (int a = 0; a < (HM ? 1 : 2); ++a)
#pragma unroll
            for (int b = 0; b < 2; ++b)
#pragma unroll
                for (int m = 0; m < 4; ++m)
#pragma unroll
                    for (int n = 0; n < 2; ++n) acc[a][b][m][n] = (f32x4){0.f, 0.f, 0.f, 0.f};
        cur = nxt; cA = nA; cB = nB; ++ui;
        if (wr == 1) PG8_BAR;
    }
    PG8_WAIT_V(0);
    PG8_BAR;
#undef PG8_SA
#undef PG8_SB
#undef PG8_STAGE
#undef PG8_LDA
#undef PG8_LDB
#undef PG8_MMA
#undef PG8_WAIT_V
#undef PG8_WAIT_L
#undef PG8_BAR
#undef PG8_SCHED
}

struct SchedGrid {
    int nMa, nNa, nMb, nNb, total, G, c; const char* A; const char* B; int lda, ldb, a_div, a_cols; const LAS int* pe; size_t estride; int rep;
    DI bool next(int i, Unit& u) const {
        const long L = (long)(i >> rep) * G + c; if (L >= total) return false;
        u.dup = i & rep;
        const int La = nMa * nNa; int pm, pn;
        if (L < La) {
            int wgid = (int)L;
            if ((G & 7) == 0) { const int q = La >> 3, r = La & 7, xcd = wgid & 7, off = wgid >> 3; wgid = (xcd < r ? xcd * (q + 1) : r * (q + 1) + (xcd - r) * q) + off; }
            const int nig = 8 * nNa, gid = wgid / nig, fm = gid * 8, gsz = (nMa - fm) < 8 ? (nMa - fm) : 8, w = wgid - gid * nig;
            pm = fm + w % gsz; pn = w / gsz;
        } else { const int r = (int)L - La; pm = nMa + r / nNb; pn = r % nNb; }
        size_t eoff = 0;
        if (pe) { int e = 0;
#pragma unroll
            for (int j = 0; j < 7; ++j) e += (pe[j] <= pm * 256) ? 1 : 0;
            eoff = (size_t)__builtin_amdgcn_readfirstlane(e) * estride; }
        u.pm = pm; u.pn = pn; u.A = A + ((size_t)pm * 256 * lda + (size_t)(pn / a_div) * a_cols) * 2; u.B = B + eoff + (size_t)pn * 256 * ldb * 2; return true;
    }
};
struct SchedBranch {
    int T, G, c; const char* A; const char* B; int rep;
    DI bool next(int n, Unit& u) const {
        const int tile = c + (n >> (2 + rep)) * G; if (tile >= T) return false;
        const int i = n & 3, pm = tile >> 2, pc = tile & 3;
        u.dup = 0; u.pm = pm; u.pn = i * 4 + pc; u.A = A + ((size_t)pm * 128 * OCW + (size_t)i * 512) * 2; u.B = B + (size_t)(i * 1024 + pc * 256) * 512 * 2; return true;
    }
};
struct EpiInGate {
    bf16_t* PRJ; bf16_t* GT; const float* bg;
    DI void operator()(f32x4 (&acc)[2][2][4][2], const Unit& u, int wr, int wc, int fr, int fq) const {
        const int row0 = u.pm * BM + wr * 64 + fr; const bool sg = u.pn >= 18;
        bf16_t* base = sg ? GT : PRJ; const int ldc = sg ? GTW : PRJW; const int col0 = (sg ? (u.pn - 18) : u.pn) * BM + wc * 32 + 8 * fq;
        f32x4 bv[2][2];
#pragma unroll
        for (int bj = 0; bj < 2; ++bj)
#pragma unroll
            for (int n = 0; n < 2; ++n) bv[bj][n] = sg ? *(const f32x4*)(bg + col0 + bj * HALF + 4 * n) : (f32x4){0.f, 0.f, 0.f, 0.f};
#pragma unroll
        for (int ai = 0; ai < 2; ++ai)
#pragma unroll
            for (int m = 0; m < 4; ++m) { bf16_t* rowp = base + (size_t)(row0 + ai * HALF + m * 16) * ldc + col0;
#pragma unroll
                for (int bj = 0; bj < 2; ++bj) { f32x4 v0 = acc[ai][bj][m][0] + bv[bj][0], v1 = acc[ai][bj][m][1] + bv[bj][1];
                    if (sg) { v0 = (f32x4){sigm(v0[0]), sigm(v0[1]), sigm(v0[2]), sigm(v0[3])}; v1 = (f32x4){sigm(v1[0]), sigm(v1[1]), sigm(v1[2]), sigm(v1[3])}; }
                    u32x4 w; w.x = pk2(v0[0], v0[1]); w.y = pk2(v0[2], v0[3]); w.z = pk2(v1[0], v1[1]); w.w = pk2(v1[2], v1[3]);
                    *(u32x4*)(rowp + bj * HALF) = w; } }
    }
};
struct EpiBranch {
    const bf16_t* GT; const float* SSQ; bf16_t* MRG;
    DI void operator()(f32x4 (&acc)[2][2][4][2], const Unit& u, int wr, int wc, int fr, int fq) const {
        const int i = u.pn >> 2, pc = u.pn & 3;
        const int row0 = u.pm * HALF + wr * 64 + fr; const int gcol0 = u.pn * BM + wc * 32 + 8 * fq, col0 = pc * BM + wc * 32 + 8 * fq;
#pragma unroll
        for (int mp = 0; mp < 4; ++mp) {
            u32x4 g[1][2]; float rs[1];
#pragma unroll
            for (int mm = 0; mm < 1; ++mm) { const int row = row0 + (mp + mm) * 16; const bf16_t* gp = GT + (size_t)row * GTW + gcol0;
                g[mm][0] = *(const u32x4*)gp; g[mm][1] = *(const u32x4*)(gp + HALF); rs[mm] = 1.f;
                if (i == 3) { const f32x4 s0 = *(const f32x4*)(SSQ + (size_t)row * 8), s1 = *(const f32x4*)(SSQ + (size_t)row * 8 + 4);
                    rs[mm] = __builtin_amdgcn_rsqf(((s0[0] + s0[1]) + (s0[2] + s0[3]) + (s1[0] + s1[1]) + (s1[2] + s1[3])) * (1.f / 512.f) + RMS_EPS); } }
#pragma unroll
            for (int mm = 0; mm < 1; ++mm) { const int m = mp + mm;
#pragma unroll
                for (int bj = 0; bj < 2; ++bj) { const u32x4 gg = g[mm][bj]; const f32x4 a0 = acc[0][bj][m][0] * rs[mm], a1 = acc[0][bj][m][1] * rs[mm];
                    acc[1][bj][m][0] += (f32x4){bflo(gg.x) * a0[0], bfhi(gg.x) * a0[1], bflo(gg.y) * a0[2], bfhi(gg.y) * a0[3]};
                    acc[1][bj][m][1] += (f32x4){bflo(gg.z) * a1[0], bfhi(gg.z) * a1[1], bflo(gg.w) * a1[2], bfhi(gg.w) * a1[3]}; } }
        }
        if (i == 3) {
#pragma unroll
            for (int m = 0; m < 4; ++m)
#pragma unroll
                for (int bj = 0; bj < 2; ++bj) { const f32x4 t0 = acc[1][bj][m][0], t1 = acc[1][bj][m][1];
                    u32x4 w; w.x = pk2(t0[0], t0[1]); w.y = pk2(t0[2], t0[3]); w.z = pk2(t1[0], t1[1]); w.w = pk2(t1[2], t1[3]);
                    *(u32x4*)(MRG + (size_t)(row0 + m * 16) * DM + col0 + bj * HALF) = w;
                    acc[1][bj][m][0] = (f32x4){0.f, 0.f, 0.f, 0.f}; acc[1][bj][m][1] = (f32x4){0.f, 0.f, 0.f, 0.f}; }
        }
    }
};
struct EpiResid {
    bf16_t* XS; const float* mv; bf16_t* plainO; bf16_t* dummy;
    DI void operator()(f32x4 (&acc)[2][2][4][2], const Unit& u, int wr, int wc, int fr, int fq) const {
        const int row0 = u.pm * BM + wr * 64 + fr; const int col0 = u.pn * BM + wc * 32 + 8 * fq;
        if (plainO || u.dup) { bf16_t* const po = plainO ? plainO : dummy;
#pragma unroll
            for (int ai = 0; ai < 2; ++ai)
#pragma unroll
                for (int m = 0; m < 4; ++m) { bf16_t* rowp = po + (size_t)(row0 + ai * HALF + m * 16) * DM + col0;
#pragma unroll
                    for (int bj = 0; bj < 2; ++bj) { const f32x4 v0 = acc[ai][bj][m][0], v1 = acc[ai][bj][m][1];
                        u32x4 w; w.x = pk2(v0[0], v0[1]); w.y = pk2(v0[2], v0[3]); w.z = pk2(v1[0], v1[1]); w.w = pk2(v1[2], v1[3]);
                        *(u32x4*)(rowp + bj * HALF) = w; } }
            return;
        }
        const int v = u.pm < 128 ? (u.pm >> 5) : 4;
        const float* g = mv + (size_t)v * 6144 + col0;
        f32x4 gv[2][2];
#pragma unroll
        for (int bj = 0; bj < 2; ++bj)
#pragma unroll
            for (int n = 0; n < 2; ++n) gv[bj][n] = *(const f32x4*)(g + bj * HALF + 4 * n);
#pragma unroll
        for (int ai = 0; ai < 2; ++ai)
#pragma unroll
            for (int mp = 0; mp < 2; ++mp) {
                u32x4 x[2][2];
#pragma unroll
                for (int mm = 0; mm < 2; ++mm) { const bf16_t* rowp = XS + (size_t)(row0 + ai * HALF + (2 * mp + mm) * 16) * DM + col0;
#pragma unroll
                    for (int bj = 0; bj < 2; ++bj) x[mm][bj] = *(const u32x4*)(rowp + bj * HALF); }
#pragma unroll
                for (int mm = 0; mm < 2; ++mm) { const int m = 2 * mp + mm; bf16_t* rowp = XS + (size_t)(row0 + ai * HALF + m * 16) * DM + col0;
#pragma unroll
                    for (int bj = 0; bj < 2; ++bj) { const u32x4 xx = x[mm][bj];
                        const f32x4 y0 = (f32x4){bflo(xx.x), bfhi(xx.x), bflo(xx.y), bfhi(xx.y)} * ALPHA + gv[bj][0] * acc[ai][bj][m][0];
                        const f32x4 y1 = (f32x4){bflo(xx.z), bfhi(xx.z), bflo(xx.w), bfhi(xx.w)} * ALPHA + gv[bj][1] * acc[ai][bj][m][1];
                        u32x4 w; w.x = pk2(y0[0], y0[1]); w.y = pk2(y0[2], y0[3]); w.z = pk2(y1[0], y1[1]); w.w = pk2(y1[2], y1[3]); *(u32x4*)(rowp + bj * HALF) = w; } }
            }
    }
};
struct EpiSwiGLU {
    bf16_t* HID; int ldc;
    DI void operator()(f32x4 (&acc)[2][2][4][2], const Unit& u, int wr, int wc, int fr, int fq) const {
        const int row0 = u.pm * BM + wr * 64 + fr; const int col0 = u.pn * HALF + wc * 32 + 8 * fq;
#pragma unroll
        for (int ai = 0; ai < 2; ++ai)
#pragma unroll
            for (int m = 0; m < 4; ++m) { bf16_t* rowp = HID + (size_t)(row0 + ai * HALF + m * 16) * ldc + col0;
                const f32x4 g0 = acc[ai][0][m][0], g1 = acc[ai][0][m][1], u0 = acc[ai][1][m][0], u1 = acc[ai][1][m][1];
                u32x4 w; w.x = pk2(silu(g0[0]) * u0[0], silu(g0[1]) * u0[1]); w.y = pk2(silu(g0[2]) * u0[2], silu(g0[3]) * u0[3]);
                w.z = pk2(silu(g1[0]) * u1[0], silu(g1[1]) * u1[1]); w.w = pk2(silu(g1[2]) * u1[2], silu(g1[3]) * u1[3]);
                *(u32x4*)rowp = w; }
    }
};
}

struct Args { const float* in[31]; float* out; unsigned char* ws; int ph_lo, ph_hi; };
enum { I_X = 0, I_C, I_CTX, I_CCTX, I_WMOD, I_BMOD, I_WIN, I_WGATE, I_BGATE, I_RPB, I_SINK, I_QGQ, I_QGK, I_CONVW, I_CONVB, I_DTB, I_ALOG, I_DSKIP, I_NORMG,
       I_WBR, I_WOUT, I_LN1G, I_LN1B, I_LN2G, I_LN2B, I_FUP, I_FDN, I_MRW, I_MRB, I_MUP, I_MDN };
struct Frame {
    LAS unsigned char* lds; gu32* ctl; int tid, lane, wave, vcu, G, bx;
    const float* const* in; float* out; unsigned char* ws;
};
#define WSP(T, off) ((T*)(F.ws + (off)))
DI Frame launder(const Frame& F0) {
    Frame F = F0;
    asm volatile("" : "+s"(F.wave), "+s"(F.vcu), "+s"(F.ws), "+s"(F.lds));
    F.lane = (int)__builtin_amdgcn_mbcnt_hi(~0u, __builtin_amdgcn_mbcnt_lo(~0u, 0u)); F.tid = F.wave * 64 + F.lane;
    asm volatile("" : "+v"(F.tid), "+v"(F.lane));
    F.ws = (unsigned char*)(GAS unsigned char*)F.ws;
    return F;
}

DI void transpose_item(const float* W, int ld, bf16_t* dst, int ldk, int koff, int map_h, int rowoff, int cscale, const float* kscale, LAS float* scr, int kb, int nb, int lane) {
    const int k0 = 64 * kb, n0 = 32 * nb;
    float tmp[32];
#pragma unroll
    for (int i = 0; i < 32; ++i) tmp[i] = W[(size_t)(k0 + 2 * i + (lane >> 5)) * ld + n0 + (lane & 31)];
#pragma unroll
    for (int i = 0; i < 32; ++i) scr[(2 * i + (lane >> 5)) * 33 + (lane & 31)] = tmp[i];
    asm volatile("s_waitcnt lgkmcnt(0)" ::: "memory");
    const int c = lane & 7;
    float ks[8];
#pragma unroll
    for (int e = 0; e < 8; ++e) ks[e] = kscale ? kscale[k0 + 8 * c + e] : 1.f;
#pragma unroll
    for (int j = 0; j < 4; ++j) { const int nl = (lane >> 3) + 8 * j, n = n0 + nl; const LAS float* s = scr + (8 * c) * 33 + nl;
        float cs = 1.f; if (cscale && (n < 512 || (n >= 1536 && n < 2048))) cs = C2;
        int drow;
        if (map_h == 0) drow = rowoff + n;
        else if (n < map_h) drow = rowoff + 256 * (n >> 7) + (n & 127);
        else { const int n2 = n - map_h; drow = rowoff + 256 * (n2 >> 7) + 128 + (n2 & 127); }
        u32x4 o; o.x = pk2(s[0 * 33] * ks[0] * cs, s[1 * 33] * ks[1] * cs); o.y = pk2(s[2 * 33] * ks[2] * cs, s[3 * 33] * ks[3] * cs);
        o.z = pk2(s[4 * 33] * ks[4] * cs, s[5 * 33] * ks[5] * cs); o.w = pk2(s[6 * 33] * ks[6] * cs, s[7 * 33] * ks[7] * cs);
        *(u32x4*)(dst + (size_t)drow * ldk + koff + k0 + 8 * c) = o; }
    asm volatile("s_waitcnt lgkmcnt(0)" ::: "memory");
}
struct CvtJob { const float* W; int K, N, ld; bf16_t* dst; int ldk, koff, map_h, rowoff, cscale; const float* kscale; };
DI void get_job(const Frame& F, int j, CvtJob& J) {
    J.koff = 0; J.map_h = 0; J.rowoff = 0; J.cscale = 0; J.kscale = nullptr;
    if (j < 52) {
        const int l = j / 13, r = j % 13;
        if (r == 0) { J.W = F.in[I_WIN] + (size_t)l * DM * DIN; J.K = DM; J.N = PRJW; J.ld = DIN; J.dst = WSP(bf16_t, WS_WCOMB + l * SZ_WCOMB); J.ldk = DM; J.cscale = 1; }
        else if (r < 5) { const int i = r - 1; J.W = F.in[I_WGATE] + ((size_t)l * 4 + i) * DM * DM; J.K = DM; J.N = DM; J.ld = DM; J.dst = WSP(bf16_t, WS_WCOMB + l * SZ_WCOMB); J.ldk = DM; J.rowoff = PRJW + 1024 * i; }
        else if (r < 9) { const int i = r - 5; J.W = F.in[I_WBR] + ((size_t)l * 4 + i) * 512 * DM; J.K = 512; J.N = DM; J.ld = DM; J.dst = WSP(bf16_t, WS_WB + l * SZ_WB); J.ldk = 512; J.rowoff = 1024 * i;
            if (i == 3) J.kscale = F.in[I_NORMG] + l * 512; }
        else { J.W = F.in[I_WOUT] + (size_t)l * DM * DM; J.K = (r == 9) ? DM : 0; J.N = DM; J.ld = DM; J.dst = WSP(bf16_t, WS_WO + l * SZ_WO); J.ldk = DM; }
    } else if (j < 56) {
        const int i = (j - 52) >> 1;
        if (((j - 52) & 1) == 0) { J.W = F.in[I_FUP] + (size_t)i * DM * 2 * DFF; J.K = DM; J.N = 2 * DFF; J.ld = 2 * DFF; J.dst = WSP(bf16_t, WS_WUP + i * SZ_WUP); J.ldk = DM; J.map_h = DFF; }
        else { J.W = F.in[I_FDN] + (size_t)i * DFF * DM; J.K = DFF; J.N = DM; J.ld = DM; J.dst = WSP(bf16_t, WS_WDN + i * SZ_WDN); J.ldk = DFF; }
    } else {
        const int q = j - 56, ie = q >> 1, i = ie >> 3, e = ie & 7;
        if ((q & 1) == 0) { J.W = F.in[I_MUP] + ((size_t)i * NEXP + e) * DM * 2 * DFFE; J.K = DM; J.N = 2 * DFFE; J.ld = 2 * DFFE; J.dst = WSP(bf16_t, WS_MUP + i * SZ_MUP); J.ldk = DM; J.map_h = DFFE; J.rowoff = e * 2 * DFFE; }
        else { J.W = F.in[I_MDN] + ((size_t)i * NEXP + e) * DFFE * DM; J.K = DFFE; J.N = DM; J.ld = DM; J.dst = WSP(bf16_t, WS_MDN + i * SZ_MDN); J.ldk = DFFE; J.rowoff = e * DM; }
    }
}
constexpr int NJOBS = 52 + 4 + 32;

DI void phase_prologue_a(const Frame& F) {
    const int NGW = F.G * NWAVES, gw = F.vcu * NWAVES + F.wave;
    {
        LAS float* sv = (LAS float*)(F.lds + 73728);
        LAS float* red = (LAS float*)(F.lds + 73728 + 20480);
        for (int i = F.tid; i < 5 * 1024; i += NTHR) { const int v = i >> 10, k = i & 1023; const float c = v < 4 ? F.in[I_C][v * DM + k] : F.in[I_CCTX][k]; sv[i] = silu(c); }
        __syncthreads();
        float* MV = WSP(float, WS_MVEC);
        for (int item = F.vcu; item < 4 * 96; item += F.G) {
            const int l = item / 96, n0 = (item % 96) * 64, c = F.tid & 63, ks = F.tid >> 6;
            const float* w = F.in[I_WMOD] + (size_t)l * DM * 6144 + n0 + c;
            float a0 = 0.f, a1 = 0.f, a2 = 0.f, a3 = 0.f, a4 = 0.f;
#pragma unroll 8
            for (int k = ks * 128; k < ks * 128 + 128; ++k) { const float wv = w[(size_t)k * 6144]; a0 += sv[k] * wv; a1 += sv[1024 + k] * wv; a2 += sv[2048 + k] * wv; a3 += sv[3072 + k] * wv; a4 += sv[4096 + k] * wv; }
            red[(ks * 5 + 0) * 64 + c] = a0; red[(ks * 5 + 1) * 64 + c] = a1; red[(ks * 5 + 2) * 64 + c] = a2; red[(ks * 5 + 3) * 64 + c] = a3; red[(ks * 5 + 4) * 64 + c] = a4;
            __syncthreads();
            if (F.tid < 320) { const int v = F.tid >> 6, cc = F.tid & 63; float s = F.in[I_BMOD][l * 6144 + n0 + cc];
#pragma unroll
                for (int q = 0; q < 8; ++q) s += red[(q * 5 + v) * 64 + cc];
                MV[((size_t)l * 5 + v) * 6144 + n0 + cc] = s; }
            __syncthreads();
        }
    }
    {
        float* rc = WSP(float, WS_ROPE); float* rs = rc + SEQ * 32;
        for (int i = F.vcu * NTHR + F.tid; i < SEQ * 32; i += F.G * NTHR) {
            const int t = i >> 5, p = i & 31; const float pos = (p < 16) ? (float)(t >> 6) : (float)(t & 63);
            const float invf = exp2f(-(float)(p & 15) * (13.287712379549449f / 16.f));
            const float ang = pos * invf; const float rev = ang * 0.15915494309189535f; const float fr = rev - rintf(rev);
            rc[i] = __builtin_amdgcn_cosf(fr); rs[i] = __builtin_amdgcn_sinf(fr);
        }
    }
    {
        LAS float* scr = (LAS float*)(F.lds + F.wave * 8448);
        int base = 0;
        for (int j = 0; j < NJOBS; ++j) {
            CvtJob J; get_job(F, j, J);
            const int nblk = J.N / 32, nit = (J.K / 64) * nblk;
            int vid = (gw - base) % NGW; if (vid < 0) vid += NGW;
            for (int it = vid; it < nit; it += NGW) transpose_item(J.W, J.ld, J.dst, J.ldk, J.koff, J.map_h, J.rowoff, J.cscale, J.kscale, scr, it / nblk, it % nblk, F.lane);
            base = (base + nit) % NGW;
        }
    }
}

DI void load_wdt(const Frame& F, int l) {
    LAS float* wd = (LAS float*)F.lds; const float* w = F.in[I_WIN] + (size_t)l * DM * DIN + PRJW;
    for (int i = F.tid; i < DM * 16; i += NTHR) { const int k = i >> 4; wd[(((k & 3) << 8) + (k >> 2)) * 20 + (i & 15)] = w[(size_t)k * DIN + (i & 15)]; }
}
DI void emit_h_dt(const Frame& F, const f32x4 (&xn)[4], const float* mv, int m, const float* dtb) {
    bf16_t* hb = WSP(bf16_t, WS_HB) + (size_t)m * DM; float* DT = WSP(float, WS_DT);
    const LAS float* wd = (const LAS float*)F.lds;
    float acc[16];
#pragma unroll
    for (int c = 0; c < 16; ++c) acc[c] = 0.f;
#pragma unroll
    for (int j = 0; j < 4; ++j) {
        const int k = 4 * F.lane + 256 * j;
        const f32x4 sh = *(const f32x4*)(mv + k), sc = *(const f32x4*)(mv + 1024 + k);
        const f32x4 h = xn[j] * (sc + 1.f) + sh;
        u32x2 w; w.x = pk2(h[0], h[1]); w.y = pk2(h[2], h[3]); *(u32x2*)(hb + k) = w;
#pragma unroll
        for (int e = 0; e < 4; ++e) {
            const LAS f32x4* wr = (const LAS f32x4*)(wd + ((e << 8) + (k >> 2)) * 20);
#pragma unroll
            for (int q = 0; q < 4; ++q) { const f32x4 wv = wr[q]; acc[4 * q] += h[e] * wv[0]; acc[4 * q + 1] += h[e] * wv[1]; acc[4 * q + 2] += h[e] * wv[2]; acc[4 * q + 3] += h[e] * wv[3]; }
            asm volatile("" ::: "memory");
        }
    }
    const bool b0 = F.lane & 1, b1 = F.lane & 2, b2 = F.lane & 4, b3 = F.lane & 8;
    float t8[8], t4[4], t2[2], t1;
#pragma unroll
    for (int i = 0; i < 8; ++i) { const float keep = b0 ? acc[2 * i + 1] : acc[2 * i], give = b0 ? acc[2 * i] : acc[2 * i + 1]; t8[i] = keep + __shfl_xor(give, 1); }
#pragma unroll
    for (int i = 0; i < 4; ++i) { const float keep = b1 ? t8[2 * i + 1] : t8[2 * i], give = b1 ? t8[2 * i] : t8[2 * i + 1]; t4[i] = keep + __shfl_xor(give, 2); }
#pragma unroll
    for (int i = 0; i < 2; ++i) { const float keep = b2 ? t4[2 * i + 1] : t4[2 * i], give = b2 ? t4[2 * i] : t4[2 * i + 1]; t2[i] = keep + __shfl_xor(give, 4); }
    { const float keep = b3 ? t2[1] : t2[0], give = b3 ? t2[0] : t2[1]; t1 = keep + __shfl_xor(give, 8); }
    t1 += __shfl_xor(t1, 16); t1 += __shfl_xor(t1, 32);
    if (F.lane < 16) { const float x = t1 + dtb[F.lane]; const float t = __expf(x); const float sp = t < 0.01f ? t * (1.f + t * (-0.5f + t * (1.f / 3.f))) : __logf(1.f + t); DT[(size_t)m * 16 + F.lane] = x > 15.f ? x : sp; }
}
DI void ln_rows(f32x4 (&v)[4], const float* g, const float* b, int lane) {
    float s = 0.f;
#pragma unroll
    for (int j = 0; j < 4; ++j) s += (v[j][0] + v[j][1]) + (v[j][2] + v[j][3]);
    const float mean = wave_sum(s) * (1.f / DM); float s2 = 0.f;
#pragma unroll
    for (int j = 0; j < 4; ++j) { v[j] = v[j] - mean; s2 += (v[j][0] * v[j][0] + v[j][1] * v[j][1]) + (v[j][2] * v[j][2] + v[j][3] * v[j][3]); }
    const float rstd = 1.f / sqrtf(wave_sum(s2) * (1.f / DM) + LN_EPS);
#pragma unroll
    for (int j = 0; j < 4; ++j) { const int k = 4 * lane + 256 * j; v[j] = v[j] * rstd * *(const f32x4*)(g + k) + *(const f32x4*)(b + k); }
}
DI void phase_prologue_b(const Frame& F) {
    load_wdt(F, 0); __syncthreads();
    const int NGW = F.G * NWAVES, gw = F.vcu * NWAVES + F.wave;
    bf16_t* XS = WSP(bf16_t, WS_XS); const float* MV = WSP(float, WS_MVEC);
    const float* dtb = F.in[I_DTB];
    for (int m = gw; m < MTOT; m += NGW) {
        const float* src = m < NLAT ? F.in[I_X] + (size_t)m * DM : F.in[I_CTX] + (size_t)(m - NLAT) * DM; const int v = m < NLAT ? (m >> 13) : 4;
        f32x4 x[4];
#pragma unroll
        for (int j = 0; j < 4; ++j) { x[j] = *(const f32x4*)(src + 4 * F.lane + 256 * j); st4bf(XS + (size_t)m * DM + 4 * F.lane + 256 * j, x[j]); }
        emit_h_dt(F, x, MV + (size_t)v * 6144, m, dtb);
    }
}
DI void phase_ln1(const Frame& F, int l, int mrows) {
    const bool moe = l & 1; const int mi = l >> 1;
    LAS float* wrt = (LAS float*)F.lds;
    if (moe) { const float* w = F.in[I_MRW] + (size_t)mi * DM * 8; for (int i = F.tid; i < DM * 8; i += NTHR) { const int k = i >> 3; wrt[(((k & 3) << 8) + (k >> 2)) * 12 + (i & 7)] = w[i]; } __syncthreads(); }
    const int NGW = F.G * NWAVES, gw = F.vcu * NWAVES + F.wave;
    bf16_t* XS = WSP(bf16_t, WS_XS); const float* MV = WSP(float, WS_MVEC) + (size_t)l * 5 * 6144; bf16_t* HB = WSP(bf16_t, WS_HB);
    const float* g = F.in[I_LN1G] + l * DM; const float* b = F.in[I_LN1B] + l * DM;
    unsigned* SL = WSP(unsigned, WS_SLOT); unsigned* gcnt = (unsigned*)F.ctl + CW_MOECNT + mi * 1024;
    int cnt = 0, nst = 0; int me0 = 0, me1 = 0, mr0 = 0, mr1 = 0, mm = 0; float mg0 = 0.f, mg1 = 0.f;
    f32x4 xnx[4];
    if (gw < mrows) {
#pragma unroll
        for (int j = 0; j < 4; ++j) xnx[j] = ld4bf(XS + (size_t)gw * DM + 4 * F.lane + 256 * j);
    }
    for (int m = gw; m < mrows; m += NGW) {
        const int v = m < NLAT ? (m >> 13) : 4;
        f32x4 x[4];
#pragma unroll
        for (int j = 0; j < 4; ++j) x[j] = xnx[j];
        if (m + NGW < mrows) {
#pragma unroll
            for (int j = 0; j < 4; ++j) xnx[j] = ld4bf(XS + (size_t)(m + NGW) * DM + 4 * F.lane + 256 * j);
        }
        ln_rows(x, g, b, F.lane);
        float acc[8];
#pragma unroll
        for (int c = 0; c < 8; ++c) acc[c] = 0.f;
        const float* mv = MV + (size_t)v * 6144;
#pragma unroll
        for (int j = 0; j < 4; ++j) {
            const int k = 4 * F.lane + 256 * j;
            st4bf(XS + (size_t)m * DM + k, x[j]);
            const f32x4 sh = *(const f32x4*)(mv + 3072 + k), sc = *(const f32x4*)(mv + 4096 + k);
            const f32x4 h = x[j] * (sc + 1.f) + sh;
            u32x2 w; w.x = pk2(h[0], h[1]); w.y = pk2(h[2], h[3]); *(u32x2*)(HB + (size_t)m * DM + k) = w;
            if (moe) {
#pragma unroll
                for (int e = 0; e < 4; ++e) { const LAS f32x4* wr = (const LAS f32x4*)(wrt + ((e << 8) + (k >> 2)) * 12);
#pragma unroll
                    for (int q = 0; q < 2; ++q) { const f32x4 wv = wr[q]; acc[4 * q] += h[e] * wv[0]; acc[4 * q + 1] += h[e] * wv[1]; acc[4 * q + 2] += h[e] * wv[2]; acc[4 * q + 3] += h[e] * wv[3]; } }
            }
        }
        if (moe) {
            const bool b0 = F.lane & 1, b1 = F.lane & 2, b2 = F.lane & 4;
            float t4[4], t2[2], t1;
#pragma unroll
            for (int i = 0; i < 4; ++i) { const float keep = b0 ? acc[2 * i + 1] : acc[2 * i], give = b0 ? acc[2 * i] : acc[2 * i + 1]; t4[i] = keep + __shfl_xor(give, 1); }
#pragma unroll
            for (int i = 0; i < 2; ++i) { const float keep = b1 ? t4[2 * i + 1] : t4[2 * i], give = b1 ? t4[2 * i] : t4[2 * i + 1]; t2[i] = keep + __shfl_xor(give, 2); }
            { const float keep = b2 ? t2[1] : t2[0], give = b2 ? t2[0] : t2[1]; t1 = keep + __shfl_xor(give, 4); }
            t1 += __shfl_xor(t1, 8); t1 += __shfl_xor(t1, 16); t1 += __shfl_xor(t1, 32);
            t1 += F.in[I_MRB][mi * 8 + (F.lane & 7)];
            float lg[8];
#pragma unroll
            for (int e = 0; e < 8; ++e) lg[e] = __shfl(t1, e);
            int e0 = 0; float l0 = lg[0];
#pragma unroll
            for (int e = 1; e < 8; ++e) if (lg[e] > l0) { l0 = lg[e]; e0 = e; }
            int e1 = -1; float l1 = -3.0e38f;
#pragma unroll
            for (int e = 0; e < 8; ++e) if (e != e0 && lg[e] > l1) { l1 = lg[e]; e1 = e; }
            const float g1 = 1.f / (1.f + __expf(l0 - l1)), g0 = 1.f - g1;
            const int r0 = __shfl(cnt, e0); if (F.lane == e0) cnt++;
            const int r1 = __shfl(cnt, e1); if (F.lane == e1) cnt++;
            if (F.lane == nst) { me0 = e0; me1 = e1; mr0 = r0; mr1 = r1; mg0 = g0; mg1 = g1; mm = m; }
            ++nst;
        }
        if (moe && (nst == 64 || m + NGW >= mrows)) {
            unsigned base = 0u; if (F.lane < 8) base = __hip_atomic_fetch_add(gcnt + F.lane * 64, (unsigned)cnt, __ATOMIC_RELAXED, __HIP_MEMORY_SCOPE_AGENT);
            const unsigned p0 = __shfl(base, me0) + mr0, p1 = __shfl(base, me1) + mr1;
            if (F.lane < nst) { u32x4 a; a.x = me0; a.y = me1; a.z = p0; a.w = p1; *(u32x4*)(SL + (size_t)mm * 8) = a; u32x2 c; c.x = __float_as_uint(mg0); c.y = __float_as_uint(mg1); *(u32x2*)(SL + (size_t)mm * 8 + 4) = c; }
            cnt = 0; nst = 0;
        }
    }
}
DI void moe_pad_ends(const Frame& F, int mi, int (&pe)[8]) {
    unsigned* gcnt = (unsigned*)F.ctl + CW_MOECNT + mi * 1024; int run = 0;
#pragma unroll
    for (int e = 0; e < 8; ++e) { const int c = (int)__builtin_amdgcn_readfirstlane(__hip_atomic_load(gcnt + e * 64, __ATOMIC_RELAXED, __HIP_MEMORY_SCOPE_AGENT)); run += (c + 255) & ~255; pe[e] = run; }
}
DI int moe_pad_ends_lds(const Frame& F, int mi) {
    int pe[8]; moe_pad_ends(F, mi, pe);
    LAS int* d = (LAS int*)(F.lds + MISC_OFF + 64);
    __syncthreads();
    if (F.tid == 0) {
#pragma unroll
        for (int e = 0; e < 8; ++e) d[e] = pe[e];
    }
    __syncthreads();
    return pe[7];
}
DI void phase_gather(const Frame& F, int l, int mrows) {
    int pe[8]; moe_pad_ends(F, l >> 1, pe);
    const int NGW = F.G * NWAVES, gw = F.vcu * NWAVES + F.wave;
    unsigned* SL = WSP(unsigned, WS_SLOT); const bf16_t* HB = WSP(bf16_t, WS_HB); bf16_t* XP = WSP(bf16_t, WS_XPAD);
    for (int m = gw; m < mrows; m += NGW) {
        const u32x4 a = *(const u32x4*)(SL + (size_t)m * 8);
        int ps0 = 0, ps1 = 0;
#pragma unroll
        for (int e = 1; e < 8; ++e) { if ((int)a.x == e) ps0 = pe[e - 1]; if ((int)a.y == e) ps1 = pe[e - 1]; }
        const int d0 = ps0 + (int)a.z, d1 = ps1 + (int)a.w;
        const u32x4* src = (const u32x4*)(HB + (size_t)m * DM);
        const u32x4 v0 = src[F.lane], v1 = src[64 + F.lane];
        u32x4* q0 = (u32x4*)(XP + (size_t)d0 * DM); u32x4* q1 = (u32x4*)(XP + (size_t)d1 * DM);
        q0[F.lane] = v0; q0[64 + F.lane] = v1; q1[F.lane] = v0; q1[64 + F.lane] = v1;
        if (F.lane == 0) { u32x2 d; d.x = d0; d.y = d1; *(u32x2*)(SL + (size_t)m * 8 + 2) = d; }
    }
}
DI void phase_ln2(const Frame& F, int l, int mrows) {
    const bool moe = l & 1, lastl = (l == DEPTH - 1);
    if (!lastl) { load_wdt(F, l + 1); __syncthreads(); }
    const int NGW = F.G * NWAVES, gw = F.vcu * NWAVES + F.wave;
    bf16_t* XS = WSP(bf16_t, WS_XS); const float* MVl = WSP(float, WS_MVEC) + (size_t)l * 5 * 6144; const float* MVn = WSP(float, WS_MVEC) + (size_t)(l + 1) * 5 * 6144;
    const float* g = F.in[I_LN2G] + l * DM; const float* b = F.in[I_LN2B] + l * DM;
    const unsigned* SL = WSP(unsigned, WS_SLOT); const bf16_t* YP = WSP(bf16_t, WS_YPAD);
    const float* dtb = F.in[I_DTB] + (lastl ? 0 : (l + 1) * 16);
    f32x4 xnx[4]; u32x4 anx = (u32x4){0u, 0u, 0u, 0u}; u32x2 gnx = (u32x2){0u, 0u};
    if (gw < mrows) {
#pragma unroll
        for (int j = 0; j < 4; ++j) xnx[j] = ld4bf(XS + (size_t)gw * DM + 4 * F.lane + 256 * j);
        if (moe) { anx = *(const u32x4*)(SL + (size_t)gw * 8); gnx = *(const u32x2*)(SL + (size_t)gw * 8 + 4); }
    }
    for (int m = gw; m < mrows; m += NGW) {
        const int v = m < NLAT ? (m >> 13) : 4;
        f32x4 x[4];
#pragma unroll
        for (int j = 0; j < 4; ++j) x[j] = xnx[j];
        const u32x4 a = anx; const u32x2 gg = gnx;
        if (m + NGW < mrows) {
#pragma unroll
            for (int j = 0; j < 4; ++j) xnx[j] = ld4bf(XS + (size_t)(m + NGW) * DM + 4 * F.lane + 256 * j);
            if (moe) { anx = *(const u32x4*)(SL + (size_t)(m + NGW) * 8); gnx = *(const u32x2*)(SL + (size_t)(m + NGW) * 8 + 4); }
        }
        if (moe) {
            const float g0 = __uint_as_float(gg.x), g1 = __uint_as_float(gg.y);
            const bf16_t* y0 = YP + (size_t)a.z * DM; const bf16_t* y1 = YP + (size_t)a.w * DM;
#pragma unroll
            for (int j = 0; j < 4; ++j) { const int k = 4 * F.lane + 256 * j; const u32x2 u0 = *(const u32x2*)(y0 + k), u1 = *(const u32x2*)(y1 + k);
                const f32x4 gt = *(const f32x4*)(MVl + (size_t)v * 6144 + 5120 + k);
                f32x4 f; f[0] = g0 * bflo(u0.x) + g1 * bflo(u1.x); f[1] = g0 * bfhi(u0.x) + g1 * bfhi(u1.x); f[2] = g0 * bflo(u0.y) + g1 * bflo(u1.y); f[3] = g0 * bfhi(u0.y) + g1 * bfhi(u1.y);
                if (ABL & 16) f = (f32x4){0.f, 0.f, 0.f, 0.f};
                x[j] = x[j] * ALPHA + gt * f; }
        }
        ln_rows(x, g, b, F.lane);
        if (lastl) {
#pragma unroll
            for (int j = 0; j < 4; ++j) *(f32x4*)(F.out + (size_t)m * DM + 4 * F.lane + 256 * j) = x[j];
        } else {
#pragma unroll
            for (int j = 0; j < 4; ++j) st4bf(XS + (size_t)m * DM + 4 * F.lane + 256 * j, x[j]);
            emit_h_dt(F, x, MVn + (size_t)v * 6144, m, dtb);
        }
    }
}

DI void phase_qkprep_rows(const Frame& F, int l) {
    const int NGW = F.G * NWAVES, gw = F.vcu * NWAVES + F.wave;
    bf16_t* PRJ = WSP(bf16_t, WS_PRJ); const float* rc = WSP(float, WS_ROPE); const float* rs = rc + SEQ * 32;
    const float* gq = F.in[I_QGQ] + l * 64; const float* gk = F.in[I_QGK] + l * 64;
    const int hs = F.lane >> 4, i2 = 2 * (F.lane & 15);
    const float gq0 = gq[i2], gq1 = gq[i2 + 1], gq2 = gq[32 + i2], gq3 = gq[32 + i2 + 1], gk0 = gk[i2], gk1 = gk[i2 + 1], gk2 = gk[32 + i2], gk3 = gk[32 + i2 + 1];
    for (int m = gw; m < MTOT; m += NGW) {
        const bool lat = m < NLAT; const int t = m & (SEQ - 1);
        float c0 = 1.f, c1 = 1.f, s0 = 0.f, s1 = 0.f;
        if (lat) { const f32x2 cc = *(const f32x2*)(rc + t * 32 + i2), ss = *(const f32x2*)(rs + t * 32 + i2); c0 = cc[0]; c1 = cc[1]; s0 = ss[0]; s1 = ss[1]; }
        unsigned u1[5], u2[5];
#pragma unroll
        for (int it = 0; it < 5; ++it) {
            const int hd = it * 4 + hs;
            const int col = hd < 8 ? C_SWQ + 64 * hd : hd < 10 ? C_SWK + 64 * (hd - 8) : hd < 18 ? C_GAQ + 64 * (hd - 10) : C_GAK + 64 * (hd - 18);
            const bf16_t* p = PRJ + (size_t)m * PRJW + col + i2; u1[it] = *(const unsigned*)p; u2[it] = *(const unsigned*)(p + 32);
        }
#pragma unroll
        for (int it = 0; it < 5; ++it) {
            const int hd = it * 4 + hs;
            const int col = hd < 8 ? C_SWQ + 64 * hd : hd < 10 ? C_SWK + 64 * (hd - 8) : hd < 18 ? C_GAQ + 64 * (hd - 10) : C_GAK + 64 * (hd - 18);
            bf16_t* p = PRJ + (size_t)m * PRJW + col + i2;
            float a0 = bflo(u1[it]), a1 = bfhi(u1[it]), b0 = bflo(u2[it]), b1 = bfhi(u2[it]);
            if (hd >= 10) {
                float ss = a0 * a0 + a1 * a1 + b0 * b0 + b1 * b1;
                ss += __shfl_xor(ss, 1); ss += __shfl_xor(ss, 2); ss += __shfl_xor(ss, 4); ss += __shfl_xor(ss, 8);
                const float rn = 1.f / sqrtf(ss * (1.f / 64.f) + RMS_EPS); const bool isq = hd < 18; const float post = isq ? C2 : 1.f;
                a0 *= rn * (isq ? gq0 : gk0) * post; a1 *= rn * (isq ? gq1 : gk1) * post; b0 *= rn * (isq ? gq2 : gk2) * post; b1 *= rn * (isq ? gq3 : gk3) * post;
            }
            const float o0 = a0 * c0 - b0 * s0, o1 = a1 * c1 - b1 * s1, q0 = b0 * c0 + a0 * s0, q1 = b1 * c1 + a1 * s1;
            *(unsigned*)p = pk2(o0, o1); *(unsigned*)(p + 32) = pk2(q0, q1);
        }
    }
}

namespace ga_body {
using bf16=__hip_bfloat16;
using bf16x8=__attribute__((ext_vector_type(8)))short;
using s16x4=__attribute__((ext_vector_type(4)))short;
using f32x16=__attribute__((ext_vector_type(16)))float;
using u32x4=__attribute__((ext_vector_type(4)))unsigned;
constexpr int SEQ=8192,D=64,PQ=4608,PO=2048,NCTXT=4;
constexpr int NW=8,QBLK=32,QB=QBLK*NW,KVBLK=64,NQB=SEQ/QB;
__device__ __forceinline__ int crow(int r,int hi){return (r&3)+8*(r>>2)+4*hi;}
#define SBAR() __builtin_amdgcn_sched_barrier(0)
__device__ __forceinline__ void cmask(f32x16&p0,f32x16&p1,int jb,int qrel,int hi){
  const float NEG=-INFINITY; int kb=64*jb+4*hi;
  #pragma unroll
  for(int r=0;r<16;++r){int kv=kb+(r&3)+8*(r>>2); if(kv>qrel)p0[r]=NEG; if(kv+32>qrel)p1[r]=NEG;}
}

constexpr int NSLOT=3, SLOTB=8192;
constexpr int LDS_K=0, LDS_V=NSLOT*SLOTB, LDS_WS=2*NSLOT*SLOTB, LDS_OST=LDS_WS+NW*64*4, LDS_BYTES=LDS_OST+NW*4096;
constexpr float C2=0.125f*1.4426950408889634f;
__device__ __forceinline__ void glds16(const void*gsrc,unsigned lds_dst){unsigned keep;
  asm volatile("s_mov_b32 %0, m0\n\ts_mov_b32 m0, %2\n\ts_nop 0\n\tglobal_load_lds_dwordx4 %1, off\n\ts_mov_b32 m0, %0":"=&s"(keep):"v"(gsrc),"s"(lds_dst):"memory");}
__device__ __forceinline__ float max3f(float a,float b,float c){float r;asm("v_max3_f32 %0, %1, %2, %3":"=v"(r):"v"(a),"v"(b),"v"(c));return r;}
__device__ __forceinline__ float max2f(float a,float b){float r;asm("v_max_f32_e32 %0, %1, %2":"=v"(r):"v"(a),"v"(b));return r;}
__device__ __forceinline__ float fadd_s(float a,float b){float r;asm("v_add_f32_e32 %0, %1, %2":"=v"(r):"v"(a),"v"(b));return r;}
__device__ __forceinline__ float fsub_s(float a,float b){float r;asm("v_sub_f32_e32 %0, %1, %2":"=v"(r):"v"(a),"v"(b));return r;}
typedef float f32x2_t __attribute__((ext_vector_type(2))); typedef __bf16 bf16x2_t __attribute__((ext_vector_type(2)));
__device__ __forceinline__ unsigned cvtpk_s(float lo,float hi){f32x2_t v={lo,hi};bf16x2_t b=__builtin_convertvector(v,bf16x2_t);return __builtin_bit_cast(unsigned,b);}
#define WAIT_BAR(N) asm volatile("s_waitcnt vmcnt(" #N ") lgkmcnt(0)\n\ts_barrier":::"memory")

__device__ __forceinline__ void qkt(f32x16&p0,f32x16&p1,const char*Kslot,const bf16x8*qr,const f32x16&negm,int r32,int hi){
  const char*kb=Kslot+hi*1024+r32*16;
  #pragma unroll
  for(int d0=0;d0<4;++d0){
    const bf16x8 b0=*reinterpret_cast<const bf16x8*>(kb+d0*2048);
    const bf16x8 b1=*reinterpret_cast<const bf16x8*>(kb+d0*2048+512);
    if(d0==0){p0=__builtin_amdgcn_mfma_f32_32x32x16_bf16(b0,qr[0],negm,0,0,0);p1=__builtin_amdgcn_mfma_f32_32x32x16_bf16(b1,qr[0],negm,0,0,0);}
    else{p0=__builtin_amdgcn_mfma_f32_32x32x16_bf16(b0,qr[d0],p0,0,0,0);p1=__builtin_amdgcn_mfma_f32_32x32x16_bf16(b1,qr[d0],p1,0,0,0);}}
}
typedef __attribute__((address_space(3))) const char* lds_cptr;
typedef short v4i16_t __attribute__((ext_vector_type(4)));
__device__ __forceinline__ void kload8(bf16x8*kf,lds_cptr kp){
  kf[0]=*(const __attribute__((address_space(3))) bf16x8*)(kp);      kf[1]=*(const __attribute__((address_space(3))) bf16x8*)(kp+512);
  kf[2]=*(const __attribute__((address_space(3))) bf16x8*)(kp+2048); kf[3]=*(const __attribute__((address_space(3))) bf16x8*)(kp+2560);
  kf[4]=*(const __attribute__((address_space(3))) bf16x8*)(kp+4096); kf[5]=*(const __attribute__((address_space(3))) bf16x8*)(kp+4608);
  kf[6]=*(const __attribute__((address_space(3))) bf16x8*)(kp+6144); kf[7]=*(const __attribute__((address_space(3))) bf16x8*)(kp+6656);
}
__device__ __forceinline__ void kload2(bf16x8*kf,lds_cptr kp,int j){ kf[2*j]=*(const __attribute__((address_space(3))) bf16x8*)(kp+j*2048); kf[2*j+1]=*(const __attribute__((address_space(3))) bf16x8*)(kp+j*2048+512); }
__device__ __forceinline__ s16x4 vtr(lds_cptr p){ return __builtin_bit_cast(s16x4,__builtin_amdgcn_ds_read_tr16_b64_v4i16((__attribute__((address_space(3))) v4i16_t*)p)); }
__device__ __forceinline__ float rowmax(const f32x16&p0,const f32x16&p1){
  float a=max3f(p0[0],p0[1],p1[0]),b=max3f(p0[2],p0[3],p1[1]);a=max3f(a,p1[2],p1[3]);
  #pragma unroll
  for(int r=4;r<16;r+=4){a=max3f(a,p0[r],p0[r+1]);b=max3f(b,p0[r+2],p0[r+3]);a=max3f(a,p1[r],p1[r+1]);b=max3f(b,p1[r+2],p1[r+3]);}
  const float m=max2f(a,b);
  auto rr=__builtin_amdgcn_permlane32_swap(__float_as_uint(m),__float_as_uint(m),false,false);
  return max2f(__uint_as_float(rr[0]),__uint_as_float(rr[1]));
}
__device__ __forceinline__ void pv(f32x16*o,int vb,bf16x8 pa0,bf16x8 pa1,bf16x8 pa2,bf16x8 pa3){
  #pragma unroll
  for(int d0=0;d0<2;++d0){s16x4 lo[4],hi[4];
    #pragma unroll
    for(int ks=0;ks<4;++ks){
      asm volatile("ds_read_b64_tr_b16 %0,%1 offset:%c2":"=&v"(lo[ks]):"v"(vb),"i"(d0*4096+ks*1024):"memory");
      asm volatile("ds_read_b64_tr_b16 %0,%1 offset:%c2":"=&v"(hi[ks]):"v"(vb),"i"(d0*4096+ks*1024+512):"memory");}
    asm volatile("s_waitcnt lgkmcnt(0)":::"memory");SBAR();
    #define PK(k) (bf16x8){lo[k][0],lo[k][1],lo[k][2],lo[k][3],hi[k][0],hi[k][1],hi[k][2],hi[k][3]}
    o[d0]=__builtin_amdgcn_mfma_f32_32x32x16_bf16(pa0,PK(0),o[d0],0,0,0);
    o[d0]=__builtin_amdgcn_mfma_f32_32x32x16_bf16(pa1,PK(1),o[d0],0,0,0);
    o[d0]=__builtin_amdgcn_mfma_f32_32x32x16_bf16(pa2,PK(2),o[d0],0,0,0);
    o[d0]=__builtin_amdgcn_mfma_f32_32x32x16_bf16(pa3,PK(3),o[d0],0,0,0);
    #undef PK
  }
}

#ifndef ATTN_STORE16
#define ATTN_STORE16(p,v) (*(u32x4*)(p)=(v))
#endif
template<int MODE> __device__ __forceinline__ void amask(f32x16&p0,f32x16&p1,int t,int g0,int qb,int wid,int r32,int hi,const __attribute__((address_space(3))) float*biasT){
  if(MODE==0||t<NCTXT)return;
  const float NEG=-INFINITY; const int g=g0+t-NCTXT;
  if(MODE==1){ int d0=64*g-(256*qb+32*wid+r32)+4*hi; asm volatile("":"+v"(d0));
    #pragma unroll
    for(int r=0;r<16;++r){const int dd=d0+(r&3)+8*(r>>2); if(dd>128||dd<-128)p0[r]=NEG; if(dd+32>128||dd+32<-128)p1[r]=NEG;}
  } else {
    const int gr=4*qb+(wid>>1); int rs=gr-4; rs=rs<0?0:(rs>120?120:rs); const bool rel=(g>=rs&&g<rs+8);
    const int qc=32*(wid&1)+r32; int cs=qc-8; cs=cs<0?0:(cs>48?48:cs); asm volatile("":"+v"(cs));
    const int dr=rel?(g-gr+7):0; const __attribute__((address_space(3))) float*bt=biasT+dr*31+15-qc+4*hi; const int k0=4*hi-cs;
    #pragma unroll
    for(int r=0;r<16;++r){const int ko=(r&3)+8*(r>>2); const unsigned u0=(unsigned)(k0+ko),u1=(unsigned)(k0+ko+32);
      p0[r]=(rel&&u0<16u)?p0[r]+bt[ko]:NEG; p1[r]=(rel&&u1<16u)?p1[r]+bt[ko+32]:NEG;
      if((r&3)==3)asm volatile("":"+v"(p0),"+v"(p1)::"memory");}
  }
}
template<int THRL,int MODE> __device__ __forceinline__ void attn_unit(int qb,const bf16*Qp,const bf16*__restrict__ Kl,const bf16*__restrict__ Vl,const bf16*__restrict__ Kc,const bf16*__restrict__ Vc,bf16*Op,char*shm,const int tid,const int NT,const int g0,const float sinkl2,const float*rpbh){
  const int lane=tid&63,r32=lane&31,hi=lane>>5; const int wid=__builtin_amdgcn_readfirstlane(tid>>6);
  const int q0=qb*QB;
  const bf16*Qw=Qp+(long)(q0+wid*QBLK)*PQ;
  const unsigned lds0=(unsigned)(uintptr_t)shm;
  float*wsf=(float*)(shm+LDS_WS)+wid*64;
  const long koff=(long)lane*PQ+wid*8;
  const long voff=(long)(16*(wid&3)+(lane>>2))*PQ+(wid>>2)*32+(lane&3)*8;
  const unsigned kdst=lds0+LDS_K+wid*1024, vdst=lds0+LDS_V+wid*1024;
  #define TILE_SRC(t,C,L) (((t)<NCTXT?(C)+(long)(t)*KVBLK*PQ:(L)+(long)((t)-NCTXT)*KVBLK*PQ))
  #define DMA_K(t,slot) glds16(TILE_SRC(t,Kc,Kl)+koff,(unsigned)__builtin_amdgcn_readfirstlane(kdst+(slot)))
  #define DMA_V(t,slot) glds16(TILE_SRC(t,Vc,Vl)+voff,(unsigned)__builtin_amdgcn_readfirstlane(vdst+(slot)))
  const int vb0=(int)(lds0+LDS_V)+((lane>>4)&1)*32+(lane&3)*8+(4*hi+((lane&15)>>2))*64;
  const char*Kbase=shm+LDS_K; bf16x8 kf[8];
  const lds_cptr shm3=(lds_cptr)shm; const lds_cptr kp0=shm3+LDS_K+hi*1024+r32*16; const lds_cptr vp0=shm3+LDS_V+((lane>>4)&1)*32+(lane&3)*8+(4*hi+((lane&15)>>2))*64;
  const __attribute__((address_space(3))) float*biasT=(const __attribute__((address_space(3))) float*)((lds_cptr)shm+LDS_BYTES);
  if(MODE==2){ __attribute__((address_space(3))) float*bw=(__attribute__((address_space(3))) float*)((lds_cptr)shm+LDS_BYTES); for(int i=tid;i<465;i+=512)bw[i]=rpbh[i]*1.4426950408889634f; }
  DMA_K(0,0);DMA_V(0,0);DMA_K(1,SLOTB);
  bf16x8 qr[4];
  #pragma unroll
  for(int d0=0;d0<4;++d0)qr[d0]=*reinterpret_cast<const bf16x8*>(&Qw[(long)r32*PQ+d0*16+hi*8]);
  float mhat=0.f,l_reg=0.f;f32x16 o[2],negm; { float zz=0.f; asm volatile("":"+v"(zz)); _Pragma("unroll") for(int r=0;r<16;++r){o[0][r]=zz;o[1][r]=zz;negm[r]=zz;} } asm volatile("":"+v"(negm));
  #define CMASK(P0,P1,t) amask<MODE>(P0,P1,t,g0,qb,wid,r32,hi,biasT)
  bool resc=false;
  #define START(P0,P1) do{ const float rm=rowmax(P0,P1); resc=false; \
    { const float dl=rm; mhat=fadd_s(mhat,dl); \
      _Pragma("unroll") for(int r=0;r<16;++r){P0[r]=fsub_s(P0[r],dl);P1[r]=fsub_s(P1[r],dl);} \
      _Pragma("unroll") for(int r=0;r<16;++r)negm[r]=-mhat; asm volatile("":"+v"(negm)); } \
    _Pragma("unroll") for(int r=0;r<16;++r)P0[r]=__builtin_amdgcn_exp2f(P0[r]); }while(0)
  #define RESC() do{ if(resc){ asm volatile("s_waitcnt lgkmcnt(0)":::"memory"); \
      _Pragma("unroll") for(int d_=0;d_<2;++d_) _Pragma("unroll") for(int r=0;r<16;++r)o[d_][r]*=wsf[crow(r,hi)]; } }while(0)
  f32x16 pA0,pA1,pB0,pB1;
  int sl_prev=0,sl_cur=0,sl_next=SLOTB;
  #define ROT() do{sl_prev=sl_cur;sl_cur=sl_next;sl_next=(sl_next==(NSLOT-1)*SLOTB)?0:sl_next+SLOTB;}while(0)
  DMA_K(2,2*SLOTB);
  WAIT_BAR(3);
  qkt(pA0,pA1,Kbase,qr,negm,r32,hi);asm volatile("s_nop 15\n\ts_nop 7":"+v"(pA0),"+v"(pA1));CMASK(pA0,pA1,0);
  START(pA0,pA1);
  _Pragma("unroll") for(int r=0;r<16;++r)pA1[r]=__builtin_amdgcn_exp2f(pA1[r]);
  WAIT_BAR(0);
  DMA_K(3,0);DMA_V(1,SLOTB);
  ROT();
  kload8(kf,kp0+sl_cur);
  WAIT_BAR(2);
  s16x4 vlo[8],vhi[8]; u32x4 pw0,pw1,pw2,pw3;
  #define PKW(P,B) cvtpk_s(P[B],P[B+1])
  #define PAF(k) __builtin_bit_cast(bf16x8,pw##k)
  #define VFR(i) (bf16x8){vlo[i][0],vlo[i][1],vlo[i][2],vlo[i][3],vhi[i][0],vhi[i][1],vhi[i][2],vhi[i][3]}
  #define PIN(x) asm volatile("":"+v"(x))
  #define MX3(a,b,c) __builtin_fmaxf(__builtin_fmaxf((a),(b)),(c))
  #define GAPA(MF,A0,A1,A2,A3,W0,W1,PW) do{ MF; sacc+=A0; sacc+=A1; sacc+=A2; sacc+=A3; PIN(sacc); W0; W1; PIN(PW); SBAR(); }while(0)
  #define EX(v) __builtin_amdgcn_exp2f(v)
  #define GAPB(MF,X,B) do{ MF; X[B]=EX(X[B]); X[B+1]=EX(X[B+1]); X[B+2]=EX(X[B+2]); X[B+3]=EX(X[B+3]); PIN(X); SBAR(); }while(0)
  #define VRD(i) do{ vlo[i]=vtr(vp_+(((i)>>2)*4096+((i)&3)*1024)); vhi[i]=vtr(vp_+(((i)>>2)*4096+((i)&3)*1024+512)); }while(0)
  #define KRD(G,j) do{ if(G){ kload2(kf,kp0+sl_next,j); SBAR(); } }while(0)
  #define STEP(C0,C1,P0,P1,t,GK,GV,GL) do{ SBAR(); \
    const lds_cptr vp_=vp0+sl_prev; \
    VRD(0); SBAR(); float sacc=(P0[0]+P0[1]); \
    GAPA(C0=__builtin_amdgcn_mfma_f32_32x32x16_bf16(kf[0],qr[0],negm,0,0,0), P0[2],P0[3],P0[4],P0[5],     pw0[0]=PKW(P0,0), pw0[1]=PKW(P0,2), pw0); \
    VRD(4); SBAR(); GAPA(C1=__builtin_amdgcn_mfma_f32_32x32x16_bf16(kf[1],qr[0],negm,0,0,0), P0[6],P0[7],P0[8],P0[9],     pw0[2]=PKW(P0,4), pw0[3]=PKW(P0,6), pw0); \
    VRD(1); SBAR(); GAPA(C0=__builtin_amdgcn_mfma_f32_32x32x16_bf16(kf[2],qr[1],C0,0,0,0),   P0[10],P0[11],P0[12],P0[13], pw1[0]=PKW(P0,8), pw1[1]=PKW(P0,10), pw1); \
    VRD(5); SBAR(); GAPA(C1=__builtin_amdgcn_mfma_f32_32x32x16_bf16(kf[3],qr[1],C1,0,0,0),   P0[14],P0[15],P1[0],P1[1],   pw1[2]=PKW(P0,12),pw1[3]=PKW(P0,14), pw1); \
    VRD(2); SBAR(); GAPA(C0=__builtin_amdgcn_mfma_f32_32x32x16_bf16(kf[4],qr[2],C0,0,0,0),   P1[2],P1[3],P1[4],P1[5],     pw2[0]=PKW(P1,0), pw2[1]=PKW(P1,2), pw2); \
    VRD(6); SBAR(); GAPA(C1=__builtin_amdgcn_mfma_f32_32x32x16_bf16(kf[5],qr[2],C1,0,0,0),   P1[6],P1[7],P1[8],P1[9],     pw2[2]=PKW(P1,4), pw2[3]=PKW(P1,6), pw2); \
    VRD(3); SBAR(); GAPA(C0=__builtin_amdgcn_mfma_f32_32x32x16_bf16(kf[6],qr[3],C0,0,0,0),   P1[10],P1[11],P1[12],P1[13], pw3[0]=PKW(P1,8), pw3[1]=PKW(P1,10), pw3); \
    VRD(7); SBAR(); GAPA(C1=__builtin_amdgcn_mfma_f32_32x32x16_bf16(kf[7],qr[3],C1,0,0,0),   P1[14],P1[15],0.f,0.f,       pw3[2]=PKW(P1,12),pw3[3]=PKW(P1,14), pw3); \
    l_reg+=sacc; \
    if(GK){DMA_K((t)+3,sl_cur);} if(GV){DMA_V((t)+1,sl_next);} \
    CMASK(C0,C1,t); \
    { float a=MX3(C0[0],C0[1],C1[0]),b=MX3(C0[2],C0[3],C1[1]); a=MX3(a,C1[2],C1[3]); \
      _Pragma("unroll") for(int r=4;r<16;r+=4){a=MX3(a,C0[r],C0[r+1]);b=MX3(b,C0[r+2],C0[r+3]);a=MX3(a,C1[r],C1[r+1]);b=MX3(b,C1[r+2],C1[r+3]);} \
      float rm=__builtin_fmaxf(a,b); { auto rr=__builtin_amdgcn_permlane32_swap(__float_as_uint(rm),__float_as_uint(rm),false,false); rm=__builtin_fmaxf(__uint_as_float(rr[0]),__uint_as_float(rr[1])); } \
      resc=false; \
      if(__builtin_expect(__any(rm>(float)THRL),0)){ const float dl=__builtin_fmaxf(rm,0.f); mhat+=dl; \
        _Pragma("unroll") for(int r=0;r<16;++r){C0[r]-=dl;C1[r]-=dl;} \
        _Pragma("unroll") for(int r=0;r<16;++r)negm[r]=-mhat; asm volatile("":"+v"(negm)); \
        const float f=__builtin_amdgcn_exp2f(-dl); l_reg*=f; if(hi==0)wsf[r32]=f; resc=true; } } \
    SBAR(); \
    GAPB(o[0]=__builtin_amdgcn_mfma_f32_32x32x16_bf16(PAF(0),VFR(0),o[0],0,0,0), C0,0); \
    GAPB(o[1]=__builtin_amdgcn_mfma_f32_32x32x16_bf16(PAF(0),VFR(4),o[1],0,0,0), C0,4); \
    KRD(GL,0); GAPB(o[0]=__builtin_amdgcn_mfma_f32_32x32x16_bf16(PAF(1),VFR(1),o[0],0,0,0), C0,8); \
    KRD(GL,1); GAPB(o[1]=__builtin_amdgcn_mfma_f32_32x32x16_bf16(PAF(1),VFR(5),o[1],0,0,0), C0,12); \
    KRD(GL,2); GAPB(o[0]=__builtin_amdgcn_mfma_f32_32x32x16_bf16(PAF(2),VFR(2),o[0],0,0,0), C1,0); \
    KRD(GL,3); GAPB(o[1]=__builtin_amdgcn_mfma_f32_32x32x16_bf16(PAF(2),VFR(6),o[1],0,0,0), C1,4); \
    GAPB(o[0]=__builtin_amdgcn_mfma_f32_32x32x16_bf16(PAF(3),VFR(3),o[0],0,0,0), C1,8); \
    GAPB(o[1]=__builtin_amdgcn_mfma_f32_32x32x16_bf16(PAF(3),VFR(7),o[1],0,0,0), C1,12); \
    }while(0)
  int t=1;
  for(;t+5<NT;t+=2){
    STEP(pB0,pB1,pA0,pA1,t,true,true,true);     WAIT_BAR(2); RESC(); ROT();
    STEP(pA0,pA1,pB0,pB1,t+1,true,true,true);   WAIT_BAR(2); RESC(); ROT();
  }
  #define ENDW(tt) do{ if((tt)+3<NT){WAIT_BAR(2);} else if((tt)+2<NT){WAIT_BAR(1);} else {WAIT_BAR(0);} }while(0)
  for(;t+1<NT;t+=2){
    STEP(pB0,pB1,pA0,pA1,t,(t+3<NT),(t+1<NT),(t+1<NT));       ENDW(t);   RESC(); ROT();
    STEP(pA0,pA1,pB0,pB1,t+1,(t+4<NT),(t+2<NT),(t+2<NT));     ENDW(t+1); RESC(); ROT();
  }
  STEP(pB0,pB1,pA0,pA1,NT-1,false,false,false); RESC();
  { float sacc=pB0[0]+pB0[1]; _Pragma("unroll") for(int r=2;r<16;++r)sacc+=pB0[r]; _Pragma("unroll") for(int r=0;r<16;++r)sacc+=pB1[r]; l_reg+=sacc;
    pw0=(u32x4){PKW(pB0,0),PKW(pB0,2),PKW(pB0,4),PKW(pB0,6)};pw1=(u32x4){PKW(pB0,8),PKW(pB0,10),PKW(pB0,12),PKW(pB0,14)};pw2=(u32x4){PKW(pB1,0),PKW(pB1,2),PKW(pB1,4),PKW(pB1,6)};pw3=(u32x4){PKW(pB1,8),PKW(pB1,10),PKW(pB1,12),PKW(pB1,14)};
    SBAR(); pv(o,vb0+sl_cur,PAF(0),PAF(1),PAF(2),PAF(3)); }
  #undef PKW
  #undef PAF
  #undef VFR
  #undef PIN
  #undef MX3
  #undef GAPA
  #undef GAPB
  #undef EX
  #undef VRD
  #undef KRD
  #undef STEP
  #undef ENDW
  if(MODE==1&&hi==0)l_reg+=__builtin_amdgcn_exp2f(sinkl2-mhat);
  {auto rr=__builtin_amdgcn_permlane32_swap(__float_as_uint(l_reg),__float_as_uint(l_reg),false,false);l_reg=__uint_as_float(rr[0])+__uint_as_float(rr[1]);}
  if(hi==0)wsf[32+r32]=l_reg;asm volatile("s_waitcnt lgkmcnt(0)":::"memory");
  float rli[16];
  #pragma unroll
  for(int r=0;r<16;++r)rli[r]=__builtin_amdgcn_rcpf(wsf[32+crow(r,hi)]);
  bf16*Ow=Op+(long)(q0+wid*QBLK)*PO;
  { bf16*stg=(bf16*)(shm+LDS_OST)+wid*2048;
    #pragma unroll
    for(int r=0;r<16;++r){const int orow=crow(r,hi);
      #pragma unroll
      for(int d0=0;d0<2;++d0)stg[orow*64+d0*32+r32]=__float2bfloat16(o[d0][r]*rli[r]);}
    asm volatile("s_waitcnt lgkmcnt(0)":::"memory");
    #pragma unroll
    for(int i=0;i<4;++i){const int row=i*8+(lane>>3),ch=lane&7; const u32x4 v=*(const u32x4*)(stg+row*64+ch*8); ATTN_STORE16(Ow+(long)row*PO+ch*8,v);} }
  asm volatile("s_waitcnt lgkmcnt(0)\n\ts_barrier":::"memory");
  #undef DMA_K
  #undef TILE_SRC
  #undef DMA_V
  #undef CMASK
  #undef START
  #undef RESC
  #undef ROT
}
#undef SBAR
#undef WAIT_BAR
}

constexpr int SD_CUM = 0, SD_DTV = 1024, SD_XC = 2048, SD_XCS = 144, SD_BC = SD_XC + 128 * SD_XCS, SD_BCS = 272, SD_CC = SD_BC + 128 * SD_BCS, SD_HS = SD_CC + 128 * SD_BCS,
              SD_SSQ = SD_HS + 2 * 64 * SD_BCS, SD_XW = SD_CC;
static_assert(SD_SSQ + 1024 <= RING_BYTES && SD_XW + 2 * 128 * SD_XCS <= RING_BYTES, "SSD LDS map");
DI int chunk_row(int b, int cidx) { return cidx < 2 ? NLAT + b * CTXL + 128 * cidx : b * SEQ + 128 * (cidx - 2); }
DI void ssd_cum(const Frame& F, int l, int b, int cidx, int hd, int wv0) {
    if (F.wave >= wv0 && F.wave < wv0 + 2) {
        const int dir = F.wave - wv0; const float* DT = WSP(float, WS_DT) + (size_t)chunk_row(b, cidx) * 16 + dir * 8 + hd;
        const float a = -__expf(F.in[I_ALOG][l * 16 + dir * 8 + hd]);
        const float d0 = DT[(size_t)(2 * F.lane) * 16], d1 = DT[(size_t)(2 * F.lane + 1) * 16];
        const float a0 = d0 * a, a1 = d1 * a, s = a0 + a1; float v = s;
        LAS float* cum = (LAS float*)(F.lds + SD_CUM) + dir * 128; LAS float* dtv = (LAS float*)(F.lds + SD_DTV) + dir * 128;
        if (dir == 0) {
#pragma unroll
            for (int o = 1; o < 64; o <<= 1) { const float t = __shfl_up(v, o); if (F.lane >= o) v += t; }
            cum[2 * F.lane] = v - s + a0; cum[2 * F.lane + 1] = v;
        } else {
#pragma unroll
            for (int o = 1; o < 64; o <<= 1) { const float t = __shfl_down(v, o); if (F.lane + o < 64) v += t; }
            cum[2 * F.lane + 1] = v - s + a1; cum[2 * F.lane] = v;
        }
        dtv[2 * F.lane] = d0; dtv[2 * F.lane + 1] = d1;
    }
}
DI void conv_items(const Frame& F, int l, int hd, int nitems, int rowbase, int seqlo, int seqhi) {
    const bf16_t* PRJ = WSP(bf16_t, WS_PRJ); const float* cw = F.in[I_CONVW] + (size_t)l * 5 * 1024; const float* cb = F.in[I_CONVB] + l * 1024;
    for (int item = F.tid; item < nitems; item += NTHR) {
        int chunk, seg, c0, dstride, dcol; LAS unsigned char* dst;
        if (item < 128) { chunk = item & 7; seg = item >> 3; c0 = 64 * hd + chunk * 8; dst = F.lds + SD_XC; dstride = SD_XCS; dcol = chunk * 16; }
        else if (item < 384) { const int q = item - 128; chunk = q & 15; seg = q >> 4; c0 = 512 + 128 * (hd >> 2) + chunk * 8; dst = F.lds + SD_BC; dstride = SD_BCS; dcol = chunk * 16; }
        else { const int q = item - 384; chunk = q & 15; seg = q >> 4; c0 = 768 + 128 * (hd >> 2) + chunk * 8; dst = F.lds + SD_CC; dstride = SD_BCS; dcol = chunk * 16; }
        const int t0 = seg * 8;
        float w[5][8], bb[8];
#pragma unroll
        for (int k = 0; k < 5; ++k) { const f32x4 wa = *(const f32x4*)(cw + k * 1024 + c0), wb = *(const f32x4*)(cw + k * 1024 + c0 + 4);
            w[k][0] = wa[0]; w[k][1] = wa[1]; w[k][2] = wa[2]; w[k][3] = wa[3]; w[k][4] = wb[0]; w[k][5] = wb[1]; w[k][6] = wb[2]; w[k][7] = wb[3]; }
        { const f32x4 ba = *(const f32x4*)(cb + c0), b2 = *(const f32x4*)(cb + c0 + 4); bb[0] = ba[0]; bb[1] = ba[1]; bb[2] = ba[2]; bb[3] = ba[3]; bb[4] = b2[0]; bb[5] = b2[1]; bb[6] = b2[2]; bb[7] = b2[3]; }
        u32x4 rows[12];
#pragma unroll
        for (int i = 0; i < 12; ++i) { const int row = rowbase + t0 - 2 + i;
            rows[i] = (row >= seqlo && row < seqhi) ? *(const u32x4*)(PRJ + (size_t)row * PRJW + C_XBC + c0) : (u32x4){0u, 0u, 0u, 0u}; }
#pragma unroll
        for (int j = 0; j < 8; ++j) {
            float y[8];
#pragma unroll
            for (int e = 0; e < 8; ++e) y[e] = bb[e];
#pragma unroll
            for (int k = 0; k < 5; ++k) { const u32x4 rr = rows[j + k];
                y[0] += w[k][0] * bflo(rr.x); y[1] += w[k][1] * bfhi(rr.x); y[2] += w[k][2] * bflo(rr.y); y[3] += w[k][3] * bfhi(rr.y);
                y[4] += w[k][4] * bflo(rr.z); y[5] += w[k][5] * bfhi(rr.z); y[6] += w[k][6] * bflo(rr.w); y[7] += w[k][7] * bfhi(rr.w); }
            u32x4 o; o.x = pk2(silu(y[0]), silu(y[1])); o.y = pk2(silu(y[2]), silu(y[3])); o.z = pk2(silu(y[4]), silu(y[5])); o.w = pk2(silu(y[6]), silu(y[7]));
            *(LAS u32x4*)(dst + (t0 + j) * dstride + dcol) = o;
        }
    }
}
DI void ssd_s1_unit(const Frame& Fin, int l, int b, int cidx, int hd) {
    const Frame F = launder(Fin);
    const int lane = F.lane, wid = F.wave, r = lane & 31, h = lane >> 5;
    const int rowbase = chunk_row(b, cidx), seqlo = cidx < 2 ? NLAT + b * CTXL : b * SEQ, seqhi = cidx < 2 ? seqlo + CTXL : seqlo + SEQ;
    __syncthreads();
    ssd_cum(F, l, b, cidx, hd, 6);
    conv_items(F, l, hd, 384, rowbase, seqlo, seqhi);
    __syncthreads();
    const LAS float* cum = (const LAS float*)(F.lds + SD_CUM); const LAS float* dtv = (const LAS float*)(F.lds + SD_DTV);
    for (int i = F.tid; i < 2 * 128 * 8; i += NTHR) {
        const int dir = i >> 10, t = (i >> 3) & 127, c8 = i & 7;
        const float ce = dir == 0 ? cum[127] : cum[128]; const float wgt = dtv[dir * 128 + t] * __expf(ce - cum[dir * 128 + t]);
        const u32x4 x = *(const LAS u32x4*)(F.lds + SD_XC + t * SD_XCS + c8 * 16);
        u32x4 o; o.x = pk2(bflo(x.x) * wgt, bfhi(x.x) * wgt); o.y = pk2(bflo(x.y) * wgt, bfhi(x.y) * wgt); o.z = pk2(bflo(x.z) * wgt, bfhi(x.z) * wgt); o.w = pk2(bflo(x.w) * wgt, bfhi(x.w) * wgt);
        *(LAS u32x4*)(F.lds + SD_XW + (dir * 128 + t) * SD_XCS + c8 * 16) = o;
    }
    __syncthreads();
    const int dir = wid >> 2, nb = wid & 3, q4 = (lane & 15) >> 2, p4 = lane & 3, blk = (lane >> 4) & 1;
    f32x16 s0, s1;
#pragma unroll
    for (int i = 0; i < 16; ++i) { s0[i] = 0.f; s1[i] = 0.f; }
    const LAS unsigned char* xa = F.lds + SD_XW + (dir * 128 + 8 * h + q4) * SD_XCS + (16 * blk + 4 * p4) * 2;
    const LAS unsigned char* ba = F.lds + SD_BC + (8 * h + q4) * SD_BCS + (32 * nb + 16 * blk + 4 * p4) * 2;
#pragma unroll
    for (int ks = 0; ks < 8; ++ks) {
        const bf16x8 bfr = cat8(tr_read(ba + (16 * ks) * SD_BCS), tr_read(ba + (16 * ks + 4) * SD_BCS));
        const bf16x8 x0 = cat8(tr_read(xa + (16 * ks) * SD_XCS), tr_read(xa + (16 * ks + 4) * SD_XCS));
        const bf16x8 x1 = cat8(tr_read(xa + (16 * ks) * SD_XCS + 64), tr_read(xa + (16 * ks + 4) * SD_XCS + 64));
        s0 = MFMA32(bfr, x0, s0); s1 = MFMA32(bfr, x1, s1);
    }
    bf16_t* ST = WSP(bf16_t, WS_ST) + ((((size_t)b * NCH + cidx) * 8 + hd) * 2 + dir) * 8192 + 32 * nb + 4 * h;
#pragma unroll
    for (int g4 = 0; g4 < 4; ++g4) { st4bf(ST + (size_t)r * 128 + 8 * g4, (f32x4){s0[4 * g4], s0[4 * g4 + 1], s0[4 * g4 + 2], s0[4 * g4 + 3]});
        st4bf(ST + (size_t)(32 + r) * 128 + 8 * g4, (f32x4){s1[4 * g4], s1[4 * g4 + 1], s1[4 * g4 + 2], s1[4 * g4 + 3]}); }
    if (F.tid < 2) WSP(float, WS_CDEC)[(((size_t)b * NCH + cidx) * 8 + hd) * 2 + F.tid] = __expf(F.tid == 0 ? cum[127] : cum[128]);
}
DI void phase_scan(const Frame& F) {
    bf16_t* ST = WSP(bf16_t, WS_ST); const float* CD = WSP(float, WS_CDEC);
    for (int gid = F.vcu * NTHR + F.tid; gid < 64 * 1024; gid += F.G * NTHR) {
        const int chain = gid >> 10, e8 = gid & 1023, b = chain >> 4, hd = (chain >> 1) & 7, dir = chain & 1;
        float hs[8];
#pragma unroll
        for (int e = 0; e < 8; ++e) hs[e] = 0.f;
        for (int k0 = 0; k0 < NCH; k0 += 11) {
            u32x4 st[11]; float dec[11];
#pragma unroll
            for (int j = 0; j < 11; ++j) { const int k = k0 + j, cidx = dir == 0 ? k : (k < 2 ? 1 - k : 67 - k); const size_t idx = (((size_t)b * NCH + cidx) * 8 + hd) * 2 + dir;
                st[j] = *((const u32x4*)(ST + idx * 8192) + e8); dec[j] = CD[idx]; }
#pragma unroll
            for (int j = 0; j < 11; ++j) { const int k = k0 + j, cidx = dir == 0 ? k : (k < 2 ? 1 - k : 67 - k); const size_t idx = (((size_t)b * NCH + cidx) * 8 + hd) * 2 + dir;
                u32x4 o; o.x = pk2(hs[0], hs[1]); o.y = pk2(hs[2], hs[3]); o.z = pk2(hs[4], hs[5]); o.w = pk2(hs[6], hs[7]); *((u32x4*)(ST + idx * 8192) + e8) = o;
                const u32x4 u = st[j]; const float d = dec[j];
                hs[0] = hs[0] * d + bflo(u.x); hs[1] = hs[1] * d + bfhi(u.x); hs[2] = hs[2] * d + bflo(u.y); hs[3] = hs[3] * d + bfhi(u.y);
                hs[4] = hs[4] * d + bflo(u.z); hs[5] = hs[5] * d + bfhi(u.z); hs[6] = hs[6] * d + bflo(u.w); hs[7] = hs[7] * d + bfhi(u.w); }
        }
    }
}
DI void ssd_s3_unit(const Frame& Fin, int l, int b, int cidx, int hd) {
    const Frame F = launder(Fin);
    const int lane = F.lane, wid = F.wave, r = lane & 31, h = lane >> 5;
    const int rowbase = chunk_row(b, cidx), seqlo = cidx < 2 ? NLAT + b * CTXL : b * SEQ, seqhi = cidx < 2 ? seqlo + CTXL : seqlo + SEQ;
    __syncthreads();
    ssd_cum(F, l, b, cidx, hd, 6);
    conv_items(F, l, hd, 640, rowbase, seqlo, seqhi);
    {
        const bf16_t* ST = WSP(bf16_t, WS_ST) + (((size_t)b * NCH + cidx) * 8 + hd) * 2 * 8192;
        for (int i = F.tid; i < 2 * 64 * 16; i += NTHR) { const int dp = i >> 4, c8 = i & 15; *(LAS u32x4*)(F.lds + SD_HS + dp * SD_BCS + c8 * 16) = *(const u32x4*)(ST + (size_t)dp * 128 + c8 * 8); }
    }
    __syncthreads();
    const LAS float* cum = (const LAS float*)(F.lds + SD_CUM); const LAS float* dtv = (const LAS float*)(F.lds + SD_DTV);
    const int lb = wid & 3, ph = wid >> 2, q4 = (lane & 15) >> 2, p4 = lane & 3, blk = (lane >> 4) & 1;
    const int lidx = 32 * lb + r;
    bf16x8 cf[8];
#pragma unroll
    for (int ks = 0; ks < 8; ++ks) cf[ks] = *(const LAS bf16x8*)(F.lds + SD_CC + lidx * SD_BCS + (16 * ks + 8 * h) * 2);
    f32x16 gt[4];
#pragma unroll
    for (int sb = 0; sb < 4; ++sb) {
#pragma unroll
        for (int i = 0; i < 16; ++i) gt[sb][i] = 0.f;
#pragma unroll
        for (int ks = 0; ks < 8; ++ks) { const bf16x8 bfr = *(const LAS bf16x8*)(F.lds + SD_BC + (32 * sb + r) * SD_BCS + (16 * ks + 8 * h) * 2); gt[sb] = MFMA32(bfr, cf[ks], gt[sb]); }
    }
    f32x16 ytot;
#pragma unroll
    for (int i = 0; i < 16; ++i) ytot[i] = 0.f;
    const LAS unsigned char* xa = F.lds + SD_XC + (4 * h + q4) * SD_XCS + (32 * ph + 16 * blk + 4 * p4) * 2;
#pragma unroll
    for (int dir = 0; dir < 2; ++dir) {
        const float cl = cum[dir * 128 + lidx];
        f32x16 acc;
#pragma unroll
        for (int i = 0; i < 16; ++i) acc[i] = 0.f;
#pragma unroll
        for (int sb = 0; sb < 4; ++sb) {
            const bool relv = dir == 0 ? (sb <= lb) : (sb >= lb);
            if (relv) {
                f32x16 mt; int rl = r; asm volatile("" : "+v"(rl));
#pragma unroll
                for (int i = 0; i < 16; ++i) { const int sl = crow(i, h), s = 32 * sb + sl;
                    const bool ok = (sb != lb) || (dir == 0 ? (sl <= rl) : (sl >= rl));
                    const float e = __expf(cl - cum[dir * 128 + s]) * dtv[dir * 128 + s];
                    mt[i] = ok ? gt[sb][i] * e : 0.f; }
                const bf16x8 pa0 = pack8<0>(mt), pa1 = pack8<1>(mt);
                const bf16x8 x0 = cat8(tr_read(xa + (32 * sb) * SD_XCS), tr_read(xa + (32 * sb + 8) * SD_XCS));
                const bf16x8 x1 = cat8(tr_read(xa + (32 * sb + 16) * SD_XCS), tr_read(xa + (32 * sb + 24) * SD_XCS));
                acc = MFMA32(x0, pa0, acc); acc = MFMA32(x1, pa1, acc);
            }
        }
        f32x16 yo;
#pragma unroll
        for (int i = 0; i < 16; ++i) yo[i] = 0.f;
#pragma unroll
        for (int ks = 0; ks < 8; ++ks) { const bf16x8 hf = *(const LAS bf16x8*)(F.lds + SD_HS + (dir * 64 + 32 * ph + r) * SD_BCS + (16 * ks + 8 * h) * 2); yo = MFMA32(hf, cf[ks], yo); }
        const float el = __expf(cl);
#pragma unroll
        for (int i = 0; i < 16; ++i) ytot[i] += acc[i] + el * yo[i];
    }
    const float dsk = F.in[I_DSKIP][l * 8 + hd];
    const int row = rowbase + lidx;
    const bf16_t* zp = WSP(bf16_t, WS_PRJ) + (size_t)row * PRJW + C_Z + 64 * hd + 32 * ph + 4 * h;
    bf16_t* op = WSP(bf16_t, WS_OC) + (size_t)row * OCW + 1536 + 64 * hd + 32 * ph + 4 * h;
    float ss = 0.f;
#pragma unroll
    for (int g4 = 0; g4 < 4; ++g4) {
        const u32x2 zz = *(const u32x2*)(zp + 8 * g4);
        const u32x2 xx = *(const LAS u32x2*)(F.lds + SD_XC + lidx * SD_XCS + (32 * ph + 8 * g4 + 4 * h) * 2);
        const float v0 = (ytot[4 * g4] + dsk * bflo(xx.x)) * silu(bflo(zz.x)), v1 = (ytot[4 * g4 + 1] + dsk * bfhi(xx.x)) * silu(bfhi(zz.x));
        const float v2 = (ytot[4 * g4 + 2] + dsk * bflo(xx.y)) * silu(bflo(zz.y)), v3 = (ytot[4 * g4 + 3] + dsk * bfhi(xx.y)) * silu(bfhi(zz.y));
        ss += (v0 * v0 + v1 * v1) + (v2 * v2 + v3 * v3);
        u32x2 w; w.x = pk2(v0, v1); w.y = pk2(v2, v3); *(u32x2*)(op + 8 * g4) = w;
    }
    ss += __shfl_xor(ss, 32);
    LAS float* sq = (LAS float*)(F.lds + SD_SSQ);
    if (h == 0) sq[ph * 128 + lidx] = ss;
    __syncthreads();
    if (F.tid < 128) WSP(float, WS_SSQ)[(size_t)(rowbase + F.tid) * 8 + hd] = sq[F.tid] + sq[128 + F.tid];
}

constexpr int PH_PER_LAYER = 11, N_PHASES = 2 + PH_PER_LAYER * DEPTH;
__global__ void __launch_bounds__(NTHR, 2) fwd_kernel(Args args) {
    extern __shared__ __attribute__((aligned(16))) unsigned char smem[];
    Frame F0;
    F0.lds = (LAS unsigned char*)smem;
    F0.tid = threadIdx.x; F0.lane = F0.tid & 63; F0.wave = __builtin_amdgcn_readfirstlane(F0.tid >> 6);
    F0.G = gridDim.x; F0.bx = blockIdx.x; { const int bx = blockIdx.x; F0.vcu = (F0.G % 8 == 0) ? (bx % 8) * (F0.G / 8) + bx / 8 : bx; }
    F0.in = args.in; F0.out = args.out; F0.ws = args.ws; F0.ctl = (gu32*)(args.ws + WS_CTL);
    volatile LAS unsigned* MISC = (volatile LAS unsigned*)(F0.lds + MISC_OFF);
    for (int u = F0.tid; u < (LDS_BYTES - RING_BYTES) / 4; u += NTHR) ((LAS unsigned*)(F0.lds + RING_BYTES))[u] = 0u;
    __syncthreads();
    XcdBarrier bar; bar.bar = (unsigned*)(F0.ctl + CW_BAR); bar.x = 0; bar.st = nullptr;
    if (!MK_PER_PHASE) bar = xcd_barrier_post((unsigned*)(F0.ctl + CW_BAR), MISC + 8);
    const int lo = args.ph_lo, hi = args.ph_hi;
#define IN(k) (lo <= (k) && (k) < hi)
#define SEAM(k) do { if (IN(k) && IN((k) + 1)) { if (MK_PER_PHASE) { if (F0.tid == 0) __hip_atomic_store(F0.ctl + 0, 0xBADBA0u, __ATOMIC_RELAXED, __HIP_MEMORY_SCOPE_AGENT); } else xcd_barrier(bar); } } while (0)

    if (PHM(11) && IN(0)) { const Frame F = launder(F0); _Pragma("nounroll") for (int rep = 0; rep < 1 + REPB(11); ++rep) { phase_prologue_a(F); __syncthreads(); } } SEAM(0);
    if (PHM(12) && IN(1)) { const Frame F = launder(F0); _Pragma("nounroll") for (int rep = 0; rep < 1 + REPB(12); ++rep) { phase_prologue_b(F); __syncthreads(); } } SEAM(1);

    for (int l = 0; l < DEPTH; ++l) {
        const int pb = 2 + PH_PER_LAYER * l;
        const bool with_ctx = l < DEPTH - 1, moe = l & 1; const int fi = l >> 1;
        const int mrows = with_ctx ? MTOT : NLAT, mtiles = with_ctx ? 132 : 128;
        if (PHM(0) && IN(pb + 0)) { const Frame F = launder(F0);
            pg8::SchedGrid S; S.nMa = mtiles; S.nNa = 34; S.nMb = with_ctx ? 0 : 4; S.nNb = 18; S.total = S.nMa * S.nNa + S.nMb * S.nNb; S.G = F.G; S.c = F.bx;
            S.A = (const char*)(F.ws + WS_HB); S.B = (const char*)(F.ws + WS_WCOMB + l * SZ_WCOMB); S.lda = DM; S.ldb = DM; S.a_div = 1; S.a_cols = 0; S.pe = nullptr; S.estride = 0; S.rep = REPB(0);
            pg8::EpiInGate E{WSP(bf16_t, WS_PRJ), WSP(bf16_t, WS_GT), F.in[I_BGATE] + (size_t)l * 4096};
            pg8::gemm_phase(F.lds, F.tid, DM, DM, DM, S, E);
        }
        SEAM(pb + 0);
        if (PHM(1) && IN(pb + 1)) { const Frame F = launder(F0);
            phase_qkprep_rows(F, l);
            for (int u = F.vcu; u < NB * NCH * 8; u += F.G) { const int hd = u & 7, cidx = (u >> 3) % NCH, b = (u >> 3) / NCH; ssd_s1_unit(F, l, b, cidx, hd); }
        }
        SEAM(pb + 1);
        if (PHM(2) && IN(pb + 2)) { const Frame F = launder(F0); phase_scan(F); }
        SEAM(pb + 2);
        if (PHM(3) && IN(pb + 3)) { const Frame F = launder(F0);
            const int nchs = with_ctx ? NCH : NCH - 2, n_s3 = NB * nchs * 8;
            _Pragma("nounroll") for (int rep = 0; rep < 1 + REPB(3); ++rep) {
            {
                for (int uu = F.vcu; uu < (1024 << REPB(13)); uu += F.G) { const int u = uu & 1023;
                    const int v = u & 1023, qblk = v & 31, b = v >> 8, hg = (v >> 5) & 3, kvh = (v >> 7) & 1, hq = kvh * 4 + hg;
                    const ga_body::bf16* P = (const ga_body::bf16*)(F.ws + WS_PRJ); const size_t lat0 = (size_t)(b * SEQ) * PRJW, ctx0 = (size_t)(NLAT + b * CTXL) * PRJW;
                    ga_body::bf16* O = (ga_body::bf16*)(F.ws + WS_OC) + (size_t)(b * SEQ) * OCW;
                    ga_body::attn_unit<8, 0>(qblk, P + lat0 + C_GAQ + hq * 64, P + lat0 + C_GAK + kvh * 64, P + lat0 + C_GAV + kvh * 64, P + ctx0 + C_GAK + kvh * 64, P + ctx0 + C_GAV + kvh * 64,
                                             O + 1024 + hq * 64, (char*)F.lds, F.tid, 132, 0, 0.f, nullptr);
                }
            }
            {
                const Frame F = launder(F0);
                for (int u = F.vcu; u < 1024; u += F.G) {
                    const int v = u & 1023, qblk = v & 31, b = v >> 8, hq = (v >> 5) & 7;
                    const ga_body::bf16* P = (const ga_body::bf16*)(F.ws + WS_PRJ); const size_t lat0 = (size_t)(b * SEQ) * PRJW, ctx0 = (size_t)(NLAT + b * CTXL) * PRJW;
                    ga_body::bf16* O = (ga_body::bf16*)(F.ws + WS_OC) + (size_t)(b * SEQ) * OCW;
                    int tlo = clampi(4 * qblk - 4, 0, 120), thi = clampi(4 * qblk - 1, 0, 120) + 8; if ((thi - tlo) & 1) { if (thi < 128) ++thi; else --tlo; }
                    const size_t lo = lat0 + (size_t)tlo * 64 * PRJW;
                    ga_body::attn_unit<8, 2>(qblk, P + lat0 + C_NAQ + hq * 64, P + lo + C_NAK + hq * 64, P + lo + C_NAV + hq * 64, P + ctx0 + C_NAK + hq * 64, P + ctx0 + C_NAV + hq * 64,
                                             O + hq * 64, (char*)F.lds, F.tid, 4 + thi - tlo, tlo, 0.f, F.in[I_RPB] + ((size_t)l * 8 + hq) * 465);
                }
            }
            {
                const Frame F = launder(F0);
                for (int u = F.vcu; u < 1024; u += F.G) {
                    const int v = u & 1023, qblk = v & 31, b = v >> 8, hg = (v >> 5) & 3, kvh = (v >> 7) & 1, hq = kvh * 4 + hg;
                    const ga_body::bf16* P = (const ga_body::bf16*)(F.ws + WS_PRJ); const size_t lat0 = (size_t)(b * SEQ) * PRJW, ctx0 = (size_t)(NLAT + b * CTXL) * PRJW;
                    ga_body::bf16* O = (ga_body::bf16*)(F.ws + WS_OC) + (size_t)(b * SEQ) * OCW;
                    const int tlo = 4 * qblk - 2 < 0 ? 0 : 4 * qblk - 2, thi = 4 * qblk + 6 > 128 ? 128 : 4 * qblk + 6; const size_t lo = lat0 + (size_t)tlo * 64 * PRJW;
                    ga_body::attn_unit<8, 1>(qblk, P + lat0 + C_SWQ + hq * 64, P + lo + C_SWK + kvh * 64, P + lo + C_SWV + kvh * 64, P + ctx0 + C_SWK + kvh * 64, P + ctx0 + C_SWV + kvh * 64,
                                             O + 512 + hq * 64, (char*)F.lds, F.tid, 4 + thi - tlo, tlo, F.in[I_SINK][l * 8 + hq] * LOG2E, nullptr);
                }
            }
            if (with_ctx) {
                const Frame F = launder(F0);
                for (int u = F.vcu; u < 96; u += F.G) {
                    const int mode = u >> 5, b = (u >> 3) & 3, hq = u & 7, kvh = mode == 0 ? hq : (hq >> 2);
                    const int qc = mode == 0 ? C_NAQ : (mode == 1 ? C_SWQ : C_GAQ), kc = mode == 0 ? C_NAK : (mode == 1 ? C_SWK : C_GAK), vc = mode == 0 ? C_NAV : (mode == 1 ? C_SWV : C_GAV), oc = mode == 0 ? 0 : (mode == 1 ? 512 : 1024);
                    const ga_body::bf16* P = (const ga_body::bf16*)(F.ws + WS_PRJ); const size_t ctx0 = (size_t)(NLAT + b * CTXL) * PRJW;
                    ga_body::bf16* O = (ga_body::bf16*)(F.ws + WS_OC) + (size_t)(NLAT + b * CTXL) * OCW + oc + hq * 64;
                    const ga_body::bf16* K = P + ctx0 + kc + kvh * 64; const ga_body::bf16* V = P + ctx0 + vc + kvh * 64;
                    if (mode == 1) ga_body::attn_unit<8, 1>(0, P + ctx0 + qc + hq * 64, K, V, K, V, O, (char*)F.lds, F.tid, 4, 0, F.in[I_SINK][l * 8 + hq] * LOG2E, nullptr);
                    else ga_body::attn_unit<8, 0>(0, P + ctx0 + qc + hq * 64, K, V, K, V, O, (char*)F.lds, F.tid, 4, 0, 0.f, nullptr);
                }
            }
            const Frame Fb = launder(F0);
            for (int u = Fb.vcu; u < n_s3; u += Fb.G) { const Frame& F = Fb;
                const int hd = u & 7, cc = (u >> 3) % nchs, b = (u >> 3) / nchs; ssd_s3_unit(F, l, b, with_ctx ? cc : cc + 2, hd);
            }
            }
        }
        SEAM(pb + 3);
        if (PHM(4) && IN(pb + 4)) { const Frame F = launder(F0);
            pg8::SchedBranch S; S.rep = REPB(4); S.T = mtiles * 8; S.G = F.G; S.c = F.vcu; S.A = (const char*)(F.ws + WS_OC); S.B = (const char*)(F.ws + WS_WB + l * SZ_WB);
            pg8::EpiBranch E{WSP(bf16_t, WS_GT), WSP(float, WS_SSQ), WSP(bf16_t, WS_PRJ)};
            pg8::gemm_phase<pg8::EpiBranch, pg8::SchedBranch, true>(F.lds, F.tid, 512, OCW, 512, S, E);
        }
        SEAM(pb + 4);
        if (PHM(5) && IN(pb + 5)) { const Frame F = launder(F0);
            pg8::SchedGrid S; S.nMa = mtiles; S.nNa = 4; S.nMb = 0; S.nNb = 1; S.total = S.nMa * S.nNa; S.G = F.G; S.c = F.bx;
            S.A = (const char*)(F.ws + WS_PRJ); S.B = (const char*)(F.ws + WS_WO + l * SZ_WO); S.lda = DM; S.ldb = DM; S.a_div = 1; S.a_cols = 0; S.pe = nullptr; S.estride = 0; S.rep = REPB(5);
            pg8::EpiResid E{WSP(bf16_t, WS_XS), WSP(float, WS_MVEC) + (size_t)l * 5 * 6144 + 2048, nullptr, WSP(bf16_t, WS_END)};
            pg8::gemm_phase(F.lds, F.tid, DM, DM, DM, S, E);
        }
        SEAM(pb + 5);
        if (PHM(6) && IN(pb + 6)) { const Frame F = launder(F0); phase_ln1(F, l, mrows); }
        SEAM(pb + 6);
        if (moe) { if (PHM(7) && IN(pb + 7)) { const Frame F = launder(F0); phase_gather(F, l, mrows); } SEAM(pb + 7); }
        if (PHM(8) && IN(pb + 8)) { const Frame F = launder(F0);
            pg8::SchedGrid S; S.rep = REPB(8); S.nMb = 0; S.nNb = 1; S.G = F.G; S.c = F.bx; S.lda = DM; S.ldb = DM; S.a_div = 1; S.a_cols = 0; S.pe = nullptr; S.estride = 0; int ldh;
            if (!moe) { S.nMa = mtiles; S.nNa = DFF / 128; S.A = (const char*)(F.ws + WS_HB); S.B = (const char*)(F.ws + WS_WUP + fi * SZ_WUP); ldh = DFF; }
            else { const int npad = moe_pad_ends_lds(F, fi); S.pe = (const LAS int*)(F.lds + MISC_OFF + 64); S.nMa = npad / 256; S.nNa = DFFE / 128;
                   S.A = (const char*)(F.ws + WS_XPAD); S.B = (const char*)(F.ws + WS_MUP + fi * SZ_MUP); S.estride = (size_t)2 * DFFE * DM * 2; ldh = DFFE; }
            S.total = S.nMa * S.nNa;
            pg8::EpiSwiGLU E{WSP(bf16_t, WS_HID), ldh};
            pg8::gemm_phase(F.lds, F.tid, DM, DM, DM, S, E);
        }
        SEAM(pb + 8);
        if (PHM(9) && IN(pb + 9)) { const Frame F = launder(F0);
            pg8::SchedGrid S; S.rep = REPB(9); S.nMb = 0; S.nNb = 1; S.nNa = 4; S.G = F.G; S.c = F.bx; S.a_div = 1; S.a_cols = 0; S.pe = nullptr; S.estride = 0; S.A = (const char*)(F.ws + WS_HID);
            pg8::EpiResid E{WSP(bf16_t, WS_XS), WSP(float, WS_MVEC) + (size_t)l * 5 * 6144 + 5120, nullptr, WSP(bf16_t, WS_END)};
            int kk;
            if (!moe) { S.nMa = mtiles; S.B = (const char*)(F.ws + WS_WDN + fi * SZ_WDN); kk = DFF; }
            else { const int npad = moe_pad_ends_lds(F, fi); S.pe = (const LAS int*)(F.lds + MISC_OFF + 64); S.nMa = npad / 256; S.B = (const char*)(F.ws + WS_MDN + fi * SZ_MDN); S.estride = (size_t)DM * DFFE * 2; kk = DFFE; E.plainO = WSP(bf16_t, WS_YPAD); }
            S.lda = kk; S.ldb = kk; S.total = S.nMa * S.nNa;
            pg8::gemm_phase(F.lds, F.tid, kk, kk, kk, S, E);
        }
        SEAM(pb + 9);
        if (PHM(10) && IN(pb + 10)) { const Frame F = launder(F0); phase_ln2(F, l, mrows); }
        if (l + 1 < DEPTH) SEAM(pb + 10);
    }
#undef IN
#undef SEAM
}

extern "C" void kernel_launch(void* const* d_in, const int* in_sizes, int n_in, void* d_out, int out_size, void* d_ws, size_t ws_size, hipStream_t stream) {
    static int grid = 0;
    if (grid == 0) {
        if (n_in != 31 || in_sizes[0] != NLAT * DM || out_size != NLAT * DM || ws_size < WS_END) {
            fprintf(stderr, "kernel_launch: unexpected shapes: n_in %d in0 %d out %d ws %zu (need %zu); nothing launched\n", n_in, n_in > 0 ? in_sizes[0] : -1, out_size, ws_size, (size_t)WS_END); grid = -1; return; }
        int dev = 0, cus = 0, per_cu = 0;
        if (hipGetDevice(&dev) != hipSuccess || hipDeviceGetAttribute(&cus, hipDeviceAttributeMultiprocessorCount, dev) != hipSuccess) { fprintf(stderr, "kernel_launch: device query failed\n"); grid = -1; return; }
        if (hipFuncSetAttribute((const void*)fwd_kernel, hipFuncAttributeMaxDynamicSharedMemorySize, LDS_BYTES) != hipSuccess) { fprintf(stderr, "kernel_launch: hipFuncSetAttribute failed\n"); grid = -1; return; }
        if (hipOccupancyMaxActiveBlocksPerMultiprocessor(&per_cu, (const void*)fwd_kernel, NTHR, LDS_BYTES) != hipSuccess || per_cu < 1)
            fprintf(stderr, "kernel_launch: note: occupancy query reports %d workgroups per CU\n", per_cu);
        (void)hipGetLastError();
        grid = cus;
    }
    if (grid < 0) return;
    if (hipMemsetAsync((char*)d_ws + WS_CTL, 0, CTL_ZERO_BYTES, stream) != hipSuccess) { fprintf(stderr, "kernel_launch: memset failed\n"); return; }
    Args a{};
    for (int i = 0; i < 31; ++i) a.in[i] = (const float*)d_in[i];
    a.out = (float*)d_out; a.ws = (unsigned char*)d_ws;
#if MK_PER_PHASE
    for (int p = 0; p < N_PHASES; ++p) { a.ph_lo = p; a.ph_hi = p + 1; hipLaunchKernelGGL(fwd_kernel, dim3(grid), dim3(NTHR), LDS_BYTES, stream, a); }
#else
    a.ph_lo = 0; a.ph_hi = N_PHASES;
    hipLaunchKernelGGL(fwd_kernel, dim3(grid), dim3(NTHR), LDS_BYTES, stream, a);
#endif
    const hipError_t le = hipPeekAtLastError();
    if (le != hipSuccess) fprintf(stderr, "kernel_launch: launch failed: %s\n", hipGetErrorName(le));
}
```

```cpp
#include <hip/hip_runtime.h>
#include <cstdio>
#include <cstdint>
#include <hip/hip_bf16.h>
#include <cmath>

#define DI __device__ __forceinline__
#define LAS __attribute__((address_space(3)))
#define GAS __attribute__((address_space(1)))
typedef unsigned short bf16_t;
typedef short bf16x8 __attribute__((ext_vector_type(8)));
typedef short s16x4 __attribute__((ext_vector_type(4)));
typedef float f32x2 __attribute__((ext_vector_type(2)));
typedef float f32x4 __attribute__((ext_vector_type(4)));
typedef float f32x16 __attribute__((ext_vector_type(16)));
typedef unsigned u32x2 __attribute__((ext_vector_type(2)));
typedef unsigned u32x4 __attribute__((ext_vector_type(4)));
typedef __bf16 bf16x2_t __attribute__((ext_vector_type(2)));
typedef GAS unsigned gu32;
typedef int v8i32_t __attribute__((ext_vector_type(8)));
typedef short bf16x16 __attribute__((ext_vector_type(16)));

#ifndef MK_PER_PHASE
#define MK_PER_PHASE 0
#endif
#ifndef PHMASK
#define PHMASK 0xFFFF
#endif
#define PHM(k) ((PHMASK >> (k)) & 1)
#ifndef REP_MASK
#define REP_MASK 0
#endif
#define REPB(k) ((REP_MASK >> (k)) & 1)
#ifndef ABL
#define ABL 0
#endif

constexpr int DM = 1024, NB = 4, SEQ = 8192, CTXL = 256, NLAT = NB * SEQ, NCTX = NB * CTXL, MTOT = NLAT + NCTX;
constexpr int DEPTH = 4, DIN = 4624, PRJW = 4608, GTW = 4096, NCOMB = PRJW + GTW, OCW = 2048;
constexpr int DFF = 2816, DFFE = 3584, NEXP = 8, MOE_ROWS_MAX = 69632;
constexpr int NCH = 66;
constexpr float ALPHA = 1.6817928305074292f;
constexpr float LOG2E = 1.4426950408889634f;
constexpr float C2 = 0.125f * LOG2E;
constexpr float LN_EPS = 1e-5f, RMS_EPS = 1e-6f;
constexpr float MOE_UP_WSCALE = 32.f, MOE_DN_WSCALE = 128.f; constexpr int MOE_UP_SCA = 0x7A7A7A7A, MOE_DN_SCA = 0x78787878;
constexpr int C_NAQ = 0, C_NAK = 512, C_NAV = 1024, C_SWQ = 1536, C_SWK = 2048, C_SWV = 2176, C_GAQ = 2304, C_GAK = 2816, C_GAV = 2944, C_Z = 3072, C_XBC = 3584;

constexpr size_t KiB = 1024, MiB = 1u << 20;
constexpr size_t WS_CTL = 0, CTL_ZERO_BYTES = 1 * MiB;
constexpr size_t WS_MVEC = 1 * MiB;
constexpr size_t WS_ROPE = WS_MVEC + 512 * KiB;
constexpr size_t WS_DT = 4 * MiB;
constexpr size_t WS_SSQ = WS_DT + (size_t)MTOT * 16 * 4;
constexpr size_t WS_SLOT = WS_SSQ + (size_t)MTOT * 8 * 4;
constexpr size_t WS_CDEC = WS_SLOT + (size_t)MTOT * 8 * 4;
constexpr size_t WS_W = 10 * MiB;
constexpr size_t SZ_WCOMB = (size_t)NCOMB * DM * 2, SZ_WB = (size_t)4096 * 512 * 2, SZ_WO = (size_t)1024 * 4096 * 2;
constexpr size_t SZ_WUP = (size_t)2 * DFF * DM * 2, SZ_WDN = (size_t)DM * DFF * 2, SZ_MUP = (size_t)NEXP * 2 * DFFE * DM * 2, SZ_MDN = (size_t)NEXP * DM * DFFE * 2;
constexpr size_t WS_WCOMB = WS_W, WS_WB = WS_WCOMB + 4 * SZ_WCOMB, WS_WO = WS_WB + 4 * SZ_WB, WS_WUP = WS_WO + 4 * SZ_WO, WS_WDN = WS_WUP + 2 * SZ_WUP,
                 WS_MUP = WS_WDN + 2 * SZ_WDN, WS_MDN = WS_MUP + 2 * SZ_MUP, WS_WEND = WS_MDN + 2 * SZ_MDN;
constexpr size_t WS_XS = (WS_WEND + 255) & ~(size_t)255;
constexpr size_t WS_HB = WS_XS + (size_t)MTOT * DM * 4;
constexpr size_t WS_U = WS_HB + (size_t)MTOT * DM * 2;
constexpr size_t WS_PRJ = WS_U;
constexpr size_t WS_GT = WS_PRJ + (size_t)MTOT * PRJW * 2;
constexpr size_t WS_OC = WS_GT + (size_t)MTOT * GTW * 2;
constexpr size_t WS_ST = WS_OC + (size_t)MTOT * OCW * 2;
constexpr size_t WS_UEND = WS_ST + (size_t)NB * NCH * 16 * 8192 * 4;
constexpr size_t WS_HID = WS_U;
constexpr size_t WS_XPAD = WS_HID + (size_t)MOE_ROWS_MAX * DFFE * 2;
constexpr size_t WS_YPAD = WS_XPAD + (size_t)MOE_ROWS_MAX * DM * 2;
static_assert(WS_YPAD + (size_t)MOE_ROWS_MAX * DM * 2 <= WS_UEND, "FFN overlay fits the union region");
constexpr size_t WS_END = WS_UEND;
constexpr int CW_BAR = 4096, CW_MOECNT = 16384;

constexpr int RING_BYTES = 131072, MISC_OFF = RING_BYTES + 320, LDS_BYTES = 147456;
constexpr int NWAVES = 8, NTHR = 512;

DI unsigned pk2(float lo, float hi) { f32x2 v = {lo, hi}; bf16x2_t b = __builtin_convertvector(v, bf16x2_t); return __builtin_bit_cast(unsigned, b); }
DI float bflo(unsigned u) { return __uint_as_float(u << 16); }
DI float bfhi(unsigned u) { return __uint_as_float(u & 0xffff0000u); }
DI f32x4 ld4bf(const bf16_t* p) { const u32x2 u = *(const u32x2*)p; return (f32x4){bflo(u.x), bfhi(u.x), bflo(u.y), bfhi(u.y)}; }
DI void st4bf(bf16_t* p, const f32x4 v) { u32x2 w; w.x = pk2(v[0], v[1]); w.y = pk2(v[2], v[3]); *(u32x2*)p = w; }
DI unsigned pk4_fp8(float a, float b, float c, float d) { int w = 0; w = __builtin_amdgcn_cvt_pk_fp8_f32(a, b, w, false); w = __builtin_amdgcn_cvt_pk_fp8_f32(c, d, w, true); return (unsigned)w; }
DI float sigm(float x) { return __builtin_amdgcn_rcpf(1.f + __expf(-x)); }
DI float silu(float x) { return x * sigm(x); }
DI float wave_sum(float v) {
#pragma unroll
    for (int o = 1; o < 64; o <<= 1) v += __shfl_xor(v, o);
    return v;
}
DI int clampi(int v, int lo, int hi) { return v < lo ? lo : (v > hi ? hi : v); }
#define MFMA32(a, b, c) __builtin_amdgcn_mfma_f32_32x32x16_bf16((a), (b), (c), 0, 0, 0)
DI int crow(int reg, int h) { return (reg & 3) + 8 * (reg >> 2) + 4 * h; }
typedef short v4i16_t __attribute__((ext_vector_type(4)));
DI s16x4 tr_read(const LAS unsigned char* p) { return __builtin_bit_cast(s16x4, __builtin_amdgcn_ds_read_tr16_b64_v4i16((LAS v4i16_t*)p)); }
DI bf16x8 cat8(s16x4 lo, s16x4 hi) { return __builtin_shufflevector(lo, hi, 0, 1, 2, 3, 4, 5, 6, 7); }
template <int S> DI bf16x8 pack8(const f32x16& x) {
    u32x4 w; w.x = pk2(x[8 * S], x[8 * S + 1]); w.y = pk2(x[8 * S + 2], x[8 * S + 3]); w.z = pk2(x[8 * S + 4], x[8 * S + 5]); w.w = pk2(x[8 * S + 6], x[8 * S + 7]);
    return __builtin_bit_cast(bf16x8, w);
}

#define XB_TMO      128
#define XB_XCNT(j)  (256  + 64 * (j))
#define XB_XSUB(j)  (1280 + 64 * (j))
#define XB_XGEN(j)  (2304 + 64 * (j))
#define XB_TOP      3328
#define XB_TOPGEN   3392
#define XCD_BAR_WORDS 3456
#define XB_SPIN_CAP (1u << 18)
DI unsigned xb_ld(unsigned* p)              { return __hip_atomic_load(p, __ATOMIC_RELAXED, __HIP_MEMORY_SCOPE_AGENT); }
DI unsigned xb_add(unsigned* p, unsigned v) { return __hip_atomic_fetch_add(p, v, __ATOMIC_RELAXED, __HIP_MEMORY_SCOPE_AGENT); }
DI unsigned xb_xcc_id() { return (unsigned)__builtin_amdgcn_s_getreg((3 << 11) | 20) & 0xFu; }
#define XB_SPIN(cond, bar) do { unsigned _sp = 0; while (cond) { __builtin_amdgcn_s_sleep(1); \
    if ((++_sp & 255u) == 0u) { if (xb_ld(&(bar)[XB_TMO])) break; if (_sp > XB_SPIN_CAP) { atomicAdd(&(bar)[XB_TMO], 1u); break; } } } } while (0)
struct XcdBarrier { unsigned* bar; unsigned x; volatile LAS unsigned* st; };
DI XcdBarrier xcd_barrier_post(unsigned* bar, volatile LAS unsigned* st) {
    XcdBarrier b; b.bar = bar; b.x = xb_xcc_id(); b.st = st;
    if (threadIdx.x == 0) (void)xb_add(&bar[XB_XCNT(b.x)], 1u);
    return b;
}
DI void xcd_barrier_complete(unsigned* bar, unsigned x, unsigned& nloc, unsigned& nx) {
    const unsigned G = gridDim.x * gridDim.y * gridDim.z;
    unsigned sum, cnt, mine, sp = 0u;
    for (;;) {
        sum = 0u; cnt = 0u; mine = 0u;
#pragma unroll
        for (unsigned j = 0; j < 16; ++j) { const unsigned c = xb_ld(&bar[XB_XCNT(j)]); sum += c; cnt += (c > 0u) ? 1u : 0u; mine = (j == x) ? c : mine; }
        if (sum == G) break;
        __builtin_amdgcn_s_sleep(1);
        if ((++sp & 255u) == 0u) { if (xb_ld(&bar[XB_TMO])) break; if (sp > XB_SPIN_CAP) { atomicAdd(&bar[XB_TMO], 1u); break; } }
    }
    nloc = mine > 0u ? mine : 1u; nx = cnt > 0u ? cnt : 1u;
}
DI void xcd_barrier(const XcdBarrier& b) {
    asm volatile("s_waitcnt vmcnt(0)" ::: "memory");
    __syncthreads();
    if (threadIdx.x == 0) {
        unsigned* bar = b.bar;
        __builtin_amdgcn_s_waitcnt(0);
        unsigned nloc = b.st[0], nx = b.st[1];
        if (nloc == 0u) { xcd_barrier_complete(bar, b.x, nloc, nx); b.st[0] = nloc; b.st[1] = nx; }
        const unsigned old = xb_add(&bar[XB_XSUB(b.x)], 1u);
        const unsigned gen = old / nloc;
        if (old + 1u == (gen + 1u) * nloc) {
            __builtin_amdgcn_fence(__ATOMIC_RELEASE, "agent");
            asm volatile("s_waitcnt vmcnt(0)" ::: "memory");
            const unsigned og = xb_add(&bar[XB_TOP], 1u);
            const unsigned tg = og / nx;
            if (og + 1u == (tg + 1u) * nx) xb_add(&bar[XB_TOPGEN], 1u);
            else XB_SPIN(xb_ld(&bar[XB_TOPGEN]) == tg, bar);
            __builtin_amdgcn_fence(__ATOMIC_ACQUIRE, "agent");
            xb_add(&bar[XB_XGEN(b.x)], 1u);
            asm volatile("s_waitcnt vmcnt(0)" ::: "memory");
        } else {
            XB_SPIN(xb_ld(&bar[XB_XGEN(b.x)]) == gen, bar);
            __builtin_amdgcn_fence(__ATOMIC_ACQUIRE, "agent");
            asm volatile("s_waitcnt vmcnt(0)" ::: "memory");
        }
    }
    __syncthreads();
}

namespace pg8 {
constexpr int BM = 256, BK = 64, HALF = 128, HTB = HALF * BK * 2, STAGE_BYTES = 8 * HTB;
__host__ __device__ __forceinline__ int lds_byte(int r, int c) { const int st = (r >> 4) * 2 + (c >> 5), rr = r & 15, cc = c & 31, ob = rr * 64 + cc * 2; return st * 1024 + (ob ^ (((ob >> 9) & 1) << 5)); }
__host__ __device__ __forceinline__ void stage_rc(int b, int& R, int& C) { const int st = b / 1024, sb = b % 1024, swz = sb ^ (((sb >> 9) & 1) << 5); R = (st >> 1) * 16 + swz / 64; C = (st & 1) * 32 + (swz % 64) / 2; }
__host__ __device__ __forceinline__ int perm32(int rho) { const int n = rho >> 4, i = rho & 15; return 8 * (i >> 2) + 4 * n + (i & 3); }
struct Unit { int pm, pn, dup; const char* A; const char* B; };

template <class Epi, class Sched, bool HM = false, bool FP8 = false>
DI void gemm_phase(LAS unsigned char* lds, const int tid, const int K, const int lda, const int ldb, const Sched& S, const Epi& E, const int sca = 0x7F7F7F7F) {
    const int wid = __builtin_amdgcn_readfirstlane(tid >> 6), lane = tid & 63, wr = wid >> 2, wc = wid & 3, fr = lane & 15, fq = lane >> 4;
    const int nt = K / BK;
    int scaw = sca, scax = 0x7F7F7F7F; if constexpr (FP8) { asm volatile("" : "+v"(scaw), "+v"(scax)); }
    unsigned voffA[2], voffB[2];
#pragma unroll
    for (int i = 0; i < 2; ++i) { int R, C; stage_rc(tid * 16 + i * 8192, R, C); const int Rb = (R & ~31) + perm32(R & 31);
        voffA[i] = (unsigned)(R * lda + C) * 2u; voffB[i] = (unsigned)(Rb * ldb + C) * 2u; }
    const size_t kstep = (size_t)(BK * 2);
    const size_t hstepA = (size_t)HALF * lda * 2, hstepB = (size_t)HALF * ldb * 2;
    const unsigned ldsw = (unsigned)wid * 1024u;
    const int aoff = lds_byte(wr * 64 + fr, fq * 8), boff = lds_byte(wc * 32 + fr, fq * 8);
#define PG8_SA(b, h) (((b) * 2 + (h)) * HTB)
#define PG8_SB(b, h) ((4 + (b) * 2 + (h)) * HTB)
#define PG8_STAGE(bufoff, gbase, voff) do { _Pragma("unroll") for (int _i = 0; _i < 2; ++_i) \
        __builtin_amdgcn_global_load_lds((const unsigned*)((const char*)(gbase) + (voff)[_i]), (LAS unsigned*)(lds + (bufoff) + ldsw + _i * 8192), 16, 0, 0); } while (0)
#define PG8_LDA(dst, b, h) do { _Pragma("unroll") for (int m = 0; m < 4; ++m) _Pragma("unroll") for (int k = 0; k < 2; ++k) dst[m][k] = *(const LAS bf16x8*)(lds + PG8_SA(b, h) + aoff + m * 2048 + k * 1024); } while (0)
#define PG8_LDB(dst, b, h) do { _Pragma("unroll") for (int n = 0; n < 2; ++n) _Pragma("unroll") for (int k = 0; k < 2; ++k) dst[n][k] = *(const LAS bf16x8*)(lds + PG8_SB(b, h) + boff + n * 2048 + k * 1024); } while (0)
#define PG8_CAT8(x) __builtin_bit_cast(v8i32_t, __builtin_shufflevector(__builtin_bit_cast(u32x4, (x)[0]), __builtin_bit_cast(u32x4, (x)[1]), 0, 1, 2, 3, 4, 5, 6, 7))
#define PG8_MMA(ai, bj, At, Bt) do { __builtin_amdgcn_s_setprio(1); \
        if constexpr (FP8) { _Pragma("unroll") for (int m = 0; m < 4; ++m) _Pragma("unroll") for (int n = 0; n < 2; ++n) \
            asm volatile("v_mfma_scale_f32_16x16x128_f8f6f4 %0, %1, %2, %0, %3, %4 op_sel_hi:[0,0,0]" : "+v"(acc[ai][bj][m][n]) : "v"(PG8_CAT8(Bt[n])), "v"(PG8_CAT8(At[m])), "v"(scaw), "v"(scax)); } \
        else { _Pragma("unroll") for (int m = 0; m < 4; ++m) _Pragma("unroll") for (int n = 0; n < 2; ++n) _Pragma("unroll") for (int k = 0; k < 2; ++k) \
            acc[ai][bj][m][n] = __builtin_amdgcn_mfma_f32_16x16x32_bf16(Bt[n][k], At[m][k], acc[ai][bj][m][n], 0, 0, 0); } \
        __builtin_amdgcn_s_setprio(0); } while (0)
#define PG8_WAIT_V(n) asm volatile("s_waitcnt vmcnt(" #n ")" ::: "memory")
#define PG8_WAIT_L(n) asm volatile("s_waitcnt lgkmcnt(" #n ")" ::: "memory")
#define PG8_BAR __builtin_amdgcn_s_barrier()
#define PG8_SCHED __builtin_amdgcn_sched_barrier(0)
    Unit cur, nxt; int ui = 0;
    if (!S.next(0, cur)) return;
    f32x4 acc[2][2][4][2];
#pragma unroll
    for (int a = 0; a < 2; ++a)
#pragma unroll
        for (int b = 0; b < 2; ++b)
#pragma unroll
            for (int m = 0; m < 4; ++m)
#pragma unroll
                for (int n = 0; n < 2; ++n) acc[a][b][m][n] = (f32x4){0.f, 0.f, 0.f, 0.f};
    bf16x8 At[4][2], B0[2][2], B1[2][2];
    const char* cA = cur.A; const char* cB = cur.B;
    PG8_STAGE(PG8_SB(0, 0), cB, voffB); PG8_STAGE(PG8_SB(0, 1), cB + hstepB, voffB); PG8_STAGE(PG8_SA(0, 0), cA, voffA); PG8_STAGE(PG8_SA(0, 1), cA + hstepA, voffA);
    if (wr == 1) PG8_BAR;
    PG8_WAIT_V(2); PG8_BAR;
    PG8_STAGE(PG8_SB(1, 0), cB + kstep, voffB); PG8_STAGE(PG8_SA(1, 0), cA + kstep, voffA); PG8_STAGE(PG8_SB(1, 1), cB + hstepB + kstep, voffB);
    PG8_WAIT_V(6); PG8_BAR;
    for (;;) {
        const bool has_next = S.next(ui + 1, nxt);
        const char* nA = has_next ? nxt.A : cA; const char* nB = has_next ? nxt.B : cB;
        _Pragma("nounroll") for (int t = 0; t < nt; t += 2) {
            const bool last = (t == nt - 2);
            const char* a1 = cA + (size_t)(t + 1) * kstep;
            const char* a2 = last ? nA : cA + (size_t)(t + 2) * kstep; const char* b2 = last ? nB : cB + (size_t)(t + 2) * kstep;
            const char* a3 = a2 + kstep; const char* b3 = b2 + kstep;
            PG8_LDB(B0, 0, 0); PG8_LDB(B1, 0, 1); PG8_SCHED; PG8_LDA(At, 0, 0); PG8_STAGE(PG8_SA(1, 1), a1 + hstepA, voffA);
            PG8_WAIT_V(8); PG8_WAIT_L(0); PG8_BAR; PG8_MMA(0, 0, At, B0); PG8_MMA(0, 1, At, B1); PG8_BAR; PG8_SCHED;
            PG8_LDA(At, 0, 1); PG8_STAGE(PG8_SB(0, 0), b2, voffB); PG8_STAGE(PG8_SB(0, 1), b2 + hstepB, voffB); PG8_STAGE(PG8_SA(0, 0), a2, voffA);
            PG8_WAIT_V(8); PG8_WAIT_L(0); PG8_BAR; if constexpr (!HM) { PG8_MMA(1, 0, At, B0); PG8_MMA(1, 1, At, B1); } PG8_BAR; PG8_SCHED;
            PG8_LDB(B0, 1, 0); PG8_LDB(B1, 1, 1); PG8_SCHED; PG8_LDA(At, 1, 0); PG8_STAGE(PG8_SA(0, 1), a2 + hstepA, voffA);
            PG8_WAIT_V(8); PG8_WAIT_L(0); PG8_BAR; PG8_MMA(0, 0, At, B0); PG8_MMA(0, 1, At, B1); PG8_BAR; PG8_SCHED;
            PG8_LDA(At, 1, 1); PG8_STAGE(PG8_SB(1, 0), b3, voffB); PG8_STAGE(PG8_SB(1, 1), b3 + hstepB, voffB); PG8_STAGE(PG8_SA(1, 0), a3, voffA);
            PG8_WAIT_V(8); PG8_WAIT_L(0); PG8_BAR; if constexpr (!HM) { PG8_MMA(1, 0, At, B0); PG8_MMA(1, 1, At, B1); } PG8_BAR; PG8_SCHED;
        }
        if (wr == 0) PG8_BAR;
        if constexpr (FP8) asm volatile("s_nop 7\n\ts_nop 7\n\ts_nop 7" ::: "memory");
        E(acc, cur, wr, wc, fr, fq);
        if (!has_next) break;
#pragma unroll
        for (int a = 0; a < (HM ? 1 : 2); ++a)
#pragma unroll
            for (int b = 0; b < 2; ++b)
#pragma unroll
                for (int m = 0; m < 4; ++m)
#pragma unroll
                    for (int n = 0; n < 2; ++n) acc[a][b][m][n] = (f32x4){0.f, 0.f, 0.f, 0.f};
        cur = nxt; cA = nA; cB = nB; ++ui;
        if (wr == 1) PG8_BAR;
    }
    PG8_WAIT_V(0);
    PG8_BAR;
#undef PG8_SA
#undef PG8_SB
#undef PG8_STAGE
#undef PG8_LDA
#undef PG8_LDB
#undef PG8_MMA
#undef PG8_CAT8
#undef PG8_WAIT_V
#undef PG8_WAIT_L
#undef PG8_BAR
#undef PG8_SCHED
}

struct SchedGrid {
    int nMa, nNa, nMb, nNb, total, G, c; const char* A; const char* B; int lda, ldb, a_div, a_cols; const LAS int* pe; size_t estride; int rep;
    DI bool next(int i, Unit& u) const {
        const long L = (long)(i >> rep) * G + c; if (L >= total) return false;
        u.dup = i & rep;
        const int La = nMa * nNa; int pm, pn;
        if (L < La) {
            int wgid = (int)L;
            if ((G & 7) == 0) { const int q = La >> 3, r = La & 7, xcd = wgid & 7, off = wgid >> 3; wgid = (xcd < r ? xcd * (q + 1) : r * (q + 1) + (xcd - r) * q) + off; }
            const int nig = 8 * nNa, gid = wgid / nig, fm = gid * 8, gsz = (nMa - fm) < 8 ? (nMa - fm) : 8, w = wgid - gid * nig;
            pm = fm + w % gsz; pn = w / gsz;
        } else { const int r = (int)L - La; pm = nMa + r / nNb; pn = r % nNb; }
        size_t eoff = 0;
        if (pe) { int e = 0;
#pragma unroll
            for (int j = 0; j < 7; ++j) e += (pe[j] <= pm * 256) ? 1 : 0;
            eoff = (size_t)__builtin_amdgcn_readfirstlane(e) * estride; }
        u.pm = pm; u.pn = pn; u.A = A + ((size_t)pm * 256 * lda + (size_t)(pn / a_div) * a_cols) * 2; u.B = B + eoff + (size_t)pn * 256 * ldb * 2; return true;
    }
};
struct SchedBranch {
    int T, G, c; const char* A; const char* B; int rep;
    DI bool next(int n, Unit& u) const {
        const int tile = c + (n >> (2 + rep)) * G; if (tile >= T) return false;
        const int i = n & 3, pm = tile >> 2, pc = tile & 3;
        u.dup = 0; u.pm = pm; u.pn = i * 4 + pc; u.A = A + ((size_t)pm * 128 * OCW + (size_t)i * 512) * 2; u.B = B + (size_t)(i * 1024 + pc * 256) * 512 * 2; return true;
    }
};
struct EpiInGate {
    bf16_t* PRJ; bf16_t* GT; const float* bg;
    DI void operator()(f32x4 (&acc)[2][2][4][2], const Unit& u, int wr, int wc, int fr, int fq) const {
        const int row0 = u.pm * BM + wr * 64 + fr; const bool sg = u.pn >= 18;
        bf16_t* base = sg ? GT : PRJ; const int ldc = sg ? GTW : PRJW; const int col0 = (sg ? (u.pn - 18) : u.pn) * BM + wc * 32 + 8 * fq;
        f32x4 bv[2][2];
#pragma unroll
        for (int bj = 0; bj < 2; ++bj)
#pragma unroll
            for (int n = 0; n < 2; ++n) bv[bj][n] = sg ? *(const f32x4*)(bg + col0 + bj * HALF + 4 * n) : (f32x4){0.f, 0.f, 0.f, 0.f};
#pragma unroll
        for (int ai = 0; ai < 2; ++ai)
#pragma unroll
            for (int m = 0; m < 4; ++m) { bf16_t* rowp = base + (size_t)(row0 + ai * HALF + m * 16) * ldc + col0;
#pragma unroll
                for (int bj = 0; bj < 2; ++bj) { f32x4 v0 = acc[ai][bj][m][0] + bv[bj][0], v1 = acc[ai][bj][m][1] + bv[bj][1];
                    if (sg) { v0 = (f32x4){sigm(v0[0]), sigm(v0[1]), sigm(v0[2]), sigm(v0[3])}; v1 = (f32x4){sigm(v1[0]), sigm(v1[1]), sigm(v1[2]), sigm(v1[3])}; }
                    u32x4 w; w.x = pk2(v0[0], v0[1]); w.y = pk2(v0[2], v0[3]); w.z = pk2(v1[0], v1[1]); w.w = pk2(v1[2], v1[3]);
                    *(u32x4*)(rowp + bj * HALF) = w; } }
    }
};
struct EpiBranch {
    const bf16_t* GT; const float* SSQ; bf16_t* MRG;
    DI void operator()(f32x4 (&acc)[2][2][4][2], const Unit& u, int wr, int wc, int fr, int fq) const {
        const int i = u.pn >> 2, pc = u.pn & 3;
        const int row0 = u.pm * HALF + wr * 64 + fr; const int gcol0 = u.pn * BM + wc * 32 + 8 * fq, col0 = pc * BM + wc * 32 + 8 * fq;
#pragma unroll
        for (int mp = 0; mp < 4; ++mp) {
            u32x4 g[1][2]; float rs[1];
#pragma unroll
            for (int mm = 0; mm < 1; ++mm) { const int row = row0 + (mp + mm) * 16; const bf16_t* gp = GT + (size_t)row * GTW + gcol0;
                g[mm][0] = *(const u32x4*)gp; g[mm][1] = *(const u32x4*)(gp + HALF); rs[mm] = 1.f;
                if (i == 3) { const f32x4 s0 = *(const f32x4*)(SSQ + (size_t)row * 8), s1 = *(const f32x4*)(SSQ + (size_t)row * 8 + 4);
                    rs[mm] = __builtin_amdgcn_rsqf(((s0[0] + s0[1]) + (s0[2] + s0[3]) + (s1[0] + s1[1]) + (s1[2] + s1[3])) * (1.f / 512.f) + RMS_EPS); } }
#pragma unroll
            for (int mm = 0; mm < 1; ++mm) { const int m = mp + mm;
#pragma unroll
                for (int bj = 0; bj < 2; ++bj) { const u32x4 gg = g[mm][bj]; const f32x4 a0 = acc[0][bj][m][0] * rs[mm], a1 = acc[0][bj][m][1] * rs[mm];
                    acc[1][bj][m][0] += (f32x4){bflo(gg.x) * a0[0], bfhi(gg.x) * a0[1], bflo(gg.y) * a0[2], bfhi(gg.y) * a0[3]};
                    acc[1][bj][m][1] += (f32x4){bflo(gg.z) * a1[0], bfhi(gg.z) * a1[1], bflo(gg.w) * a1[2], bfhi(gg.w) * a1[3]}; } }
        }
        if (i == 3) {
#pragma unroll
            for (int m = 0; m < 4; ++m)
#pragma unroll
                for (int bj = 0; bj < 2; ++bj) { const f32x4 t0 = acc[1][bj][m][0], t1 = acc[1][bj][m][1];
                    u32x4 w; w.x = pk2(t0[0], t0[1]); w.y = pk2(t0[2], t0[3]); w.z = pk2(t1[0], t1[1]); w.w = pk2(t1[2], t1[3]);
                    *(u32x4*)(MRG + (size_t)(row0 + m * 16) * DM + col0 + bj * HALF) = w;
                    acc[1][bj][m][0] = (f32x4){0.f, 0.f, 0.f, 0.f}; acc[1][bj][m][1] = (f32x4){0.f, 0.f, 0.f, 0.f}; }
        }
    }
};
struct EpiResid {
    bf16_t* XS; const float* mv; bf16_t* plainO; bf16_t* dummy;
    DI void operator()(f32x4 (&acc)[2][2][4][2], const Unit& u, int wr, int wc, int fr, int fq) const {
        const int row0 = u.pm * BM + wr * 64 + fr; const int col0 = u.pn * BM + wc * 32 + 8 * fq;
        if (plainO || u.dup) { bf16_t* const po = plainO ? plainO : dummy;
#pragma unroll
            for (int ai = 0; ai < 2; ++ai)
#pragma unroll
                for (int m = 0; m < 4; ++m) { bf16_t* rowp = po + (size_t)(row0 + ai * HALF + m * 16) * DM + col0;
#pragma unroll
                    for (int bj = 0; bj < 2; ++bj) { const f32x4 v0 = acc[ai][bj][m][0], v1 = acc[ai][bj][m][1];
                        u32x4 w; w.x = pk2(v0[0], v0[1]); w.y = pk2(v0[2], v0[3]); w.z = pk2(v1[0], v1[1]); w.w = pk2(v1[2], v1[3]);
                        *(u32x4*)(rowp + bj * HALF) = w; } }
            return;
        }
        const int v = u.pm < 128 ? (u.pm >> 5) : 4;
        const float* g = mv + (size_t)v * 6144 + col0;
        f32x4 gv[2][2];
#pragma unroll
        for (int bj = 0; bj < 2; ++bj)
#pragma unroll
            for (int n = 0; n < 2; ++n) gv[bj][n] = *(const f32x4*)(g + bj * HALF + 4 * n);
#pragma unroll
        for (int ai = 0; ai < 2; ++ai)
#pragma unroll
            for (int mp = 0; mp < 2; ++mp) {
                u32x4 x[2][2];
#pragma unroll
                for (int mm = 0; mm < 2; ++mm) { const bf16_t* rowp = XS + (size_t)(row0 + ai * HALF + (2 * mp + mm) * 16) * DM + col0;
#pragma unroll
                    for (int bj = 0; bj < 2; ++bj) x[mm][bj] = *(const u32x4*)(rowp + bj * HALF); }
#pragma unroll
                for (int mm = 0; mm < 2; ++mm) { const int m = 2 * mp + mm; bf16_t* rowp = XS + (size_t)(row0 + ai * HALF + m * 16) * DM + col0;
#pragma unroll
                    for (int bj = 0; bj < 2; ++bj) { const u32x4 xx = x[mm][bj];
                        const f32x4 y0 = (f32x4){bflo(xx.x), bfhi(xx.x), bflo(xx.y), bfhi(xx.y)} * ALPHA + gv[bj][0] * acc[ai][bj][m][0];
                        const f32x4 y1 = (f32x4){bflo(xx.z), bfhi(xx.z), bflo(xx.w), bfhi(xx.w)} * ALPHA + gv[bj][1] * acc[ai][bj][m][1];
                        u32x4 w; w.x = pk2(y0[0], y0[1]); w.y = pk2(y0[2], y0[3]); w.z = pk2(y1[0], y1[1]); w.w = pk2(y1[2], y1[3]); *(u32x4*)(rowp + bj * HALF) = w; } }
            }
    }
};
template <bool F8> struct EpiSwiGLU {
    bf16_t* HID; int ldc;
    DI void operator()(f32x4 (&acc)[2][2][4][2], const Unit& u, int wr, int wc, int fr, int fq) const {
        const int row0 = u.pm * BM + wr * 64 + fr; const int col0 = u.pn * HALF + wc * 32 + 8 * fq;
#pragma unroll
        for (int ai = 0; ai < 2; ++ai)
#pragma unroll
            for (int m = 0; m < 4; ++m) {
                const f32x4 g0 = acc[ai][0][m][0], g1 = acc[ai][0][m][1], u0 = acc[ai][1][m][0], u1 = acc[ai][1][m][1];
                const float h0 = silu(g0[0]) * u0[0], h1 = silu(g0[1]) * u0[1], h2 = silu(g0[2]) * u0[2], h3 = silu(g0[3]) * u0[3];
                const float h4 = silu(g1[0]) * u1[0], h5 = silu(g1[1]) * u1[1], h6 = silu(g1[2]) * u1[2], h7 = silu(g1[3]) * u1[3];
                if constexpr (F8) { u32x2 w; w.x = pk4_fp8(h0, h1, h2, h3); w.y = pk4_fp8(h4, h5, h6, h7); *(u32x2*)((unsigned char*)HID + (size_t)(row0 + ai * HALF + m * 16) * ldc + col0) = w; }
                else { u32x4 w; w.x = pk2(h0, h1); w.y = pk2(h2, h3); w.z = pk2(h4, h5); w.w = pk2(h6, h7); *(u32x4*)(HID + (size_t)(row0 + ai * HALF + m * 16) * ldc + col0) = w; } }
    }
};
}

struct Args { const float* in[31]; float* out; unsigned char* ws; int ph_lo, ph_hi; };
enum { I_X = 0, I_C, I_CTX, I_CCTX, I_WMOD, I_BMOD, I_WIN, I_WGATE, I_BGATE, I_RPB, I_SINK, I_QGQ, I_QGK, I_CONVW, I_CONVB, I_DTB, I_ALOG, I_DSKIP, I_NORMG,
       I_WBR, I_WOUT, I_LN1G, I_LN1B, I_LN2G, I_LN2B, I_FUP, I_FDN, I_MRW, I_MRB, I_MUP, I_MDN };
struct Frame {
    LAS unsigned char* lds; gu32* ctl; int tid, lane, wave, vcu, G, bx;
    const float* const* in; float* out; unsigned char* ws;
};
#define WSP(T, off) ((T*)(F.ws + (off)))
DI Frame launder(const Frame& F0) {
    Frame F = F0;
    asm volatile("" : "+s"(F.wave), "+s"(F.vcu), "+s"(F.ws), "+s"(F.lds));
    F.lane = (int)__builtin_amdgcn_mbcnt_hi(~0u, __builtin_amdgcn_mbcnt_lo(~0u, 0u)); F.tid = F.wave * 64 + F.lane;
    asm volatile("" : "+v"(F.tid), "+v"(F.lane));
    F.ws = (unsigned char*)(GAS unsigned char*)F.ws;
    return F;
}

DI void transpose_item(const float* W, int ld, bf16_t* dst, int ldk, int koff, int map_h, int rowoff, int cscale, const float* kscale, LAS float* scr, int kb, int nb, int lane, float f8scale) {
    const int k0 = 64 * kb, n0 = 32 * nb;
    float tmp[32];
#pragma unroll
    for (int i = 0; i < 32; ++i) tmp[i] = W[(size_t)(k0 + 2 * i + (lane >> 5)) * ld + n0 + (lane & 31)];
#pragma unroll
    for (int i = 0; i < 32; ++i) scr[(2 * i + (lane >> 5)) * 33 + (lane & 31)] = tmp[i];
    asm volatile("s_waitcnt lgkmcnt(0)" ::: "memory");
    const int c = lane & 7;
    float ks[8];
#pragma unroll
    for (int e = 0; e < 8; ++e) ks[e] = kscale ? kscale[k0 + 8 * c + e] : 1.f;
#pragma unroll
    for (int j = 0; j < 4; ++j) { const int nl = (lane >> 3) + 8 * j, n = n0 + nl; const LAS float* s = scr + (8 * c) * 33 + nl;
        float cs = 1.f; if (cscale && (n < 512 || (n >= 1536 && n < 2048))) cs = C2;
        int drow;
        if (map_h == 0) drow = rowoff + n;
        else if (n < map_h) drow = rowoff + 256 * (n >> 7) + (n & 127);
        else { const int n2 = n - map_h; drow = rowoff + 256 * (n2 >> 7) + 128 + (n2 & 127); }
        if (f8scale != 0.f) { u32x2 o; o.x = pk4_fp8(s[0 * 33] * f8scale, s[1 * 33] * f8scale, s[2 * 33] * f8scale, s[3 * 33] * f8scale); o.y = pk4_fp8(s[4 * 33] * f8scale, s[5 * 33] * f8scale, s[6 * 33] * f8scale, s[7 * 33] * f8scale);
            *(u32x2*)((unsigned char*)dst + (size_t)drow * ldk + koff + k0 + 8 * c) = o; }
        else {
        u32x4 o; o.x = pk2(s[0 * 33] * ks[0] * cs, s[1 * 33] * ks[1] * cs); o.y = pk2(s[2 * 33] * ks[2] * cs, s[3 * 33] * ks[3] * cs);
        o.z = pk2(s[4 * 33] * ks[4] * cs, s[5 * 33] * ks[5] * cs); o.w = pk2(s[6 * 33] * ks[6] * cs, s[7 * 33] * ks[7] * cs);
        *(u32x4*)(dst + (size_t)drow * ldk + koff + k0 + 8 * c) = o; } }
    asm volatile("s_waitcnt lgkmcnt(0)" ::: "memory");
}
struct CvtJob { const float* W; int K, N, ld; bf16_t* dst; int ldk, koff, map_h, rowoff, cscale; const float* kscale; float f8scale; };
DI void get_job(const Frame& F, int j, CvtJob& J) {
    J.koff = 0; J.map_h = 0; J.rowoff = 0; J.cscale = 0; J.kscale = nullptr; J.f8scale = 0.f;
    if (j < 52) {
        const int l = j / 13, r = j % 13;
        if (r == 0) { J.W = F.in[I_WIN] + (size_t)l * DM * DIN; J.K = DM; J.N = PRJW; J.ld = DIN; J.dst = WSP(bf16_t, WS_WCOMB + l * SZ_WCOMB); J.ldk = DM; J.cscale = 1; }
        else if (r < 5) { const int i = r - 1; J.W = F.in[I_WGATE] + ((size_t)l * 4 + i) * DM * DM; J.K = DM; J.N = DM; J.ld = DM; J.dst = WSP(bf16_t, WS_WCOMB + l * SZ_WCOMB); J.ldk = DM; J.rowoff = PRJW + 1024 * i; }
        else if (r < 9) { const int i = r - 5; J.W = F.in[I_WBR] + ((size_t)l * 4 + i) * 512 * DM; J.K = 512; J.N = DM; J.ld = DM; J.dst = WSP(bf16_t, WS_WB + l * SZ_WB); J.ldk = 512; J.rowoff = 1024 * i;
            if (i == 3) J.kscale = F.in[I_NORMG] + l * 512; }
        else { J.W = F.in[I_WOUT] + (size_t)l * DM * DM; J.K = (r == 9) ? DM : 0; J.N = DM; J.ld = DM; J.dst = WSP(bf16_t, WS_WO + l * SZ_WO); J.ldk = DM; }
    } else if (j < 56) {
        const int i = (j - 52) >> 1;
        if (((j - 52) & 1) == 0) { J.W = F.in[I_FUP] + (size_t)i * DM * 2 * DFF; J.K = DM; J.N = 2 * DFF; J.ld = 2 * DFF; J.dst = WSP(bf16_t, WS_WUP + i * SZ_WUP); J.ldk = DM; J.map_h = DFF; }
        else { J.W = F.in[I_FDN] + (size_t)i * DFF * DM; J.K = DFF; J.N = DM; J.ld = DM; J.dst = WSP(bf16_t, WS_WDN + i * SZ_WDN); J.ldk = DFF; }
    } else {
        const int q = j - 56, ie = q >> 1, i = ie >> 3, e = ie & 7;
        if ((q & 1) == 0) { J.W = F.in[I_MUP] + ((size_t)i * NEXP + e) * DM * 2 * DFFE; J.K = DM; J.N = 2 * DFFE; J.ld = 2 * DFFE; J.dst = WSP(bf16_t, WS_MUP + i * SZ_MUP); J.ldk = DM; J.map_h = DFFE; J.rowoff = e * 2 * DFFE; J.f8scale = MOE_UP_WSCALE; }
        else { J.W = F.in[I_MDN] + ((size_t)i * NEXP + e) * DFFE * DM; J.K = DFFE; J.N = DM; J.ld = DM; J.dst = WSP(bf16_t, WS_MDN + i * SZ_MDN); J.ldk = DFFE; J.rowoff = e * DM; J.f8scale = MOE_DN_WSCALE; }
    }
}
constexpr int NJOBS = 52 + 4 + 32;

DI void phase_prologue_a(const Frame& F) {
    const int NGW = F.G * NWAVES, gw = F.vcu * NWAVES + F.wave;
    {
        LAS float* sv = (LAS float*)(F.lds + 73728);
        LAS float* red = (LAS float*)(F.lds + 73728 + 20480);
        for (int i = F.tid; i < 5 * 1024; i += NTHR) { const int v = i >> 10, k = i & 1023; const float c = v < 4 ? F.in[I_C][v * DM + k] : F.in[I_CCTX][k]; sv[i] = silu(c); }
        __syncthreads();
        float* MV = WSP(float, WS_MVEC);
        for (int item = F.vcu; item < 4 * 96; item += F.G) {
            const int l = item / 96, n0 = (item % 96) * 64, c = F.tid & 63, ks = F.tid >> 6;
            const float* w = F.in[I_WMOD] + (size_t)l * DM * 6144 + n0 + c;
            float a0 = 0.f, a1 = 0.f, a2 = 0.f, a3 = 0.f, a4 = 0.f;
#pragma unroll 8
            for (int k = ks * 128; k < ks * 128 + 128; ++k) { const float wv = w[(size_t)k * 6144]; a0 += sv[k] * wv; a1 += sv[1024 + k] * wv; a2 += sv[2048 + k] * wv; a3 += sv[3072 + k] * wv; a4 += sv[4096 + k] * wv; }
            red[(ks * 5 + 0) * 64 + c] = a0; red[(ks * 5 + 1) * 64 + c] = a1; red[(ks * 5 + 2) * 64 + c] = a2; red[(ks * 5 + 3) * 64 + c] = a3; red[(ks * 5 + 4) * 64 + c] = a4;
            __syncthreads();
            if (F.tid < 320) { const int v = F.tid >> 6, cc = F.tid & 63; float s = F.in[I_BMOD][l * 6144 + n0 + cc];
#pragma unroll
                for (int q = 0; q < 8; ++q) s += red[(q * 5 + v) * 64 + cc];
                MV[((size_t)l * 5 + v) * 6144 + n0 + cc] = s; }
            __syncthreads();
        }
    }
    {
        float* rc = WSP(float, WS_ROPE); float* rs = rc + SEQ * 32;
        for (int i = F.vcu * NTHR + F.tid; i < SEQ * 32; i += F.G * NTHR) {
            const int t = i >> 5, p = i & 31; const float pos = (p < 16) ? (float)(t >> 6) : (float)(t & 63);
            const float invf = exp2f(-(float)(p & 15) * (13.287712379549449f / 16.f));
            const float ang = pos * invf; const float rev = ang * 0.15915494309189535f; const float fr = rev - rintf(rev);
            rc[i] = __builtin_amdgcn_cosf(fr); rs[i] = __builtin_amdgcn_sinf(fr);
        }
    }
    {
        LAS float* scr = (LAS float*)(F.lds + F.wave * 8448);
        int base = 0;
        for (int j = 0; j < NJOBS; ++j) {
            CvtJob J; get_job(F, j, J);
            const int nblk = J.N / 32, nit = (J.K / 64) * nblk;
            int vid = (gw - base) % NGW; if (vid < 0) vid += NGW;
            for (int it = vid; it < nit; it += NGW) transpose_item(J.W, J.ld, J.dst, J.ldk, J.koff, J.map_h, J.rowoff, J.cscale, J.kscale, scr, it / nblk, it % nblk, F.lane, J.f8scale);
            base = (base + nit) % NGW;
        }
    }
}

DI void load_wdt(const Frame& F, int l) {
    LAS float* wd = (LAS float*)F.lds; const float* w = F.in[I_WIN] + (size_t)l * DM * DIN + PRJW;
    for (int i = F.tid; i < DM * 16; i += NTHR) { const int k = i >> 4; wd[(((k & 3) << 8) + (k >> 2)) * 20 + (i & 15)] = w[(size_t)k * DIN + (i & 15)]; }
}
DI void emit_h_dt(const Frame& F, const f32x4 (&xn)[4], const float* mv, int m, const float* dtb) {
    bf16_t* hb = WSP(bf16_t, WS_HB) + (size_t)m * DM; float* DT = WSP(float, WS_DT);
    const LAS float* wd = (const LAS float*)F.lds;
    float acc[16];
#pragma unroll
    for (int c = 0; c < 16; ++c) acc[c] = 0.f;
#pragma unroll
    for (int j = 0; j < 4; ++j) {
        const int k = 4 * F.lane + 256 * j;
        const f32x4 sh = *(const f32x4*)(mv + k), sc = *(const f32x4*)(mv + 1024 + k);
        const f32x4 h = xn[j] * (sc + 1.f) + sh;
        u32x2 w; w.x = pk2(h[0], h[1]); w.y = pk2(h[2], h[3]); *(u32x2*)(hb + k) = w;
#pragma unroll
        for (int e = 0; e < 4; ++e) {
            const LAS f32x4* wr = (const LAS f32x4*)(wd + ((e << 8) + (k >> 2)) * 20);
#pragma unroll
            for (int q = 0; q < 4; ++q) { const f32x4 wv = wr[q]; acc[4 * q] += h[e] * wv[0]; acc[4 * q + 1] += h[e] * wv[1]; acc[4 * q + 2] += h[e] * wv[2]; acc[4 * q + 3] += h[e] * wv[3]; }
            asm volatile("" ::: "memory");
        }
    }
    const bool b0 = F.lane & 1, b1 = F.lane & 2, b2 = F.lane & 4, b3 = F.lane & 8;
    float t8[8], t4[4], t2[2], t1;
#pragma unroll
    for (int i = 0; i < 8; ++i) { const float keep = b0 ? acc[2 * i + 1] : acc[2 * i], give = b0 ? acc[2 * i] : acc[2 * i + 1]; t8[i] = keep + __shfl_xor(give, 1); }
#pragma unroll
    for (int i = 0; i < 4; ++i) { const float keep = b1 ? t8[2 * i + 1] : t8[2 * i], give = b1 ? t8[2 * i] : t8[2 * i + 1]; t4[i] = keep + __shfl_xor(give, 2); }
#pragma unroll
    for (int i = 0; i < 2; ++i) { const float keep = b2 ? t4[2 * i + 1] : t4[2 * i], give = b2 ? t4[2 * i] : t4[2 * i + 1]; t2[i] = keep + __shfl_xor(give, 4); }
    { const float keep = b3 ? t2[1] : t2[0], give = b3 ? t2[0] : t2[1]; t1 = keep + __shfl_xor(give, 8); }
    t1 += __shfl_xor(t1, 16); t1 += __shfl_xor(t1, 32);
    if (F.lane < 16) { const float x = t1 + dtb[F.lane]; const float t = __expf(x); const float sp = t < 0.01f ? t * (1.f + t * (-0.5f + t * (1.f / 3.f))) : __logf(1.f + t); DT[(size_t)m * 16 + F.lane] = x > 15.f ? x : sp; }
}
DI void ln_rows(f32x4 (&v)[4], const float* g, const float* b, int lane) {
    float s = 0.f;
#pragma unroll
    for (int j = 0; j < 4; ++j) s += (v[j][0] + v[j][1]) + (v[j][2] + v[j][3]);
    const float mean = wave_sum(s) * (1.f / DM); float s2 = 0.f;
#pragma unroll
    for (int j = 0; j < 4; ++j) { v[j] = v[j] - mean; s2 += (v[j][0] * v[j][0] + v[j][1] * v[j][1]) + (v[j][2] * v[j][2] + v[j][3] * v[j][3]); }
    const float rstd = 1.f / sqrtf(wave_sum(s2) * (1.f / DM) + LN_EPS);
#pragma unroll
    for (int j = 0; j < 4; ++j) { const int k = 4 * lane + 256 * j; v[j] = v[j] * rstd * *(const f32x4*)(g + k) + *(const f32x4*)(b + k); }
}
DI void phase_prologue_b(const Frame& F) {
    load_wdt(F, 0); __syncthreads();
    const int NGW = F.G * NWAVES, gw = F.vcu * NWAVES + F.wave;
    bf16_t* XS = WSP(bf16_t, WS_XS); const float* MV = WSP(float, WS_MVEC);
    const float* dtb = F.in[I_DTB];
    for (int m = gw; m < MTOT; m += NGW) {
        const float* src = m < NLAT ? F.in[I_X] + (size_t)m * DM : F.in[I_CTX] + (size_t)(m - NLAT) * DM; const int v = m < NLAT ? (m >> 13) : 4;
        f32x4 x[4];
#pragma unroll
        for (int j = 0; j < 4; ++j) { x[j] = *(const f32x4*)(src + 4 * F.lane + 256 * j); st4bf(XS + (size_t)m * DM + 4 * F.lane + 256 * j, x[j]); }
        emit_h_dt(F, x, MV + (size_t)v * 6144, m, dtb);
    }
}
DI void phase_ln1(const Frame& F, int l, int mrows) {
    const bool moe = l & 1; const int mi = l >> 1;
    LAS float* wrt = (LAS float*)F.lds;
    if (moe) { const float* w = F.in[I_MRW] + (size_t)mi * DM * 8; for (int i = F.tid; i < DM * 8; i += NTHR) { const int k = i >> 3; wrt[(((k & 3) << 8) + (k >> 2)) * 12 + (i & 7)] = w[i]; } __syncthreads(); }
    const int NGW = F.G * NWAVES, gw = F.vcu * NWAVES + F.wave;
    bf16_t* XS = WSP(bf16_t, WS_XS); const float* MV = WSP(float, WS_MVEC) + (size_t)l * 5 * 6144; bf16_t* HB = WSP(bf16_t, WS_HB);
    const float* g = F.in[I_LN1G] + l * DM; const float* b = F.in[I_LN1B] + l * DM;
    unsigned* SL = WSP(unsigned, WS_SLOT); unsigned* gcnt = (unsigned*)F.ctl + CW_MOECNT + mi * 1024;
    int cnt = 0, nst = 0; int me0 = 0, me1 = 0, mr0 = 0, mr1 = 0, mm = 0; float mg0 = 0.f, mg1 = 0.f;
    f32x4 xnx[4];
    if (gw < mrows) {
#pragma unroll
        for (int j = 0; j < 4; ++j) xnx[j] = ld4bf(XS + (size_t)gw * DM + 4 * F.lane + 256 * j);
    }
    for (int m = gw; m < mrows; m += NGW) {
        const int v = m < NLAT ? (m >> 13) : 4;
        f32x4 x[4];
#pragma unroll
        for (int j = 0; j < 4; ++j) x[j] = xnx[j];
        if (m + NGW < mrows) {
#pragma unroll
            for (int j = 0; j < 4; ++j) xnx[j] = ld4bf(XS + (size_t)(m + NGW) * DM + 4 * F.lane + 256 * j);
        }
        ln_rows(x, g, b, F.lane);
        float acc[8];
#pragma unroll
        for (int c = 0; c < 8; ++c) acc[c] = 0.f;
        const float* mv = MV + (size_t)v * 6144;
#pragma unroll
        for (int j = 0; j < 4; ++j) {
            const int k = 4 * F.lane + 256 * j;
            st4bf(XS + (size_t)m * DM + k, x[j]);
            const f32x4 sh = *(const f32x4*)(mv + 3072 + k), sc = *(const f32x4*)(mv + 4096 + k);
            const f32x4 h = x[j] * (sc + 1.f) + sh;
            u32x2 w; w.x = pk2(h[0], h[1]); w.y = pk2(h[2], h[3]); *(u32x2*)(HB + (size_t)m * DM + k) = w;
            if (moe) {
#pragma unroll
                for (int e = 0; e < 4; ++e) { const LAS f32x4* wr = (const LAS f32x4*)(wrt + ((e << 8) + (k >> 2)) * 12);
#pragma unroll
                    for (int q = 0; q < 2; ++q) { const f32x4 wv = wr[q]; acc[4 * q] += h[e] * wv[0]; acc[4 * q + 1] += h[e] * wv[1]; acc[4 * q + 2] += h[e] * wv[2]; acc[4 * q + 3] += h[e] * wv[3]; } }
            }
        }
        if (moe) {
            const bool b0 = F.lane & 1, b1 = F.lane & 2, b2 = F.lane & 4;
            float t4[4], t2[2], t1;
#pragma unroll
            for (int i = 0; i < 4; ++i) { const float keep = b0 ? acc[2 * i + 1] : acc[2 * i], give = b0 ? acc[2 * i] : acc[2 * i + 1]; t4[i] = keep + __shfl_xor(give, 1); }
#pragma unroll
            for (int i = 0; i < 2; ++i) { const float keep = b1 ? t4[2 * i + 1] : t4[2 * i], give = b1 ? t4[2 * i] : t4[2 * i + 1]; t2[i] = keep + __shfl_xor(give, 2); }
            { const float keep = b2 ? t2[1] : t2[0], give = b2 ? t2[0] : t2[1]; t1 = keep + __shfl_xor(give, 4); }
            t1 += __shfl_xor(t1, 8); t1 += __shfl_xor(t1, 16); t1 += __shfl_xor(t1, 32);
            t1 += F.in[I_MRB][mi * 8 + (F.lane & 7)];
            float lg[8];
#pragma unroll
            for (int e = 0; e < 8; ++e) lg[e] = __shfl(t1, e);
            int e0 = 0; float l0 = lg[0];
#pragma unroll
            for (int e = 1; e < 8; ++e) if (lg[e] > l0) { l0 = lg[e]; e0 = e; }
            int e1 = -1; float l1 = -3.0e38f;
#pragma unroll
            for (int e = 0; e < 8; ++e) if (e != e0 && lg[e] > l1) { l1 = lg[e]; e1 = e; }
            const float g1 = 1.f / (1.f + __expf(l0 - l1)), g0 = 1.f - g1;
            const int r0 = __shfl(cnt, e0); if (F.lane == e0) cnt++;
            const int r1 = __shfl(cnt, e1); if (F.lane == e1) cnt++;
            if (F.lane == nst) { me0 = e0; me1 = e1; mr0 = r0; mr1 = r1; mg0 = g0; mg1 = g1; mm = m; }
            ++nst;
        }
        if (moe && (nst == 64 || m + NGW >= mrows)) {
            unsigned base = 0u; if (F.lane < 8) base = __hip_atomic_fetch_add(gcnt + F.lane * 64, (unsigned)cnt, __ATOMIC_RELAXED, __HIP_MEMORY_SCOPE_AGENT);
            const unsigned p0 = __shfl(base, me0) + mr0, p1 = __shfl(base, me1) + mr1;
            if (F.lane < nst) { u32x4 a; a.x = me0; a.y = me1; a.z = p0; a.w = p1; *(u32x4*)(SL + (size_t)mm * 8) = a; u32x2 c; c.x = __float_as_uint(mg0); c.y = __float_as_uint(mg1); *(u32x2*)(SL + (size_t)mm * 8 + 4) = c; }
            cnt = 0; nst = 0;
        }
    }
}
DI void moe_pad_ends(const Frame& F, int mi, int (&pe)[8]) {
    unsigned* gcnt = (unsigned*)F.ctl + CW_MOECNT + mi * 1024; int run = 0;
#pragma unroll
    for (int e = 0; e < 8; ++e) { const int c = (int)__builtin_amdgcn_readfirstlane(__hip_atomic_load(gcnt + e * 64, __ATOMIC_RELAXED, __HIP_MEMORY_SCOPE_AGENT)); run += (c + 255) & ~255; pe[e] = run; }
}
DI int moe_pad_ends_lds(const Frame& F, int mi) {
    int pe[8]; moe_pad_ends(F, mi, pe);
    LAS int* d = (LAS int*)(F.lds + MISC_OFF + 64);
    __syncthreads();
    if (F.tid == 0) {
#pragma unroll
        for (int e = 0; e < 8; ++e) d[e] = pe[e];
    }
    __syncthreads();
    return pe[7];
}
DI void phase_gather(const Frame& F, int l, int mrows) {
    int pe[8]; moe_pad_ends(F, l >> 1, pe);
    const int NGW = F.G * NWAVES, gw = F.vcu * NWAVES + F.wave;
    unsigned* SL = WSP(unsigned, WS_SLOT); const bf16_t* HB = WSP(bf16_t, WS_HB); bf16_t* XP = WSP(bf16_t, WS_XPAD);
    for (int m = gw; m < mrows; m += NGW) {
        const u32x4 a = *(const u32x4*)(SL + (size_t)m * 8);
        int ps0 = 0, ps1 = 0;
#pragma unroll
        for (int e = 1; e < 8; ++e) { if ((int)a.x == e) ps0 = pe[e - 1]; if ((int)a.y == e) ps1 = pe[e - 1]; }
        const int d0 = ps0 + (int)a.z, d1 = ps1 + (int)a.w;
        const u32x4* src = (const u32x4*)(HB + (size_t)m * DM);
        const u32x4 v0 = src[F.lane], v1 = src[64 + F.lane];
        u32x2 w0, w1; w0.x = pk4_fp8(bflo(v0.x), bfhi(v0.x), bflo(v0.y), bfhi(v0.y)); w0.y = pk4_fp8(bflo(v0.z), bfhi(v0.z), bflo(v0.w), bfhi(v0.w));
        w1.x = pk4_fp8(bflo(v1.x), bfhi(v1.x), bflo(v1.y), bfhi(v1.y)); w1.y = pk4_fp8(bflo(v1.z), bfhi(v1.z), bflo(v1.w), bfhi(v1.w));
        u32x2* q0 = (u32x2*)((unsigned char*)XP + (size_t)d0 * DM); u32x2* q1 = (u32x2*)((unsigned char*)XP + (size_t)d1 * DM);
        q0[F.lane] = w0; q0[64 + F.lane] = w1; q1[F.lane] = w0; q1[64 + F.lane] = w1;
        if (F.lane == 0) { u32x2 d; d.x = d0; d.y = d1; *(u32x2*)(SL + (size_t)m * 8 + 2) = d; }
    }
}
DI void phase_ln2(const Frame& F, int l, int mrows) {
    const bool moe = l & 1, lastl = (l == DEPTH - 1);
    if (!lastl) { load_wdt(F, l + 1); __syncthreads(); }
    const int NGW = F.G * NWAVES, gw = F.vcu * NWAVES + F.wave;
    bf16_t* XS = WSP(bf16_t, WS_XS); const float* MVl = WSP(float, WS_MVEC) + (size_t)l * 5 * 6144; const float* MVn = WSP(float, WS_MVEC) + (size_t)(l + 1) * 5 * 6144;
    const float* g = F.in[I_LN2G] + l * DM; const float* b = F.in[I_LN2B] + l * DM;
    const unsigned* SL = WSP(unsigned, WS_SLOT); const bf16_t* YP = WSP(bf16_t, WS_YPAD);
    const float* dtb = F.in[I_DTB] + (lastl ? 0 : (l + 1) * 16);
    f32x4 xnx[4]; u32x4 anx = (u32x4){0u, 0u, 0u, 0u}; u32x2 gnx = (u32x2){0u, 0u};
    if (gw < mrows) {
#pragma unroll
        for (int j = 0; j < 4; ++j) xnx[j] = ld4bf(XS + (size_t)gw * DM + 4 * F.lane + 256 * j);
        if (moe) { anx = *(const u32x4*)(SL + (size_t)gw * 8); gnx = *(const u32x2*)(SL + (size_t)gw * 8 + 4); }
    }
    for (int m = gw; m < mrows; m += NGW) {
        const int v = m < NLAT ? (m >> 13) : 4;
        f32x4 x[4];
#pragma unroll
        for (int j = 0; j < 4; ++j) x[j] = xnx[j];
        const u32x4 a = anx; const u32x2 gg = gnx;
        if (m + NGW < mrows) {
#pragma unroll
            for (int j = 0; j < 4; ++j) xnx[j] = ld4bf(XS + (size_t)(m + NGW) * DM + 4 * F.lane + 256 * j);
            if (moe) { anx = *(const u32x4*)(SL + (size_t)(m + NGW) * 8); gnx = *(const u32x2*)(SL + (size_t)(m + NGW) * 8 + 4); }
        }
        if (moe) {
            const float g0 = __uint_as_float(gg.x), g1 = __uint_as_float(gg.y);
            const bf16_t* y0 = YP + (size_t)a.z * DM; const bf16_t* y1 = YP + (size_t)a.w * DM;
#pragma unroll
            for (int j = 0; j < 4; ++j) { const int k = 4 * F.lane + 256 * j; const u32x2 u0 = *(const u32x2*)(y0 + k), u1 = *(const u32x2*)(y1 + k);
                const f32x4 gt = *(const f32x4*)(MVl + (size_t)v * 6144 + 5120 + k);
                f32x4 f; f[0] = g0 * bflo(u0.x) + g1 * bflo(u1.x); f[1] = g0 * bfhi(u0.x) + g1 * bfhi(u1.x); f[2] = g0 * bflo(u0.y) + g1 * bflo(u1.y); f[3] = g0 * bfhi(u0.y) + g1 * bfhi(u1.y);
                if (ABL & 16) f = (f32x4){0.f, 0.f, 0.f, 0.f};
                x[j] = x[j] * ALPHA + gt * f; }
        }
        ln_rows(x, g, b, F.lane);
        if (lastl) {
#pragma unroll
            for (int j = 0; j < 4; ++j) *(f32x4*)(F.out + (size_t)m * DM + 4 * F.lane + 256 * j) = x[j];
        } else {
#pragma unroll
            for (int j = 0; j < 4; ++j) st4bf(XS + (size_t)m * DM + 4 * F.lane + 256 * j, x[j]);
            emit_h_dt(F, x, MVn + (size_t)v * 6144, m, dtb);
        }
    }
}

DI void phase_qkprep_rows(const Frame& F, int l) {
    const int NGW = F.G * NWAVES, gw = F.vcu * NWAVES + F.wave;
    bf16_t* PRJ = WSP(bf16_t, WS_PRJ); const float* rc = WSP(float, WS_ROPE); const float* rs = rc + SEQ * 32;
    const float* gq = F.in[I_QGQ] + l * 64; const float* gk = F.in[I_QGK] + l * 64;
    const int hs = F.lane >> 4, i2 = 2 * (F.lane & 15);
    const float gq0 = gq[i2], gq1 = gq[i2 + 1], gq2 = gq[32 + i2], gq3 = gq[32 + i2 + 1], gk0 = gk[i2], gk1 = gk[i2 + 1], gk2 = gk[32 + i2], gk3 = gk[32 + i2 + 1];
    for (int m = gw; m < MTOT; m += NGW) {
        const bool lat = m < NLAT; const int t = m & (SEQ - 1);
        float c0 = 1.f, c1 = 1.f, s0 = 0.f, s1 = 0.f;
        if (lat) { const f32x2 cc = *(const f32x2*)(rc + t * 32 + i2), ss = *(const f32x2*)(rs + t * 32 + i2); c0 = cc[0]; c1 = cc[1]; s0 = ss[0]; s1 = ss[1]; }
        unsigned u1[5], u2[5];
#pragma unroll
        for (int it = 0; it < 5; ++it) {
            const int hd = it * 4 + hs;
            const int col = hd < 8 ? C_SWQ + 64 * hd : hd < 10 ? C_SWK + 64 * (hd - 8) : hd < 18 ? C_GAQ + 64 * (hd - 10) : C_GAK + 64 * (hd - 18);
            const bf16_t* p = PRJ + (size_t)m * PRJW + col + i2; u1[it] = *(const unsigned*)p; u2[it] = *(const unsigned*)(p + 32);
        }
#pragma unroll
        for (int it = 0; it < 5; ++it) {
            const int hd = it * 4 + hs;
            const int col = hd < 8 ? C_SWQ + 64 * hd : hd < 10 ? C_SWK + 64 * (hd - 8) : hd < 18 ? C_GAQ + 64 * (hd - 10) : C_GAK + 64 * (hd - 18);
            bf16_t* p = PRJ + (size_t)m * PRJW + col + i2;
            float a0 = bflo(u1[it]), a1 = bfhi(u1[it]), b0 = bflo(u2[it]), b1 = bfhi(u2[it]);
            if (hd >= 10) {
                float ss = a0 * a0 + a1 * a1 + b0 * b0 + b1 * b1;
                ss += __shfl_xor(ss, 1); ss += __shfl_xor(ss, 2); ss += __shfl_xor(ss, 4); ss += __shfl_xor(ss, 8);
                const float rn = 1.f / sqrtf(ss * (1.f / 64.f) + RMS_EPS); const bool isq = hd < 18; const float post = isq ? C2 : 1.f;
                a0 *= rn * (isq ? gq0 : gk0) * post; a1 *= rn * (isq ? gq1 : gk1) * post; b0 *= rn * (isq ? gq2 : gk2) * post; b1 *= rn * (isq ? gq3 : gk3) * post;
            }
            const float o0 = a0 * c0 - b0 * s0, o1 = a1 * c1 - b1 * s1, q0 = b0 * c0 + a0 * s0, q1 = b1 * c1 + a1 * s1;
            *(unsigned*)p = pk2(o0, o1); *(unsigned*)(p + 32) = pk2(q0, q1);
        }
    }
}

namespace ga_body {
using bf16=__hip_bfloat16;
using bf16x8=__attribute__((ext_vector_type(8)))short;
using s16x4=__attribute__((ext_vector_type(4)))short;
using f32x16=__attribute__((ext_vector_type(16)))float;
using u32x4=__attribute__((ext_vector_type(4)))unsigned;
constexpr int SEQ=8192,D=64,PQ=4608,PO=2048,NCTXT=4;
constexpr int NW=8,QBLK=32,QB=QBLK*NW,KVBLK=64,NQB=SEQ/QB;
__device__ __forceinline__ int crow(int r,int hi){return (r&3)+8*(r>>2)+4*hi;}
#define SBAR() __builtin_amdgcn_sched_barrier(0)
__device__ __forceinline__ void cmask(f32x16&p0,f32x16&p1,int jb,int qrel,int hi){
  const float NEG=-INFINITY; int kb=64*jb+4*hi;
  #pragma unroll
  for(int r=0;r<16;++r){int kv=kb+(r&3)+8*(r>>2); if(kv>qrel)p0[r]=NEG; if(kv+32>qrel)p1[r]=NEG;}
}

constexpr int NSLOT=3, SLOTB=8192;
constexpr int LDS_K=0, LDS_V=NSLOT*SLOTB, LDS_WS=2*NSLOT*SLOTB, LDS_OST=LDS_WS+NW*64*4, LDS_BYTES=LDS_OST+NW*4096;
constexpr float C2=0.125f*1.4426950408889634f;
__device__ __forceinline__ void glds16(const void*gsrc,unsigned lds_dst){unsigned keep;
  asm volatile("s_mov_b32 %0, m0\n\ts_mov_b32 m0, %2\n\ts_nop 0\n\tglobal_load_lds_dwordx4 %1, off\n\ts_mov_b32 m0, %0":"=&s"(keep):"v"(gsrc),"s"(lds_dst):"memory");}
__device__ __forceinline__ float max3f(float a,float b,float c){float r;asm("v_max3_f32 %0, %1, %2, %3":"=v"(r):"v"(a),"v"(b),"v"(c));return r;}
__device__ __forceinline__ float max2f(float a,float b){float r;asm("v_max_f32_e32 %0, %1, %2":"=v"(r):"v"(a),"v"(b));return r;}
__device__ __forceinline__ float fadd_s(float a,float b){float r;asm("v_add_f32_e32 %0, %1, %2":"=v"(r):"v"(a),"v"(b));return r;}
__device__ __forceinline__ float fsub_s(float a,float b){float r;asm("v_sub_f32_e32 %0, %1, %2":"=v"(r):"v"(a),"v"(b));return r;}
typedef float f32x2_t __attribute__((ext_vector_type(2))); typedef __bf16 bf16x2_t __attribute__((ext_vector_type(2)));
__device__ __forceinline__ unsigned cvtpk_s(float lo,float hi){f32x2_t v={lo,hi};bf16x2_t b=__builtin_convertvector(v,bf16x2_t);return __builtin_bit_cast(unsigned,b);}
#define WAIT_BAR(N) asm volatile("s_waitcnt vmcnt(" #N ") lgkmcnt(0)\n\ts_barrier":::"memory")

__device__ __forceinline__ void qkt(f32x16&p0,f32x16&p1,const char*Kslot,const bf16x8*qr,const f32x16&negm,int r32,int hi){
  const char*kb=Kslot+hi*1024+r32*16;
  #pragma unroll
  for(int d0=0;d0<4;++d0){
    const bf16x8 b0=*reinterpret_cast<const bf16x8*>(kb+d0*2048);
    const bf16x8 b1=*reinterpret_cast<const bf16x8*>(kb+d0*2048+512);
    if(d0==0){p0=__builtin_amdgcn_mfma_f32_32x32x16_bf16(b0,qr[0],negm,0,0,0);p1=__builtin_amdgcn_mfma_f32_32x32x16_bf16(b1,qr[0],negm,0,0,0);}
    else{p0=__builtin_amdgcn_mfma_f32_32x32x16_bf16(b0,qr[d0],p0,0,0,0);p1=__builtin_amdgcn_mfma_f32_32x32x16_bf16(b1,qr[d0],p1,0,0,0);}}
}
typedef __attribute__((address_space(3))) const char* lds_cptr;
typedef short v4i16_t __attribute__((ext_vector_type(4)));
__device__ __forceinline__ void kload8(bf16x8*kf,lds_cptr kp){
  kf[0]=*(const __attribute__((address_space(3))) bf16x8*)(kp);      kf[1]=*(const __attribute__((address_space(3))) bf16x8*)(kp+512);
  kf[2]=*(const __attribute__((address_space(3))) bf16x8*)(kp+2048); kf[3]=*(const __attribute__((address_space(3))) bf16x8*)(kp+2560);
  kf[4]=*(const __attribute__((address_space(3))) bf16x8*)(kp+4096); kf[5]=*(const __attribute__((address_space(3))) bf16x8*)(kp+4608);
  kf[6]=*(const __attribute__((address_space(3))) bf16x8*)(kp+6144); kf[7]=*(const __attribute__((address_space(3))) bf16x8*)(kp+6656);
}
__device__ __forceinline__ void kload2(bf16x8*kf,lds_cptr kp,int j){ kf[2*j]=*(const __attribute__((address_space(3))) bf16x8*)(kp+j*2048); kf[2*j+1]=*(const __attribute__((address_space(3))) bf16x8*)(kp+j*2048+512); }
__device__ __forceinline__ s16x4 vtr(lds_cptr p){ return __builtin_bit_cast(s16x4,__builtin_amdgcn_ds_read_tr16_b64_v4i16((__attribute__((address_space(3))) v4i16_t*)p)); }
__device__ __forceinline__ float rowmax(const f32x16&p0,const f32x16&p1){
  float a=max3f(p0[0],p0[1],p1[0]),b=max3f(p0[2],p0[3],p1[1]);a=max3f(a,p1[2],p1[3]);
  #pragma unroll
  for(int r=4;r<16;r+=4){a=max3f(a,p0[r],p0[r+1]);b=max3f(b,p0[r+2],p0[r+3]);a=max3f(a,p1[r],p1[r+1]);b=max3f(b,p1[r+2],p1[r+3]);}
  const float m=max2f(a,b);
  auto rr=__builtin_amdgcn_permlane32_swap(__float_as_uint(m),__float_as_uint(m),false,false);
  return max2f(__uint_as_float(rr[0]),__uint_as_float(rr[1]));
}
__device__ __forceinline__ void pv(f32x16*o,int vb,bf16x8 pa0,bf16x8 pa1,bf16x8 pa2,bf16x8 pa3){
  #pragma unroll
  for(int d0=0;d0<2;++d0){s16x4 lo[4],hi[4];
    #pragma unroll
    for(int ks=0;ks<4;++ks){
      asm volatile("ds_read_b64_tr_b16 %0,%1 offset:%c2":"=&v"(lo[ks]):"v"(vb),"i"(d0*4096+ks*1024):"memory");
      asm volatile("ds_read_b64_tr_b16 %0,%1 offset:%c2":"=&v"(hi[ks]):"v"(vb),"i"(d0*4096+ks*1024+512):"memory");}
    asm volatile("s_waitcnt lgkmcnt(0)":::"memory");SBAR();
    #define PK(k) (bf16x8){lo[k][0],lo[k][1],lo[k][2],lo[k][3],hi[k][0],hi[k][1],hi[k][2],hi[k][3]}
    o[d0]=__builtin_amdgcn_mfma_f32_32x32x16_bf16(pa0,PK(0),o[d0],0,0,0);
    o[d0]=__builtin_amdgcn_mfma_f32_32x32x16_bf16(pa1,PK(1),o[d0],0,0,0);
    o[d0]=__builtin_amdgcn_mfma_f32_32x32x16_bf16(pa2,PK(2),o[d0],0,0,0);
    o[d0]=__builtin_amdgcn_mfma_f32_32x32x16_bf16(pa3,PK(3),o[d0],0,0,0);
    #undef PK
  }
}

#ifndef ATTN_STORE16
#define ATTN_STORE16(p,v) (*(u32x4*)(p)=(v))
#endif
template<int MODE> __device__ __forceinline__ void amask(f32x16&p0,f32x16&p1,int t,int g0,int qb,int wid,int r32,int hi,const __attribute__((address_space(3))) float*biasT){
  if(MODE==0||t<NCTXT)return;
  const float NEG=-INFINITY; const int g=g0+t-NCTXT;
  if(MODE==1){ int d0=64*g-(256*qb+32*wid+r32)+4*hi; asm volatile("":"+v"(d0));
    #pragma unroll
    for(int r=0;r<16;++r){const int dd=d0+(r&3)+8*(r>>2); if(dd>128||dd<-128)p0[r]=NEG; if(dd+32>128||dd+32<-128)p1[r]=NEG;}
  } else {
    const int gr=4*qb+(wid>>1); int rs=gr-4; rs=rs<0?0:(rs>120?120:rs); const bool rel=(g>=rs&&g<rs+8);
    const int qc=32*(wid&1)+r32; int cs=qc-8; cs=cs<0?0:(cs>48?48:cs); asm volatile("":"+v"(cs));
    const int dr=rel?(g-gr+7):0; const __attribute__((address_space(3))) float*bt=biasT+dr*31+15-qc+4*hi; const int k0=4*hi-cs;
    #pragma unroll
    for(int r=0;r<16;++r){const int ko=(r&3)+8*(r>>2); const unsigned u0=(unsigned)(k0+ko),u1=(unsigned)(k0+ko+32);
      p0[r]=(rel&&u0<16u)?p0[r]+bt[ko]:NEG; p1[r]=(rel&&u1<16u)?p1[r]+bt[ko+32]:NEG;
      if((r&3)==3)asm volatile("":"+v"(p0),"+v"(p1)::"memory");}
  }
}
template<int THRL,int MODE> __device__ __forceinline__ void attn_unit(int qb,const bf16*Qp,const bf16*__restrict__ Kl,const bf16*__restrict__ Vl,const bf16*__restrict__ Kc,const bf16*__restrict__ Vc,bf16*Op,char*shm,const int tid,const int NT,const int g0,const float sinkl2,const float*rpbh){
  const int lane=tid&63,r32=lane&31,hi=lane>>5; const int wid=__builtin_amdgcn_readfirstlane(tid>>6);
  const int q0=qb*QB;
  const bf16*Qw=Qp+(long)(q0+wid*QBLK)*PQ;
  const unsigned lds0=(unsigned)(uintptr_t)shm;
  float*wsf=(float*)(shm+LDS_WS)+wid*64;
  const long koff=(long)lane*PQ+wid*8;
  const long voff=(long)(16*(wid&3)+(lane>>2))*PQ+(wid>>2)*32+(lane&3)*8;
  const unsigned kdst=lds0+LDS_K+wid*1024, vdst=lds0+LDS_V+wid*1024;
  #define TILE_SRC(t,C,L) (((t)<NCTXT?(C)+(long)(t)*KVBLK*PQ:(L)+(long)((t)-NCTXT)*KVBLK*PQ))
  #define DMA_K(t,slot) glds16(TILE_SRC(t,Kc,Kl)+koff,(unsigned)__builtin_amdgcn_readfirstlane(kdst+(slot)))
  #define DMA_V(t,slot) glds16(TILE_SRC(t,Vc,Vl)+voff,(unsigned)__builtin_amdgcn_readfirstlane(vdst+(slot)))
  const int vb0=(int)(lds0+LDS_V)+((lane>>4)&1)*32+(lane&3)*8+(4*hi+((lane&15)>>2))*64;
  const char*Kbase=shm+LDS_K; bf16x8 kf[8];
  const lds_cptr shm3=(lds_cptr)shm; const lds_cptr kp0=shm3+LDS_K+hi*1024+r32*16; const lds_cptr vp0=shm3+LDS_V+((lane>>4)&1)*32+(lane&3)*8+(4*hi+((lane&15)>>2))*64;
  const __attribute__((address_space(3))) float*biasT=(const __attribute__((address_space(3))) float*)((lds_cptr)shm+LDS_BYTES);
  if(MODE==2){ __attribute__((address_space(3))) float*bw=(__attribute__((address_space(3))) float*)((lds_cptr)shm+LDS_BYTES); for(int i=tid;i<465;i+=512)bw[i]=rpbh[i]*1.4426950408889634f; }
  DMA_K(0,0);DMA_V(0,0);DMA_K(1,SLOTB);
  bf16x8 qr[4];
  #pragma unroll
  for(int d0=0;d0<4;++d0)qr[d0]=*reinterpret_cast<const bf16x8*>(&Qw[(long)r32*PQ+d0*16+hi*8]);
  float mhat=0.f,l_reg=0.f;f32x16 o[2],negm; { float zz=0.f; asm volatile("":"+v"(zz)); _Pragma("unroll") for(int r=0;r<16;++r){o[0][r]=zz;o[1][r]=zz;negm[r]=zz;} } asm volatile("":"+v"(negm));
  #define CMASK(P0,P1,t) amask<MODE>(P0,P1,t,g0,qb,wid,r32,hi,biasT)
  bool resc=false;
  #define START(P0,P1) do{ const float rm=rowmax(P0,P1); resc=false; \
    { const float dl=rm; mhat=fadd_s(mhat,dl); \
      _Pragma("unroll") for(int r=0;r<16;++r){P0[r]=fsub_s(P0[r],dl);P1[r]=fsub_s(P1[r],dl);} \
      _Pragma("unroll") for(int r=0;r<16;++r)negm[r]=-mhat; asm volatile("":"+v"(negm)); } \
    _Pragma("unroll") for(int r=0;r<16;++r)P0[r]=__builtin_amdgcn_exp2f(P0[r]); }while(0)
  #define RESC() do{ if(resc){ asm volatile("s_waitcnt lgkmcnt(0)":::"memory"); \
      _Pragma("unroll") for(int d_=0;d_<2;++d_) _Pragma("unroll") for(int r=0;r<16;++r)o[d_][r]*=wsf[crow(r,hi)]; } }while(0)
  f32x16 pA0,pA1,pB0,pB1;
  int sl_prev=0,sl_cur=0,sl_next=SLOTB;
  #define ROT() do{sl_prev=sl_cur;sl_cur=sl_next;sl_next=(sl_next==(NSLOT-1)*SLOTB)?0:sl_next+SLOTB;}while(0)
  DMA_K(2,2*SLOTB);
  WAIT_BAR(3);
  qkt(pA0,pA1,Kbase,qr,negm,r32,hi);asm volatile("s_nop 15\n\ts_nop 7":"+v"(pA0),"+v"(pA1));CMASK(pA0,pA1,0);
  START(pA0,pA1);
  _Pragma("unroll") for(int r=0;r<16;++r)pA1[r]=__builtin_amdgcn_exp2f(pA1[r]);
  WAIT_BAR(0);
  DMA_K(3,0);DMA_V(1,SLOTB);
  ROT();
  kload8(kf,kp0+sl_cur);
  WAIT_BAR(2);
  s16x4 vlo[8],vhi[8]; u32x4 pw0,pw1,pw2,pw3;
  #define PKW(P,B) cvtpk_s(P[B],P[B+1])
  #define PAF(k) __builtin_bit_cast(bf16x8,pw##k)
  #define VFR(i) (bf16x8){vlo[i][0],vlo[i][1],vlo[i][2],vlo[i][3],vhi[i][0],vhi[i][1],vhi[i][2],vhi[i][3]}
  #define PIN(x) asm volatile("":"+v"(x))
  #define MX3(a,b,c) __builtin_fmaxf(__builtin_fmaxf((a),(b)),(c))
  #define GAPA(MF,A0,A1,A2,A3,W0,W1,PW) do{ MF; sacc+=A0; sacc+=A1; sacc+=A2; sacc+=A3; PIN(sacc); W0; W1; PIN(PW); SBAR(); }while(0)
  #define EX(v) __builtin_amdgcn_exp2f(v)
  #define GAPB(MF,X,B) do{ MF; X[B]=EX(X[B]); X[B+1]=EX(X[B+1]); X[B+2]=EX(X[B+2]); X[B+3]=EX(X[B+3]); PIN(X); SBAR(); }while(0)
  #define VRD(i) do{ vlo[i]=vtr(vp_+(((i)>>2)*4096+((i)&3)*1024)); vhi[i]=vtr(vp_+(((i)>>2)*4096+((i)&3)*1024+512)); }while(0)
  #define KRD(G,j) do{ if(G){ kload2(kf,kp0+sl_next,j); SBAR(); } }while(0)
  #define STEP(C0,C1,P0,P1,t,GK,GV,GL) do{ SBAR(); \
    const lds_cptr vp_=vp0+sl_prev; \
    VRD(0); SBAR(); float sacc=(P0[0]+P0[1]); \
    GAPA(C0=__builtin_amdgcn_mfma_f32_32x32x16_bf16(kf[0],qr[0],negm,0,0,0), P0[2],P0[3],P0[4],P0[5],     pw0[0]=PKW(P0,0), pw0[1]=PKW(P0,2), pw0); \
    VRD(4); SBAR(); GAPA(C1=__builtin_amdgcn_mfma_f32_32x32x16_bf16(kf[1],qr[0],negm,0,0,0), P0[6],P0[7],P0[8],P0[9],     pw0[2]=PKW(P0,4), pw0[3]=PKW(P0,6), pw0); \
    VRD(1); SBAR(); GAPA(C0=__builtin_amdgcn_mfma_f32_32x32x16_bf16(kf[2],qr[1],C0,0,0,0),   P0[10],P0[11],P0[12],P0[13], pw1[0]=PKW(P0,8), pw1[1]=PKW(P0,10), pw1); \
    VRD(5); SBAR(); GAPA(C1=__builtin_amdgcn_mfma_f32_32x32x16_bf16(kf[3],qr[1],C1,0,0,0),   P0[14],P0[15],P1[0],P1[1],   pw1[2]=PKW(P0,12),pw1[3]=PKW(P0,14), pw1); \
    VRD(2); SBAR(); GAPA(C0=__builtin_amdgcn_mfma_f32_32x32x16_bf16(kf[4],qr[2],C0,0,0,0),   P1[2],P1[3],P1[4],P1[5],     pw2[0]=PKW(P1,0), pw2[1]=PKW(P1,2), pw2); \
    VRD(6); SBAR(); GAPA(C1=__builtin_amdgcn_mfma_f32_32x32x16_bf16(kf[5],qr[2],C1,0,0,0),   P1[6],P1[7],P1[8],P1[9],     pw2[2]=PKW(P1,4), pw2[3]=PKW(P1,6), pw2); \
    VRD(3); SBAR(); GAPA(C0=__builtin_amdgcn_mfma_f32_32x32x16_bf16(kf[6],qr[3],C0,0,0,0),   P1[10],P1[11],P1[12],P1[13], pw3[0]=PKW(P1,8), pw3[1]=PKW(P1,10), pw3); \
    VRD(7); SBAR(); GAPA(C1=__builtin_amdgcn_mfma_f32_32x32x16_bf16(kf[7],qr[3],C1,0,0,0),   P1[14],P1[15],0.f,0.f,       pw3[2]=PKW(P1,12),pw3[3]=PKW(P1,14), pw3); \
    l_reg+=sacc; \
    if(GK){DMA_K((t)+3,sl_cur);} if(GV){DMA_V((t)+1,sl_next);} \
    CMASK(C0,C1,t); \
    { float a=MX3(C0[0],C0[1],C1[0]),b=MX3(C0[2],C0[3],C1[1]); a=MX3(a,C1[2],C1[3]); \
      _Pragma("unroll") for(int r=4;r<16;r+=4){a=MX3(a,C0[r],C0[r+1]);b=MX3(b,C0[r+2],C0[r+3]);a=MX3(a,C1[r],C1[r+1]);b=MX3(b,C1[r+2],C1[r+3]);} \
      float rm=__builtin_fmaxf(a,b); { auto rr=__builtin_amdgcn_permlane32_swap(__float_as_uint(rm),__float_as_uint(rm),false,false); rm=__builtin_fmaxf(__uint_as_float(rr[0]),__uint_as_float(rr[1])); } \
      resc=false; \
      if(__builtin_expect(__any(rm>(float)THRL),0)){ const float dl=__builtin_fmaxf(rm,0.f); mhat+=dl; \
        _Pragma("unroll") for(int r=0;r<16;++r){C0[r]-=dl;C1[r]-=dl;} \
        _Pragma("unroll") for(int r=0;r<16;++r)negm[r]=-mhat; asm volatile("":"+v"(negm)); \
        const float f=__builtin_amdgcn_exp2f(-dl); l_reg*=f; if(hi==0)wsf[r32]=f; resc=true; } } \
    SBAR(); \
    GAPB(o[0]=__builtin_amdgcn_mfma_f32_32x32x16_bf16(PAF(0),VFR(0),o[0],0,0,0), C0,0); \
    GAPB(o[1]=__builtin_amdgcn_mfma_f32_32x32x16_bf16(PAF(0),VFR(4),o[1],0,0,0), C0,4); \
    KRD(GL,0); GAPB(o[0]=__builtin_amdgcn_mfma_f32_32x32x16_bf16(PAF(1),VFR(1),o[0],0,0,0), C0,8); \
    KRD(GL,1); GAPB(o[1]=__builtin_amdgcn_mfma_f32_32x32x16_bf16(PAF(1),VFR(5),o[1],0,0,0), C0,12); \
    KRD(GL,2); GAPB(o[0]=__builtin_amdgcn_mfma_f32_32x32x16_bf16(PAF(2),VFR(2),o[0],0,0,0), C1,0); \
    KRD(GL,3); GAPB(o[1]=__builtin_amdgcn_mfma_f32_32x32x16_bf16(PAF(2),VFR(6),o[1],0,0,0), C1,4); \
    GAPB(o[0]=__builtin_amdgcn_mfma_f32_32x32x16_bf16(PAF(3),VFR(3),o[0],0,0,0), C1,8); \
    GAPB(o[1]=__builtin_amdgcn_mfma_f32_32x32x16_bf16(PAF(3),VFR(7),o[1],0,0,0), C1,12); \
    }while(0)
  int t=1;
  for(;t+5<NT;t+=2){
    STEP(pB0,pB1,pA0,pA1,t,true,true,true);     WAIT_BAR(2); RESC(); ROT();
    STEP(pA0,pA1,pB0,pB1,t+1,true,true,true);   WAIT_BAR(2); RESC(); ROT();
  }
  #define ENDW(tt) do{ if((tt)+3<NT){WAIT_BAR(2);} else if((tt)+2<NT){WAIT_BAR(1);} else {WAIT_BAR(0);} }while(0)
  for(;t+1<NT;t+=2){
    STEP(pB0,pB1,pA0,pA1,t,(t+3<NT),(t+1<NT),(t+1<NT));       ENDW(t);   RESC(); ROT();
    STEP(pA0,pA1,pB0,pB1,t+1,(t+4<NT),(t+2<NT),(t+2<NT));     ENDW(t+1); RESC(); ROT();
  }
  STEP(pB0,pB1,pA0,pA1,NT-1,false,false,false); RESC();
  { float sacc=pB0[0]+pB0[1]; _Pragma("unroll") for(int r=2;r<16;++r)sacc+=pB0[r]; _Pragma("unroll") for(int r=0;r<16;++r)sacc+=pB1[r]; l_reg+=sacc;
    pw0=(u32x4){PKW(pB0,0),PKW(pB0,2),PKW(pB0,4),PKW(pB0,6)};pw1=(u32x4){PKW(pB0,8),PKW(pB0,10),PKW(pB0,12),PKW(pB0,14)};pw2=(u32x4){PKW(pB1,0),PKW(pB1,2),PKW(pB1,4),PKW(pB1,6)};pw3=(u32x4){PKW(pB1,8),PKW(pB1,10),PKW(pB1,12),PKW(pB1,14)};
    SBAR(); pv(o,vb0+sl_cur,PAF(0),PAF(1),PAF(2),PAF(3)); }
  #undef PKW
  #undef PAF
  #undef VFR
  #undef PIN
  #undef MX3
  #undef GAPA
  #undef GAPB
  #undef EX
  #undef VRD
  #undef KRD
  #undef STEP
  #undef ENDW
  if(MODE==1&&hi==0)l_reg+=__builtin_amdgcn_exp2f(sinkl2-mhat);
  {auto rr=__builtin_amdgcn_permlane32_swap(__float_as_uint(l_reg),__float_as_uint(l_reg),false,false);l_reg=__uint_as_float(rr[0])+__uint_as_float(rr[1]);}
  if(hi==0)wsf[32+r32]=l_reg;asm volatile("s_waitcnt lgkmcnt(0)":::"memory");
  float rli[16];
  #pragma unroll
  for(int r=0;r<16;++r)rli[r]=__builtin_amdgcn_rcpf(wsf[32+crow(r,hi)]);
  bf16*Ow=Op+(long)(q0+wid*QBLK)*PO;
  { bf16*stg=(bf16*)(shm+LDS_OST)+wid*2048;
    #pragma unroll
    for(int r=0;r<16;++r){const int orow=crow(r,hi);
      #pragma unroll
      for(int d0=0;d0<2;++d0)stg[orow*64+d0*32+r32]=__float2bfloat16(o[d0][r]*rli[r]);}
    asm volatile("s_waitcnt lgkmcnt(0)":::"memory");
    #pragma unroll
    for(int i=0;i<4;++i){const int row=i*8+(lane>>3),ch=lane&7; const u32x4 v=*(const u32x4*)(stg+row*64+ch*8); ATTN_STORE16(Ow+(long)row*PO+ch*8,v);} }
  asm volatile("s_waitcnt lgkmcnt(0)\n\ts_barrier":::"memory");
  #undef DMA_K
  #undef TILE_SRC
  #undef DMA_V
  #undef CMASK
  #undef START
  #undef RESC
  #undef ROT
}
#undef SBAR
#undef WAIT_BAR
}

constexpr int SD_CUM = 0, SD_DTV = 1024, SD_XC = 2048, SD_XCS = 144, SD_BC = SD_XC + 128 * SD_XCS, SD_BCS = 272, SD_CC = SD_BC + 128 * SD_BCS, SD_HS = SD_CC + 128 * SD_BCS,
              SD_SSQ = SD_HS + 2 * 64 * SD_BCS, SD_XW = SD_CC;
static_assert(SD_SSQ + 1024 <= RING_BYTES && SD_XW + 2 * 128 * SD_XCS <= RING_BYTES, "SSD LDS map");
DI int chunk_row(int b, int cidx) { return cidx < 2 ? NLAT + b * CTXL + 128 * cidx : b * SEQ + 128 * (cidx - 2); }
DI void ssd_cum(const Frame& F, int l, int b, int cidx, int hd, int wv0) {
    if (F.wave >= wv0 && F.wave < wv0 + 2) {
        const int dir = F.wave - wv0; const float* DT = WSP(float, WS_DT) + (size_t)chunk_row(b, cidx) * 16 + dir * 8 + hd;
        const float a = -__expf(F.in[I_ALOG][l * 16 + dir * 8 + hd]);
        const float d0 = DT[(size_t)(2 * F.lane) * 16], d1 = DT[(size_t)(2 * F.lane + 1) * 16];
        const float a0 = d0 * a, a1 = d1 * a, s = a0 + a1; float v = s;
        LAS float* cum = (LAS float*)(F.lds + SD_CUM) + dir * 128; LAS float* dtv = (LAS float*)(F.lds + SD_DTV) + dir * 128;
        if (dir == 0) {
#pragma unroll
            for (int o = 1; o < 64; o <<= 1) { const float t = __shfl_up(v, o); if (F.lane >= o) v += t; }
            cum[2 * F.lane] = v - s + a0; cum[2 * F.lane + 1] = v;
        } else {
#pragma unroll
            for (int o = 1; o < 64; o <<= 1) { const float t = __shfl_down(v, o); if (F.lane + o < 64) v += t; }
            cum[2 * F.lane + 1] = v - s + a1; cum[2 * F.lane] = v;
        }
        dtv[2 * F.lane] = d0; dtv[2 * F.lane + 1] = d1;
    }
}
DI void conv_items(const Frame& F, int l, int hd, int nitems, int rowbase, int seqlo, int seqhi) {
    const bf16_t* PRJ = WSP(bf16_t, WS_PRJ); const float* cw = F.in[I_CONVW] + (size_t)l * 5 * 1024; const float* cb = F.in[I_CONVB] + l * 1024;
    for (int item = F.tid; item < nitems; item += NTHR) {
        int chunk, seg, c0, dstride, dcol; LAS unsigned char* dst;
        if (item < 128) { chunk = item & 7; seg = item >> 3; c0 = 64 * hd + chunk * 8; dst = F.lds + SD_XC; dstride = SD_XCS; dcol = chunk * 16; }
        else if (item < 384) { const int q = item - 128; chunk = q & 15; seg = q >> 4; c0 = 512 + 128 * (hd >> 2) + chunk * 8; dst = F.lds + SD_BC; dstride = SD_BCS; dcol = chunk * 16; }
        else { const int q = item - 384; chunk = q & 15; seg = q >> 4; c0 = 768 + 128 * (hd >> 2) + chunk * 8; dst = F.lds + SD_CC; dstride = SD_BCS; dcol = chunk * 16; }
        const int t0 = seg * 8;
        float w[5][8], bb[8];
#pragma unroll
        for (int k = 0; k < 5; ++k) { const f32x4 wa = *(const f32x4*)(cw + k * 1024 + c0), wb = *(const f32x4*)(cw + k * 1024 + c0 + 4);
            w[k][0] = wa[0]; w[k][1] = wa[1]; w[k][2] = wa[2]; w[k][3] = wa[3]; w[k][4] = wb[0]; w[k][5] = wb[1]; w[k][6] = wb[2]; w[k][7] = wb[3]; }
        { const f32x4 ba = *(const f32x4*)(cb + c0), b2 = *(const f32x4*)(cb + c0 + 4); bb[0] = ba[0]; bb[1] = ba[1]; bb[2] = ba[2]; bb[3] = ba[3]; bb[4] = b2[0]; bb[5] = b2[1]; bb[6] = b2[2]; bb[7] = b2[3]; }
        u32x4 rows[12];
#pragma unroll
        for (int i = 0; i < 12; ++i) { const int row = rowbase + t0 - 2 + i;
            rows[i] = (row >= seqlo && row < seqhi) ? *(const u32x4*)(PRJ + (size_t)row * PRJW + C_XBC + c0) : (u32x4){0u, 0u, 0u, 0u}; }
#pragma unroll
        for (int j = 0; j < 8; ++j) {
            float y[8];
#pragma unroll
            for (int e = 0; e < 8; ++e) y[e] = bb[e];
#pragma unroll
            for (int k = 0; k < 5; ++k) { const u32x4 rr = rows[j + k];
                y[0] += w[k][0] * bflo(rr.x); y[1] += w[k][1] * bfhi(rr.x); y[2] += w[k][2] * bflo(rr.y); y[3] += w[k][3] * bfhi(rr.y);
                y[4] += w[k][4] * bflo(rr.z); y[5] += w[k][5] * bfhi(rr.z); y[6] += w[k][6] * bflo(rr.w); y[7] += w[k][7] * bfhi(rr.w); }
            u32x4 o; o.x = pk2(silu(y[0]), silu(y[1])); o.y = pk2(silu(y[2]), silu(y[3])); o.z = pk2(silu(y[4]), silu(y[5])); o.w = pk2(silu(y[6]), silu(y[7]));
            *(LAS u32x4*)(dst + (t0 + j) * dstride + dcol) = o;
        }
    }
}
DI void ssd_s1_unit(const Frame& Fin, int l, int b, int cidx, int hd) {
    const Frame F = launder(Fin);
    const int lane = F.lane, wid = F.wave, r = lane & 31, h = lane >> 5;
    const int rowbase = chunk_row(b, cidx), seqlo = cidx < 2 ? NLAT + b * CTXL : b * SEQ, seqhi = cidx < 2 ? seqlo + CTXL : seqlo + SEQ;
    __syncthreads();
    ssd_cum(F, l, b, cidx, hd, 6);
    conv_items(F, l, hd, 384, rowbase, seqlo, seqhi);
    __syncthreads();
    const LAS float* cum = (const LAS float*)(F.lds + SD_CUM); const LAS float* dtv = (const LAS float*)(F.lds + SD_DTV);
    for (int i = F.tid; i < 2 * 128 * 8; i += NTHR) {
        const int dir = i >> 10, t = (i >> 3) & 127, c8 = i & 7;
        const float ce = dir == 0 ? cum[127] : cum[128]; const float wgt = dtv[dir * 128 + t] * __expf(ce - cum[dir * 128 + t]);
        const u32x4 x = *(const LAS u32x4*)(F.lds + SD_XC + t * SD_XCS + c8 * 16);
        u32x4 o; o.x = pk2(bflo(x.x) * wgt, bfhi(x.x) * wgt); o.y = pk2(bflo(x.y) * wgt, bfhi(x.y) * wgt); o.z = pk2(bflo(x.z) * wgt, bfhi(x.z) * wgt); o.w = pk2(bflo(x.w) * wgt, bfhi(x.w) * wgt);
        *(LAS u32x4*)(F.lds + SD_XW + (dir * 128 + t) * SD_XCS + c8 * 16) = o;
    }
    __syncthreads();
    const int dir = wid >> 2, nb = wid & 3, q4 = (lane & 15) >> 2, p4 = lane & 3, blk = (lane >> 4) & 1;
    f32x16 s0, s1;
#pragma unroll
    for (int i = 0; i < 16; ++i) { s0[i] = 0.f; s1[i] = 0.f; }
    const LAS unsigned char* xa = F.lds + SD_XW + (dir * 128 + 8 * h + q4) * SD_XCS + (16 * blk + 4 * p4) * 2;
    const LAS unsigned char* ba = F.lds + SD_BC + (8 * h + q4) * SD_BCS + (32 * nb + 16 * blk + 4 * p4) * 2;
#pragma unroll
    for (int ks = 0; ks < 8; ++ks) {
        const bf16x8 bfr = cat8(tr_read(ba + (16 * ks) * SD_BCS), tr_read(ba + (16 * ks + 4) * SD_BCS));
        const bf16x8 x0 = cat8(tr_read(xa + (16 * ks) * SD_XCS), tr_read(xa + (16 * ks + 4) * SD_XCS));
        const bf16x8 x1 = cat8(tr_read(xa + (16 * ks) * SD_XCS + 64), tr_read(xa + (16 * ks + 4) * SD_XCS + 64));
        s0 = MFMA32(bfr, x0, s0); s1 = MFMA32(bfr, x1, s1);
    }
    bf16_t* ST = WSP(bf16_t, WS_ST) + ((((size_t)b * NCH + cidx) * 8 + hd) * 2 + dir) * 8192 + 32 * nb + 4 * h;
#pragma unroll
    for (int g4 = 0; g4 < 4; ++g4) { st4bf(ST + (size_t)r * 128 + 8 * g4, (f32x4){s0[4 * g4], s0[4 * g4 + 1], s0[4 * g4 + 2], s0[4 * g4 + 3]});
        st4bf(ST + (size_t)(32 + r) * 128 + 8 * g4, (f32x4){s1[4 * g4], s1[4 * g4 + 1], s1[4 * g4 + 2], s1[4 * g4 + 3]}); }
    if (F.tid < 2) WSP(float, WS_CDEC)[(((size_t)b * NCH + cidx) * 8 + hd) * 2 + F.tid] = __expf(F.tid == 0 ? cum[127] : cum[128]);
}
DI void phase_scan(const Frame& F) {
    bf16_t* ST = WSP(bf16_t, WS_ST); const float* CD = WSP(float, WS_CDEC);
    for (int gid = F.vcu * NTHR + F.tid; gid < 64 * 1024; gid += F.G * NTHR) {
        const int chain = gid >> 10, e8 = gid & 1023, b = chain >> 4, hd = (chain >> 1) & 7, dir = chain & 1;
        float hs[8];
#pragma unroll
        for (int e = 0; e < 8; ++e) hs[e] = 0.f;
        for (int k0 = 0; k0 < NCH; k0 += 11) {
            u32x4 st[11]; float dec[11];
#pragma unroll
            for (int j = 0; j < 11; ++j) { const int k = k0 + j, cidx = dir == 0 ? k : (k < 2 ? 1 - k : 67 - k); const size_t idx = (((size_t)b * NCH + cidx) * 8 + hd) * 2 + dir;
                st[j] = *((const u32x4*)(ST + idx * 8192) + e8); dec[j] = CD[idx]; }
#pragma unroll
            for (int j = 0; j < 11; ++j) { const int k = k0 + j, cidx = dir == 0 ? k : (k < 2 ? 1 - k : 67 - k); const size_t idx = (((size_t)b * NCH + cidx) * 8 + hd) * 2 + dir;
                u32x4 o; o.x = pk2(hs[0], hs[1]); o.y = pk2(hs[2], hs[3]); o.z = pk2(hs[4], hs[5]); o.w = pk2(hs[6], hs[7]); *((u32x4*)(ST + idx * 8192) + e8) = o;
                const u32x4 u = st[j]; const float d = dec[j];
                hs[0] = hs[0] * d + bflo(u.x); hs[1] = hs[1] * d + bfhi(u.x); hs[2] = hs[2] * d + bflo(u.y); hs[3] = hs[3] * d + bfhi(u.y);
                hs[4] = hs[4] * d + bflo(u.z); hs[5] = hs[5] * d + bfhi(u.z); hs[6] = hs[6] * d + bflo(u.w); hs[7] = hs[7] * d + bfhi(u.w); }
        }
    }
}
DI void ssd_s3_unit(const Frame& Fin, int l, int b, int cidx, int hd) {
    const Frame F = launder(Fin);
    const int lane = F.lane, wid = F.wave, r = lane & 31, h = lane >> 5;
    const int rowbase = chunk_row(b, cidx), seqlo = cidx < 2 ? NLAT + b * CTXL : b * SEQ, seqhi = cidx < 2 ? seqlo + CTXL : seqlo + SEQ;
    __syncthreads();
    ssd_cum(F, l, b, cidx, hd, 6);
    conv_items(F, l, hd, 640, rowbase, seqlo, seqhi);
    {
        const bf16_t* ST = WSP(bf16_t, WS_ST) + (((size_t)b * NCH + cidx) * 8 + hd) * 2 * 8192;
        for (int i = F.tid; i < 2 * 64 * 16; i += NTHR) { const int dp = i >> 4, c8 = i & 15; *(LAS u32x4*)(F.lds + SD_HS + dp * SD_BCS + c8 * 16) = *(const u32x4*)(ST + (size_t)dp * 128 + c8 * 8); }
    }
    __syncthreads();
    const LAS float* cum = (const LAS float*)(F.lds + SD_CUM); const LAS float* dtv = (const LAS float*)(F.lds + SD_DTV);
    const int lb = wid & 3, ph = wid >> 2, q4 = (lane & 15) >> 2, p4 = lane & 3, blk = (lane >> 4) & 1;
    const int lidx = 32 * lb + r;
    bf16x8 cf[8];
#pragma unroll
    for (int ks = 0; ks < 8; ++ks) cf[ks] = *(const LAS bf16x8*)(F.lds + SD_CC + lidx * SD_BCS + (16 * ks + 8 * h) * 2);
    f32x16 gt[4];
#pragma unroll
    for (int sb = 0; sb < 4; ++sb) {
#pragma unroll
        for (int i = 0; i < 16; ++i) gt[sb][i] = 0.f;
#pragma unroll
        for (int ks = 0; ks < 8; ++ks) { const bf16x8 bfr = *(const LAS bf16x8*)(F.lds + SD_BC + (32 * sb + r) * SD_BCS + (16 * ks + 8 * h) * 2); gt[sb] = MFMA32(bfr, cf[ks], gt[sb]); }
    }
    f32x16 ytot;
#pragma unroll
    for (int i = 0; i < 16; ++i) ytot[i] = 0.f;
    const LAS unsigned char* xa = F.lds + SD_XC + (4 * h + q4) * SD_XCS + (32 * ph + 16 * blk + 4 * p4) * 2;
#pragma unroll
    for (int dir = 0; dir < 2; ++dir) {
        const float cl = cum[dir * 128 + lidx];
        f32x16 acc;
#pragma unroll
        for (int i = 0; i < 16; ++i) acc[i] = 0.f;
#pragma unroll
        for (int sb = 0; sb < 4; ++sb) {
            const bool relv = dir == 0 ? (sb <= lb) : (sb >= lb);
            if (relv) {
                f32x16 mt; int rl = r; asm volatile("" : "+v"(rl));
#pragma unroll
                for (int i = 0; i < 16; ++i) { const int sl = crow(i, h), s = 32 * sb + sl;
                    const bool ok = (sb != lb) || (dir == 0 ? (sl <= rl) : (sl >= rl));
                    const float e = __expf(cl - cum[dir * 128 + s]) * dtv[dir * 128 + s];
                    mt[i] = ok ? gt[sb][i] * e : 0.f; }
                const bf16x8 pa0 = pack8<0>(mt), pa1 = pack8<1>(mt);
                const bf16x8 x0 = cat8(tr_read(xa + (32 * sb) * SD_XCS), tr_read(xa + (32 * sb + 8) * SD_XCS));
                const bf16x8 x1 = cat8(tr_read(xa + (32 * sb + 16) * SD_XCS), tr_read(xa + (32 * sb + 24) * SD_XCS));
                acc = MFMA32(x0, pa0, acc); acc = MFMA32(x1, pa1, acc);
            }
        }
        f32x16 yo;
#pragma unroll
        for (int i = 0; i < 16; ++i) yo[i] = 0.f;
#pragma unroll
        for (int ks = 0; ks < 8; ++ks) { const bf16x8 hf = *(const LAS bf16x8*)(F.lds + SD_HS + (dir * 64 + 32 * ph + r) * SD_BCS + (16 * ks + 8 * h) * 2); yo = MFMA32(hf, cf[ks], yo); }
        const float el = __expf(cl);
#pragma unroll
        for (int i = 0; i < 16; ++i) ytot[i] += acc[i] + el * yo[i];
    }
    const float dsk = F.in[I_DSKIP][l * 8 + hd];
    const int row = rowbase + lidx;
    const bf16_t* zp = WSP(bf16_t, WS_PRJ) + (size_t)row * PRJW + C_Z + 64 * hd + 32 * ph + 4 * h;
    bf16_t* op = WSP(bf16_t, WS_OC) + (size_t)row * OCW + 1536 + 64 * hd + 32 * ph + 4 * h;
    float ss = 0.f;
#pragma unroll
    for (int g4 = 0; g4 < 4; ++g4) {
        const u32x2 zz = *(const u32x2*)(zp + 8 * g4);
        const u32x2 xx = *(const LAS u32x2*)(F.lds + SD_XC + lidx * SD_XCS + (32 * ph + 8 * g4 + 4 * h) * 2);
        const float v0 = (ytot[4 * g4] + dsk * bflo(xx.x)) * silu(bflo(zz.x)), v1 = (ytot[4 * g4 + 1] + dsk * bfhi(xx.x)) * silu(bfhi(zz.x));
        const float v2 = (ytot[4 * g4 + 2] + dsk * bflo(xx.y)) * silu(bflo(zz.y)), v3 = (ytot[4 * g4 + 3] + dsk * bfhi(xx.y)) * silu(bfhi(zz.y));
        ss += (v0 * v0 + v1 * v1) + (v2 * v2 + v3 * v3);
        u32x2 w; w.x = pk2(v0, v1); w.y = pk2(v2, v3); *(u32x2*)(op + 8 * g4) = w;
    }
    ss += __shfl_xor(ss, 32);
    LAS float* sq = (LAS float*)(F.lds + SD_SSQ);
    if (h == 0) sq[ph * 128 + lidx] = ss;
    __syncthreads();
    if (F.tid < 128) WSP(float, WS_SSQ)[(size_t)(rowbase + F.tid) * 8 + hd] = sq[F.tid] + sq[128 + F.tid];
}

constexpr int PH_PER_LAYER = 11, N_PHASES = 2 + PH_PER_LAYER * DEPTH;
__global__ void __launch_bounds__(NTHR, 2) fwd_kernel(Args args) {
    extern __shared__ __attribute__((aligned(16))) unsigned char smem[];
    Frame F0;
    F0.lds = (LAS unsigned char*)smem;
    F0.tid = threadIdx.x; F0.lane = F0.tid & 63; F0.wave = __builtin_amdgcn_readfirstlane(F0.tid >> 6);
    F0.G = gridDim.x; F0.bx = blockIdx.x; { const int bx = blockIdx.x; F0.vcu = (F0.G % 8 == 0) ? (bx % 8) * (F0.G / 8) + bx / 8 : bx; }
    F0.in = args.in; F0.out = args.out; F0.ws = args.ws; F0.ctl = (gu32*)(args.ws + WS_CTL);
    volatile LAS unsigned* MISC = (volatile LAS unsigned*)(F0.lds + MISC_OFF);
    for (int u = F0.tid; u < (LDS_BYTES - RING_BYTES) / 4; u += NTHR) ((LAS unsigned*)(F0.lds + RING_BYTES))[u] = 0u;
    __syncthreads();
    XcdBarrier bar; bar.bar = (unsigned*)(F0.ctl + CW_BAR); bar.x = 0; bar.st = nullptr;
    if (!MK_PER_PHASE) bar = xcd_barrier_post((unsigned*)(F0.ctl + CW_BAR), MISC + 8);
    const int lo = args.ph_lo, hi = args.ph_hi;
#define IN(k) (lo <= (k) && (k) < hi)
#define SEAM(k) do { if (IN(k) && IN((k) + 1)) { if (MK_PER_PHASE) { if (F0.tid == 0) __hip_atomic_store(F0.ctl + 0, 0xBADBA0u, __ATOMIC_RELAXED, __HIP_MEMORY_SCOPE_AGENT); } else xcd_barrier(bar); } } while (0)

    if (PHM(11) && IN(0)) { const Frame F = launder(F0); _Pragma("nounroll") for (int rep = 0; rep < 1 + REPB(11); ++rep) { phase_prologue_a(F); __syncthreads(); } } SEAM(0);
    if (PHM(12) && IN(1)) { const Frame F = launder(F0); _Pragma("nounroll") for (int rep = 0; rep < 1 + REPB(12); ++rep) { phase_prologue_b(F); __syncthreads(); } } SEAM(1);

    for (int l = 0; l < DEPTH; ++l) {
        const int pb = 2 + PH_PER_LAYER * l;
        const bool with_ctx = l < DEPTH - 1, moe = l & 1; const int fi = l >> 1;
        const int mrows = with_ctx ? MTOT : NLAT, mtiles = with_ctx ? 132 : 128;
        if (PHM(0) && IN(pb + 0)) { const Frame F = launder(F0);
            pg8::SchedGrid S; S.nMa = mtiles; S.nNa = 34; S.nMb = with_ctx ? 0 : 4; S.nNb = 18; S.total = S.nMa * S.nNa + S.nMb * S.nNb; S.G = F.G; S.c = F.bx;
            S.A = (const char*)(F.ws + WS_HB); S.B = (const char*)(F.ws + WS_WCOMB + l * SZ_WCOMB); S.lda = DM; S.ldb = DM; S.a_div = 1; S.a_cols = 0; S.pe = nullptr; S.estride = 0; S.rep = REPB(0);
            pg8::EpiInGate E{WSP(bf16_t, WS_PRJ), WSP(bf16_t, WS_GT), F.in[I_BGATE] + (size_t)l * 4096};
            pg8::gemm_phase(F.lds, F.tid, DM, DM, DM, S, E);
        }
        SEAM(pb + 0);
        if (PHM(1) && IN(pb + 1)) { const Frame F = launder(F0);
            phase_qkprep_rows(F, l);
            for (int uu = F.vcu; uu < ((NB * NCH * 8) << REPB(15)); uu += F.G) { const int u = uu < NB * NCH * 8 ? uu : uu - NB * NCH * 8; const int hd = u & 7, cidx = (u >> 3) % NCH, b = (u >> 3) / NCH; ssd_s1_unit(F, l, b, cidx, hd); }
        }
        SEAM(pb + 1);
        if (PHM(2) && IN(pb + 2)) { const Frame F = launder(F0); phase_scan(F); }
        SEAM(pb + 2);
        if (PHM(3) && IN(pb + 3)) { const Frame F = launder(F0);
            const int nchs = with_ctx ? NCH : NCH - 2, n_s3 = NB * nchs * 8;
            _Pragma("nounroll") for (int rep = 0; rep < 1 + REPB(3); ++rep) {
            {
                for (int uu = F.vcu; uu < (1024 << REPB(13)); uu += F.G) { const int u = uu & 1023;
                    const int v = u & 1023, qblk = v & 31, b = v >> 8, hg = (v >> 5) & 3, kvh = (v >> 7) & 1, hq = kvh * 4 + hg;
                    const ga_body::bf16* P = (const ga_body::bf16*)(F.ws + WS_PRJ); const size_t lat0 = (size_t)(b * SEQ) * PRJW, ctx0 = (size_t)(NLAT + b * CTXL) * PRJW;
                    ga_body::bf16* O = (ga_body::bf16*)(F.ws + WS_OC) + (size_t)(b * SEQ) * OCW;
                    ga_body::attn_unit<8, 0>(qblk, P + lat0 + C_GAQ + hq * 64, P + lat0 + C_GAK + kvh * 64, P + lat0 + C_GAV + kvh * 64, P + ctx0 + C_GAK + kvh * 64, P + ctx0 + C_GAV + kvh * 64,
                                             O + 1024 + hq * 64, (char*)F.lds, F.tid, 132, 0, 0.f, nullptr);
                }
            }
            {
                const Frame F = launder(F0);
                for (int uu = F.vcu; uu < (1024 << REPB(14)); uu += F.G) { const int u = uu & 1023;
                    const int v = u & 1023, qblk = v & 31, b = v >> 8, hq = (v >> 5) & 7;
                    const ga_body::bf16* P = (const ga_body::bf16*)(F.ws + WS_PRJ); const size_t lat0 = (size_t)(b * SEQ) * PRJW, ctx0 = (size_t)(NLAT + b * CTXL) * PRJW;
                    ga_body::bf16* O = (ga_body::bf16*)(F.ws + WS_OC) + (size_t)(b * SEQ) * OCW;
                    int tlo = clampi(4 * qblk - 4, 0, 120), thi = clampi(4 * qblk - 1, 0, 120) + 8; if ((thi - tlo) & 1) { if (thi < 128) ++thi; else --tlo; }
                    const size_t lo = lat0 + (size_t)tlo * 64 * PRJW;
                    ga_body::attn_unit<8, 2>(qblk, P + lat0 + C_NAQ + hq * 64, P + lo + C_NAK + hq * 64, P + lo + C_NAV + hq * 64, P + ctx0 + C_NAK + hq * 64, P + ctx0 + C_NAV + hq * 64,
                                             O + hq * 64, (char*)F.lds, F.tid, 4 + thi - tlo, tlo, 0.f, F.in[I_RPB] + ((size_t)l * 8 + hq) * 465);
                }
            }
            {
                const Frame F = launder(F0);
                for (int uu = F.vcu; uu < (1024 << REPB(14)); uu += F.G) { const int u = uu & 1023;
                    const int v = u & 1023, qblk = v & 31, b = v >> 8, hg = (v >> 5) & 3, kvh = (v >> 7) & 1, hq = kvh * 4 + hg;
                    const ga_body::bf16* P = (const ga_body::bf16*)(F.ws + WS_PRJ); const size_t lat0 = (size_t)(b * SEQ) * PRJW, ctx0 = (size_t)(NLAT + b * CTXL) * PRJW;
                    ga_body::bf16* O = (ga_body::bf16*)(F.ws + WS_OC) + (size_t)(b * SEQ) * OCW;
                    const int tlo = 4 * qblk - 2 < 0 ? 0 : 4 * qblk - 2, thi = 4 * qblk + 6 > 128 ? 128 : 4 * qblk + 6; const size_t lo = lat0 + (size_t)tlo * 64 * PRJW;
                    ga_body::attn_unit<8, 1>(qblk, P + lat0 + C_SWQ + hq * 64, P + lo + C_SWK + kvh * 64, P + lo + C_SWV + kvh * 64, P + ctx0 + C_SWK + kvh * 64, P + ctx0 + C_SWV + kvh * 64,
                                             O + 512 + hq * 64, (char*)F.lds, F.tid, 4 + thi - tlo, tlo, F.in[I_SINK][l * 8 + hq] * LOG2E, nullptr);
                }
            }
            if (with_ctx) {
                const Frame F = launder(F0);
                for (int uu = F.vcu; uu < (96 << REPB(14)); uu += F.G) { const int u = uu < 96 ? uu : uu - 96;
                    const int mode = u >> 5, b = (u >> 3) & 3, hq = u & 7, kvh = mode == 0 ? hq : (hq >> 2);
                    const int qc = mode == 0 ? C_NAQ : (mode == 1 ? C_SWQ : C_GAQ), kc = mode == 0 ? C_NAK : (mode == 1 ? C_SWK : C_GAK), vc = mode == 0 ? C_NAV : (mode == 1 ? C_SWV : C_GAV), oc = mode == 0 ? 0 : (mode == 1 ? 512 : 1024);
                    const ga_body::bf16* P = (const ga_body::bf16*)(F.ws + WS_PRJ); const size_t ctx0 = (size_t)(NLAT + b * CTXL) * PRJW;
                    ga_body::bf16* O = (ga_body::bf16*)(F.ws + WS_OC) + (size_t)(NLAT + b * CTXL) * OCW + oc + hq * 64;
                    const ga_body::bf16* K = P + ctx0 + kc + kvh * 64; const ga_body::bf16* V = P + ctx0 + vc + kvh * 64;
                    if (mode == 1) ga_body::attn_unit<8, 1>(0, P + ctx0 + qc + hq * 64, K, V, K, V, O, (char*)F.lds, F.tid, 4, 0, F.in[I_SINK][l * 8 + hq] * LOG2E, nullptr);
                    else ga_body::attn_unit<8, 0>(0, P + ctx0 + qc + hq * 64, K, V, K, V, O, (char*)F.lds, F.tid, 4, 0, 0.f, nullptr);
                }
            }
            const Frame Fb = launder(F0);
            for (int uu = Fb.vcu; uu < (n_s3 << REPB(14)); uu += Fb.G) { const Frame& F = Fb; const int u = uu < n_s3 ? uu : uu - n_s3;
                const int hd = u & 7, cc = (u >> 3) % nchs, b = (u >> 3) / nchs; ssd_s3_unit(F, l, b, with_ctx ? cc : cc + 2, hd);
            }
            }
        }
        SEAM(pb + 3);
        if (PHM(4) && IN(pb + 4)) { const Frame F = launder(F0);
            pg8::SchedBranch S; S.rep = REPB(4); S.T = mtiles * 8; S.G = F.G; S.c = F.vcu; S.A = (const char*)(F.ws + WS_OC); S.B = (const char*)(F.ws + WS_WB + l * SZ_WB);
            pg8::EpiBranch E{WSP(bf16_t, WS_GT), WSP(float, WS_SSQ), WSP(bf16_t, WS_PRJ)};
            pg8::gemm_phase<pg8::EpiBranch, pg8::SchedBranch, true>(F.lds, F.tid, 512, OCW, 512, S, E);
        }
        SEAM(pb + 4);
        if (PHM(5) && IN(pb + 5)) { const Frame F = launder(F0);
            pg8::SchedGrid S; S.nMa = mtiles; S.nNa = 4; S.nMb = 0; S.nNb = 1; S.total = S.nMa * S.nNa; S.G = F.G; S.c = F.bx;
            S.A = (const char*)(F.ws + WS_PRJ); S.B = (const char*)(F.ws + WS_WO + l * SZ_WO); S.lda = DM; S.ldb = DM; S.a_div = 1; S.a_cols = 0; S.pe = nullptr; S.estride = 0; S.rep = REPB(5);
            pg8::EpiResid E{WSP(bf16_t, WS_XS), WSP(float, WS_MVEC) + (size_t)l * 5 * 6144 + 2048, nullptr, WSP(bf16_t, WS_END)};
            pg8::gemm_phase(F.lds, F.tid, DM, DM, DM, S, E);
        }
        SEAM(pb + 5);
        if (PHM(6) && IN(pb + 6)) { const Frame F = launder(F0); phase_ln1(F, l, mrows); }
        SEAM(pb + 6);
        if (moe) { if (PHM(7) && IN(pb + 7)) { const Frame F = launder(F0); phase_gather(F, l, mrows); } SEAM(pb + 7); }
        if (PHM(8) && IN(pb + 8)) {
            if (!moe) { const Frame F = launder(F0);
                pg8::SchedGrid S; S.rep = REPB(8); S.nMb = 0; S.nNb = 1; S.G = F.G; S.c = F.bx; S.lda = DM; S.ldb = DM; S.a_div = 1; S.a_cols = 0; S.pe = nullptr; S.estride = 0;
                S.nMa = mtiles; S.nNa = DFF / 128; S.A = (const char*)(F.ws + WS_HB); S.B = (const char*)(F.ws + WS_WUP + fi * SZ_WUP); S.total = S.nMa * S.nNa;
                pg8::EpiSwiGLU<false> E{WSP(bf16_t, WS_HID), DFF};
                pg8::gemm_phase(F.lds, F.tid, DM, DM, DM, S, E);
            } else { const Frame F = launder(F0);
                pg8::SchedGrid S; S.rep = REPB(8); S.nMb = 0; S.nNb = 1; S.G = F.G; S.c = F.bx; S.lda = DM / 2; S.ldb = DM / 2; S.a_div = 1; S.a_cols = 0;
                const int npad = moe_pad_ends_lds(F, fi); S.pe = (const LAS int*)(F.lds + MISC_OFF + 64); S.nMa = npad / 256; S.nNa = DFFE / 128;
                S.A = (const char*)(F.ws + WS_XPAD); S.B = (const char*)(F.ws + WS_MUP + fi * SZ_MUP); S.estride = (size_t)2 * DFFE * DM; S.total = S.nMa * S.nNa;
                pg8::EpiSwiGLU<true> E{WSP(bf16_t, WS_HID), DFFE};
                pg8::gemm_phase<pg8::EpiSwiGLU<true>, pg8::SchedGrid, false, true>(F.lds, F.tid, DM / 2, DM / 2, DM / 2, S, E, MOE_UP_SCA);
            }
        }
        SEAM(pb + 8);
        if (PHM(9) && IN(pb + 9)) {
            if (!moe) { const Frame F = launder(F0);
                pg8::SchedGrid S; S.rep = REPB(9); S.nMb = 0; S.nNb = 1; S.nNa = 4; S.G = F.G; S.c = F.bx; S.a_div = 1; S.a_cols = 0; S.pe = nullptr; S.estride = 0; S.A = (const char*)(F.ws + WS_HID);
                pg8::EpiResid E{WSP(bf16_t, WS_XS), WSP(float, WS_MVEC) + (size_t)l * 5 * 6144 + 5120, nullptr, WSP(bf16_t, WS_END)};
                S.nMa = mtiles; S.B = (const char*)(F.ws + WS_WDN + fi * SZ_WDN); S.lda = DFF; S.ldb = DFF; S.total = S.nMa * S.nNa;
                pg8::gemm_phase(F.lds, F.tid, DFF, DFF, DFF, S, E);
            } else { const Frame F = launder(F0);
                pg8::SchedGrid S; S.rep = REPB(9); S.nMb = 0; S.nNb = 1; S.nNa = 4; S.G = F.G; S.c = F.bx; S.a_div = 1; S.a_cols = 0; S.A = (const char*)(F.ws + WS_HID);
                pg8::EpiResid E{WSP(bf16_t, WS_XS), WSP(float, WS_MVEC) + (size_t)l * 5 * 6144 + 5120, WSP(bf16_t, WS_YPAD), WSP(bf16_t, WS_END)};
                const int npad = moe_pad_ends_lds(F, fi); S.pe = (const LAS int*)(F.lds + MISC_OFF + 64); S.nMa = npad / 256; S.B = (const char*)(F.ws + WS_MDN + fi * SZ_MDN); S.estride = (size_t)DM * DFFE;
                S.lda = DFFE / 2; S.ldb = DFFE / 2; S.total = S.nMa * S.nNa;
                pg8::gemm_phase<pg8::EpiResid, pg8::SchedGrid, false, true>(F.lds, F.tid, DFFE / 2, DFFE / 2, DFFE / 2, S, E, MOE_DN_SCA);
            }
        }
        SEAM(pb + 9);
        if (PHM(10) && IN(pb + 10)) { const Frame F = launder(F0); phase_ln2(F, l, mrows); }
        if (l + 1 < DEPTH) SEAM(pb + 10);
    }
#undef IN
#undef SEAM
}

extern "C" void kernel_launch(void* const* d_in, const int* in_sizes, int n_in, void* d_out, int out_size, void* d_ws, size_t ws_size, hipStream_t stream) {
    static int grid = 0;
    if (grid == 0) {
        if (n_in != 31 || in_sizes[0] != NLAT * DM || out_size != NLAT * DM || ws_size < WS_END) {
            fprintf(stderr, "kernel_launch: unexpected shapes: n_in %d in0 %d out %d ws %zu (need %zu); nothing launched\n", n_in, n_in > 0 ? in_sizes[0] : -1, out_size, ws_size, (size_t)WS_END); grid = -1; return; }
        int dev = 0, cus = 0, per_cu = 0;
        if (hipGetDevice(&dev) != hipSuccess || hipDeviceGetAttribute(&cus, hipDeviceAttributeMultiprocessorCount, dev) != hipSuccess) { fprintf(stderr, "kernel_launch: device query failed\n"); grid = -1; return; }
        if (hipFuncSetAttribute((const void*)fwd_kernel, hipFuncAttributeMaxDynamicSharedMemorySize, LDS_BYTES) != hipSuccess) { fprintf(stderr, "kernel_launch: hipFuncSetAttribute failed\n"); grid = -1; return; }
        if (hipOccupancyMaxActiveBlocksPerMultiprocessor(&per_cu, (const void*)fwd_kernel, NTHR, LDS_BYTES) != hipSuccess || per_cu < 1)
            fprintf(stderr, "kernel_launch: note: occupancy query reports %d workgroups per CU\n", per_cu);
        (void)hipGetLastError();
        grid = cus;
    }
    if (grid < 0) return;
    if (hipMemsetAsync((char*)d_ws + WS_CTL, 0, CTL_ZERO_BYTES, stream) != hipSuccess) { fprintf(stderr, "kernel_launch: memset failed\n"); return; }
    Args a{};
    for (int i = 0; i < 31; ++i) a.in[i] = (const float*)d_in[i];
    a.out = (float*)d_out; a.ws = (unsigned char*)d_ws;
#if MK_PER_PHASE
    for (int p = 0; p < N_PHASES; ++p) { a.ph_lo = p; a.ph_hi = p + 1; hipLaunchKernelGGL(fwd_kernel, dim3(grid), dim3(NTHR), LDS_BYTES, stream, a); }
#else
    a.ph_lo = 0; a.ph_hi = N_PHASES;
    hipLaunchKernelGGL(fwd_kernel, dim3(grid), dim3(NTHR), LDS_BYTES, stream, a);
#endif
    const hipError_t le = hipPeekAtLastError();
    if (le != hipSuccess) fprintf(stderr, "kernel_launch: launch failed: %s\n", hipGetErrorName(le));
}
```

```cpp
#include <hip/hip_runtime.h>
#include <cstdio>
#include <cstdint>
#include <hip/hip_bf16.h>
#include <cmath>

#define DI __device__ __forceinline__
#define LAS __attribute__((address_space(3)))
#define GAS __attribute__((address_space(1)))
typedef unsigned short bf16_t;
typedef short bf16x8 __attribute__((ext_vector_type(8)));
typedef short s16x4 __attribute__((ext_vector_type(4)));
typedef float f32x2 __attribute__((ext_vector_type(2)));
typedef float f32x4 __attribute__((ext_vector_type(4)));
typedef float f32x16 __attribute__((ext_vector_type(16)));
typedef unsigned u32x2 __attribute__((ext_vector_type(2)));
typedef unsigned u32x4 __attribute__((ext_vector_type(4)));
typedef __bf16 bf16x2_t __attribute__((ext_vector_type(2)));
typedef GAS unsigned gu32;
typedef int v8i32_t __attribute__((ext_vector_type(8)));
typedef short bf16x16 __attribute__((ext_vector_type(16)));

#ifndef MK_PER_PHASE
#define MK_PER_PHASE 0
#endif
#ifndef PHMASK
#define PHMASK 0xFFFF
#endif
#define PHM(k) ((PHMASK >> (k)) & 1)
#ifndef REP_MASK
#define REP_MASK 0
#endif
#define REPB(k) ((REP_MASK >> (k)) & 1)
#ifndef ABL
#define ABL 0
#endif

constexpr int DM = 1024, NB = 4, SEQ = 8192, CTXL = 256, NLAT = NB * SEQ, NCTX = NB * CTXL, MTOT = NLAT + NCTX;
constexpr int DEPTH = 4, DIN = 4624, PRJW = 4608, GTW = 4096, NCOMB = PRJW + GTW, OCW = 2048;
constexpr int DFF = 2816, DFFE = 3584, NEXP = 8, MOE_ROWS_MAX = 69632;
constexpr int NCH = 66;
constexpr float ALPHA = 1.6817928305074292f;
constexpr float LOG2E = 1.4426950408889634f;
constexpr float C2 = 0.125f * LOG2E;
constexpr float LN_EPS = 1e-5f, RMS_EPS = 1e-6f;
constexpr float MOE_UP_WSCALE = 32.f, MOE_DN_WSCALE = 128.f; constexpr int MOE_UP_SCA = 0x7A7A7A7A, MOE_DN_SCA = 0x78787878;
constexpr int C_NAQ = 0, C_NAK = 512, C_NAV = 1024, C_SWQ = 1536, C_SWK = 2048, C_SWV = 2176, C_GAQ = 2304, C_GAK = 2816, C_GAV = 2944, C_Z = 3072, C_XBC = 3584;

constexpr size_t KiB = 1024, MiB = 1u << 20;
constexpr size_t WS_CTL = 0, CTL_ZERO_BYTES = 1 * MiB;
constexpr size_t WS_MVEC = 1 * MiB;
constexpr size_t WS_ROPE = WS_MVEC + 512 * KiB;
constexpr size_t WS_DT = 4 * MiB;
constexpr size_t WS_SSQ = WS_DT + (size_t)MTOT * 16 * 4;
constexpr size_t WS_SLOT = WS_SSQ + (size_t)MTOT * 8 * 4;
constexpr size_t WS_CDEC = WS_SLOT + (size_t)MTOT * 8 * 4;
constexpr size_t WS_W = 10 * MiB;
constexpr size_t SZ_WCOMB = (size_t)NCOMB * DM * 2, SZ_WB = (size_t)4096 * 512 * 2, SZ_WO = (size_t)1024 * 4096 * 2;
constexpr size_t SZ_WUP = (size_t)2 * DFF * DM * 2, SZ_WDN = (size_t)DM * DFF * 2, SZ_MUP = (size_t)NEXP * 2 * DFFE * DM * 2, SZ_MDN = (size_t)NEXP * DM * DFFE * 2;
constexpr size_t WS_WCOMB = WS_W, WS_WB = WS_WCOMB + 4 * SZ_WCOMB, WS_WO = WS_WB + 4 * SZ_WB, WS_WUP = WS_WO + 4 * SZ_WO, WS_WDN = WS_WUP + 2 * SZ_WUP,
                 WS_MUP = WS_WDN + 2 * SZ_WDN, WS_MDN = WS_MUP + 2 * SZ_MUP, WS_WEND = WS_MDN + 2 * SZ_MDN;
constexpr size_t WS_XS = (WS_WEND + 255) & ~(size_t)255;
constexpr size_t WS_HB = WS_XS + (size_t)MTOT * DM * 4;
constexpr size_t WS_U = WS_HB + (size_t)MTOT * DM * 2;
constexpr size_t WS_PRJ = WS_U;
constexpr size_t WS_GT = WS_PRJ + (size_t)MTOT * PRJW * 2;
constexpr size_t WS_OC = WS_GT + (size_t)MTOT * GTW * 2;
constexpr size_t WS_ST = WS_OC + (size_t)MTOT * OCW * 2;
constexpr size_t WS_UEND = WS_ST + (size_t)NB * NCH * 16 * 8192 * 4;
constexpr size_t WS_HID = WS_U;
constexpr size_t WS_XPAD = WS_HID + (size_t)MOE_ROWS_MAX * DFFE * 2;
constexpr size_t WS_YPAD = WS_XPAD + (size_t)MOE_ROWS_MAX * DM * 2;
static_assert(WS_YPAD + (size_t)MOE_ROWS_MAX * DM * 2 <= WS_UEND, "FFN overlay fits the union region");
constexpr size_t WS_END = WS_UEND;
constexpr int CW_BAR = 4096, CW_MOECNT = 16384;

constexpr int RING_BYTES = 131072, MISC_OFF = RING_BYTES + 320, LDS_BYTES = 147456;
constexpr int NWAVES = 8, NTHR = 512;

DI unsigned pk2(float lo, float hi) { f32x2 v = {lo, hi}; bf16x2_t b = __builtin_convertvector(v, bf16x2_t); return __builtin_bit_cast(unsigned, b); }
DI float bflo(unsigned u) { return __uint_as_float(u << 16); }
DI float bfhi(unsigned u) { return __uint_as_float(u & 0xffff0000u); }
DI f32x4 ld4bf(const bf16_t* p) { const u32x2 u = *(const u32x2*)p; return (f32x4){bflo(u.x), bfhi(u.x), bflo(u.y), bfhi(u.y)}; }
DI void st4bf(bf16_t* p, const f32x4 v) { u32x2 w; w.x = pk2(v[0], v[1]); w.y = pk2(v[2], v[3]); *(u32x2*)p = w; }
DI unsigned pk4_fp8(float a, float b, float c, float d) { int w = 0; w = __builtin_amdgcn_cvt_pk_fp8_f32(a, b, w, false); w = __builtin_amdgcn_cvt_pk_fp8_f32(c, d, w, true); return (unsigned)w; }
DI float sigm(float x) { return __builtin_amdgcn_rcpf(1.f + __expf(-x)); }
DI float silu(float x) { return x * sigm(x); }
DI float wave_sum(float v) {
#pragma unroll
    for (int o = 1; o < 64; o <<= 1) v += __shfl_xor(v, o);
    return v;
}
DI int clampi(int v, int lo, int hi) { return v < lo ? lo : (v > hi ? hi : v); }
#define MFMA32(a, b, c) __builtin_amdgcn_mfma_f32_32x32x16_bf16((a), (b), (c), 0, 0, 0)
DI int crow(int reg, int h) { return (reg & 3) + 8 * (reg >> 2) + 4 * h; }
typedef short v4i16_t __attribute__((ext_vector_type(4)));
DI s16x4 tr_read(const LAS unsigned char* p) { return __builtin_bit_cast(s16x4, __builtin_amdgcn_ds_read_tr16_b64_v4i16((LAS v4i16_t*)p)); }
DI bf16x8 cat8(s16x4 lo, s16x4 hi) { return __builtin_shufflevector(lo, hi, 0, 1, 2, 3, 4, 5, 6, 7); }
template <int S> DI bf16x8 pack8(const f32x16& x) {
    u32x4 w; w.x = pk2(x[8 * S], x[8 * S + 1]); w.y = pk2(x[8 * S + 2], x[8 * S + 3]); w.z = pk2(x[8 * S + 4], x[8 * S + 5]); w.w = pk2(x[8 * S + 6], x[8 * S + 7]);
    return __builtin_bit_cast(bf16x8, w);
}

#define XB_TMO      128
#define XB_XCNT(j)  (256  + 64 * (j))
#define XB_XSUB(j)  (1280 + 64 * (j))
#define XB_XGEN(j)  (2304 + 64 * (j))
#define XB_TOP      3328
#define XB_TOPGEN   3392
#define XCD_BAR_WORDS 3456
#define XB_SPIN_CAP (1u << 18)
DI unsigned xb_ld(unsigned* p)              { return __hip_atomic_load(p, __ATOMIC_RELAXED, __HIP_MEMORY_SCOPE_AGENT); }
DI unsigned xb_add(unsigned* p, unsigned v) { return __hip_atomic_fetch_add(p, v, __ATOMIC_RELAXED, __HIP_MEMORY_SCOPE_AGENT); }
DI unsigned xb_xcc_id() { return (unsigned)__builtin_amdgcn_s_getreg((3 << 11) | 20) & 0xFu; }
#define XB_SPIN(cond, bar) do { unsigned _sp = 0; while (cond) { __builtin_amdgcn_s_sleep(1); \
    if ((++_sp & 255u) == 0u) { if (xb_ld(&(bar)[XB_TMO])) break; if (_sp > XB_SPIN_CAP) { atomicAdd(&(bar)[XB_TMO], 1u); break; } } } } while (0)
struct XcdBarrier { unsigned* bar; unsigned x; volatile LAS unsigned* st; };
DI XcdBarrier xcd_barrier_post(unsigned* bar, volatile LAS unsigned* st) {
    XcdBarrier b; b.bar = bar; b.x = xb_xcc_id(); b.st = st;
    if (threadIdx.x == 0) (void)xb_add(&bar[XB_XCNT(b.x)], 1u);
    return b;
}
DI void xcd_barrier_complete(unsigned* bar, unsigned x, unsigned& nloc, unsigned& nx) {
    const unsigned G = gridDim.x * gridDim.y * gridDim.z;
    unsigned sum, cnt, mine, sp = 0u;
    for (;;) {
        sum = 0u; cnt = 0u; mine = 0u;
#pragma unroll
        for (unsigned j = 0; j < 16; ++j) { const unsigned c = xb_ld(&bar[XB_XCNT(j)]); sum += c; cnt += (c > 0u) ? 1u : 0u; mine = (j == x) ? c : mine; }
        if (sum == G) break;
        __builtin_amdgcn_s_sleep(1);
        if ((++sp & 255u) == 0u) { if (xb_ld(&bar[XB_TMO])) break; if (sp > XB_SPIN_CAP) { atomicAdd(&bar[XB_TMO], 1u); break; } }
    }
    nloc = mine > 0u ? mine : 1u; nx = cnt > 0u ? cnt : 1u;
}
DI void xcd_barrier(const XcdBarrier& b) {
    asm volatile("s_waitcnt vmcnt(0)" ::: "memory");
    __syncthreads();
    if (threadIdx.x == 0) {
        unsigned* bar = b.bar;
        __builtin_amdgcn_s_waitcnt(0);
        unsigned nloc = b.st[0], nx = b.st[1];
        if (nloc == 0u) { xcd_barrier_complete(bar, b.x, nloc, nx); b.st[0] = nloc; b.st[1] = nx; }
        const unsigned old = xb_add(&bar[XB_XSUB(b.x)], 1u);
        const unsigned gen = old / nloc;
        if (old + 1u == (gen + 1u) * nloc) {
            __builtin_amdgcn_fence(__ATOMIC_RELEASE, "agent");
            asm volatile("s_waitcnt vmcnt(0)" ::: "memory");
            const unsigned og = xb_add(&bar[XB_TOP], 1u);
            const unsigned tg = og / nx;
            if (og + 1u == (tg + 1u) * nx) xb_add(&bar[XB_TOPGEN], 1u);
            else XB_SPIN(xb_ld(&bar[XB_TOPGEN]) == tg, bar);
            __builtin_amdgcn_fence(__ATOMIC_ACQUIRE, "agent");
            xb_add(&bar[XB_XGEN(b.x)], 1u);
            asm volatile("s_waitcnt vmcnt(0)" ::: "memory");
        } else {
            XB_SPIN(xb_ld(&bar[XB_XGEN(b.x)]) == gen, bar);
            __builtin_amdgcn_fence(__ATOMIC_ACQUIRE, "agent");
            asm volatile("s_waitcnt vmcnt(0)" ::: "memory");
        }
    }
    __syncthreads();
}

namespace pg8 {
constexpr int BM = 256, BK = 64, HALF = 128, HTB = HALF * BK * 2, STAGE_BYTES = 8 * HTB;
__host__ __device__ __forceinline__ int lds_byte(int r, int c) { const int st = (r >> 4) * 2 + (c >> 5), rr = r & 15, cc = c & 31, ob = rr * 64 + cc * 2; return st * 1024 + (ob ^ (((ob >> 9) & 1) << 5)); }
__host__ __device__ __forceinline__ void stage_rc(int b, int& R, int& C) { const int st = b / 1024, sb = b % 1024, swz = sb ^ (((sb >> 9) & 1) << 5); R = (st >> 1) * 16 + swz / 64; C = (st & 1) * 32 + (swz % 64) / 2; }
__host__ __device__ __forceinline__ int perm32(int rho) { const int n = rho >> 4, i = rho & 15; return 8 * (i >> 2) + 4 * n + (i & 3); }
struct Unit { int pm, pn, dup; const char* A; const char* B; };

template <class Epi, class Sched, bool HM = false, bool FP8 = false>
DI void gemm_phase(LAS unsigned char* lds, const int tid, const int K, const int lda, const int ldb, const Sched& S, const Epi& E, const int sca = 0x7F7F7F7F) {
    const int wid = __builtin_amdgcn_readfirstlane(tid >> 6), lane = tid & 63, wr = wid >> 2, wc = wid & 3, fr = lane & 15, fq = lane >> 4;
    const int nt = K / BK;
    int scaw = sca, scax = 0x7F7F7F7F; if constexpr (FP8) { asm volatile("" : "+v"(scaw), "+v"(scax)); }
    unsigned voffA[2], voffB[2];
#pragma unroll
    for (int i = 0; i < 2; ++i) { int R, C; stage_rc(tid * 16 + i * 8192, R, C); const int Rb = (R & ~31) + perm32(R & 31);
        voffA[i] = (unsigned)(R * lda + C) * 2u; voffB[i] = (unsigned)(Rb * ldb + C) * 2u; }
    const size_t kstep = (size_t)(BK * 2);
    const size_t hstepA = (size_t)HALF * lda * 2, hstepB = (size_t)HALF * ldb * 2;
    const unsigned ldsw = (unsigned)wid * 1024u;
    const int aoff = lds_byte(wr * 64 + fr, fq * 8), boff = lds_byte(wc * 32 + fr, fq * 8);
#define PG8_SA(b, h) (((b) * 2 + (h)) * HTB)
#define PG8_SB(b, h) ((4 + (b) * 2 + (h)) * HTB)
#define PG8_STAGE(bufoff, gbase, voff) do { _Pragma("unroll") for (int _i = 0; _i < 2; ++_i) \
        __builtin_amdgcn_global_load_lds((const unsigned*)((const char*)(gbase) + (voff)[_i]), (LAS unsigned*)(lds + (bufoff) + ldsw + _i * 8192), 16, 0, 0); } while (0)
#define PG8_LDA(dst, b, h) do { _Pragma("unroll") for (int m = 0; m < 4; ++m) _Pragma("unroll") for (int k = 0; k < 2; ++k) dst[m][k] = *(const LAS bf16x8*)(lds + PG8_SA(b, h) + aoff + m * 2048 + k * 1024); } while (0)
#define PG8_LDB(dst, b, h) do { _Pragma("unroll") for (int n = 0; n < 2; ++n) _Pragma("unroll") for (int k = 0; k < 2; ++k) dst[n][k] = *(const LAS bf16x8*)(lds + PG8_SB(b, h) + boff + n * 2048 + k * 1024); } while (0)
#define PG8_CAT8(x) __builtin_bit_cast(v8i32_t, __builtin_shufflevector(__builtin_bit_cast(u32x4, (x)[0]), __builtin_bit_cast(u32x4, (x)[1]), 0, 1, 2, 3, 4, 5, 6, 7))
#define PG8_MMA(ai, bj, At, Bt) do { __builtin_amdgcn_s_setprio(1); \
        if constexpr (FP8) { _Pragma("unroll") for (int m = 0; m < 4; ++m) _Pragma("unroll") for (int n = 0; n < 2; ++n) \
            asm volatile("v_mfma_scale_f32_16x16x128_f8f6f4 %0, %1, %2, %0, %3, %4 op_sel_hi:[0,0,0]" : "+v"(acc[ai][bj][m][n]) : "v"(PG8_CAT8(Bt[n])), "v"(PG8_CAT8(At[m])), "v"(scaw), "v"(scax)); } \
        else { _Pragma("unroll") for (int m = 0; m < 4; ++m) _Pragma("unroll") for (int n = 0; n < 2; ++n) _Pragma("unroll") for (int k = 0; k < 2; ++k) \
            acc[ai][bj][m][n] = __builtin_amdgcn_mfma_f32_16x16x32_bf16(Bt[n][k], At[m][k], acc[ai][bj][m][n], 0, 0, 0); } \
        __builtin_amdgcn_s_setprio(0); } while (0)
#define PG8_WAIT_V(n) asm volatile("s_waitcnt vmcnt(" #n ")" ::: "memory")
#define PG8_WAIT_L(n) asm volatile("s_waitcnt lgkmcnt(" #n ")" ::: "memory")
#define PG8_BAR __builtin_amdgcn_s_barrier()
#define PG8_SCHED __builtin_amdgcn_sched_barrier(0)
    Unit cur, nxt; int ui = 0;
    if (!S.next(0, cur)) return;
    f32x4 acc[2][2][4][2];
#pragma unroll
    for (int a = 0; a < 2; ++a)
#pragma unroll
        for (int b = 0; b < 2; ++b)
#pragma unroll
            for (int m = 0; m < 4; ++m)
#pragma unroll
                for (int n = 0; n < 2; ++n) acc[a][b][m][n] = (f32x4){0.f, 0.f, 0.f, 0.f};
    bf16x8 At[4][2], B0[2][2], B1[2][2];
    const char* cA = cur.A; const char* cB = cur.B;
    PG8_STAGE(PG8_SB(0, 0), cB, voffB); PG8_STAGE(PG8_SB(0, 1), cB + hstepB, voffB); PG8_STAGE(PG8_SA(0, 0), cA, voffA); PG8_STAGE(PG8_SA(0, 1), cA + hstepA, voffA);
    if (wr == 1) PG8_BAR;
    PG8_WAIT_V(2); PG8_BAR;
    PG8_STAGE(PG8_SB(1, 0), cB + kstep, voffB); PG8_STAGE(PG8_SA(1, 0), cA + kstep, voffA); PG8_STAGE(PG8_SB(1, 1), cB + hstepB + kstep, voffB);
    PG8_WAIT_V(6); PG8_BAR;
    for (;;) {
        const bool has_next = S.next(ui + 1, nxt);
        const char* nA = has_next ? nxt.A : cA; const char* nB = has_next ? nxt.B : cB;
        _Pragma("nounroll") for (int t = 0; t < nt; t += 2) {
            const bool last = (t == nt - 2);
            const char* a1 = cA + (size_t)(t + 1) * kstep;
            const char* a2 = last ? nA : cA + (size_t)(t + 2) * kstep; const char* b2 = last ? nB : cB + (size_t)(t + 2) * kstep;
            const char* a3 = a2 + kstep; const char* b3 = b2 + kstep;
            PG8_LDB(B0, 0, 0); PG8_LDB(B1, 0, 1); PG8_SCHED; PG8_LDA(At, 0, 0); PG8_STAGE(PG8_SA(1, 1), a1 + hstepA, voffA);
            PG8_WAIT_V(8); PG8_WAIT_L(0); PG8_BAR; PG8_MMA(0, 0, At, B0); PG8_MMA(0, 1, At, B1); PG8_BAR; PG8_SCHED;
            PG8_LDA(At, 0, 1); PG8_STAGE(PG8_SB(0, 0), b2, voffB); PG8_STAGE(PG8_SB(0, 1), b2 + hstepB, voffB); PG8_STAGE(PG8_SA(0, 0), a2, voffA);
            PG8_WAIT_V(8); PG8_WAIT_L(0); PG8_BAR; if constexpr (!HM) { PG8_MMA(1, 0, At, B0); PG8_MMA(1, 1, At, B1); } PG8_BAR; PG8_SCHED;
            PG8_LDB(B0, 1, 0); PG8_LDB(B1, 1, 1); PG8_SCHED; PG8_LDA(At, 1, 0); PG8_STAGE(PG8_SA(0, 1), a2 + hstepA, voffA);
            PG8_WAIT_V(8); PG8_WAIT_L(0); PG8_BAR; PG8_MMA(0, 0, At, B0); PG8_MMA(0, 1, At, B1); PG8_BAR; PG8_SCHED;
            PG8_LDA(At, 1, 1); PG8_STAGE(PG8_SB(1, 0), b3, voffB); PG8_STAGE(PG8_SB(1, 1), b3 + hstepB, voffB); PG8_STAGE(PG8_SA(1, 0), a3, voffA);
            PG8_WAIT_V(8); PG8_WAIT_L(0); PG8_BAR; if constexpr (!HM) { PG8_MMA(1, 0, At, B0); PG8_MMA(1, 1, At, B1); } PG8_BAR; PG8_SCHED;
        }
        if (wr == 0) PG8_BAR;
        if constexpr (FP8) asm volatile("s_nop 7\n\ts_nop 7\n\ts_nop 7" ::: "memory");
        E(acc, cur, wr, wc, fr, fq);
        if (!has_next) break;
#pragma unroll
        for (int a = 0; a < (HM ? 1 : 2); ++a)
#pragma unroll
            for (int b = 0; b < 2; ++b)
#pragma unroll
                for (int m = 0; m < 4; ++m)
#pragma unroll
                    for (int n = 0; n < 2; ++n) acc[a][b][m][n] = (f32x4){0.f, 0.f, 0.f, 0.f};
        cur = nxt; cA = nA; cB = nB; ++ui;
        if (wr == 1) PG8_BAR;
    }
    PG8_WAIT_V(0);
    PG8_BAR;
#undef PG8_SA
#undef PG8_SB
#undef PG8_STAGE
#undef PG8_LDA
#undef PG8_LDB
#undef PG8_MMA
#undef PG8_CAT8
#undef PG8_WAIT_V
#undef PG8_WAIT_L
#undef PG8_BAR
#undef PG8_SCHED
}

struct SchedGrid {
    int nMa, nNa, nMb, nNb, total, G, c; const char* A; const char* B; int lda, ldb, a_div, a_cols; const LAS int* pe; size_t estride; int rep;
    DI bool next(int i, Unit& u) const {
        const long L = (long)(i >> rep) * G + c; if (L >= total) return false;
        u.dup = i & rep;
        const int La = nMa * nNa; int pm, pn;
        if (L < La) {
            int wgid = (int)L;
            if ((G & 7) == 0) { const int q = La >> 3, r = La & 7, xcd = wgid & 7, off = wgid >> 3; wgid = (xcd < r ? xcd * (q + 1) : r * (q + 1) + (xcd - r) * q) + off; }
            const int nig = 8 * nNa, gid = wgid / nig, fm = gid * 8, gsz = (nMa - fm) < 8 ? (nMa - fm) : 8, w = wgid - gid * nig;
            pm = fm + w % gsz; pn = w / gsz;
        } else { const int r = (int)L - La; pm = nMa + r / nNb; pn = r % nNb; }
        size_t eoff = 0;
        if (pe) { int e = 0;
#pragma unroll
            for (int j = 0; j < 7; ++j) e += (pe[j] <= pm * 256) ? 1 : 0;
            eoff = (size_t)__builtin_amdgcn_readfirstlane(e) * estride; }
        u.pm = pm; u.pn = pn; u.A = A + ((size_t)pm * 256 * lda + (size_t)(pn / a_div) * a_cols) * 2; u.B = B + eoff + (size_t)pn * 256 * ldb * 2; return true;
    }
};
struct SchedBranch {
    int T, G, c; const char* A; const char* B; int rep;
    DI bool next(int n, Unit& u) const {
        const int tile = c + (n >> (2 + rep)) * G; if (tile >= T) return false;
        const int i = n & 3, pm = tile >> 2, pc = tile & 3;
        u.dup = 0; u.pm = pm; u.pn = i * 4 + pc; u.A = A + ((size_t)pm * 128 * OCW + (size_t)i * 512) * 2; u.B = B + (size_t)(i * 1024 + pc * 256) * 512 * 2; return true;
    }
};
struct EpiInGate {
    bf16_t* PRJ; bf16_t* GT; const float* bg;
    DI void operator()(f32x4 (&acc)[2][2][4][2], const Unit& u, int wr, int wc, int fr, int fq) const {
        const int row0 = u.pm * BM + wr * 64 + fr; const bool sg = u.pn >= 18;
        bf16_t* base = sg ? GT : PRJ; const int ldc = sg ? GTW : PRJW; const int col0 = (sg ? (u.pn - 18) : u.pn) * BM + wc * 32 + 8 * fq;
        f32x4 bv[2][2];
#pragma unroll
        for (int bj = 0; bj < 2; ++bj)
#pragma unroll
            for (int n = 0; n < 2; ++n) bv[bj][n] = sg ? *(const f32x4*)(bg + col0 + bj * HALF + 4 * n) : (f32x4){0.f, 0.f, 0.f, 0.f};
#pragma unroll
        for (int ai = 0; ai < 2; ++ai)
#pragma unroll
            for (int m = 0; m < 4; ++m) { bf16_t* rowp = base + (size_t)(row0 + ai * HALF + m * 16) * ldc + col0;
#pragma unroll
                for (int bj = 0; bj < 2; ++bj) { f32x4 v0 = acc[ai][bj][m][0] + bv[bj][0], v1 = acc[ai][bj][m][1] + bv[bj][1];
                    if (sg) { v0 = (f32x4){sigm(v0[0]), sigm(v0[1]), sigm(v0[2]), sigm(v0[3])}; v1 = (f32x4){sigm(v1[0]), sigm(v1[1]), sigm(v1[2]), sigm(v1[3])}; }
                    u32x4 w; w.x = pk2(v0[0], v0[1]); w.y = pk2(v0[2], v0[3]); w.z = pk2(v1[0], v1[1]); w.w = pk2(v1[2], v1[3]);
                    *(u32x4*)(rowp + bj * HALF) = w; } }
    }
};
struct EpiBranch {
    const bf16_t* GT; const float* SSQ; bf16_t* MRG;
    DI void operator()(f32x4 (&acc)[2][2][4][2], const Unit& u, int wr, int wc, int fr, int fq) const {
        const int i = u.pn >> 2, pc = u.pn & 3;
        const int row0 = u.pm * HALF + wr * 64 + fr; const int gcol0 = u.pn * BM + wc * 32 + 8 * fq, col0 = pc * BM + wc * 32 + 8 * fq;
#pragma unroll
        for (int mp = 0; mp < 4; ++mp) {
            u32x4 g[1][2]; float rs[1];
#pragma unroll
            for (int mm = 0; mm < 1; ++mm) { const int row = row0 + (mp + mm) * 16; const bf16_t* gp = GT + (size_t)row * GTW + gcol0;
                g[mm][0] = *(const u32x4*)gp; g[mm][1] = *(const u32x4*)(gp + HALF); rs[mm] = 1.f;
                if (i == 3) { const f32x4 s0 = *(const f32x4*)(SSQ + (size_t)row * 8), s1 = *(const f32x4*)(SSQ + (size_t)row * 8 + 4);
                    rs[mm] = __builtin_amdgcn_rsqf(((s0[0] + s0[1]) + (s0[2] + s0[3]) + (s1[0] + s1[1]) + (s1[2] + s1[3])) * (1.f / 512.f) + RMS_EPS); } }
#pragma unroll
            for (int mm = 0; mm < 1; ++mm) { const int m = mp + mm;
#pragma unroll
                for (int bj = 0; bj < 2; ++bj) { const u32x4 gg = g[mm][bj]; const f32x4 a0 = acc[0][bj][m][0] * rs[mm], a1 = acc[0][bj][m][1] * rs[mm];
                    acc[1][bj][m][0] += (f32x4){bflo(gg.x) * a0[0], bfhi(gg.x) * a0[1], bflo(gg.y) * a0[2], bfhi(gg.y) * a0[3]};
                    acc[1][bj][m][1] += (f32x4){bflo(gg.z) * a1[0], bfhi(gg.z) * a1[1], bflo(gg.w) * a1[2], bfhi(gg.w) * a1[3]}; } }
        }
        if (i == 3) {
#pragma unroll
            for (int m = 0; m < 4; ++m)
#pragma unroll
                for (int bj = 0; bj < 2; ++bj) { const f32x4 t0 = acc[1][bj][m][0], t1 = acc[1][bj][m][1];
                    u32x4 w; w.x = pk2(t0[0], t0[1]); w.y = pk2(t0[2], t0[3]); w.z = pk2(t1[0], t1[1]); w.w = pk2(t1[2], t1[3]);
                    *(u32x4*)(MRG + (size_t)(row0 + m * 16) * DM + col0 + bj * HALF) = w;
                    acc[1][bj][m][0] = (f32x4){0.f, 0.f, 0.f, 0.f}; acc[1][bj][m][1] = (f32x4){0.f, 0.f, 0.f, 0.f}; }
        }
    }
};
struct EpiResid {
    bf16_t* XS; const float* mv; bf16_t* plainO; bf16_t* dummy;
    DI void operator()(f32x4 (&acc)[2][2][4][2], const Unit& u, int wr, int wc, int fr, int fq) const {
        const int row0 = u.pm * BM + wr * 64 + fr; const int col0 = u.pn * BM + wc * 32 + 8 * fq;
        if (plainO || u.dup) { bf16_t* const po = plainO ? plainO : dummy;
#pragma unroll
            for (int ai = 0; ai < 2; ++ai)
#pragma unroll
                for (int m = 0; m < 4; ++m) { bf16_t* rowp = po + (size_t)(row0 + ai * HALF + m * 16) * DM + col0;
#pragma unroll
                    for (int bj = 0; bj < 2; ++bj) { const f32x4 v0 = acc[ai][bj][m][0], v1 = acc[ai][bj][m][1];
                        u32x4 w; w.x = pk2(v0[0], v0[1]); w.y = pk2(v0[2], v0[3]); w.z = pk2(v1[0], v1[1]); w.w = pk2(v1[2], v1[3]);
                        *(u32x4*)(rowp + bj * HALF) = w; } }
            return;
        }
        const int v = u.pm < 128 ? (u.pm >> 5) : 4;
        const float* g = mv + (size_t)v * 6144 + col0;
        f32x4 gv[2][2];
#pragma unroll
        for (int bj = 0; bj < 2; ++bj)
#pragma unroll
            for (int n = 0; n < 2; ++n) gv[bj][n] = *(const f32x4*)(g + bj * HALF + 4 * n);
#pragma unroll
        for (int ai = 0; ai < 2; ++ai)
#pragma unroll
            for (int mp = 0; mp < 2; ++mp) {
                u32x4 x[2][2];
#pragma unroll
                for (int mm = 0; mm < 2; ++mm) { const bf16_t* rowp = XS + (size_t)(row0 + ai * HALF + (2 * mp + mm) * 16) * DM + col0;
#pragma unroll
                    for (int bj = 0; bj < 2; ++bj) x[mm][bj] = *(const u32x4*)(rowp + bj * HALF); }
#pragma unroll
                for (int mm = 0; mm < 2; ++mm) { const int m = 2 * mp + mm; bf16_t* rowp = XS + (size_t)(row0 + ai * HALF + m * 16) * DM + col0;
#pragma unroll
                    for (int bj = 0; bj < 2; ++bj) { const u32x4 xx = x[mm][bj];
                        const f32x4 y0 = (f32x4){bflo(xx.x), bfhi(xx.x), bflo(xx.y), bfhi(xx.y)} * ALPHA + gv[bj][0] * acc[ai][bj][m][0];
                        const f32x4 y1 = (f32x4){bflo(xx.z), bfhi(xx.z), bflo(xx.w), bfhi(xx.w)} * ALPHA + gv[bj][1] * acc[ai][bj][m][1];
                        u32x4 w; w.x = pk2(y0[0], y0[1]); w.y = pk2(y0[2], y0[3]); w.z = pk2(y1[0], y1[1]); w.w = pk2(y1[2], y1[3]); *(u32x4*)(rowp + bj * HALF) = w; } }
            }
    }
};
template <bool F8> struct EpiSwiGLU {
    bf16_t* HID; int ldc;
    DI void operator()(f32x4 (&acc)[2][2][4][2], const Unit& u, int wr, int wc, int fr, int fq) const {
        const int row0 = u.pm * BM + wr * 64 + fr; const int col0 = u.pn * HALF + wc * 32 + 8 * fq;
#pragma unroll
        for (int ai = 0; ai < 2; ++ai)
#pragma unroll
            for (int m = 0; m < 4; ++m) {
                const f32x4 g0 = acc[ai][0][m][0], g1 = acc[ai][0][m][1], u0 = acc[ai][1][m][0], u1 = acc[ai][1][m][1];
                const float h0 = silu(g0[0]) * u0[0], h1 = silu(g0[1]) * u0[1], h2 = silu(g0[2]) * u0[2], h3 = silu(g0[3]) * u0[3];
                const float h4 = silu(g1[0]) * u1[0], h5 = silu(g1[1]) * u1[1], h6 = silu(g1[2]) * u1[2], h7 = silu(g1[3]) * u1[3];
                if constexpr (F8) { u32x2 w; w.x = pk4_fp8(h0, h1, h2, h3); w.y = pk4_fp8(h4, h5, h6, h7); *(u32x2*)((unsigned char*)HID + (size_t)(row0 + ai * HALF + m * 16) * ldc + col0) = w; }
                else { u32x4 w; w.x = pk2(h0, h1); w.y = pk2(h2, h3); w.z = pk2(h4, h5); w.w = pk2(h6, h7); *(u32x4*)(HID + (size_t)(row0 + ai * HALF + m * 16) * ldc + col0) = w; } }
    }
};
}

struct Args { const float* in[31]; float* out; unsigned char* ws; int ph_lo, ph_hi; };
enum { I_X = 0, I_C, I_CTX, I_CCTX, I_WMOD, I_BMOD, I_WIN, I_WGATE, I_BGATE, I_RPB, I_SINK, I_QGQ, I_QGK, I_CONVW, I_CONVB, I_DTB, I_ALOG, I_DSKIP, I_NORMG,
       I_WBR, I_WOUT, I_LN1G, I_LN1B, I_LN2G, I_LN2B, I_FUP, I_FDN, I_MRW, I_MRB, I_MUP, I_MDN };
struct Frame {
    LAS unsigned char* lds; gu32* ctl; int tid, lane, wave, vcu, G, bx;
    const float* const* in; float* out; unsigned char* ws;
};
#define WSP(T, off) ((T*)(F.ws + (off)))
DI Frame launder(const Frame& F0) {
    Frame F = F0;
    asm volatile("" : "+s"(F.wave), "+s"(F.vcu), "+s"(F.ws), "+s"(F.lds));
    F.lane = (int)__builtin_amdgcn_mbcnt_hi(~0u, __builtin_amdgcn_mbcnt_lo(~0u, 0u)); F.tid = F.wave * 64 + F.lane;
    asm volatile("" : "+v"(F.tid), "+v"(F.lane));
    F.ws = (unsigned char*)(GAS unsigned char*)F.ws;
    return F;
}

DI void transpose_load(const float* W, int ld, int kb, int nb, int lane, float (&tmp)[32]) {
    const int k0 = 64 * kb, n0 = 32 * nb;
#pragma unroll
    for (int i = 0; i < 32; ++i) tmp[i] = W[(size_t)(k0 + 2 * i + (lane >> 5)) * ld + n0 + (lane & 31)];
}
DI void transpose_item(const float* W, int ld, bf16_t* dst, int ldk, int koff, int map_h, int rowoff, int cscale, const float* kscale, LAS float* scr, int kb, int nb, int lane, float f8scale, const float (&tmp)[32]) {
    const int k0 = 64 * kb, n0 = 32 * nb;
#pragma unroll
    for (int i = 0; i < 32; ++i) scr[(2 * i + (lane >> 5)) * 33 + (lane & 31)] = tmp[i];
    asm volatile("s_waitcnt lgkmcnt(0)" ::: "memory");
    const int c = lane & 7;
    float ks[8];
#pragma unroll
    for (int e = 0; e < 8; ++e) ks[e] = kscale ? kscale[k0 + 8 * c + e] : 1.f;
#pragma unroll
    for (int j = 0; j < 4; ++j) { const int nl = (lane >> 3) + 8 * j, n = n0 + nl; const LAS float* s = scr + (8 * c) * 33 + nl;
        float cs = 1.f; if (cscale && (n < 512 || (n >= 1536 && n < 2048))) cs = C2;
        int drow;
        if (map_h == 0) drow = rowoff + n;
        else if (n < map_h) drow = rowoff + 256 * (n >> 7) + (n & 127);
        else { const int n2 = n - map_h; drow = rowoff + 256 * (n2 >> 7) + 128 + (n2 & 127); }
        if (f8scale != 0.f) { u32x2 o; o.x = pk4_fp8(s[0 * 33] * f8scale, s[1 * 33] * f8scale, s[2 * 33] * f8scale, s[3 * 33] * f8scale); o.y = pk4_fp8(s[4 * 33] * f8scale, s[5 * 33] * f8scale, s[6 * 33] * f8scale, s[7 * 33] * f8scale);
            *(u32x2*)((unsigned char*)dst + (size_t)drow * ldk + koff + k0 + 8 * c) = o; }
        else {
        u32x4 o; o.x = pk2(s[0 * 33] * ks[0] * cs, s[1 * 33] * ks[1] * cs); o.y = pk2(s[2 * 33] * ks[2] * cs, s[3 * 33] * ks[3] * cs);
        o.z = pk2(s[4 * 33] * ks[4] * cs, s[5 * 33] * ks[5] * cs); o.w = pk2(s[6 * 33] * ks[6] * cs, s[7 * 33] * ks[7] * cs);
        *(u32x4*)(dst + (size_t)drow * ldk + koff + k0 + 8 * c) = o; } }
    asm volatile("s_waitcnt lgkmcnt(0)" ::: "memory");
}
struct CvtJob { const float* W; int K, N, ld; bf16_t* dst; int ldk, koff, map_h, rowoff, cscale; const float* kscale; float f8scale; };
DI void get_job(const Frame& F, int j, CvtJob& J) {
    J.koff = 0; J.map_h = 0; J.rowoff = 0; J.cscale = 0; J.kscale = nullptr; J.f8scale = 0.f;
    if (j < 52) {
        const int l = j / 13, r = j % 13;
        if (r == 0) { J.W = F.in[I_WIN] + (size_t)l * DM * DIN; J.K = DM; J.N = PRJW; J.ld = DIN; J.dst = WSP(bf16_t, WS_WCOMB + l * SZ_WCOMB); J.ldk = DM; J.cscale = 1; }
        else if (r < 5) { const int i = r - 1; J.W = F.in[I_WGATE] + ((size_t)l * 4 + i) * DM * DM; J.K = DM; J.N = DM; J.ld = DM; J.dst = WSP(bf16_t, WS_WCOMB + l * SZ_WCOMB); J.ldk = DM; J.rowoff = PRJW + 1024 * i; }
        else if (r < 9) { const int i = r - 5; J.W = F.in[I_WBR] + ((size_t)l * 4 + i) * 512 * DM; J.K = 512; J.N = DM; J.ld = DM; J.dst = WSP(bf16_t, WS_WB + l * SZ_WB); J.ldk = 512; J.rowoff = 1024 * i;
            if (i == 3) J.kscale = F.in[I_NORMG] + l * 512; }
        else { J.W = F.in[I_WOUT] + (size_t)l * DM * DM; J.K = (r == 9) ? DM : 0; J.N = DM; J.ld = DM; J.dst = WSP(bf16_t, WS_WO + l * SZ_WO); J.ldk = DM; }
    } else if (j < 56) {
        const int i = (j - 52) >> 1;
        if (((j - 52) & 1) == 0) { J.W = F.in[I_FUP] + (size_t)i * DM * 2 * DFF; J.K = DM; J.N = 2 * DFF; J.ld = 2 * DFF; J.dst = WSP(bf16_t, WS_WUP + i * SZ_WUP); J.ldk = DM; J.map_h = DFF; }
        else { J.W = F.in[I_FDN] + (size_t)i * DFF * DM; J.K = DFF; J.N = DM; J.ld = DM; J.dst = WSP(bf16_t, WS_WDN + i * SZ_WDN); J.ldk = DFF; }
    } else {
        const int q = j - 56, ie = q >> 1, i = ie >> 3, e = ie & 7;
        if ((q & 1) == 0) { J.W = F.in[I_MUP] + ((size_t)i * NEXP + e) * DM * 2 * DFFE; J.K = DM; J.N = 2 * DFFE; J.ld = 2 * DFFE; J.dst = WSP(bf16_t, WS_MUP + i * SZ_MUP); J.ldk = DM; J.map_h = DFFE; J.rowoff = e * 2 * DFFE; J.f8scale = MOE_UP_WSCALE; }
        else { J.W = F.in[I_MDN] + ((size_t)i * NEXP + e) * DFFE * DM; J.K = DFFE; J.N = DM; J.ld = DM; J.dst = WSP(bf16_t, WS_MDN + i * SZ_MDN); J.ldk = DFFE; J.rowoff = e * DM; J.f8scale = MOE_DN_WSCALE; }
    }
}
constexpr int NJOBS = 52 + 4 + 32;

DI void phase_prologue_a(const Frame& F) {
    const int NGW = F.G * NWAVES, gw = F.vcu * NWAVES + F.wave;
    {
        LAS float* sv = (LAS float*)(F.lds + 73728);
        LAS float* red = (LAS float*)(F.lds + 73728 + 20480);
        for (int i = F.tid; i < 5 * 1024; i += NTHR) { const int v = i >> 10, k = i & 1023; const float c = v < 4 ? F.in[I_C][v * DM + k] : F.in[I_CCTX][k]; sv[i] = silu(c); }
        __syncthreads();
        float* MV = WSP(float, WS_MVEC);
        for (int item = F.vcu; item < 4 * 96; item += F.G) {
            const int l = item / 96, n0 = (item % 96) * 64, c = F.tid & 63, ks = F.tid >> 6;
            const float* w = F.in[I_WMOD] + (size_t)l * DM * 6144 + n0 + c;
            float a0 = 0.f, a1 = 0.f, a2 = 0.f, a3 = 0.f, a4 = 0.f;
#pragma unroll 32
            for (int k = ks * 128; k < ks * 128 + 128; ++k) { const float wv = w[(size_t)k * 6144]; a0 += sv[k] * wv; a1 += sv[1024 + k] * wv; a2 += sv[2048 + k] * wv; a3 += sv[3072 + k] * wv; a4 += sv[4096 + k] * wv; }
            red[(ks * 5 + 0) * 64 + c] = a0; red[(ks * 5 + 1) * 64 + c] = a1; red[(ks * 5 + 2) * 64 + c] = a2; red[(ks * 5 + 3) * 64 + c] = a3; red[(ks * 5 + 4) * 64 + c] = a4;
            __syncthreads();
            if (F.tid < 320) { const int v = F.tid >> 6, cc = F.tid & 63; float s = F.in[I_BMOD][l * 6144 + n0 + cc];
#pragma unroll
                for (int q = 0; q < 8; ++q) s += red[(q * 5 + v) * 64 + cc];
                MV[((size_t)l * 5 + v) * 6144 + n0 + cc] = s; }
            __syncthreads();
        }
    }
    {
        float* rc = WSP(float, WS_ROPE); float* rs = rc + SEQ * 32;
        for (int i = F.vcu * NTHR + F.tid; i < SEQ * 32; i += F.G * NTHR) {
            const int t = i >> 5, p = i & 31; const float pos = (p < 16) ? (float)(t >> 6) : (float)(t & 63);
            const float invf = exp2f(-(float)(p & 15) * (13.287712379549449f / 16.f));
            const float ang = pos * invf; const float rev = ang * 0.15915494309189535f; const float fr = rev - rintf(rev);
            rc[i] = __builtin_amdgcn_cosf(fr); rs[i] = __builtin_amdgcn_sinf(fr);
        }
    }
    {
        LAS float* scr = (LAS float*)(F.lds + F.wave * 8448);
        LAS int* pre = (LAS int*)(F.lds + 106496);
        __syncthreads();
        if (F.tid == 0) { int run = 0; for (int j = 0; j < NJOBS; ++j) { CvtJob J; get_job(F, j, J); pre[j] = run; run += (J.K / 64) * (J.N / 32); } pre[NJOBS] = run; }
        __syncthreads();
        const int total = pre[NJOBS];
        float cur[32], nxt[32];
        int g = gw, j = 0, it = 0; CvtJob J; J.W = nullptr; J.K = 0; J.N = 32; J.ld = 0; J.dst = nullptr; J.ldk = 0; J.koff = 0; J.map_h = 0; J.rowoff = 0; J.cscale = 0; J.kscale = nullptr; J.f8scale = 0.f;
        if (g < total) { while (pre[j + 1] <= g) ++j; j = __builtin_amdgcn_readfirstlane(j); get_job(F, j, J); it = g - pre[j]; const int nblk = J.N / 32; transpose_load(J.W, J.ld, it / nblk, it % nblk, F.lane, cur); }
        while (g < total) {
            const int gn = g + NGW; int jn = j, itn = 0; CvtJob Jn = J;
            if (gn < total) { while (pre[jn + 1] <= gn) ++jn; jn = __builtin_amdgcn_readfirstlane(jn); if (jn != j) get_job(F, jn, Jn); itn = gn - pre[jn]; const int nblk = Jn.N / 32; transpose_load(Jn.W, Jn.ld, itn / nblk, itn % nblk, F.lane, nxt); }
            { const int nblk = J.N / 32; transpose_item(J.W, J.ld, J.dst, J.ldk, J.koff, J.map_h, J.rowoff, J.cscale, J.kscale, scr, it / nblk, it % nblk, F.lane, J.f8scale, cur); }
#pragma unroll
            for (int i = 0; i < 32; ++i) cur[i] = nxt[i];
            J = Jn; j = jn; it = itn; g = gn;
        }
    }
}

DI void load_wdt(const Frame& F, int l) {
    LAS float* wd = (LAS float*)F.lds; const float* w = F.in[I_WIN] + (size_t)l * DM * DIN + PRJW;
    for (int i = F.tid; i < DM * 16; i += NTHR) { const int k = i >> 4; wd[(((k & 3) << 8) + (k >> 2)) * 20 + (i & 15)] = w[(size_t)k * DIN + (i & 15)]; }
}
DI void emit_h_dt(const Frame& F, const f32x4 (&xn)[4], const float* mv, int m, const float* dtb) {
    bf16_t* hb = WSP(bf16_t, WS_HB) + (size_t)m * DM; float* DT = WSP(float, WS_DT);
    const LAS float* wd = (const LAS float*)F.lds;
    float acc[16];
#pragma unroll
    for (int c = 0; c < 16; ++c) acc[c] = 0.f;
#pragma unroll
    for (int j = 0; j < 4; ++j) {
        const int k = 4 * F.lane + 256 * j;
        const f32x4 sh = *(const f32x4*)(mv + k), sc = *(const f32x4*)(mv + 1024 + k);
        const f32x4 h = xn[j] * (sc + 1.f) + sh;
        u32x2 w; w.x = pk2(h[0], h[1]); w.y = pk2(h[2], h[3]); *(u32x2*)(hb + k) = w;
#pragma unroll
        for (int e = 0; e < 4; ++e) {
            const LAS f32x4* wr = (const LAS f32x4*)(wd + ((e << 8) + (k >> 2)) * 20);
#pragma unroll
            for (int q = 0; q < 4; ++q) { const f32x4 wv = wr[q]; acc[4 * q] += h[e] * wv[0]; acc[4 * q + 1] += h[e] * wv[1]; acc[4 * q + 2] += h[e] * wv[2]; acc[4 * q + 3] += h[e] * wv[3]; }
            asm volatile("" ::: "memory");
        }
    }
    const bool b0 = F.lane & 1, b1 = F.lane & 2, b2 = F.lane & 4, b3 = F.lane & 8;
    float t8[8], t4[4], t2[2], t1;
#pragma unroll
    for (int i = 0; i < 8; ++i) { const float keep = b0 ? acc[2 * i + 1] : acc[2 * i], give = b0 ? acc[2 * i] : acc[2 * i + 1]; t8[i] = keep + __shfl_xor(give, 1); }
#pragma unroll
    for (int i = 0; i < 4; ++i) { const float keep = b1 ? t8[2 * i + 1] : t8[2 * i], give = b1 ? t8[2 * i] : t8[2 * i + 1]; t4[i] = keep + __shfl_xor(give, 2); }
#pragma unroll
    for (int i = 0; i < 2; ++i) { const float keep = b2 ? t4[2 * i + 1] : t4[2 * i], give = b2 ? t4[2 * i] : t4[2 * i + 1]; t2[i] = keep + __shfl_xor(give, 4); }
    { const float keep = b3 ? t2[1] : t2[0], give = b3 ? t2[0] : t2[1]; t1 = keep + __shfl_xor(give, 8); }
    t1 += __shfl_xor(t1, 16); t1 += __shfl_xor(t1, 32);
    if (F.lane < 16) { const float x = t1 + dtb[F.lane]; const float t = __expf(x); const float sp = t < 0.01f ? t * (1.f + t * (-0.5f + t * (1.f / 3.f))) : __logf(1.f + t); DT[(size_t)m * 16 + F.lane] = x > 15.f ? x : sp; }
}
DI void ln_rows(f32x4 (&v)[4], const float* g, const float* b, int lane) {
    float s = 0.f;
#pragma unroll
    for (int j = 0; j < 4; ++j) s += (v[j][0] + v[j][1]) + (v[j][2] + v[j][3]);
    const float mean = wave_sum(s) * (1.f / DM); float s2 = 0.f;
#pragma unroll
    for (int j = 0; j < 4; ++j) { v[j] = v[j] - mean; s2 += (v[j][0] * v[j][0] + v[j][1] * v[j][1]) + (v[j][2] * v[j][2] + v[j][3] * v[j][3]); }
    const float rstd = 1.f / sqrtf(wave_sum(s2) * (1.f / DM) + LN_EPS);
#pragma unroll
    for (int j = 0; j < 4; ++j) { const int k = 4 * lane + 256 * j; v[j] = v[j] * rstd * *(const f32x4*)(g + k) + *(const f32x4*)(b + k); }
}
DI void phase_prologue_b(const Frame& F) {
    load_wdt(F, 0); __syncthreads();
    const int NGW = F.G * NWAVES, gw = F.vcu * NWAVES + F.wave;
    bf16_t* XS = WSP(bf16_t, WS_XS); const float* MV = WSP(float, WS_MVEC);
    const float* dtb = F.in[I_DTB];
    for (int m = gw; m < MTOT; m += NGW) {
        const float* src = m < NLAT ? F.in[I_X] + (size_t)m * DM : F.in[I_CTX] + (size_t)(m - NLAT) * DM; const int v = m < NLAT ? (m >> 13) : 4;
        f32x4 x[4];
#pragma unroll
        for (int j = 0; j < 4; ++j) { x[j] = *(const f32x4*)(src + 4 * F.lane + 256 * j); st4bf(XS + (size_t)m * DM + 4 * F.lane + 256 * j, x[j]); }
        emit_h_dt(F, x, MV + (size_t)v * 6144, m, dtb);
    }
}
DI void phase_ln1(const Frame& F, int l, int mrows) {
    const bool moe = l & 1; const int mi = l >> 1;
    LAS float* wrt = (LAS float*)F.lds;
    if (moe) { const float* w = F.in[I_MRW] + (size_t)mi * DM * 8; for (int i = F.tid; i < DM * 8; i += NTHR) { const int k = i >> 3; wrt[(((k & 3) << 8) + (k >> 2)) * 12 + (i & 7)] = w[i]; } __syncthreads(); }
    const int NGW = F.G * NWAVES, gw = F.vcu * NWAVES + F.wave;
    bf16_t* XS = WSP(bf16_t, WS_XS); const float* MV = WSP(float, WS_MVEC) + (size_t)l * 5 * 6144; bf16_t* HB = WSP(bf16_t, WS_HB);
    const float* g = F.in[I_LN1G] + l * DM; const float* b = F.in[I_LN1B] + l * DM;
    unsigned* SL = WSP(unsigned, WS_SLOT); unsigned* gcnt = (unsigned*)F.ctl + CW_MOECNT + mi * 1024;
    int cnt = 0, nst = 0; int me0 = 0, me1 = 0, mr0 = 0, mr1 = 0, mm = 0; float mg0 = 0.f, mg1 = 0.f;
    u32x2 xn1[4], xn2[4];
#pragma unroll
    for (int j = 0; j < 4; ++j) { xn1[j] = (u32x2){0u, 0u}; xn2[j] = (u32x2){0u, 0u}; }
    if (gw < mrows) {
#pragma unroll
        for (int j = 0; j < 4; ++j) xn1[j] = *(const u32x2*)(XS + (size_t)gw * DM + 4 * F.lane + 256 * j);
    }
    if (gw + NGW < mrows) {
#pragma unroll
        for (int j = 0; j < 4; ++j) xn2[j] = *(const u32x2*)(XS + (size_t)(gw + NGW) * DM + 4 * F.lane + 256 * j);
    }
    for (int m = gw; m < mrows; m += NGW) {
        const int v = m < NLAT ? (m >> 13) : 4;
        f32x4 x[4];
#pragma unroll
        for (int j = 0; j < 4; ++j) { x[j] = (f32x4){bflo(xn1[j].x), bfhi(xn1[j].x), bflo(xn1[j].y), bfhi(xn1[j].y)}; xn1[j] = xn2[j]; }
        if (m + 2 * NGW < mrows) {
#pragma unroll
            for (int j = 0; j < 4; ++j) xn2[j] = *(const u32x2*)(XS + (size_t)(m + 2 * NGW) * DM + 4 * F.lane + 256 * j);
        }
        ln_rows(x, g, b, F.lane);
        float acc[8];
#pragma unroll
        for (int c = 0; c < 8; ++c) acc[c] = 0.f;
        const float* mv = MV + (size_t)v * 6144;
#pragma unroll
        for (int j = 0; j < 4; ++j) {
            const int k = 4 * F.lane + 256 * j;
            st4bf(XS + (size_t)m * DM + k, x[j]);
            const f32x4 sh = *(const f32x4*)(mv + 3072 + k), sc = *(const f32x4*)(mv + 4096 + k);
            const f32x4 h = x[j] * (sc + 1.f) + sh;
            u32x2 w; w.x = pk2(h[0], h[1]); w.y = pk2(h[2], h[3]); *(u32x2*)(HB + (size_t)m * DM + k) = w;
            if (moe) {
#pragma unroll
                for (int e = 0; e < 4; ++e) { const LAS f32x4* wr = (const LAS f32x4*)(wrt + ((e << 8) + (k >> 2)) * 12);
#pragma unroll
                    for (int q = 0; q < 2; ++q) { const f32x4 wv = wr[q]; acc[4 * q] += h[e] * wv[0]; acc[4 * q + 1] += h[e] * wv[1]; acc[4 * q + 2] += h[e] * wv[2]; acc[4 * q + 3] += h[e] * wv[3]; } }
            }
        }
        if (moe) {
            const bool b0 = F.lane & 1, b1 = F.lane & 2, b2 = F.lane & 4;
            float t4[4], t2[2], t1;
#pragma unroll
            for (int i = 0; i < 4; ++i) { const float keep = b0 ? acc[2 * i + 1] : acc[2 * i], give = b0 ? acc[2 * i] : acc[2 * i + 1]; t4[i] = keep + __shfl_xor(give, 1); }
#pragma unroll
            for (int i = 0; i < 2; ++i) { const float keep = b1 ? t4[2 * i + 1] : t4[2 * i], give = b1 ? t4[2 * i] : t4[2 * i + 1]; t2[i] = keep + __shfl_xor(give, 2); }
            { const float keep = b2 ? t2[1] : t2[0], give = b2 ? t2[0] : t2[1]; t1 = keep + __shfl_xor(give, 4); }
            t1 += __shfl_xor(t1, 8); t1 += __shfl_xor(t1, 16); t1 += __shfl_xor(t1, 32);
            t1 += F.in[I_MRB][mi * 8 + (F.lane & 7)];
            float lg[8];
#pragma unroll
            for (int e = 0; e < 8; ++e) lg[e] = __shfl(t1, e);
            int e0 = 0; float l0 = lg[0];
#pragma unroll
            for (int e = 1; e < 8; ++e) if (lg[e] > l0) { l0 = lg[e]; e0 = e; }
            int e1 = -1; float l1 = -3.0e38f;
#pragma unroll
            for (int e = 0; e < 8; ++e) if (e != e0 && lg[e] > l1) { l1 = lg[e]; e1 = e; }
            const float g1 = 1.f / (1.f + __expf(l0 - l1)), g0 = 1.f - g1;
            const int r0 = __shfl(cnt, e0); if (F.lane == e0) cnt++;
            const int r1 = __shfl(cnt, e1); if (F.lane == e1) cnt++;
            if (F.lane == nst) { me0 = e0; me1 = e1; mr0 = r0; mr1 = r1; mg0 = g0; mg1 = g1; mm = m; }
            ++nst;
        }
        if (moe && (nst == 64 || m + NGW >= mrows)) {
            unsigned base = 0u; if (F.lane < 8) base = __hip_atomic_fetch_add(gcnt + F.lane * 64, (unsigned)cnt, __ATOMIC_RELAXED, __HIP_MEMORY_SCOPE_AGENT);
            const unsigned p0 = __shfl(base, me0) + mr0, p1 = __shfl(base, me1) + mr1;
            if (F.lane < nst) { u32x4 a; a.x = me0; a.y = me1; a.z = p0; a.w = p1; *(u32x4*)(SL + (size_t)mm * 8) = a; u32x2 c; c.x = __float_as_uint(mg0); c.y = __float_as_uint(mg1); *(u32x2*)(SL + (size_t)mm * 8 + 4) = c; }
            cnt = 0; nst = 0;
        }
    }
}
DI void moe_pad_ends(const Frame& F, int mi, int (&pe)[8]) {
    unsigned* gcnt = (unsigned*)F.ctl + CW_MOECNT + mi * 1024; int run = 0;
#pragma unroll
    for (int e = 0; e < 8; ++e) { const int c = (int)__builtin_amdgcn_readfirstlane(__hip_atomic_load(gcnt + e * 64, __ATOMIC_RELAXED, __HIP_MEMORY_SCOPE_AGENT)); run += (c + 255) & ~255; pe[e] = run; }
}
DI int moe_pad_ends_lds(const Frame& F, int mi) {
    int pe[8]; moe_pad_ends(F, mi, pe);
    LAS int* d = (LAS int*)(F.lds + MISC_OFF + 64);
    __syncthreads();
    if (F.tid == 0) {
#pragma unroll
        for (int e = 0; e < 8; ++e) d[e] = pe[e];
    }
    __syncthreads();
    return pe[7];
}
DI void phase_gather(const Frame& F, int l, int mrows) {
    int pe[8]; moe_pad_ends(F, l >> 1, pe);
    const int NGW = F.G * NWAVES, gw = F.vcu * NWAVES + F.wave;
    unsigned* SL = WSP(unsigned, WS_SLOT); const bf16_t* HB = WSP(bf16_t, WS_HB); bf16_t* XP = WSP(bf16_t, WS_XPAD);
    for (int m = gw; m < mrows; m += NGW) {
        const u32x4 a = *(const u32x4*)(SL + (size_t)m * 8);
        int ps0 = 0, ps1 = 0;
#pragma unroll
        for (int e = 1; e < 8; ++e) { if ((int)a.x == e) ps0 = pe[e - 1]; if ((int)a.y == e) ps1 = pe[e - 1]; }
        const int d0 = ps0 + (int)a.z, d1 = ps1 + (int)a.w;
        const u32x4* src = (const u32x4*)(HB + (size_t)m * DM);
        const u32x4 v0 = src[F.lane], v1 = src[64 + F.lane];
        u32x2 w0, w1; w0.x = pk4_fp8(bflo(v0.x), bfhi(v0.x), bflo(v0.y), bfhi(v0.y)); w0.y = pk4_fp8(bflo(v0.z), bfhi(v0.z), bflo(v0.w), bfhi(v0.w));
        w1.x = pk4_fp8(bflo(v1.x), bfhi(v1.x), bflo(v1.y), bfhi(v1.y)); w1.y = pk4_fp8(bflo(v1.z), bfhi(v1.z), bflo(v1.w), bfhi(v1.w));
        u32x2* q0 = (u32x2*)((unsigned char*)XP + (size_t)d0 * DM); u32x2* q1 = (u32x2*)((unsigned char*)XP + (size_t)d1 * DM);
        q0[F.lane] = w0; q0[64 + F.lane] = w1; q1[F.lane] = w0; q1[64 + F.lane] = w1;
        if (F.lane == 0) { u32x2 d; d.x = d0; d.y = d1; *(u32x2*)(SL + (size_t)m * 8 + 2) = d; }
    }
}
DI void phase_ln2(const Frame& F, int l, int mrows) {
    const bool moe = l & 1, lastl = (l == DEPTH - 1);
    if (!lastl) { load_wdt(F, l + 1); __syncthreads(); }
    const int NGW = F.G * NWAVES, gw = F.vcu * NWAVES + F.wave;
    bf16_t* XS = WSP(bf16_t, WS_XS); const float* MVl = WSP(float, WS_MVEC) + (size_t)l * 5 * 6144; const float* MVn = WSP(float, WS_MVEC) + (size_t)(l + 1) * 5 * 6144;
    const float* g = F.in[I_LN2G] + l * DM; const float* b = F.in[I_LN2B] + l * DM;
    const unsigned* SL = WSP(unsigned, WS_SLOT); const bf16_t* YP = WSP(bf16_t, WS_YPAD);
    const float* dtb = F.in[I_DTB] + (lastl ? 0 : (l + 1) * 16);
    u32x2 xn1[4], xn2[4]; u32x4 anx = (u32x4){0u, 0u, 0u, 0u}; u32x2 gnx = (u32x2){0u, 0u};
#pragma unroll
    for (int j = 0; j < 4; ++j) { xn1[j] = (u32x2){0u, 0u}; xn2[j] = (u32x2){0u, 0u}; }
    if (gw < mrows) {
#pragma unroll
        for (int j = 0; j < 4; ++j) xn1[j] = *(const u32x2*)(XS + (size_t)gw * DM + 4 * F.lane + 256 * j);
        if (moe) { anx = *(const u32x4*)(SL + (size_t)gw * 8); gnx = *(const u32x2*)(SL + (size_t)gw * 8 + 4); }
    }
    if (gw + NGW < mrows) {
#pragma unroll
        for (int j = 0; j < 4; ++j) xn2[j] = *(const u32x2*)(XS + (size_t)(gw + NGW) * DM + 4 * F.lane + 256 * j);
    }
    for (int m = gw; m < mrows; m += NGW) {
        const int v = m < NLAT ? (m >> 13) : 4;
        f32x4 x[4];
#pragma unroll
        for (int j = 0; j < 4; ++j) { x[j] = (f32x4){bflo(xn1[j].x), bfhi(xn1[j].x), bflo(xn1[j].y), bfhi(xn1[j].y)}; xn1[j] = xn2[j]; }
        const u32x4 a = anx; const u32x2 gg = gnx;
        if (m + NGW < mrows && moe) { anx = *(const u32x4*)(SL + (size_t)(m + NGW) * 8); gnx = *(const u32x2*)(SL + (size_t)(m + NGW) * 8 + 4); }
        if (m + 2 * NGW < mrows) {
#pragma unroll
            for (int j = 0; j < 4; ++j) xn2[j] = *(const u32x2*)(XS + (size_t)(m + 2 * NGW) * DM + 4 * F.lane + 256 * j);
        }
        if (moe) {
            const float g0 = __uint_as_float(gg.x), g1 = __uint_as_float(gg.y);
            const bf16_t* y0 = YP + (size_t)a.z * DM; const bf16_t* y1 = YP + (size_t)a.w * DM;
#pragma unroll
            for (int j = 0; j < 4; ++j) { const int k = 4 * F.lane + 256 * j; const u32x2 u0 = *(const u32x2*)(y0 + k), u1 = *(const u32x2*)(y1 + k);
                const f32x4 gt = *(const f32x4*)(MVl + (size_t)v * 6144 + 5120 + k);
                f32x4 f; f[0] = g0 * bflo(u0.x) + g1 * bflo(u1.x); f[1] = g0 * bfhi(u0.x) + g1 * bfhi(u1.x); f[2] = g0 * bflo(u0.y) + g1 * bflo(u1.y); f[3] = g0 * bfhi(u0.y) + g1 * bfhi(u1.y);
                if (ABL & 16) f = (f32x4){0.f, 0.f, 0.f, 0.f};
                x[j] = x[j] * ALPHA + gt * f; }
        }
        ln_rows(x, g, b, F.lane);
        if (lastl) {
#pragma unroll
            for (int j = 0; j < 4; ++j) *(f32x4*)(F.out + (size_t)m * DM + 4 * F.lane + 256 * j) = x[j];
        } else {
#pragma unroll
            for (int j = 0; j < 4; ++j) st4bf(XS + (size_t)m * DM + 4 * F.lane + 256 * j, x[j]);
            emit_h_dt(F, x, MVn + (size_t)v * 6144, m, dtb);
        }
    }
}

DI void phase_qkprep_rows(const Frame& F, int l) {
    const int NGW = F.G * NWAVES, gw = F.vcu * NWAVES + F.wave;
    bf16_t* PRJ = WSP(bf16_t, WS_PRJ); const float* rc = WSP(float, WS_ROPE); const float* rs = rc + SEQ * 32;
    const float* gq = F.in[I_QGQ] + l * 64; const float* gk = F.in[I_QGK] + l * 64;
    const int hs = F.lane >> 4, i2 = 2 * (F.lane & 15);
    const float gq0 = gq[i2], gq1 = gq[i2 + 1], gq2 = gq[32 + i2], gq3 = gq[32 + i2 + 1], gk0 = gk[i2], gk1 = gk[i2 + 1], gk2 = gk[32 + i2], gk3 = gk[32 + i2 + 1];
    int pcol[5];
#pragma unroll
    for (int it = 0; it < 5; ++it) { const int hd = it * 4 + hs; pcol[it] = (hd < 8 ? C_SWQ + 64 * hd : hd < 10 ? C_SWK + 64 * (hd - 8) : hd < 18 ? C_GAQ + 64 * (hd - 10) : C_GAK + 64 * (hd - 18)) + i2; asm volatile("" : "+v"(pcol[it])); }
#define PREP_COL(it) (pcol[it] - i2)
    unsigned n1[5], n2[5]; f32x2 ncc = (f32x2){1.f, 1.f}, nss = (f32x2){0.f, 0.f};
#pragma unroll
    for (int it = 0; it < 5; ++it) { n1[it] = 0u; n2[it] = 0u; }
    if (gw < MTOT) {
#pragma unroll
        for (int it = 0; it < 5; ++it) { const bf16_t* p = PRJ + (size_t)gw * PRJW + PREP_COL(it) + i2; n1[it] = *(const unsigned*)p; n2[it] = *(const unsigned*)(p + 32); }
        if (gw < NLAT) { const int t = gw & (SEQ - 1); ncc = *(const f32x2*)(rc + t * 32 + i2); nss = *(const f32x2*)(rs + t * 32 + i2); }
    }
    for (int m = gw; m < MTOT; m += NGW) {
        unsigned u1[5], u2[5];
#pragma unroll
        for (int it = 0; it < 5; ++it) { u1[it] = n1[it]; u2[it] = n2[it]; }
        const float c0 = ncc[0], c1 = ncc[1], s0 = nss[0], s1 = nss[1];
        const int mn = m + NGW;
        if (mn < MTOT) {
#pragma unroll
            for (int it = 0; it < 5; ++it) { const bf16_t* p = PRJ + (size_t)mn * PRJW + PREP_COL(it) + i2; n1[it] = *(const unsigned*)p; n2[it] = *(const unsigned*)(p + 32); }
            if (mn < NLAT) { const int t = mn & (SEQ - 1); ncc = *(const f32x2*)(rc + t * 32 + i2); nss = *(const f32x2*)(rs + t * 32 + i2); } else { ncc = (f32x2){1.f, 1.f}; nss = (f32x2){0.f, 0.f}; }
        }
#pragma unroll
        for (int it = 0; it < 5; ++it) {
            const int hd = it * 4 + hs;
            bf16_t* p = PRJ + (size_t)m * PRJW + PREP_COL(it) + i2;
            float a0 = bflo(u1[it]), a1 = bfhi(u1[it]), b0 = bflo(u2[it]), b1 = bfhi(u2[it]);
            if (hd >= 10) {
                float ss = a0 * a0 + a1 * a1 + b0 * b0 + b1 * b1;
                ss += __shfl_xor(ss, 1); ss += __shfl_xor(ss, 2); ss += __shfl_xor(ss, 4); ss += __shfl_xor(ss, 8);
                const float rn = 1.f / sqrtf(ss * (1.f / 64.f) + RMS_EPS); const bool isq = hd < 18; const float post = isq ? C2 : 1.f;
                a0 *= rn * (isq ? gq0 : gk0) * post; a1 *= rn * (isq ? gq1 : gk1) * post; b0 *= rn * (isq ? gq2 : gk2) * post; b1 *= rn * (isq ? gq3 : gk3) * post;
            }
            const float o0 = a0 * c0 - b0 * s0, o1 = a1 * c1 - b1 * s1, q0 = b0 * c0 + a0 * s0, q1 = b1 * c1 + a1 * s1;
            *(unsigned*)p = pk2(o0, o1); *(unsigned*)(p + 32) = pk2(q0, q1);
        }
    }
#undef PREP_COL
}

namespace ga_body {
using bf16=__hip_bfloat16;
using bf16x8=__attribute__((ext_vector_type(8)))short;
using s16x4=__attribute__((ext_vector_type(4)))short;
using f32x16=__attribute__((ext_vector_type(16)))float;
using u32x4=__attribute__((ext_vector_type(4)))unsigned;
constexpr int SEQ=8192,D=64,PQ=4608,PO=2048,NCTXT=4;
constexpr int NW=8,QBLK=32,QB=QBLK*NW,KVBLK=64,NQB=SEQ/QB;
__device__ __forceinline__ int crow(int r,int hi){return (r&3)+8*(r>>2)+4*hi;}
#define SBAR() __builtin_amdgcn_sched_barrier(0)
__device__ __forceinline__ void cmask(f32x16&p0,f32x16&p1,int jb,int qrel,int hi){
  const float NEG=-INFINITY; int kb=64*jb+4*hi;
  #pragma unroll
  for(int r=0;r<16;++r){int kv=kb+(r&3)+8*(r>>2); if(kv>qrel)p0[r]=NEG; if(kv+32>qrel)p1[r]=NEG;}
}

constexpr int NSLOT=3, SLOTB=8192;
constexpr int LDS_K=0, LDS_V=NSLOT*SLOTB, LDS_WS=2*NSLOT*SLOTB, LDS_OST=LDS_WS+NW*64*4, LDS_BYTES=LDS_OST+NW*4096;
constexpr float C2=0.125f*1.4426950408889634f;
__device__ __forceinline__ void glds16(const void*gsrc,unsigned lds_dst){unsigned keep;
  asm volatile("s_mov_b32 %0, m0\n\ts_mov_b32 m0, %2\n\ts_nop 0\n\tglobal_load_lds_dwordx4 %1, off\n\ts_mov_b32 m0, %0":"=&s"(keep):"v"(gsrc),"s"(lds_dst):"memory");}
__device__ __forceinline__ float max3f(float a,float b,float c){float r;asm("v_max3_f32 %0, %1, %2, %3":"=v"(r):"v"(a),"v"(b),"v"(c));return r;}
__device__ __forceinline__ float max2f(float a,float b){float r;asm("v_max_f32_e32 %0, %1, %2":"=v"(r):"v"(a),"v"(b));return r;}
__device__ __forceinline__ float fadd_s(float a,float b){float r;asm("v_add_f32_e32 %0, %1, %2":"=v"(r):"v"(a),"v"(b));return r;}
__device__ __forceinline__ float fsub_s(float a,float b){float r;asm("v_sub_f32_e32 %0, %1, %2":"=v"(r):"v"(a),"v"(b));return r;}
typedef float f32x2_t __attribute__((ext_vector_type(2))); typedef __bf16 bf16x2_t __attribute__((ext_vector_type(2)));
__device__ __forceinline__ unsigned cvtpk_s(float lo,float hi){f32x2_t v={lo,hi};bf16x2_t b=__builtin_convertvector(v,bf16x2_t);return __builtin_bit_cast(unsigned,b);}
#define WAIT_BAR(N) asm volatile("s_waitcnt vmcnt(" #N ") lgkmcnt(0)\n\ts_barrier":::"memory")

__device__ __forceinline__ void qkt(f32x16&p0,f32x16&p1,const char*Kslot,const bf16x8*qr,const f32x16&negm,int r32,int hi){
  const char*kb=Kslot+hi*1024+r32*16;
  #pragma unroll
  for(int d0=0;d0<4;++d0){
    const bf16x8 b0=*reinterpret_cast<const bf16x8*>(kb+d0*2048);
    const bf16x8 b1=*reinterpret_cast<const bf16x8*>(kb+d0*2048+512);
    if(d0==0){p0=__builtin_amdgcn_mfma_f32_32x32x16_bf16(b0,qr[0],negm,0,0,0);p1=__builtin_amdgcn_mfma_f32_32x32x16_bf16(b1,qr[0],negm,0,0,0);}
    else{p0=__builtin_amdgcn_mfma_f32_32x32x16_bf16(b0,qr[d0],p0,0,0,0);p1=__builtin_amdgcn_mfma_f32_32x32x16_bf16(b1,qr[d0],p1,0,0,0);}}
}
typedef __attribute__((address_space(3))) const char* lds_cptr;
typedef short v4i16_t __attribute__((ext_vector_type(4)));
__device__ __forceinline__ void kload8(bf16x8*kf,lds_cptr kp){
  kf[0]=*(const __attribute__((address_space(3))) bf16x8*)(kp);      kf[1]=*(const __attribute__((address_space(3))) bf16x8*)(kp+512);
  kf[2]=*(const __attribute__((address_space(3))) bf16x8*)(kp+2048); kf[3]=*(const __attribute__((address_space(3))) bf16x8*)(kp+2560);
  kf[4]=*(const __attribute__((address_space(3))) bf16x8*)(kp+4096); kf[5]=*(const __attribute__((address_space(3))) bf16x8*)(kp+4608);
  kf[6]=*(const __attribute__((address_space(3))) bf16x8*)(kp+6144); kf[7]=*(const __attribute__((address_space(3))) bf16x8*)(kp+6656);
}
__device__ __forceinline__ void kload2(bf16x8*kf,lds_cptr kp,int j){ kf[2*j]=*(const __attribute__((address_space(3))) bf16x8*)(kp+j*2048); kf[2*j+1]=*(const __attribute__((address_space(3))) bf16x8*)(kp+j*2048+512); }
__device__ __forceinline__ s16x4 vtr(lds_cptr p){ return __builtin_bit_cast(s16x4,__builtin_amdgcn_ds_read_tr16_b64_v4i16((__attribute__((address_space(3))) v4i16_t*)p)); }
__device__ __forceinline__ float rowmax(const f32x16&p0,const f32x16&p1){
  float a=max3f(p0[0],p0[1],p1[0]),b=max3f(p0[2],p0[3],p1[1]);a=max3f(a,p1[2],p1[3]);
  #pragma unroll
  for(int r=4;r<16;r+=4){a=max3f(a,p0[r],p0[r+1]);b=max3f(b,p0[r+2],p0[r+3]);a=max3f(a,p1[r],p1[r+1]);b=max3f(b,p1[r+2],p1[r+3]);}
  const float m=max2f(a,b);
  auto rr=__builtin_amdgcn_permlane32_swap(__float_as_uint(m),__float_as_uint(m),false,false);
  return max2f(__uint_as_float(rr[0]),__uint_as_float(rr[1]));
}
__device__ __forceinline__ void pv(f32x16*o,int vb,bf16x8 pa0,bf16x8 pa1,bf16x8 pa2,bf16x8 pa3){
  #pragma unroll
  for(int d0=0;d0<2;++d0){s16x4 lo[4],hi[4];
    #pragma unroll
    for(int ks=0;ks<4;++ks){
      asm volatile("ds_read_b64_tr_b16 %0,%1 offset:%c2":"=&v"(lo[ks]):"v"(vb),"i"(d0*4096+ks*1024):"memory");
      asm volatile("ds_read_b64_tr_b16 %0,%1 offset:%c2":"=&v"(hi[ks]):"v"(vb),"i"(d0*4096+ks*1024+512):"memory");}
    asm volatile("s_waitcnt lgkmcnt(0)":::"memory");SBAR();
    #define PK(k) (bf16x8){lo[k][0],lo[k][1],lo[k][2],lo[k][3],hi[k][0],hi[k][1],hi[k][2],hi[k][3]}
    o[d0]=__builtin_amdgcn_mfma_f32_32x32x16_bf16(pa0,PK(0),o[d0],0,0,0);
    o[d0]=__builtin_amdgcn_mfma_f32_32x32x16_bf16(pa1,PK(1),o[d0],0,0,0);
    o[d0]=__builtin_amdgcn_mfma_f32_32x32x16_bf16(pa2,PK(2),o[d0],0,0,0);
    o[d0]=__builtin_amdgcn_mfma_f32_32x32x16_bf16(pa3,PK(3),o[d0],0,0,0);
    #undef PK
  }
}

#ifndef ATTN_STORE16
#define ATTN_STORE16(p,v) (*(u32x4*)(p)=(v))
#endif
template<int MODE> __device__ __forceinline__ void amask(f32x16&p0,f32x16&p1,int t,int g0,int qb,int wid,int r32,int hi,const __attribute__((address_space(3))) float*biasT){
  if(MODE==0||t<NCTXT)return;
  const float NEG=-INFINITY; const int g=g0+t-NCTXT;
  if(MODE==1){ int d0=64*g-(256*qb+32*wid+r32)+4*hi; asm volatile("":"+v"(d0));
    #pragma unroll
    for(int r=0;r<16;++r){const int dd=d0+(r&3)+8*(r>>2); if(dd>128||dd<-128)p0[r]=NEG; if(dd+32>128||dd+32<-128)p1[r]=NEG;}
  } else {
    const int gr=4*qb+(wid>>1); int rs=gr-4; rs=rs<0?0:(rs>120?120:rs); const bool rel=(g>=rs&&g<rs+8);
    const int qc=32*(wid&1)+r32; int cs=qc-8; cs=cs<0?0:(cs>48?48:cs); asm volatile("":"+v"(cs));
    const int dr=rel?(g-gr+7):0; const __attribute__((address_space(3))) float*bt=biasT+dr*31+15-qc+4*hi; const int k0=4*hi-cs;
    #pragma unroll
    for(int r=0;r<16;++r){const int ko=(r&3)+8*(r>>2); const unsigned u0=(unsigned)(k0+ko),u1=(unsigned)(k0+ko+32);
      p0[r]=(rel&&u0<16u)?p0[r]+bt[ko]:NEG; p1[r]=(rel&&u1<16u)?p1[r]+bt[ko+32]:NEG;
      if((r&3)==3)asm volatile("":"+v"(p0),"+v"(p1)::"memory");}
  }
}
template<int THRL,int MODE> __device__ __forceinline__ void attn_unit(int qb,const bf16*Qp,const bf16*__restrict__ Kl,const bf16*__restrict__ Vl,const bf16*__restrict__ Kc,const bf16*__restrict__ Vc,bf16*Op,char*shm,const int tid,const int NT,const int g0,const float sinkl2,const float*rpbh){
  const int lane=tid&63,r32=lane&31,hi=lane>>5; const int wid=__builtin_amdgcn_readfirstlane(tid>>6);
  const int q0=qb*QB;
  const bf16*Qw=Qp+(long)(q0+wid*QBLK)*PQ;
  const unsigned lds0=(unsigned)(uintptr_t)shm;
  float*wsf=(float*)(shm+LDS_WS)+wid*64;
  const long koff=(long)lane*PQ+wid*8;
  const long voff=(long)(16*(wid&3)+(lane>>2))*PQ+(wid>>2)*32+(lane&3)*8;
  const unsigned kdst=lds0+LDS_K+wid*1024, vdst=lds0+LDS_V+wid*1024;
  #define TILE_SRC(t,C,L) (((t)<NCTXT?(C)+(long)(t)*KVBLK*PQ:(L)+(long)((t)-NCTXT)*KVBLK*PQ))
  #define DMA_K(t,slot) glds16(TILE_SRC(t,Kc,Kl)+koff,(unsigned)__builtin_amdgcn_readfirstlane(kdst+(slot)))
  #define DMA_V(t,slot) glds16(TILE_SRC(t,Vc,Vl)+voff,(unsigned)__builtin_amdgcn_readfirstlane(vdst+(slot)))
  const int vb0=(int)(lds0+LDS_V)+((lane>>4)&1)*32+(lane&3)*8+(4*hi+((lane&15)>>2))*64;
  const char*Kbase=shm+LDS_K; bf16x8 kf[8];
  const lds_cptr shm3=(lds_cptr)shm; const lds_cptr kp0=shm3+LDS_K+hi*1024+r32*16; const lds_cptr vp0=shm3+LDS_V+((lane>>4)&1)*32+(lane&3)*8+(4*hi+((lane&15)>>2))*64;
  const __attribute__((address_space(3))) float*biasT=(const __attribute__((address_space(3))) float*)((lds_cptr)shm+LDS_BYTES);
  if(MODE==2){ __attribute__((address_space(3))) float*bw=(__attribute__((address_space(3))) float*)((lds_cptr)shm+LDS_BYTES); for(int i=tid;i<465;i+=512)bw[i]=rpbh[i]*1.4426950408889634f; }
  DMA_K(0,0);DMA_V(0,0);DMA_K(1,SLOTB);
  bf16x8 qr[4];
  #pragma unroll
  for(int d0=0;d0<4;++d0)qr[d0]=*reinterpret_cast<const bf16x8*>(&Qw[(long)r32*PQ+d0*16+hi*8]);
  float mhat=0.f,l_reg=0.f;f32x16 o[2],negm; { float zz=0.f; asm volatile("":"+v"(zz)); _Pragma("unroll") for(int r=0;r<16;++r){o[0][r]=zz;o[1][r]=zz;negm[r]=zz;} } asm volatile("":"+v"(negm));
  #define CMASK(P0,P1,t) amask<MODE>(P0,P1,t,g0,qb,wid,r32,hi,biasT)
  bool resc=false;
  #define START(P0,P1) do{ const float rm=rowmax(P0,P1); resc=false; \
    { const float dl=rm; mhat=fadd_s(mhat,dl); \
      _Pragma("unroll") for(int r=0;r<16;++r){P0[r]=fsub_s(P0[r],dl);P1[r]=fsub_s(P1[r],dl);} \
      _Pragma("unroll") for(int r=0;r<16;++r)negm[r]=-mhat; asm volatile("":"+v"(negm)); } \
    _Pragma("unroll") for(int r=0;r<16;++r)P0[r]=__builtin_amdgcn_exp2f(P0[r]); }while(0)
  #define RESC() do{ if(resc){ asm volatile("s_waitcnt lgkmcnt(0)":::"memory"); \
      _Pragma("unroll") for(int d_=0;d_<2;++d_) _Pragma("unroll") for(int r=0;r<16;++r)o[d_][r]*=wsf[crow(r,hi)]; } }while(0)
  f32x16 pA0,pA1,pB0,pB1;
  int sl_prev=0,sl_cur=0,sl_next=SLOTB;
  #define ROT() do{sl_prev=sl_cur;sl_cur=sl_next;sl_next=(sl_next==(NSLOT-1)*SLOTB)?0:sl_next+SLOTB;}while(0)
  DMA_K(2,2*SLOTB);
  WAIT_BAR(3);
  qkt(pA0,pA1,Kbase,qr,negm,r32,hi);asm volatile("s_nop 15\n\ts_nop 7":"+v"(pA0),"+v"(pA1));CMASK(pA0,pA1,0);
  START(pA0,pA1);
  _Pragma("unroll") for(int r=0;r<16;++r)pA1[r]=__builtin_amdgcn_exp2f(pA1[r]);
  WAIT_BAR(0);
  DMA_K(3,0);DMA_V(1,SLOTB);
  ROT();
  kload8(kf,kp0+sl_cur);
  WAIT_BAR(2);
  s16x4 vlo[8],vhi[8]; u32x4 pw0,pw1,pw2,pw3;
  #define PKW(P,B) cvtpk_s(P[B],P[B+1])
  #define PAF(k) __builtin_bit_cast(bf16x8,pw##k)
  #define VFR(i) (bf16x8){vlo[i][0],vlo[i][1],vlo[i][2],vlo[i][3],vhi[i][0],vhi[i][1],vhi[i][2],vhi[i][3]}
  #define PIN(x) asm volatile("":"+v"(x))
  #define MX3(a,b,c) __builtin_fmaxf(__builtin_fmaxf((a),(b)),(c))
  #define GAPA(MF,A0,A1,A2,A3,W0,W1,PW) do{ MF; sacc+=A0; sacc+=A1; sacc+=A2; sacc+=A3; PIN(sacc); W0; W1; PIN(PW); SBAR(); }while(0)
  #define EX(v) __builtin_amdgcn_exp2f(v)
  #define GAPB(MF,X,B) do{ MF; X[B]=EX(X[B]); X[B+1]=EX(X[B+1]); X[B+2]=EX(X[B+2]); X[B+3]=EX(X[B+3]); PIN(X); SBAR(); }while(0)
  #define VRD(i) do{ vlo[i]=vtr(vp_+(((i)>>2)*4096+((i)&3)*1024)); vhi[i]=vtr(vp_+(((i)>>2)*4096+((i)&3)*1024+512)); }while(0)
  #define KRD(G,j) do{ if(G){ kload2(kf,kp0+sl_next,j); SBAR(); } }while(0)
  #define STEP(C0,C1,P0,P1,t,GK,GV,GL) do{ SBAR(); \
    const lds_cptr vp_=vp0+sl_prev; \
    VRD(0); SBAR(); float sacc=(P0[0]+P0[1]); \
    GAPA(C0=__builtin_amdgcn_mfma_f32_32x32x16_bf16(kf[0],qr[0],negm,0,0,0), P0[2],P0[3],P0[4],P0[5],     pw0[0]=PKW(P0,0), pw0[1]=PKW(P0,2), pw0); \
    VRD(4); SBAR(); GAPA(C1=__builtin_amdgcn_mfma_f32_32x32x16_bf16(kf[1],qr[0],negm,0,0,0), P0[6],P0[7],P0[8],P0[9],     pw0[2]=PKW(P0,4), pw0[3]=PKW(P0,6), pw0); \
    VRD(1); SBAR(); GAPA(C0=__builtin_amdgcn_mfma_f32_32x32x16_bf16(kf[2],qr[1],C0,0,0,0),   P0[10],P0[11],P0[12],P0[13], pw1[0]=PKW(P0,8), pw1[1]=PKW(P0,10), pw1); \
    VRD(5); SBAR(); GAPA(C1=__builtin_amdgcn_mfma_f32_32x32x16_bf16(kf[3],qr[1],C1,0,0,0),   P0[14],P0[15],P1[0],P1[1],   pw1[2]=PKW(P0,12),pw1[3]=PKW(P0,14), pw1); \
    VRD(2); SBAR(); GAPA(C0=__builtin_amdgcn_mfma_f32_32x32x16_bf16(kf[4],qr[2],C0,0,0,0),   P1[2],P1[3],P1[4],P1[5],     pw2[0]=PKW(P1,0), pw2[1]=PKW(P1,2), pw2); \
    VRD(6); SBAR(); GAPA(C1=__builtin_amdgcn_mfma_f32_32x32x16_bf16(kf[5],qr[2],C1,0,0,0),   P1[6],P1[7],P1[8],P1[9],     pw2[2]=PKW(P1,4), pw2[3]=PKW(P1,6), pw2); \
    VRD(3); SBAR(); GAPA(C0=__builtin_amdgcn_mfma_f32_32x32x16_bf16(kf[6],qr[3],C0,0,0,0),   P1[10],P1[11],P1[12],P1[13], pw3[0]=PKW(P1,8), pw3[1]=PKW(P1,10), pw3); \
    VRD(7); SBAR(); GAPA(C1=__builtin_amdgcn_mfma_f32_32x32x16_bf16(kf[7],qr[3],C1,0,0,0),   P1[14],P1[15],0.f,0.f,       pw3[2]=PKW(P1,12),pw3[3]=PKW(P1,14), pw3); \
    l_reg+=sacc; \
    if(GK){DMA_K((t)+3,sl_cur);} if(GV){DMA_V((t)+1,sl_next);} \
    CMASK(C0,C1,t); \
    { float a=MX3(C0[0],C0[1],C1[0]),b=MX3(C0[2],C0[3],C1[1]); a=MX3(a,C1[2],C1[3]); \
      _Pragma("unroll") for(int r=4;r<16;r+=4){a=MX3(a,C0[r],C0[r+1]);b=MX3(b,C0[r+2],C0[r+3]);a=MX3(a,C1[r],C1[r+1]);b=MX3(b,C1[r+2],C1[r+3]);} \
      float rm=__builtin_fmaxf(a,b); { auto rr=__builtin_amdgcn_permlane32_swap(__float_as_uint(rm),__float_as_uint(rm),false,false); rm=__builtin_fmaxf(__uint_as_float(rr[0]),__uint_as_float(rr[1])); } \
      resc=false; \
      if(__builtin_expect(__any(rm>(float)THRL),0)){ const float dl=__builtin_fmaxf(rm,0.f); mhat+=dl; \
        _Pragma("unroll") for(int r=0;r<16;++r){C0[r]-=dl;C1[r]-=dl;} \
        _Pragma("unroll") for(int r=0;r<16;++r)negm[r]=-mhat; asm volatile("":"+v"(negm)); \
        const float f=__builtin_amdgcn_exp2f(-dl); l_reg*=f; if(hi==0)wsf[r32]=f; resc=true; } } \
    SBAR(); \
    GAPB(o[0]=__builtin_amdgcn_mfma_f32_32x32x16_bf16(PAF(0),VFR(0),o[0],0,0,0), C0,0); \
    GAPB(o[1]=__builtin_amdgcn_mfma_f32_32x32x16_bf16(PAF(0),VFR(4),o[1],0,0,0), C0,4); \
    KRD(GL,0); GAPB(o[0]=__builtin_amdgcn_mfma_f32_32x32x16_bf16(PAF(1),VFR(1),o[0],0,0,0), C0,8); \
    KRD(GL,1); GAPB(o[1]=__builtin_amdgcn_mfma_f32_32x32x16_bf16(PAF(1),VFR(5),o[1],0,0,0), C0,12); \
    KRD(GL,2); GAPB(o[0]=__builtin_amdgcn_mfma_f32_32x32x16_bf16(PAF(2),VFR(2),o[0],0,0,0), C1,0); \
    KRD(GL,3); GAPB(o[1]=__builtin_amdgcn_mfma_f32_32x32x16_bf16(PAF(2),VFR(6),o[1],0,0,0), C1,4); \
    GAPB(o[0]=__builtin_amdgcn_mfma_f32_32x32x16_bf16(PAF(3),VFR(3),o[0],0,0,0), C1,8); \
    GAPB(o[1]=__builtin_amdgcn_mfma_f32_32x32x16_bf16(PAF(3),VFR(7),o[1],0,0,0), C1,12); \
    }while(0)
  int t=1;
  for(;t+5<NT;t+=2){
    STEP(pB0,pB1,pA0,pA1,t,true,true,true);     WAIT_BAR(2); RESC(); ROT();
    STEP(pA0,pA1,pB0,pB1,t+1,true,true,true);   WAIT_BAR(2); RESC(); ROT();
  }
  #define ENDW(tt) do{ if((tt)+3<NT){WAIT_BAR(2);} else if((tt)+2<NT){WAIT_BAR(1);} else {WAIT_BAR(0);} }while(0)
  for(;t+1<NT;t+=2){
    STEP(pB0,pB1,pA0,pA1,t,(t+3<NT),(t+1<NT),(t+1<NT));       ENDW(t);   RESC(); ROT();
    STEP(pA0,pA1,pB0,pB1,t+1,(t+4<NT),(t+2<NT),(t+2<NT));     ENDW(t+1); RESC(); ROT();
  }
  STEP(pB0,pB1,pA0,pA1,NT-1,false,false,false); RESC();
  { float sacc=pB0[0]+pB0[1]; _Pragma("unroll") for(int r=2;r<16;++r)sacc+=pB0[r]; _Pragma("unroll") for(int r=0;r<16;++r)sacc+=pB1[r]; l_reg+=sacc;
    pw0=(u32x4){PKW(pB0,0),PKW(pB0,2),PKW(pB0,4),PKW(pB0,6)};pw1=(u32x4){PKW(pB0,8),PKW(pB0,10),PKW(pB0,12),PKW(pB0,14)};pw2=(u32x4){PKW(pB1,0),PKW(pB1,2),PKW(pB1,4),PKW(pB1,6)};pw3=(u32x4){PKW(pB1,8),PKW(pB1,10),PKW(pB1,12),PKW(pB1,14)};
    SBAR(); pv(o,vb0+sl_cur,PAF(0),PAF(1),PAF(2),PAF(3)); }
  #undef PKW
  #undef PAF
  #undef VFR
  #undef PIN
  #undef MX3
  #undef GAPA
  #undef GAPB
  #undef EX
  #undef VRD
  #undef KRD
  #undef STEP
  #undef ENDW
  if(MODE==1&&hi==0)l_reg+=__builtin_amdgcn_exp2f(sinkl2-mhat);
  {auto rr=__builtin_amdgcn_permlane32_swap(__float_as_uint(l_reg),__float_as_uint(l_reg),false,false);l_reg=__uint_as_float(rr[0])+__uint_as_float(rr[1]);}
  if(hi==0)wsf[32+r32]=l_reg;asm volatile("s_waitcnt lgkmcnt(0)":::"memory");
  float rli[16];
  #pragma unroll
  for(int r=0;r<16;++r)rli[r]=__builtin_amdgcn_rcpf(wsf[32+crow(r,hi)]);
  bf16*Ow=Op+(long)(q0+wid*QBLK)*PO;
  { bf16*stg=(bf16*)(shm+LDS_OST)+wid*2048;
    #pragma unroll
    for(int r=0;r<16;++r){const int orow=crow(r,hi);
      #pragma unroll
      for(int d0=0;d0<2;++d0)stg[orow*64+d0*32+r32]=__float2bfloat16(o[d0][r]*rli[r]);}
    asm volatile("s_waitcnt lgkmcnt(0)":::"memory");
    #pragma unroll
    for(int i=0;i<4;++i){const int row=i*8+(lane>>3),ch=lane&7; const u32x4 v=*(const u32x4*)(stg+row*64+ch*8); ATTN_STORE16(Ow+(long)row*PO+ch*8,v);} }
  asm volatile("s_waitcnt lgkmcnt(0)\n\ts_barrier":::"memory");
  #undef DMA_K
  #undef TILE_SRC
  #undef DMA_V
  #undef CMASK
  #undef START
  #undef RESC
  #undef ROT
}
#undef SBAR
#undef WAIT_BAR
}

constexpr int SD_CUM = 0, SD_DTV = 1024, SD_XC = 2048, SD_XCS = 144, SD_BC = SD_XC + 128 * SD_XCS, SD_BCS = 272, SD_CC = SD_BC + 128 * SD_BCS, SD_HS = SD_CC + 128 * SD_BCS,
              SD_SSQ = SD_HS + 2 * 64 * SD_BCS, SD_XW = SD_CC;
static_assert(SD_SSQ + 1024 <= RING_BYTES && SD_XW + 2 * 128 * SD_XCS <= RING_BYTES, "SSD LDS map");
DI int chunk_row(int b, int cidx) { return cidx < 2 ? NLAT + b * CTXL + 128 * cidx : b * SEQ + 128 * (cidx - 2); }
DI void ssd_cum(const Frame& F, int l, int b, int cidx, int hd, int wv0) {
    if (F.wave >= wv0 && F.wave < wv0 + 2) {
        const int dir = F.wave - wv0; const float* DT = WSP(float, WS_DT) + (size_t)chunk_row(b, cidx) * 16 + dir * 8 + hd;
        const float a = -__expf(F.in[I_ALOG][l * 16 + dir * 8 + hd]);
        const float d0 = DT[(size_t)(2 * F.lane) * 16], d1 = DT[(size_t)(2 * F.lane + 1) * 16];
        const float a0 = d0 * a, a1 = d1 * a, s = a0 + a1; float v = s;
        LAS float* cum = (LAS float*)(F.lds + SD_CUM) + dir * 128; LAS float* dtv = (LAS float*)(F.lds + SD_DTV) + dir * 128;
        if (dir == 0) {
#pragma unroll
            for (int o = 1; o < 64; o <<= 1) { const float t = __shfl_up(v, o); if (F.lane >= o) v += t; }
            cum[2 * F.lane] = v - s + a0; cum[2 * F.lane + 1] = v;
        } else {
#pragma unroll
            for (int o = 1; o < 64; o <<= 1) { const float t = __shfl_down(v, o); if (F.lane + o < 64) v += t; }
            cum[2 * F.lane + 1] = v - s + a1; cum[2 * F.lane] = v;
        }
        dtv[2 * F.lane] = d0; dtv[2 * F.lane + 1] = d1;
    }
}
DI void conv_items(const Frame& F, int l, int hd, int nitems, int rowbase, int seqlo, int seqhi) {
    const bf16_t* PRJ = WSP(bf16_t, WS_PRJ); const float* cw = F.in[I_CONVW] + (size_t)l * 5 * 1024; const float* cb = F.in[I_CONVB] + l * 1024;
    for (int item = F.tid; item < nitems; item += NTHR) {
        int chunk, seg, c0, dstride, dcol; LAS unsigned char* dst;
        if (item < 128) { chunk = item & 7; seg = item >> 3; c0 = 64 * hd + chunk * 8; dst = F.lds + SD_XC; dstride = SD_XCS; dcol = chunk * 16; }
        else if (item < 384) { const int q = item - 128; chunk = q & 15; seg = q >> 4; c0 = 512 + 128 * (hd >> 2) + chunk * 8; dst = F.lds + SD_BC; dstride = SD_BCS; dcol = chunk * 16; }
        else { const int q = item - 384; chunk = q & 15; seg = q >> 4; c0 = 768 + 128 * (hd >> 2) + chunk * 8; dst = F.lds + SD_CC; dstride = SD_BCS; dcol = chunk * 16; }
        const int t0 = seg * 8;
        float w[5][8], bb[8];
#pragma unroll
        for (int k = 0; k < 5; ++k) { const f32x4 wa = *(const f32x4*)(cw + k * 1024 + c0), wb = *(const f32x4*)(cw + k * 1024 + c0 + 4);
            w[k][0] = wa[0]; w[k][1] = wa[1]; w[k][2] = wa[2]; w[k][3] = wa[3]; w[k][4] = wb[0]; w[k][5] = wb[1]; w[k][6] = wb[2]; w[k][7] = wb[3]; }
        { const f32x4 ba = *(const f32x4*)(cb + c0), b2 = *(const f32x4*)(cb + c0 + 4); bb[0] = ba[0]; bb[1] = ba[1]; bb[2] = ba[2]; bb[3] = ba[3]; bb[4] = b2[0]; bb[5] = b2[1]; bb[6] = b2[2]; bb[7] = b2[3]; }
        u32x4 rows[12];
#pragma unroll
        for (int i = 0; i < 12; ++i) { const int row = rowbase + t0 - 2 + i;
            rows[i] = (row >= seqlo && row < seqhi) ? *(const u32x4*)(PRJ + (size_t)row * PRJW + C_XBC + c0) : (u32x4){0u, 0u, 0u, 0u}; }
#pragma unroll
        for (int j = 0; j < 8; ++j) {
            float y[8];
#pragma unroll
            for (int e = 0; e < 8; ++e) y[e] = bb[e];
#pragma unroll
            for (int k = 0; k < 5; ++k) { const u32x4 rr = rows[j + k];
                y[0] += w[k][0] * bflo(rr.x); y[1] += w[k][1] * bfhi(rr.x); y[2] += w[k][2] * bflo(rr.y); y[3] += w[k][3] * bfhi(rr.y);
                y[4] += w[k][4] * bflo(rr.z); y[5] += w[k][5] * bfhi(rr.z); y[6] += w[k][6] * bflo(rr.w); y[7] += w[k][7] * bfhi(rr.w); }
            u32x4 o; o.x = pk2(silu(y[0]), silu(y[1])); o.y = pk2(silu(y[2]), silu(y[3])); o.z = pk2(silu(y[4]), silu(y[5])); o.w = pk2(silu(y[6]), silu(y[7]));
            *(LAS u32x4*)(dst + (t0 + j) * dstride + dcol) = o;
        }
    }
}
DI void ssd_s1_unit(const Frame& Fin, int l, int b, int cidx, int hd) {
    const Frame F = launder(Fin);
    const int lane = F.lane, wid = F.wave, r = lane & 31, h = lane >> 5;
    const int rowbase = chunk_row(b, cidx), seqlo = cidx < 2 ? NLAT + b * CTXL : b * SEQ, seqhi = cidx < 2 ? seqlo + CTXL : seqlo + SEQ;
    __syncthreads();
    ssd_cum(F, l, b, cidx, hd, 6);
    conv_items(F, l, hd, 384, rowbase, seqlo, seqhi);
    __syncthreads();
    const LAS float* cum = (const LAS float*)(F.lds + SD_CUM); const LAS float* dtv = (const LAS float*)(F.lds + SD_DTV);
    for (int i = F.tid; i < 2 * 128 * 8; i += NTHR) {
        const int dir = i >> 10, t = (i >> 3) & 127, c8 = i & 7;
        const float ce = dir == 0 ? cum[127] : cum[128]; const float wgt = dtv[dir * 128 + t] * __expf(ce - cum[dir * 128 + t]);
        const u32x4 x = *(const LAS u32x4*)(F.lds + SD_XC + t * SD_XCS + c8 * 16);
        u32x4 o; o.x = pk2(bflo(x.x) * wgt, bfhi(x.x) * wgt); o.y = pk2(bflo(x.y) * wgt, bfhi(x.y) * wgt); o.z = pk2(bflo(x.z) * wgt, bfhi(x.z) * wgt); o.w = pk2(bflo(x.w) * wgt, bfhi(x.w) * wgt);
        *(LAS u32x4*)(F.lds + SD_XW + (dir * 128 + t) * SD_XCS + c8 * 16) = o;
    }
    __syncthreads();
    const int dir = wid >> 2, nb = wid & 3, q4 = (lane & 15) >> 2, p4 = lane & 3, blk = (lane >> 4) & 1;
    f32x16 s0, s1;
#pragma unroll
    for (int i = 0; i < 16; ++i) { s0[i] = 0.f; s1[i] = 0.f; }
    const LAS unsigned char* xa = F.lds + SD_XW + (dir * 128 + 8 * h + q4) * SD_XCS + (16 * blk + 4 * p4) * 2;
    const LAS unsigned char* ba = F.lds + SD_BC + (8 * h + q4) * SD_BCS + (32 * nb + 16 * blk + 4 * p4) * 2;
#pragma unroll
    for (int ks = 0; ks < 8; ++ks) {
        const bf16x8 bfr = cat8(tr_read(ba + (16 * ks) * SD_BCS), tr_read(ba + (16 * ks + 4) * SD_BCS));
        const bf16x8 x0 = cat8(tr_read(xa + (16 * ks) * SD_XCS), tr_read(xa + (16 * ks + 4) * SD_XCS));
        const bf16x8 x1 = cat8(tr_read(xa + (16 * ks) * SD_XCS + 64), tr_read(xa + (16 * ks + 4) * SD_XCS + 64));
        s0 = MFMA32(bfr, x0, s0); s1 = MFMA32(bfr, x1, s1);
    }
    bf16_t* ST = WSP(bf16_t, WS_ST) + ((((size_t)b * NCH + cidx) * 8 + hd) * 2 + dir) * 8192 + 32 * nb + 4 * h;
#pragma unroll
    for (int g4 = 0; g4 < 4; ++g4) { st4bf(ST + (size_t)r * 128 + 8 * g4, (f32x4){s0[4 * g4], s0[4 * g4 + 1], s0[4 * g4 + 2], s0[4 * g4 + 3]});
        st4bf(ST + (size_t)(32 + r) * 128 + 8 * g4, (f32x4){s1[4 * g4], s1[4 * g4 + 1], s1[4 * g4 + 2], s1[4 * g4 + 3]}); }
    if (F.tid < 2) WSP(float, WS_CDEC)[(((size_t)b * NCH + cidx) * 8 + hd) * 2 + F.tid] = __expf(F.tid == 0 ? cum[127] : cum[128]);
}
DI void phase_scan(const Frame& F) {
    bf16_t* ST = WSP(bf16_t, WS_ST); const float* CD = WSP(float, WS_CDEC);
    for (int gid = F.vcu * NTHR + F.tid; gid < 64 * 1024; gid += F.G * NTHR) {
        const int chain = gid >> 10, e8 = gid & 1023, b = chain >> 4, hd = (chain >> 1) & 7, dir = chain & 1;
        float hs[8];
#pragma unroll
        for (int e = 0; e < 8; ++e) hs[e] = 0.f;
        for (int k0 = 0; k0 < NCH; k0 += 11) {
            u32x4 st[11]; float dec[11];
#pragma unroll
            for (int j = 0; j < 11; ++j) { const int k = k0 + j, cidx = dir == 0 ? k : (k < 2 ? 1 - k : 67 - k); const size_t idx = (((size_t)b * NCH + cidx) * 8 + hd) * 2 + dir;
                st[j] = *((const u32x4*)(ST + idx * 8192) + e8); dec[j] = CD[idx]; }
#pragma unroll
            for (int j = 0; j < 11; ++j) { const int k = k0 + j, cidx = dir == 0 ? k : (k < 2 ? 1 - k : 67 - k); const size_t idx = (((size_t)b * NCH + cidx) * 8 + hd) * 2 + dir;
                u32x4 o; o.x = pk2(hs[0], hs[1]); o.y = pk2(hs[2], hs[3]); o.z = pk2(hs[4], hs[5]); o.w = pk2(hs[6], hs[7]); *((u32x4*)(ST + idx * 8192) + e8) = o;
                const u32x4 u = st[j]; const float d = dec[j];
                hs[0] = hs[0] * d + bflo(u.x); hs[1] = hs[1] * d + bfhi(u.x); hs[2] = hs[2] * d + bflo(u.y); hs[3] = hs[3] * d + bfhi(u.y);
                hs[4] = hs[4] * d + bflo(u.z); hs[5] = hs[5] * d + bfhi(u.z); hs[6] = hs[6] * d + bflo(u.w); hs[7] = hs[7] * d + bfhi(u.w); }
        }
    }
}
DI void ssd_s3_unit(const Frame& Fin, int l, int b, int cidx, int hd) {
    const Frame F = launder(Fin);
    const int lane = F.lane, wid = F.wave, r = lane & 31, h = lane >> 5;
    const int rowbase = chunk_row(b, cidx), seqlo = cidx < 2 ? NLAT + b * CTXL : b * SEQ, seqhi = cidx < 2 ? seqlo + CTXL : seqlo + SEQ;
    __syncthreads();
    ssd_cum(F, l, b, cidx, hd, 6);
    conv_items(F, l, hd, 640, rowbase, seqlo, seqhi);
    {
        const bf16_t* ST = WSP(bf16_t, WS_ST) + (((size_t)b * NCH + cidx) * 8 + hd) * 2 * 8192;
        for (int i = F.tid; i < 2 * 64 * 16; i += NTHR) { const int dp = i >> 4, c8 = i & 15; *(LAS u32x4*)(F.lds + SD_HS + dp * SD_BCS + c8 * 16) = *(const u32x4*)(ST + (size_t)dp * 128 + c8 * 8); }
    }
    __syncthreads();
    const LAS float* cum = (const LAS float*)(F.lds + SD_CUM); const LAS float* dtv = (const LAS float*)(F.lds + SD_DTV);
    const int lb = wid & 3, ph = wid >> 2, q4 = (lane & 15) >> 2, p4 = lane & 3, blk = (lane >> 4) & 1;
    const int lidx = 32 * lb + r;
    bf16x8 cf[8];
#pragma unroll
    for (int ks = 0; ks < 8; ++ks) cf[ks] = *(const LAS bf16x8*)(F.lds + SD_CC + lidx * SD_BCS + (16 * ks + 8 * h) * 2);
    f32x16 gt[4];
#pragma unroll
    for (int sb = 0; sb < 4; ++sb) {
#pragma unroll
        for (int i = 0; i < 16; ++i) gt[sb][i] = 0.f;
#pragma unroll
        for (int ks = 0; ks < 8; ++ks) { const bf16x8 bfr = *(const LAS bf16x8*)(F.lds + SD_BC + (32 * sb + r) * SD_BCS + (16 * ks + 8 * h) * 2); gt[sb] = MFMA32(bfr, cf[ks], gt[sb]); }
    }
    f32x16 ytot;
#pragma unroll
    for (int i = 0; i < 16; ++i) ytot[i] = 0.f;
    const LAS unsigned char* xa = F.lds + SD_XC + (4 * h + q4) * SD_XCS + (32 * ph + 16 * blk + 4 * p4) * 2;
#pragma unroll
    for (int dir = 0; dir < 2; ++dir) {
        const float cl = cum[dir * 128 + lidx];
        f32x16 acc;
#pragma unroll
        for (int i = 0; i < 16; ++i) acc[i] = 0.f;
#pragma unroll
        for (int sb = 0; sb < 4; ++sb) {
            const bool relv = dir == 0 ? (sb <= lb) : (sb >= lb);
            if (relv) {
                f32x16 mt; int rl = r; asm volatile("" : "+v"(rl));
#pragma unroll
                for (int i = 0; i < 16; ++i) { const int sl = crow(i, h), s = 32 * sb + sl;
                    const bool ok = (sb != lb) || (dir == 0 ? (sl <= rl) : (sl >= rl));
                    const float e = __expf(cl - cum[dir * 128 + s]) * dtv[dir * 128 + s];
                    mt[i] = ok ? gt[sb][i] * e : 0.f; }
                const bf16x8 pa0 = pack8<0>(mt), pa1 = pack8<1>(mt);
                const bf16x8 x0 = cat8(tr_read(xa + (32 * sb) * SD_XCS), tr_read(xa + (32 * sb + 8) * SD_XCS));
                const bf16x8 x1 = cat8(tr_read(xa + (32 * sb + 16) * SD_XCS), tr_read(xa + (32 * sb + 24) * SD_XCS));
                acc = MFMA32(x0, pa0, acc); acc = MFMA32(x1, pa1, acc);
            }
        }
        f32x16 yo;
#pragma unroll
        for (int i = 0; i < 16; ++i) yo[i] = 0.f;
#pragma unroll
        for (int ks = 0; ks < 8; ++ks) { const bf16x8 hf = *(const LAS bf16x8*)(F.lds + SD_HS + (dir * 64 + 32 * ph + r) * SD_BCS + (16 * ks + 8 * h) * 2); yo = MFMA32(hf, cf[ks], yo); }
        const float el = __expf(cl);
#pragma unroll
        for (int i = 0; i < 16; ++i) ytot[i] += acc[i] + el * yo[i];
    }
    const float dsk = F.in[I_DSKIP][l * 8 + hd];
    const int row = rowbase + lidx;
    const bf16_t* zp = WSP(bf16_t, WS_PRJ) + (size_t)row * PRJW + C_Z + 64 * hd + 32 * ph + 4 * h;
    bf16_t* op = WSP(bf16_t, WS_OC) + (size_t)row * OCW + 1536 + 64 * hd + 32 * ph + 4 * h;
    float ss = 0.f;
#pragma unroll
    for (int g4 = 0; g4 < 4; ++g4) {
        const u32x2 zz = *(const u32x2*)(zp + 8 * g4);
        const u32x2 xx = *(const LAS u32x2*)(F.lds + SD_XC + lidx * SD_XCS + (32 * ph + 8 * g4 + 4 * h) * 2);
        const float v0 = (ytot[4 * g4] + dsk * bflo(xx.x)) * silu(bflo(zz.x)), v1 = (ytot[4 * g4 + 1] + dsk * bfhi(xx.x)) * silu(bfhi(zz.x));
        const float v2 = (ytot[4 * g4 + 2] + dsk * bflo(xx.y)) * silu(bflo(zz.y)), v3 = (ytot[4 * g4 + 3] + dsk * bfhi(xx.y)) * silu(bfhi(zz.y));
        ss += (v0 * v0 + v1 * v1) + (v2 * v2 + v3 * v3);
        u32x2 w; w.x = pk2(v0, v1); w.y = pk2(v2, v3); *(u32x2*)(op + 8 * g4) = w;
    }
    ss += __shfl_xor(ss, 32);
    LAS float* sq = (LAS float*)(F.lds + SD_SSQ);
    if (h == 0) sq[ph * 128 + lidx] = ss;
    __syncthreads();
    if (F.tid < 128) WSP(float, WS_SSQ)[(size_t)(rowbase + F.tid) * 8 + hd] = sq[F.tid] + sq[128 + F.tid];
}

constexpr int PH_PER_LAYER = 11, N_PHASES = 2 + PH_PER_LAYER * DEPTH;
__global__ void __launch_bounds__(NTHR, 2) fwd_kernel(Args args) {
    extern __shared__ __attribute__((aligned(16))) unsigned char smem[];
    Frame F0;
    F0.lds = (LAS unsigned char*)smem;
    F0.tid = threadIdx.x; F0.lane = F0.tid & 63; F0.wave = __builtin_amdgcn_readfirstlane(F0.tid >> 6);
    F0.G = gridDim.x; F0.bx = blockIdx.x; { const int bx = blockIdx.x; F0.vcu = (F0.G % 8 == 0) ? (bx % 8) * (F0.G / 8) + bx / 8 : bx; }
    F0.in = args.in; F0.out = args.out; F0.ws = args.ws; F0.ctl = (gu32*)(args.ws + WS_CTL);
    volatile LAS unsigned* MISC = (volatile LAS unsigned*)(F0.lds + MISC_OFF);
    for (int u = F0.tid; u < (LDS_BYTES - RING_BYTES) / 4; u += NTHR) ((LAS unsigned*)(F0.lds + RING_BYTES))[u] = 0u;
    __syncthreads();
    XcdBarrier bar; bar.bar = (unsigned*)(F0.ctl + CW_BAR); bar.x = 0; bar.st = nullptr;
    if (!MK_PER_PHASE) bar = xcd_barrier_post((unsigned*)(F0.ctl + CW_BAR), MISC + 8);
    const int lo = args.ph_lo, hi = args.ph_hi;
#define IN(k) (lo <= (k) && (k) < hi)
#define SEAM(k) do { if (IN(k) && IN((k) + 1)) { if (MK_PER_PHASE) { if (F0.tid == 0) __hip_atomic_store(F0.ctl + 0, 0xBADBA0u, __ATOMIC_RELAXED, __HIP_MEMORY_SCOPE_AGENT); } else xcd_barrier(bar); } } while (0)

    if (PHM(11) && IN(0)) { const Frame F = launder(F0); _Pragma("nounroll") for (int rep = 0; rep < 1 + REPB(11); ++rep) { phase_prologue_a(F); __syncthreads(); } } SEAM(0);
    if (PHM(12) && IN(1)) { const Frame F = launder(F0); _Pragma("nounroll") for (int rep = 0; rep < 1 + REPB(12); ++rep) { phase_prologue_b(F); __syncthreads(); } } SEAM(1);

    for (int l = 0; l < DEPTH; ++l) {
        const int pb = 2 + PH_PER_LAYER * l;
        const bool with_ctx = l < DEPTH - 1, moe = l & 1; const int fi = l >> 1;
        const int mrows = with_ctx ? MTOT : NLAT, mtiles = with_ctx ? 132 : 128;
        if (PHM(0) && IN(pb + 0)) { const Frame F = launder(F0);
            pg8::SchedGrid S; S.nMa = mtiles; S.nNa = 34; S.nMb = with_ctx ? 0 : 4; S.nNb = 18; S.total = S.nMa * S.nNa + S.nMb * S.nNb; S.G = F.G; S.c = F.bx;
            S.A = (const char*)(F.ws + WS_HB); S.B = (const char*)(F.ws + WS_WCOMB + l * SZ_WCOMB); S.lda = DM; S.ldb = DM; S.a_div = 1; S.a_cols = 0; S.pe = nullptr; S.estride = 0; S.rep = REPB(0);
            pg8::EpiInGate E{WSP(bf16_t, WS_PRJ), WSP(bf16_t, WS_GT), F.in[I_BGATE] + (size_t)l * 4096};
            pg8::gemm_phase(F.lds, F.tid, DM, DM, DM, S, E);
        }
        SEAM(pb + 0);
        if (REPB(10)) { _Pragma("nounroll") for (int q = 0; q < 10; ++q) xcd_barrier(bar); }
        if (PHM(1) && IN(pb + 1)) { const Frame F = launder(F0);
            phase_qkprep_rows(F, l);
            for (int uu = F.vcu; uu < ((NB * NCH * 8) << REPB(15)); uu += F.G) { const int u = uu < NB * NCH * 8 ? uu : uu - NB * NCH * 8; const int hd = u & 7, cidx = (u >> 3) % NCH, b = (u >> 3) / NCH; ssd_s1_unit(F, l, b, cidx, hd); }
        }
        SEAM(pb + 1);
        if (PHM(2) && IN(pb + 2)) { const Frame F = launder(F0); phase_scan(F); }
        SEAM(pb + 2);
        if (PHM(3) && IN(pb + 3)) { const Frame F = launder(F0);
            const int nchs = with_ctx ? NCH : NCH - 2, n_s3 = NB * nchs * 8;
            _Pragma("nounroll") for (int rep = 0; rep < 1 + REPB(3); ++rep) {
            {
                for (int uu = F.vcu; uu < (1024 << REPB(13)); uu += F.G) { const int u = uu & 1023;
                    const int v = u & 1023, qblk = v & 31, b = v >> 8, hg = (v >> 5) & 3, kvh = (v >> 7) & 1, hq = kvh * 4 + hg;
                    const ga_body::bf16* P = (const ga_body::bf16*)(F.ws + WS_PRJ); const size_t lat0 = (size_t)(b * SEQ) * PRJW, ctx0 = (size_t)(NLAT + b * CTXL) * PRJW;
                    ga_body::bf16* O = (ga_body::bf16*)(F.ws + WS_OC) + (size_t)(b * SEQ) * OCW;
                    ga_body::attn_unit<8, 0>(qblk, P + lat0 + C_GAQ + hq * 64, P + lat0 + C_GAK + kvh * 64, P + lat0 + C_GAV + kvh * 64, P + ctx0 + C_GAK + kvh * 64, P + ctx0 + C_GAV + kvh * 64,
                                             O + 1024 + hq * 64, (char*)F.lds, F.tid, 132, 0, 0.f, nullptr);
                }
            }
            {
                const Frame F = launder(F0);
                for (int uu = F.vcu; uu < (1024 << REPB(14)); uu += F.G) { const int u = uu & 1023;
                    const int v = u & 1023, qblk = v & 31, b = v >> 8, hq = (v >> 5) & 7;
                    const ga_body::bf16* P = (const ga_body::bf16*)(F.ws + WS_PRJ); const size_t lat0 = (size_t)(b * SEQ) * PRJW, ctx0 = (size_t)(NLAT + b * CTXL) * PRJW;
                    ga_body::bf16* O = (ga_body::bf16*)(F.ws + WS_OC) + (size_t)(b * SEQ) * OCW;
                    int tlo = clampi(4 * qblk - 4, 0, 120), thi = clampi(4 * qblk - 1, 0, 120) + 8; if ((thi - tlo) & 1) { if (thi < 128) ++thi; else --tlo; }
                    const size_t lo = lat0 + (size_t)tlo * 64 * PRJW;
                    ga_body::attn_unit<8, 2>(qblk, P + lat0 + C_NAQ + hq * 64, P + lo + C_NAK + hq * 64, P + lo + C_NAV + hq * 64, P + ctx0 + C_NAK + hq * 64, P + ctx0 + C_NAV + hq * 64,
                                             O + hq * 64, (char*)F.lds, F.tid, 4 + thi - tlo, tlo, 0.f, F.in[I_RPB] + ((size_t)l * 8 + hq) * 465);
                }
            }
            {
                const Frame F = launder(F0);
                for (int uu = F.vcu; uu < (1024 << REPB(14)); uu += F.G) { const int u = uu & 1023;
                    const int v = u & 1023, qblk = v & 31, b = v >> 8, hg = (v >> 5) & 3, kvh = (v >> 7) & 1, hq = kvh * 4 + hg;
                    const ga_body::bf16* P = (const ga_body::bf16*)(F.ws + WS_PRJ); const size_t lat0 = (size_t)(b * SEQ) * PRJW, ctx0 = (size_t)(NLAT + b * CTXL) * PRJW;
                    ga_body::bf16* O = (ga_body::bf16*)(F.ws + WS_OC) + (size_t)(b * SEQ) * OCW;
                    const int tlo = 4 * qblk - 2 < 0 ? 0 : 4 * qblk - 2, thi = 4 * qblk + 6 > 128 ? 128 : 4 * qblk + 6; const size_t lo = lat0 + (size_t)tlo * 64 * PRJW;
                    ga_body::attn_unit<8, 1>(qblk, P + lat0 + C_SWQ + hq * 64, P + lo + C_SWK + kvh * 64, P + lo + C_SWV + kvh * 64, P + ctx0 + C_SWK + kvh * 64, P + ctx0 + C_SWV + kvh * 64,
                                             O + 512 + hq * 64, (char*)F.lds, F.tid, 4 + thi - tlo, tlo, F.in[I_SINK][l * 8 + hq] * LOG2E, nullptr);
                }
            }
            if (with_ctx) {
                const Frame F = launder(F0);
                for (int uu = F.vcu; uu < (96 << REPB(14)); uu += F.G) { const int u = uu < 96 ? uu : uu - 96;
                    const int mode = u >> 5, b = (u >> 3) & 3, hq = u & 7, kvh = mode == 0 ? hq : (hq >> 2);
                    const int qc = mode == 0 ? C_NAQ : (mode == 1 ? C_SWQ : C_GAQ), kc = mode == 0 ? C_NAK : (mode == 1 ? C_SWK : C_GAK), vc = mode == 0 ? C_NAV : (mode == 1 ? C_SWV : C_GAV), oc = mode == 0 ? 0 : (mode == 1 ? 512 : 1024);
                    const ga_body::bf16* P = (const ga_body::bf16*)(F.ws + WS_PRJ); const size_t ctx0 = (size_t)(NLAT + b * CTXL) * PRJW;
                    ga_body::bf16* O = (ga_body::bf16*)(F.ws + WS_OC) + (size_t)(NLAT + b * CTXL) * OCW + oc + hq * 64;
                    const ga_body::bf16* K = P + ctx0 + kc + kvh * 64; const ga_body::bf16* V = P + ctx0 + vc + kvh * 64;
                    if (mode == 1) ga_body::attn_unit<8, 1>(0, P + ctx0 + qc + hq * 64, K, V, K, V, O, (char*)F.lds, F.tid, 4, 0, F.in[I_SINK][l * 8 + hq] * LOG2E, nullptr);
                    else ga_body::attn_unit<8, 0>(0, P + ctx0 + qc + hq * 64, K, V, K, V, O, (char*)F.lds, F.tid, 4, 0, 0.f, nullptr);
                }
            }
            const Frame Fb = launder(F0);
            for (int uu = Fb.vcu; uu < (n_s3 << REPB(14)); uu += Fb.G) { const Frame& F = Fb; const int u = uu < n_s3 ? uu : uu - n_s3;
                const int hd = u & 7, cc = (u >> 3) % nchs, b = (u >> 3) / nchs; ssd_s3_unit(F, l, b, with_ctx ? cc : cc + 2, hd);
            }
            }
        }
        SEAM(pb + 3);
        if (PHM(4) && IN(pb + 4)) { const Frame F = launder(F0);
            pg8::SchedBranch S; S.rep = REPB(4); S.T = mtiles * 8; S.G = F.G; S.c = F.vcu; S.A = (const char*)(F.ws + WS_OC); S.B = (const char*)(F.ws + WS_WB + l * SZ_WB);
            pg8::EpiBranch E{WSP(bf16_t, WS_GT), WSP(float, WS_SSQ), WSP(bf16_t, WS_PRJ)};
            pg8::gemm_phase<pg8::EpiBranch, pg8::SchedBranch, true>(F.lds, F.tid, 512, OCW, 512, S, E);
        }
        SEAM(pb + 4);
        if (PHM(5) && IN(pb + 5)) { const Frame F = launder(F0);
            pg8::SchedGrid S; S.nMa = mtiles; S.nNa = 4; S.nMb = 0; S.nNb = 1; S.total = S.nMa * S.nNa; S.G = F.G; S.c = F.bx;
            S.A = (const char*)(F.ws + WS_PRJ); S.B = (const char*)(F.ws + WS_WO + l * SZ_WO); S.lda = DM; S.ldb = DM; S.a_div = 1; S.a_cols = 0; S.pe = nullptr; S.estride = 0; S.rep = REPB(5);
            pg8::EpiResid E{WSP(bf16_t, WS_XS), WSP(float, WS_MVEC) + (size_t)l * 5 * 6144 + 2048, nullptr, WSP(bf16_t, WS_END)};
            pg8::gemm_phase(F.lds, F.tid, DM, DM, DM, S, E);
        }
        SEAM(pb + 5);
        if (PHM(6) && IN(pb + 6)) { const Frame F = launder(F0); phase_ln1(F, l, mrows); }
        SEAM(pb + 6);
        if (moe) { if (PHM(7) && IN(pb + 7)) { const Frame F = launder(F0); phase_gather(F, l, mrows); } SEAM(pb + 7); }
        if (PHM(8) && IN(pb + 8)) {
            if (!moe) { const Frame F = launder(F0);
                pg8::SchedGrid S; S.rep = REPB(8); S.nMb = 0; S.nNb = 1; S.G = F.G; S.c = F.bx; S.lda = DM; S.ldb = DM; S.a_div = 1; S.a_cols = 0; S.pe = nullptr; S.estride = 0;
                S.nMa = mtiles; S.nNa = DFF / 128; S.A = (const char*)(F.ws + WS_HB); S.B = (const char*)(F.ws + WS_WUP + fi * SZ_WUP); S.total = S.nMa * S.nNa;
                pg8::EpiSwiGLU<false> E{WSP(bf16_t, WS_HID), DFF};
                pg8::gemm_phase(F.lds, F.tid, DM, DM, DM, S, E);
            } else { const Frame F = launder(F0);
                pg8::SchedGrid S; S.rep = REPB(8); S.nMb = 0; S.nNb = 1; S.G = F.G; S.c = F.bx; S.lda = DM / 2; S.ldb = DM / 2; S.a_div = 1; S.a_cols = 0;
                const int npad = moe_pad_ends_lds(F, fi); S.pe = (const LAS int*)(F.lds + MISC_OFF + 64); S.nMa = npad / 256; S.nNa = DFFE / 128;
                S.A = (const char*)(F.ws + WS_XPAD); S.B = (const char*)(F.ws + WS_MUP + fi * SZ_MUP); S.estride = (size_t)2 * DFFE * DM; S.total = S.nMa * S.nNa;
                pg8::EpiSwiGLU<true> E{WSP(bf16_t, WS_HID), DFFE};
                pg8::gemm_phase<pg8::EpiSwiGLU<true>, pg8::SchedGrid, false, true>(F.lds, F.tid, DM / 2, DM / 2, DM / 2, S, E, MOE_UP_SCA);
            }
        }
        SEAM(pb + 8);
        if (PHM(9) && IN(pb + 9)) {
            if (!moe) { const Frame F = launder(F0);
                pg8::SchedGrid S; S.rep = REPB(9); S.nMb = 0; S.nNb = 1; S.nNa = 4; S.G = F.G; S.c = F.bx; S.a_div = 1; S.a_cols = 0; S.pe = nullptr; S.estride = 0; S.A = (const char*)(F.ws + WS_HID);
                pg8::EpiResid E{WSP(bf16_t, WS_XS), WSP(float, WS_MVEC) + (size_t)l * 5 * 6144 + 5120, nullptr, WSP(bf16_t, WS_END)};
                S.nMa = mtiles; S.B = (const char*)(F.ws + WS_WDN + fi * SZ_WDN); S.lda = DFF; S.ldb = DFF; S.total = S.nMa * S.nNa;
                pg8::gemm_phase(F.lds, F.tid, DFF, DFF, DFF, S, E);
            } else { const Frame F = launder(F0);
                pg8::SchedGrid S; S.rep = REPB(9); S.nMb = 0; S.nNb = 1; S.nNa = 4; S.G = F.G; S.c = F.bx; S.a_div = 1; S.a_cols = 0; S.A = (const char*)(F.ws + WS_HID);
                pg8::EpiResid E{WSP(bf16_t, WS_XS), WSP(float, WS_MVEC) + (size_t)l * 5 * 6144 + 5120, WSP(bf16_t, WS_YPAD), WSP(bf16_t, WS_END)};
                const int npad = moe_pad_ends_lds(F, fi); S.pe = (const LAS int*)(F.lds + MISC_OFF + 64); S.nMa = npad / 256; S.B = (const char*)(F.ws + WS_MDN + fi * SZ_MDN); S.estride = (size_t)DM * DFFE;
                S.lda = DFFE / 2; S.ldb = DFFE / 2; S.total = S.nMa * S.nNa;
                pg8::gemm_phase<pg8::EpiResid, pg8::SchedGrid, false, true>(F.lds, F.tid, DFFE / 2, DFFE / 2, DFFE / 2, S, E, MOE_DN_SCA);
            }
        }
        SEAM(pb + 9);
        if (PHM(10) && IN(pb + 10)) { const Frame F = launder(F0); phase_ln2(F, l, mrows); }
        if (l + 1 < DEPTH) SEAM(pb + 10);
    }
#undef IN
#undef SEAM
}

extern "C" void kernel_launch(void* const* d_in, const int* in_sizes, int n_in, void* d_out, int out_size, void* d_ws, size_t ws_size, hipStream_t stream) {
    static int grid = 0;
    if (grid == 0) {
        if (n_in != 31 || in_sizes[0] != NLAT * DM || out_size != NLAT * DM || ws_size < WS_END) {
            fprintf(stderr, "kernel_launch: unexpected shapes: n_in %d in0 %d out %d ws %zu (need %zu); nothing launched\n", n_in, n_in > 0 ? in_sizes[0] : -1, out_size, ws_size, (size_t)WS_END); grid = -1; return; }
        int dev = 0, cus = 0, per_cu = 0;
        if (hipGetDevice(&dev) != hipSuccess || hipDeviceGetAttribute(&cus, hipDeviceAttributeMultiprocessorCount, dev) != hipSuccess) { fprintf(stderr, "kernel_launch: device query failed\n"); grid = -1; return; }
        if (hipFuncSetAttribute((const void*)fwd_kernel, hipFuncAttributeMaxDynamicSharedMemorySize, LDS_BYTES) != hipSuccess) { fprintf(stderr, "kernel_launch: hipFuncSetAttribute failed\n"); grid = -1; return; }
        if (hipOccupancyMaxActiveBlocksPerMultiprocessor(&per_cu, (const void*)fwd_kernel, NTHR, LDS_BYTES) != hipSuccess || per_cu < 1)
            fprintf(stderr, "kernel_launch: note: occupancy query reports %d workgroups per CU\n", per_cu);
        (void)hipGetLastError();
        grid = cus;
    }
    if (grid < 0) return;
    if (hipMemsetAsync((char*)d_ws + WS_CTL, 0, CTL_ZERO_BYTES, stream) != hipSuccess) { fprintf(stderr, "kernel_launch: memset failed\n"); return; }
    Args a{};
    for (int i = 0; i < 31; ++i) a.in[i] = (const float*)d_in[i];
    a.out = (float*)d_out; a.ws = (unsigned char*)d_ws;
#if MK_PER_PHASE
    for (int p = 0; p < N_PHASES; ++p) { a.ph_lo = p; a.ph_hi = p + 1; hipLaunchKernelGGL(fwd_kernel, dim3(grid), dim3(NTHR), LDS_BYTES, stream, a); }
#else
    a.ph_lo = 0; a.ph_hi = N_PHASES;
    hipLaunchKernelGGL(fwd_kernel, dim3(grid), dim3(NTHR), LDS_BYTES, stream, a);
#endif
    const hipError_t le = hipPeekAtLastError();
    if (le != hipSuccess) fprintf(stderr, "kernel_launch: launch failed: %s\n", hipGetErrorName(le));
}
```
